# Optimizing an MI355X kernel written in HIP

```python
import jax
import jax.numpy as jnp
from jax import lax
import numpy as np

D_MODEL = 2048
BATCH = 8
SEQ = 4096
DEPTH = 2

CTX_LEN = 256
GRID_W = 64
N_MOD = 9
D_FF = 5632
FFN_RES_WEIGHT = 0.5
EPS = 1e-6
POS_THETA = 10000.0
CHUNK = 64

D_GLA = D_MODEL // 2
GLA_HEADS = 4
GLA_DK = D_GLA // (2 * GLA_HEADS)
GLA_DV = D_GLA // GLA_HEADS
GLA_LOWRANK = 16
GLA_TAU = 16.0
GLA_LOG_DECAY_MIN = -1.0
D_RG = D_MODEL // 2
RG_BLOCKS = 8
RG_BLOCK = D_RG // RG_BLOCKS
RG_C = 8.0
CONV_W = 4
CONV_LEFT = 2
D_ML = D_MODEL
ML_HEADS = 8
ML_DV = D_ML // ML_HEADS
ML_DK = ML_DV // 2

AB_SIZES = (GLA_HEADS * GLA_DK, GLA_HEADS * GLA_DK, D_GLA, D_GLA, 2 * GLA_LOWRANK, D_RG, D_RG)
ML_SIZES = (ML_HEADS * ML_DK, ML_HEADS * ML_DK, D_ML, D_ML, 4 * ML_HEADS)
AB_COLS = sum(AB_SIZES)
ML_COLS = sum(ML_SIZES)
N_EVEN = (DEPTH + 1) // 2
N_ODD = DEPTH // 2

kernel_name = "hybrid_gla_rglru_mlstm_macaron_dit"


def rmsnorm(x, g):
    x32 = x.astype(jnp.float32)
    y = x32 * lax.rsqrt(jnp.mean(x32 * x32, axis=-1, keepdims=True) + EPS)
    return (y * g.astype(jnp.float32)).astype(x.dtype)


def modulate(h, g, shift, scale):
    return rmsnorm(h, g) * (1.0 + scale) + shift


def add_residual(h, y, g, gate, weight):
    return h + weight * gate * rmsnorm(y, g)


def swiglu(u, w_in, w_out):
    a, b = jnp.split(u @ w_in, 2, axis=-1)
    return (jax.nn.silu(a) * b) @ w_out


def ffn_sub(h, mod, ng, w_in, w_out, slot):
    u = modulate(h, ng[2 * slot], mod[:, :, 3 * slot], mod[:, :, 3 * slot + 1])
    return add_residual(h, swiglu(u, w_in, w_out), ng[2 * slot + 1], mod[:, :, 3 * slot + 2], FFN_RES_WEIGHT)


def split_cols(t, sizes):
    idx = []
    acc = 0
    for s in sizes[:-1]:
        acc += s
        idx.append(acc)
    return jnp.split(t, idx, axis=-1)


def to_heads(t, n_heads):
    b, l, _ = t.shape
    return t.reshape(b, l, n_heads, -1).transpose(0, 2, 1, 3)


def from_heads(t):
    b, h, l, d = t.shape
    return t.transpose(0, 2, 1, 3).reshape(b, l, h * d)


def to_chunks(t):
    n = t.shape[2] // CHUNK
    return jnp.moveaxis(t.reshape(t.shape[:2] + (n, CHUNK) + t.shape[3:]), 2, 0)


def from_chunks(t):
    t = jnp.moveaxis(t, 0, 2)
    return t.reshape(t.shape[:2] + (-1,) + t.shape[4:])


def pos_embed_2d(rows, dtype):
    row = jnp.repeat(jnp.arange(rows), GRID_W)
    col = jnp.tile(jnp.arange(GRID_W), rows)
    n_freq = D_MODEL // 4
    omega = POS_THETA ** (-jnp.arange(n_freq, dtype=jnp.float32) / n_freq)

    def enc(p):
        ang = p.astype(jnp.float32)[:, None] * omega[None, :]
        return jnp.concatenate([jnp.sin(ang), jnp.cos(ang)], axis=-1)

    return jnp.concatenate([enc(row), enc(col)], axis=-1).astype(dtype)


def dwconv_centred(t, w, b):
    l = t.shape[1]
    tp = jnp.pad(t, ((0, 0), (CONV_LEFT, CONV_W - 1 - CONV_LEFT), (0, 0)))
    y = b
    for tap in range(CONV_W):
        y = y + tp[:, tap:tap + l] * w[tap]
    return y


def blockdiag(t, w):
    b, l, _ = t.shape
    return jnp.einsum('blnc,ncd->blnd', t.reshape(b, l, RG_BLOCKS, RG_BLOCK), w).reshape(b, l, -1)


def lin_combine(left, right):
    a_l, b_l = left
    a_r, b_r = right
    return a_l * a_r, a_r * b_l + b_r


def rglru_dir(xb, w_a, b_a, w_i, b_i, lam, h0):
    f32 = jnp.float32
    r = jax.nn.sigmoid(blockdiag(xb, w_a.astype(f32)) + b_a.astype(f32))
    i = jax.nn.sigmoid(blockdiag(xb, w_i.astype(f32)) + b_i.astype(f32))
    log_a = -RG_C * r * jax.nn.softplus(-lam.astype(f32))
    a = jnp.exp(log_a)
    bx = jnp.sqrt(-jnp.expm1(2.0 * log_a)) * (i * xb)
    bx = bx.at[:, 0].add(a[:, 0] * h0)
    _, h = lax.associative_scan(lin_combine, (a, bx), axis=1)
    return h


def gla_scan(q, k, v, log_a, s0, readout):
    tril = jnp.tril(jnp.ones((CHUNK, CHUNK), dtype=bool))

    def body(s, inp):
        qc, kc, vc, lc = inp
        b = jnp.cumsum(lc, axis=2)
        b_last = b[:, :, -1:, :]
        s_new = jnp.exp(b_last[:, :, 0, :, None]) * s + jnp.einsum('bhjd,bhjv->bhdv', kc * jnp.exp(b_last - b), vc)
        if not readout:
            return s_new, None
        b_ref = b[:, :, CHUNK // 2:CHUNK // 2 + 1, :]
        scores = jnp.einsum('bhid,bhjd->bhij', qc * jnp.exp(b - b_ref), kc * jnp.exp(b_ref - b))
        scores = jnp.where(tril, scores, 0.0)
        o = jnp.einsum('bhij,bhjv->bhiv', scores, vc) + jnp.einsum('bhid,bhdv->bhiv', qc * jnp.exp(b), s)
        return s_new, o

    s_fin, o = lax.scan(body, s0, (to_chunks(q), to_chunks(k), to_chunks(v), to_chunks(log_a)))
    if not readout:
        return None, s_fin
    return from_chunks(o), s_fin


def mlstm_scan(q, k, v, i_pre, log_f, state, readout):
    tril = jnp.tril(jnp.ones((CHUNK, CHUNK), dtype=bool))

    def body(carry, inp):
        cm, nm, mm = carry
        qc, kc, vc, ic, fc = inp
        b = jnp.cumsum(fc, axis=-1)
        b_last = b[..., -1]
        g = b_last[..., None] - b + ic
        m_new = jnp.maximum(b_last + mm, jnp.max(g, axis=-1))
        wk = jnp.exp(g - m_new[..., None])
        decay = jnp.exp(b_last + mm - m_new)
        c_new = decay[..., None, None] * cm + jnp.einsum('bhj,bhjd,bhjv->bhdv', wk, kc, vc)
        n_new = decay[..., None] * nm + jnp.einsum('bhj,bhjd->bhd', wk, kc)
        if not readout:
            return (c_new, n_new, m_new), None
        d_log = jnp.where(tril, b[..., :, None] - b[..., None, :] + ic[..., None, :], -jnp.inf)
        inter = b + mm[..., None]
        m_row = jnp.maximum(inter, jnp.max(d_log, axis=-1))
        w_intra = jnp.exp(d_log - m_row[..., None])
        w_inter = jnp.exp(inter - m_row)
        s = jnp.einsum('bhid,bhjd->bhij', qc, kc) * w_intra
        num = jnp.einsum('bhij,bhjv->bhiv', s, vc) + w_inter[..., None] * jnp.einsum('bhid,bhdv->bhiv', qc, cm)
        den = jnp.sum(s, axis=-1) + w_inter * jnp.einsum('bhid,bhd->bhi', qc, nm)
        h = num / jnp.maximum(jnp.abs(den), jnp.exp(-m_row))[..., None]
        return (c_new, n_new, m_new), h

    st_fin, h = lax.scan(body, state, (to_chunks(q), to_chunks(k), to_chunks(v), to_chunks(i_pre), to_chunks(log_f)))
    if not readout:
        return None, st_fin
    return from_chunks(h), st_fin


def mixer_ab(u, state, w_in, w_alpha2, b_alpha, gla_g, conv_w, conv_b, w_a, b_a, w_i, b_i, lam, w_out, readout):
    f32 = jnp.float32
    s_f0, s_b0, r_f0, r_b0 = state
    q, k, v, g, lr, xr, gr = split_cols(u @ w_in, AB_SIZES)
    qh = to_heads(q.astype(f32), GLA_HEADS) * GLA_DK ** -0.5
    kh = to_heads(k.astype(f32), GLA_HEADS)
    vh = to_heads(v.astype(f32), GLA_HEADS)
    lr_f, lr_b = jnp.split(lr.astype(f32), 2, axis=-1)

    def log_decay(lr_d, d):
        z = lr_d @ w_alpha2[d].astype(f32) + b_alpha[d].astype(f32)
        return to_heads(jnp.maximum(jax.nn.log_sigmoid(z) / GLA_TAU, GLA_LOG_DECAY_MIN), GLA_HEADS)

    o_f, s_f = gla_scan(qh, kh, vh, log_decay(lr_f, 0), s_f0, readout)
    o_b, s_b = gla_scan(jnp.flip(qh, 2), jnp.flip(kh, 2), jnp.flip(vh, 2), jnp.flip(log_decay(lr_b, 1), 2), s_b0, readout)
    xb = dwconv_centred(xr, conv_w, conv_b).astype(f32)
    h_f = rglru_dir(xb, w_a[0], b_a[0], w_i[0], b_i[0], lam[0], r_f0)
    h_b = jnp.flip(rglru_dir(jnp.flip(xb, 1), w_a[1], b_a[1], w_i[1], b_i[1], lam[1], r_b0), 1)
    new_state = (s_f, s_b, h_f[:, -1], h_b[:, 0])
    if not readout:
        return None, new_state
    o = rmsnorm(o_f + jnp.flip(o_b, 2), gla_g)
    y_gla = from_heads(o).astype(u.dtype) * jax.nn.silu(g)
    y_rg = (h_f + h_b).astype(u.dtype) * jax.nn.gelu(gr)
    return jnp.concatenate([y_gla, y_rg], axis=-1) @ w_out, new_state


def mixer_c(u, state, w_in, b_gates, norm_g_h, w_out, readout):
    f32 = jnp.float32
    st_f0, st_b0 = state
    q, k, v, o, gates = split_cols(u @ w_in, ML_SIZES)
    gates = jnp.transpose(gates.astype(f32) + b_gates.astype(f32), (0, 2, 1))
    i_f, f_f, i_b, f_b = jnp.split(gates, 4, axis=1)
    qh = to_heads(q.astype(f32), ML_HEADS) * ML_DK ** -0.5
    kh = to_heads(k.astype(f32), ML_HEADS)
    vh = to_heads(v.astype(f32), ML_HEADS)
    h_f, st_f = mlstm_scan(qh, kh, vh, i_f, jax.nn.log_sigmoid(f_f), st_f0, readout)
    h_b, st_b = mlstm_scan(jnp.flip(qh, 2), jnp.flip(kh, 2), jnp.flip(vh, 2), jnp.flip(i_b, 2),
                           jnp.flip(jax.nn.log_sigmoid(f_b), 2), st_b0, readout)
    if not readout:
        return None, (st_f, st_b)
    h = rmsnorm(h_f + jnp.flip(h_b, 2), norm_g_h)
    return (jax.nn.sigmoid(o) * from_heads(h).astype(u.dtype)) @ w_out, (st_f, st_b)


def setup_inputs(seed: int = 0) -> dict:
    key = jax.random.key(seed)
    ks = jax.random.split(key, 32)
    f32 = jnp.float32

    def nrm(k, shape, scale):
        return scale * jax.random.normal(k, shape, f32)

    s = jax.random.uniform(ks[20], (N_EVEN, 2, D_RG), f32, 0.9, 0.999) ** (1.0 / RG_C)
    rg_lambda = jnp.log(s) - jnp.log1p(-s)
    ml_b_gates = jnp.concatenate([
        nrm(ks[24], (N_ODD, ML_HEADS), 0.1), 3.0 + nrm(ks[25], (N_ODD, ML_HEADS), 0.5),
        nrm(ks[26], (N_ODD, ML_HEADS), 0.1), 3.0 + nrm(ks[27], (N_ODD, ML_HEADS), 0.5)], axis=-1)
    return {
        "x": nrm(ks[0], (BATCH, SEQ, D_MODEL), 1.0),
        "c": nrm(ks[1], (BATCH, D_MODEL), 1.0),
        "ctx": nrm(ks[2], (BATCH, CTX_LEN, D_MODEL), 1.0),
        "c_ctx": nrm(ks[3], (D_MODEL,), 1.0),
        "w_mod": nrm(ks[4], (DEPTH, D_MODEL, N_MOD * D_MODEL), 0.5 * D_MODEL ** -0.5),
        "b_mod": nrm(ks[5], (DEPTH, N_MOD * D_MODEL), 0.01),
        "norm_g": 1.0 + nrm(ks[6], (DEPTH, 6, D_MODEL), 0.05),
        "ffn1_w_in": nrm(ks[7], (DEPTH, D_MODEL, 2 * D_FF), D_MODEL ** -0.5),
        "ffn1_w_out": nrm(ks[8], (DEPTH, D_FF, D_MODEL), D_FF ** -0.5),
        "ffn2_w_in": nrm(ks[9], (DEPTH, D_MODEL, 2 * D_FF), D_MODEL ** -0.5),
        "ffn2_w_out": nrm(ks[10], (DEPTH, D_FF, D_MODEL), D_FF ** -0.5),
        "ab_w_in": nrm(ks[11], (N_EVEN, D_MODEL, AB_COLS), D_MODEL ** -0.5),
        "gla_w_alpha2": nrm(ks[12], (N_EVEN, 2, GLA_LOWRANK, GLA_HEADS * GLA_DK), GLA_LOWRANK ** -0.5),
        "gla_b_alpha": nrm(ks[13], (N_EVEN, 2, GLA_HEADS * GLA_DK), 0.01),
        "gla_norm_g": 1.0 + nrm(ks[14], (N_EVEN, GLA_DV), 0.05),
        "rg_conv_w": nrm(ks[15], (N_EVEN, CONV_W, D_RG), CONV_W ** -0.5),
        "rg_conv_b": nrm(ks[16], (N_EVEN, D_RG), 0.01),
        "rg_w_a": nrm(ks[17], (N_EVEN, 2, RG_BLOCKS, RG_BLOCK, RG_BLOCK), RG_BLOCK ** -0.5),
        "rg_b_a": nrm(ks[18], (N_EVEN, 2, D_RG), 0.01),
        "rg_w_i": nrm(ks[19], (N_EVEN, 2, RG_BLOCKS, RG_BLOCK, RG_BLOCK), RG_BLOCK ** -0.5),
        "rg_b_i": nrm(ks[21], (N_EVEN, 2, D_RG), 0.01),
        "rg_lambda": rg_lambda,
        "ab_w_out": nrm(ks[22], (N_EVEN, D_GLA + D_RG, D_MODEL), (D_GLA + D_RG) ** -0.5),
        "ml_w_in": nrm(ks[23], (N_ODD, D_MODEL, ML_COLS), D_MODEL ** -0.5),
        "ml_b_gates": ml_b_gates,
        "ml_norm_g": 1.0 + nrm(ks[28], (N_ODD, ML_DV), 0.05),
        "ml_w_out": nrm(ks[29], (N_ODD, D_ML, D_MODEL), D_ML ** -0.5),
    }


def reference(x, c, ctx, c_ctx, w_mod, b_mod, norm_g, ffn1_w_in, ffn1_w_out, ffn2_w_in, ffn2_w_out,
              ab_w_in, gla_w_alpha2, gla_b_alpha, gla_norm_g, rg_conv_w, rg_conv_b, rg_w_a, rg_b_a,
              rg_w_i, rg_b_i, rg_lambda, ab_w_out, ml_w_in, ml_b_gates, ml_norm_g, ml_w_out):
    f32 = jnp.float32
    bsz, n_lat, _ = x.shape
    ROWS = n_lat // GRID_W
    h_lat = x + pos_embed_2d(ROWS, x.dtype)[None]
    h_ctx = ctx
    gla_zero = jnp.zeros((bsz, GLA_HEADS, GLA_DK, GLA_DV), f32)
    rg_zero = jnp.zeros((bsz, D_RG), f32)
    ml_zero = (jnp.zeros((bsz, ML_HEADS, ML_DK, ML_DV), f32), jnp.zeros((bsz, ML_HEADS, ML_DK), f32),
               jnp.zeros((bsz, ML_HEADS), f32))
    for layer in range(DEPTH):
        last = layer == DEPTH - 1
        ng = norm_g[layer]
        mod_lat = (jax.nn.silu(c) @ w_mod[layer] + b_mod[layer]).reshape(bsz, 1, N_MOD, D_MODEL)
        mod_ctx = (jax.nn.silu(c_ctx) @ w_mod[layer] + b_mod[layer]).reshape(1, 1, N_MOD, D_MODEL)
        h_ctx = ffn_sub(h_ctx, mod_ctx, ng, ffn1_w_in[layer], ffn1_w_out[layer], 0)
        h_lat = ffn_sub(h_lat, mod_lat, ng, ffn1_w_in[layer], ffn1_w_out[layer], 0)
        u_ctx = modulate(h_ctx, ng[2], mod_ctx[:, :, 3], mod_ctx[:, :, 4])
        u_lat = modulate(h_lat, ng[2], mod_lat[:, :, 3], mod_lat[:, :, 4])
        j = layer // 2
        if layer % 2 == 0:
            weights = (ab_w_in[j], gla_w_alpha2[j], gla_b_alpha[j], gla_norm_g[j], rg_conv_w[j], rg_conv_b[j],
                       rg_w_a[j], rg_b_a[j], rg_w_i[j], rg_b_i[j], rg_lambda[j], ab_w_out[j])
            y_ctx, ctx_state = mixer_ab(u_ctx, (gla_zero, gla_zero, rg_zero, rg_zero), *weights, readout=not last)
            y_lat, _ = mixer_ab(u_lat, ctx_state, *weights, readout=True)
        else:
            weights = (ml_w_in[j], ml_b_gates[j], ml_norm_g[j], ml_w_out[j])
            y_ctx, ctx_state = mixer_c(u_ctx, (ml_zero, ml_zero), *weights, readout=not last)
            y_lat, _ = mixer_c(u_lat, ctx_state, *weights, readout=True)
        h_lat = add_residual(h_lat, y_lat, ng[3], mod_lat[:, :, 5], 1.0)
        h_lat = ffn_sub(h_lat, mod_lat, ng, ffn2_w_in[layer], ffn2_w_out[layer], 2)
        if not last:
            h_ctx = add_residual(h_ctx, y_ctx, ng[3], mod_ctx[:, :, 5], 1.0)
            h_ctx = ffn_sub(h_ctx, mod_ctx, ng, ffn2_w_in[layer], ffn2_w_out[layer], 2)
    return h_lat
```

```cpp
#include <hip/hip_runtime.h>
#include <cstdio>
#include <cstdint>
__device__ __forceinline__ int fresh_tid() { int t = threadIdx.x; asm volatile("" : "+v"(t)); return t; }
namespace pg8 {
#define PG8_LAS __attribute__((address_space(3)))
typedef unsigned short bf16_t;
typedef short bf16x8 __attribute__((ext_vector_type(8)));
typedef float f32x4 __attribute__((ext_vector_type(4)));
typedef unsigned u32x4 __attribute__((ext_vector_type(4)));
constexpr int BM = 256, BK = 64, HALF = 128, HTB = HALF * BK * 2  , STAGE_BYTES = 8 * HTB, NXCD = 8, WGM = 8;

__host__ __device__ __forceinline__ int lds_byte(int r, int c) { const int st = (r >> 4) * 2 + (c >> 5), rr = r & 15, cc = c & 31, ob = rr * 64 + cc * 2; return st * 1024 + (ob ^ (((ob >> 9) & 1) << 5)); }
__host__ __device__ __forceinline__ void stage_rc(int b, int& R, int& C) { const int st = b / 1024, sb = b % 1024, swz = sb ^ (((sb >> 9) & 1) << 5); R = (st >> 1) * 16 + swz / 64; C = (st & 1) * 32 + (swz % 64) / 2; }
__host__ __device__ __forceinline__ int perm32(int rho) { const int n = rho >> 4, i = rho & 15; return 8 * (i >> 2) + 4 * n + (i & 3); }

struct Unit { int pm, pn; };
struct Gemm { const bf16_t* A; const bf16_t* Bt; int M, N, K; };

struct StaticOrder {
    int nM, nN, nwg, G, c;
    __host__ __device__ void init(int M, int N, int G_, int c_) { nM = M / BM; nN = N / BM; nwg = nM * nN; G = G_; c = c_; }
    __host__ __device__ bool next(int i, Unit& u) const {
        const long L = (long)i * G + c; if (L >= nwg) return false;
        int wgid = (int)L; { const int q = nwg / NXCD, r = nwg % NXCD, xcd = wgid % NXCD, off = wgid / NXCD; wgid = (xcd < r ? xcd * (q + 1) : r * (q + 1) + (xcd - r) * q) + off; }
        const int nig = WGM * nN, gid = wgid / nig, fm = gid * WGM, gsz = (nM - fm) < WGM ? (nM - fm) : WGM;
        u.pm = fm + ((wgid % nig) % gsz); u.pn = (wgid % nig) / gsz; return true;
    }
    __device__ __forceinline__ void a_ready(const Unit&) const {}
    __device__ __forceinline__ void done(const Unit&) const {}
};

__device__ __forceinline__ unsigned cvt_pk_bf16(float lo, float hi) { unsigned r; asm volatile("v_cvt_pk_bf16_f32 %0, %1, %2" : "=v"(r) : "v"(lo), "v"(hi)); return r; }
__device__ __forceinline__ float silu_f(float x) { return x * __builtin_amdgcn_rcpf(1.0f + __expf(-x)); }

struct EpiF32 {
    static constexpr bool PERM = false, AFTER_DRAIN = false;
    float* C; int ldc;
    __device__ __forceinline__ void operator()(const f32x4 (&acc)[2][2][4][2], const Unit& u, int wr, int wc, int fr, int fq) const {
        const int row0 = u.pm * BM + wr * 64 + fr, col0 = u.pn * BM + wc * 32 + 4 * fq;
#pragma unroll
        for (int ai = 0; ai < 2; ++ai)
#pragma unroll
            for (int m = 0; m < 4; ++m) { float* rowp = C + (size_t)(row0 + ai * HALF + m * 16) * ldc + col0;
#pragma unroll
                for (int bj = 0; bj < 2; ++bj)
#pragma unroll
                    for (int n = 0; n < 2; ++n) *(f32x4*)(rowp + bj * HALF + n * 16) = acc[ai][bj][m][n]; }
    }
};
struct EpiSwiglu {
    static constexpr bool PERM = true, AFTER_DRAIN = false;
    bf16_t* O; int ldc;
    __device__ __forceinline__ void operator()(const f32x4 (&acc)[2][2][4][2], const Unit& u, int wr, int wc, int fr, int fq) const {
        const int row0 = u.pm * BM + wr * 64 + fr, col0 = u.pn * HALF + wc * 32 + 8 * fq;
#pragma unroll
        for (int ai = 0; ai < 2; ++ai)
#pragma unroll
            for (int m = 0; m < 4; ++m) { bf16_t* rowp = O + (size_t)(row0 + ai * HALF + m * 16) * ldc + col0;
                const f32x4 a0 = acc[ai][0][m][0], a1 = acc[ai][0][m][1], b0 = acc[ai][1][m][0], b1 = acc[ai][1][m][1];
                f32x4 v0, v1;
#pragma unroll
                for (int j = 0; j < 4; ++j) { v0[j] = silu_f(a0[j]) * b0[j]; v1[j] = silu_f(a1[j]) * b1[j]; }
                u32x4 w; w.x = cvt_pk_bf16(v0[0], v0[1]); w.y = cvt_pk_bf16(v0[2], v0[3]); w.z = cvt_pk_bf16(v1[0], v1[1]); w.w = cvt_pk_bf16(v1[2], v1[3]);
                *(u32x4*)rowp = w; }
    }
};
struct EpiProj {
    static constexpr bool PERM = true, AFTER_DRAIN = false;
    bf16_t* O; int ldc; float* gates; int gate_pn;
    __device__ __forceinline__ void operator()(const f32x4 (&acc)[2][2][4][2], const Unit& u, int wr, int wc, int fr, int fq) const {
        const int row0 = u.pm * BM + wr * 64 + fr, col0 = u.pn * BM + wc * 32 + 8 * fq;
#pragma unroll
        for (int ai = 0; ai < 2; ++ai)
#pragma unroll
            for (int m = 0; m < 4; ++m) { bf16_t* rowp = O + (size_t)(row0 + ai * HALF + m * 16) * ldc + col0;
#pragma unroll
                for (int bj = 0; bj < 2; ++bj) { const f32x4 v0 = acc[ai][bj][m][0], v1 = acc[ai][bj][m][1];
                    u32x4 w; w.x = cvt_pk_bf16(v0[0], v0[1]); w.y = cvt_pk_bf16(v0[2], v0[3]); w.z = cvt_pk_bf16(v1[0], v1[1]); w.w = cvt_pk_bf16(v1[2], v1[3]);
                    *(u32x4*)(rowp + bj * HALF) = w; } }
        if (u.pn == gate_pn && wc == 0) {
#pragma unroll
            for (int ai = 0; ai < 2; ++ai)
#pragma unroll
                for (int m = 0; m < 4; ++m) { float* gp = gates + (size_t)(row0 + ai * HALF + m * 16) * 32 + 8 * fq;
                    *(f32x4*)gp = acc[ai][0][m][0]; *(f32x4*)(gp + 4) = acc[ai][0][m][1]; }
        }
    }
};

template <class Epi, class Sched, bool ALIGN_EPI = false, bool SP2 = false>
__device__ __forceinline__ void gemm_phase(PG8_LAS unsigned char* lds, const Gemm g, const Sched& S, const Epi& E) {
    const int tid = fresh_tid(), wid = __builtin_amdgcn_readfirstlane(tid >> 6), lane = tid & 63, wr = wid >> 2, wc = wid & 3, fr = lane & 15, fq = lane >> 4;
    const int K = g.K, nt = K / BK;
    unsigned voffA[2], voffB[2];
#pragma unroll
    for (int i = 0; i < 2; ++i) { int R, C; stage_rc(tid * 16 + i * 8192, R, C); const int Rb = Epi::PERM ? ((R & ~31) + perm32(R & 31)) : R;
        voffA[i] = (unsigned)(R * K + C) * 2u; voffB[i] = (unsigned)(Rb * K + C) * 2u; }
    const size_t kstep = (size_t)(BK * 2);
    const size_t hstep = (size_t)HALF * K * 2;
    const size_t tstep = 2 * hstep;
    const unsigned ldsw = (unsigned)wid * 1024u;
    const int aoff = lds_byte(wr * 64 + fr, fq * 8), boff = lds_byte(wc * 32 + fr, fq * 8);
#define PG8_SA(b, h) (((b) * 2 + (h)) * HTB)
#define PG8_SB(b, h) ((4 + (b) * 2 + (h)) * HTB)
#define PG8_STAGE(bufoff, gbase, voff) do { _Pragma("unroll") for (int _i = 0; _i < 2; ++_i) \
        __builtin_amdgcn_global_load_lds((const unsigned*)((const char*)(gbase) + (voff)[_i]), (PG8_LAS unsigned*)(lds + (bufoff) + ldsw + _i * 8192), 16, 0, 0); } while (0)
#define PG8_LDA(dst, b, h) do { _Pragma("unroll") for (int m = 0; m < 4; ++m) _Pragma("unroll") for (int k = 0; k < 2; ++k) dst[m][k] = *(const PG8_LAS bf16x8*)(lds + PG8_SA(b, h) + aoff + m * 2048 + k * 1024); } while (0)
#define PG8_LDB(dst, b, h) do { _Pragma("unroll") for (int n = 0; n < 2; ++n) _Pragma("unroll") for (int k = 0; k < 2; ++k) dst[n][k] = *(const PG8_LAS bf16x8*)(lds + PG8_SB(b, h) + boff + n * 2048 + k * 1024); } while (0)
#define PG8_MMA(ai, bj, At, Bt) do { __builtin_amdgcn_s_setprio(1); _Pragma("unroll") for (int m = 0; m < 4; ++m) _Pragma("unroll") for (int n = 0; n < 2; ++n) _Pragma("unroll") for (int k = 0; k < 2; ++k) \
        acc[ai][bj][m][n] = __builtin_amdgcn_mfma_f32_16x16x32_bf16(Bt[n][k], At[m][k], acc[ai][bj][m][n], 0, 0, 0); __builtin_amdgcn_s_setprio(0); } while (0)
#define PG8_WAIT_V(n) asm volatile("s_waitcnt vmcnt(" #n ")" ::: "memory")
#define PG8_WAIT_L(n) asm volatile("s_waitcnt lgkmcnt(" #n ")" ::: "memory")
#define PG8_BAR __builtin_amdgcn_s_barrier()
#define PG8_SCHED __builtin_amdgcn_sched_barrier(0)
    Unit cur, nxt; int ui = 0;
    if (!S.next(0, cur)) return;
    f32x4 acc[2][2][4][2];
#pragma unroll
    for (int a = 0; a < 2; ++a)
#pragma unroll
        for (int b = 0; b < 2; ++b)
#pragma unroll
            for (int m = 0; m < 4; ++m)
#pragma unroll
                for (int n = 0; n < 2; ++n) acc[a][b][m][n] = (f32x4){0.f, 0.f, 0.f, 0.f};
    bf16x8 At[4][2], B0[2][2], B1[2][2];
    const char* cA = (const char*)g.A + (size_t)cur.pm * tstep; const char* cB = (const char*)g.Bt + (size_t)cur.pn * tstep;
    S.a_ready(cur);
    if constexpr (SP2) {
        PG8_STAGE(PG8_SB(0, 0), cB, voffB); PG8_STAGE(PG8_SB(0, 1), cB + hstep, voffB); PG8_STAGE(PG8_SA(0, 0), cA, voffA); PG8_STAGE(PG8_SA(0, 1), cA + hstep, voffA);
        if (wr == 1) PG8_BAR;
        PG8_WAIT_V(2); PG8_BAR;
        PG8_STAGE(PG8_SB(1, 0), cB + kstep, voffB); PG8_STAGE(PG8_SA(1, 0), cA + kstep, voffA); PG8_STAGE(PG8_SB(1, 1), cB + hstep + kstep, voffB);
        PG8_WAIT_V(6); PG8_BAR;
    } else {
        PG8_STAGE(PG8_SB(0, 0), cB, voffB); PG8_STAGE(PG8_SA(0, 0), cA, voffA); PG8_STAGE(PG8_SB(0, 1), cB + hstep, voffB); PG8_STAGE(PG8_SA(0, 1), cA + hstep, voffA);
        if (wr == 1) PG8_BAR;
        PG8_WAIT_V(4); PG8_BAR;
        PG8_STAGE(PG8_SB(1, 0), cB + kstep, voffB); PG8_STAGE(PG8_SA(1, 0), cA + kstep, voffA); PG8_STAGE(PG8_SB(1, 1), cB + hstep + kstep, voffB);
        PG8_WAIT_V(6); PG8_BAR;
    }
    for (;;) {
        const bool has_next = S.next(ui + 1, nxt);
        const char* nA = has_next ? (const char*)g.A + (size_t)nxt.pm * tstep : cA; const char* nB = has_next ? (const char*)g.Bt + (size_t)nxt.pn * tstep : cB;
        for (int t = 0; t < nt; t += 2) {
            const bool last = (t == nt - 2);
            const char* a1 = cA + (size_t)(t + 1) * kstep;
            const char* a2 = last ? nA : cA + (size_t)(t + 2) * kstep; const char* b2 = last ? nB : cB + (size_t)(t + 2) * kstep;
            const char* a3 = a2 + kstep; const char* b3 = b2 + kstep;
            if (last && has_next) S.a_ready(nxt);
            if constexpr (SP2) {
            PG8_LDB(B0, 0, 0); PG8_LDB(B1, 0, 1); PG8_SCHED; PG8_LDA(At, 0, 0); PG8_STAGE(PG8_SA(1, 1), a1 + hstep, voffA);
            PG8_WAIT_V(8); PG8_WAIT_L(0); PG8_BAR; PG8_MMA(0, 0, At, B0); PG8_MMA(0, 1, At, B1); PG8_BAR; PG8_SCHED;
            PG8_LDA(At, 0, 1); PG8_STAGE(PG8_SB(0, 0), b2, voffB); PG8_STAGE(PG8_SB(0, 1), b2 + hstep, voffB); PG8_STAGE(PG8_SA(0, 0), a2, voffA);
            PG8_WAIT_V(8); PG8_WAIT_L(0); PG8_BAR; PG8_MMA(1, 0, At, B0); PG8_MMA(1, 1, At, B1); PG8_BAR; PG8_SCHED;
            PG8_LDB(B0, 1, 0); PG8_LDB(B1, 1, 1); PG8_SCHED; PG8_LDA(At, 1, 0); PG8_STAGE(PG8_SA(0, 1), a2 + hstep, voffA);
            PG8_WAIT_V(8); PG8_WAIT_L(0); PG8_BAR; PG8_MMA(0, 0, At, B0); PG8_MMA(0, 1, At, B1); PG8_BAR; PG8_SCHED;
            PG8_LDA(At, 1, 1); PG8_STAGE(PG8_SB(1, 0), b3, voffB); PG8_STAGE(PG8_SB(1, 1), b3 + hstep, voffB); PG8_STAGE(PG8_SA(1, 0), a3, voffA);
            PG8_WAIT_V(8); PG8_WAIT_L(0); PG8_BAR; PG8_MMA(1, 0, At, B0); PG8_MMA(1, 1, At, B1); PG8_BAR; PG8_SCHED;
            } else {
            PG8_LDB(B0, 0, 0); PG8_SCHED; PG8_LDA(At, 0, 0); PG8_STAGE(PG8_SA(1, 1), a1 + hstep, voffA);
            PG8_WAIT_L(8); PG8_BAR; PG8_WAIT_L(0); PG8_MMA(0, 0, At, B0); PG8_BAR; PG8_SCHED;
            PG8_LDB(B1, 0, 1); PG8_STAGE(PG8_SB(0, 0), b2, voffB);
            PG8_BAR; PG8_WAIT_L(0); PG8_MMA(0, 1, At, B1); PG8_BAR;
            PG8_LDA(At, 0, 1); PG8_STAGE(PG8_SA(0, 0), a2, voffA);
            PG8_BAR; PG8_WAIT_L(0); PG8_MMA(1, 0, At, B0); PG8_BAR; PG8_SCHED;
            PG8_STAGE(PG8_SB(0, 1), b2 + hstep, voffB);
            PG8_WAIT_V(6); PG8_BAR; PG8_MMA(1, 1, At, B1); PG8_BAR;
            PG8_LDB(B0, 1, 0); PG8_SCHED; PG8_LDA(At, 1, 0); PG8_STAGE(PG8_SA(0, 1), a2 + hstep, voffA);
            PG8_WAIT_L(8); PG8_BAR; PG8_WAIT_L(0); PG8_MMA(0, 0, At, B0); PG8_BAR; PG8_SCHED;
            PG8_LDB(B1, 1, 1); PG8_STAGE(PG8_SB(1, 0), b3, voffB);
            PG8_BAR; PG8_WAIT_L(0); PG8_MMA(0, 1, At, B1); PG8_BAR;
            PG8_LDA(At, 1, 1); PG8_STAGE(PG8_SA(1, 0), a3, voffA);
            PG8_BAR; PG8_WAIT_L(0); PG8_MMA(1, 0, At, B0); PG8_BAR; PG8_SCHED;
            PG8_STAGE(PG8_SB(1, 1), b3 + hstep, voffB);
            PG8_WAIT_V(6); PG8_BAR; PG8_MMA(1, 1, At, B1); PG8_BAR;
            }
        }
        if constexpr (ALIGN_EPI) { if (wr == 0) PG8_BAR; }
        if constexpr (!Epi::AFTER_DRAIN) { E(acc, cur, wr, wc, fr, fq); S.done(cur); }
        if (!has_next) break;
#pragma unroll
        for (int a = 0; a < 2; ++a)
#pragma unroll
            for (int b = 0; b < 2; ++b)
#pragma unroll
                for (int m = 0; m < 4; ++m)
#pragma unroll
                    for (int n = 0; n < 2; ++n) acc[a][b][m][n] = (f32x4){0.f, 0.f, 0.f, 0.f};
        cur = nxt; cA = nA; cB = nB; ++ui;
        if constexpr (ALIGN_EPI) { if (wr == 1) PG8_BAR; }
    }
    PG8_WAIT_V(0);
    if constexpr (!ALIGN_EPI) { if (wr == 0) PG8_BAR; }
    PG8_BAR;
    if constexpr (Epi::AFTER_DRAIN) { E.fused(acc, cur, wr, wc, fr, fq, lds, wid, lane); S.done(cur); }
#undef PG8_SA
#undef PG8_SB
#undef PG8_STAGE
#undef PG8_LDA
#undef PG8_LDB
#undef PG8_MMA
#undef PG8_WAIT_V
#undef PG8_WAIT_L
#undef PG8_BAR
#undef PG8_SCHED
}
}

#ifndef PG8_SP2
#define PG8_SP2 true
#endif
#ifndef PG8_ALIGN
#define PG8_ALIGN true
#endif

constexpr int NWAVES = 8;
constexpr int D = 2048, NB = 8, SEQ = 4096, CTXL = 256, DFF = 5632, NMOD = 9;
constexpr int MC = NB * CTXL;
constexpr int MLAT = NB * SEQ;
constexpr int M = MC + MLAT;
constexpr int NP0 = 5376, NP1 = 6400;
constexpr int NCH = (CTXL + SEQ) / 64;
constexpr float EPS = 1e-6f;
constexpr float QSCALE = 0.08838834764831845f;

constexpr size_t MiB = 1u << 20;
constexpr size_t WS_CTL = 0, CTL_ZERO_BYTES = 1 * MiB;
constexpr size_t WS_MOD = 1 * MiB;
constexpr size_t WS_GATES = 3 * MiB;
constexpr size_t WS_WRG = 8 * MiB;
constexpr size_t WS_PE = 9 * MiB;
constexpr size_t WS_HCTX = 10 * MiB;
constexpr size_t WS_W = 26 * MiB;
constexpr size_t W_F1I = WS_W, W_F1O = W_F1I + 44 * MiB, W_F2I = W_F1O + 22 * MiB, W_F2O = W_F2I + 44 * MiB, W_MI = W_F2O + 22 * MiB, W_MO = W_MI + 25 * MiB;
constexpr size_t WS_U = 192 * MiB;
constexpr size_t WS_Y = 328 * MiB;
constexpr size_t WS_BIG = 600 * MiB;
constexpr size_t WS_END = 1025 * MiB;
static_assert(W_MO + 8 * MiB <= WS_U && WS_U + (size_t)M * D * 2 <= WS_Y && WS_Y + (size_t)M * D * 4 <= WS_BIG && WS_BIG + (size_t)M * NP1 * 2 <= WS_END, "ws map");
constexpr int CW_BAR = 4096;

constexpr int SCR_BYTES = 151552;
constexpr int LDSCTL_OFF = SCR_BYTES;
constexpr int LDS_BYTES = 155648;

#define GAS __attribute__((address_space(1)))
#define LAS __attribute__((address_space(3)))
typedef unsigned short bf16;
typedef float f32x4 __attribute__((ext_vector_type(4)));
typedef float f32x2 __attribute__((ext_vector_type(2)));
typedef short bf16x8 __attribute__((ext_vector_type(8)));
typedef short bf16x4 __attribute__((ext_vector_type(4)));
typedef unsigned u32x4 __attribute__((ext_vector_type(4)));
typedef unsigned u32x2 __attribute__((ext_vector_type(2)));
#define LDS_WAIT() asm volatile("s_waitcnt lgkmcnt(0)" ::: "memory")
__device__ __forceinline__ unsigned f2bf(float f) { unsigned u = __builtin_bit_cast(unsigned, f); return (u + 0x7fffu + ((u >> 16) & 1u)) >> 16; }
__device__ __forceinline__ unsigned pk2(float lo, float hi) { return pg8::cvt_pk_bf16(lo, hi); }
__device__ __forceinline__ float bflo(unsigned w) { return __uint_as_float(w << 16); }
__device__ __forceinline__ float bfhi(unsigned w) { return __uint_as_float(w & 0xffff0000u); }
__device__ __forceinline__ float wave_sum(float v) {
#pragma unroll
    for (int o = 1; o < 64; o <<= 1) v += __shfl_xor(v, o);
    return v;
}
__device__ __forceinline__ float sigmoid_f(float x) { return __builtin_amdgcn_rcpf(1.0f + __expf(-x)); }
__device__ __forceinline__ float silu_f(float x) { return x * sigmoid_f(x); }
__device__ __forceinline__ float logsig_f(float z) { return fminf(z, 0.f) - __logf(1.0f + __expf(-fabsf(z))); }
__device__ __forceinline__ float gelu_tanh_f(float x) { const float u = 0.7978845608028654f * (x + 0.044715f * x * x * x); const float t = 1.0f - 2.0f * __builtin_amdgcn_rcpf(1.0f + __expf(2.0f * u)); return 0.5f * x * (1.0f + t); }

#define XB_TMO      128
#define XB_XCNT(j)  (256  + 64 * (j))
#define XB_XSUB(j)  (1280 + 64 * (j))
#define XB_XGEN(j)  (2304 + 64 * (j))
#define XB_TOP      3328
#define XB_TOPGEN   3392
#define XCD_BAR_WORDS 3456
#define XB_SPIN_CAP (1u << 18)

__device__ __forceinline__ unsigned xb_ld(unsigned* p)              { return __hip_atomic_load(p, __ATOMIC_RELAXED, __HIP_MEMORY_SCOPE_AGENT); }
__device__ __forceinline__ unsigned xb_add(unsigned* p, unsigned v) { return __hip_atomic_fetch_add(p, v, __ATOMIC_RELAXED, __HIP_MEMORY_SCOPE_AGENT); }
__device__ __forceinline__ unsigned xb_xcc_id() { return (unsigned)__builtin_amdgcn_s_getreg((3 << 11) | 20) & 0xFu; }
#define XB_SPIN(cond, bar) do { unsigned _sp = 0; while (cond) { __builtin_amdgcn_s_sleep(1); \
    if ((++_sp & 255u) == 0u) { if (xb_ld(&(bar)[XB_TMO])) break; if (_sp > XB_SPIN_CAP) { atomicAdd(&(bar)[XB_TMO], 1u); break; } } } } while (0)

struct XcdBarrier {
    unsigned* bar; unsigned x;
    volatile LAS unsigned* st;
};

__device__ __forceinline__ XcdBarrier xcd_barrier_post(unsigned* bar, volatile LAS unsigned* st) {
    XcdBarrier b; b.bar = bar; b.x = xb_xcc_id(); b.st = st;
    if (threadIdx.x == 0) (void)xb_add(&bar[XB_XCNT(b.x)], 1u);
    return b;
}
__device__ __forceinline__ void xcd_barrier_complete(unsigned* bar, unsigned x, unsigned& nloc, unsigned& nx) {
    const unsigned G = gridDim.x * gridDim.y * gridDim.z;
    unsigned sum, cnt, mine, sp = 0u;
    for (;;) {
        sum = 0u; cnt = 0u; mine = 0u;
#pragma unroll
        for (unsigned j = 0; j < 16; ++j) { const unsigned c = xb_ld(&bar[XB_XCNT(j)]); sum += c; cnt += (c > 0u) ? 1u : 0u; mine = (j == x) ? c : mine; }
        if (sum == G) break;
        __builtin_amdgcn_s_sleep(1);
        if ((++sp & 255u) == 0u) { if (xb_ld(&bar[XB_TMO])) break; if (sp > XB_SPIN_CAP) { atomicAdd(&bar[XB_TMO], 1u); break; } }
    }
    nloc = mine > 0u ? mine : 1u; nx = cnt > 0u ? cnt : 1u;
}

__device__ __forceinline__ void xcd_barrier(const XcdBarrier& b) {
    asm volatile("s_waitcnt vmcnt(0)" ::: "memory");
    __syncthreads();
    if (threadIdx.x == 0) {
        unsigned* bar = b.bar;
        __builtin_amdgcn_s_waitcnt(0);
        unsigned nloc = b.st[0], nx = b.st[1];
        if (nloc == 0u) { xcd_barrier_complete(bar, b.x, nloc, nx); b.st[0] = nloc; b.st[1] = nx; }
        const unsigned old = xb_add(&bar[XB_XSUB(b.x)], 1u);
        const unsigned gen = old / nloc;
        if (old + 1u == (gen + 1u) * nloc) {
            __builtin_amdgcn_fence(__ATOMIC_RELEASE, "agent");
            asm volatile("s_waitcnt vmcnt(0)" ::: "memory");
            const unsigned og = xb_add(&bar[XB_TOP], 1u);
            const unsigned tg = og / nx;
            if (og + 1u == (tg + 1u) * nx) xb_add(&bar[XB_TOPGEN], 1u);
            else XB_SPIN(xb_ld(&bar[XB_TOPGEN]) == tg, bar);
            __builtin_amdgcn_fence(__ATOMIC_ACQUIRE, "agent");
            xb_add(&bar[XB_XGEN(b.x)], 1u);
            asm volatile("s_waitcnt vmcnt(0)" ::: "memory");
        } else {
            XB_SPIN(xb_ld(&bar[XB_XGEN(b.x)]) == gen, bar);
            __builtin_amdgcn_fence(__ATOMIC_ACQUIRE, "agent");
            asm volatile("s_waitcnt vmcnt(0)" ::: "memory");
        }
    }
    __syncthreads();
}

struct Args { const float* in[27]; float* out; unsigned char* ws; int ph_lo, ph_hi; };
struct Frame {
    LAS unsigned char* lds;
    int G, wg, NGW;
    float* out; unsigned char* ws;
    const Args& A;
};
enum { I_X = 0, I_C, I_CTX, I_CCTX, I_WMOD, I_BMOD, I_NORMG, I_F1WI, I_F1WO, I_F2WI, I_F2WO, I_ABWI, I_WALPHA2, I_BALPHA, I_GLANG, I_CONVW, I_CONVB, I_RGWA, I_RGBA, I_RGWI, I_RGBI, I_LAM, I_ABWO, I_MLWI, I_MLBG, I_MLNG, I_MLWO };

__device__ __forceinline__ void pre_mod(Frame& F) {
    const int tid_ = fresh_tid(); const int lane_ = tid_ & 63, wave_ = __builtin_amdgcn_readfirstlane(tid_ >> 6), gw_ = F.wg * NWAVES + wave_; (void)lane_; (void)gw_;
    LAS float* sc = (LAS float*)F.lds;
    LAS float* red = (LAS float*)(F.lds + 9 * 2048 * 4);
    for (int i = tid_; i < 9 * 2048; i += 512) { const int bb = i >> 11, k = i & 2047; const float v = bb < 8 ? F.A.in[I_C][bb * 2048 + k] : F.A.in[I_CCTX][k]; sc[i] = v * (1.0f / (1.0f + expf(-v))); }
    __syncthreads();
    float* MOD = (float*)(F.ws + WS_MOD);
    const int q = tid_ & 15, kg = tid_ >> 4;
    for (int item = F.wg; item < 2 * 288; item += F.G) {
        const int layer = item / 288, col0 = (item % 288) * 64;
        const float* wp = F.A.in[I_WMOD] + ((size_t)layer * 2048 + (size_t)kg * 64) * 18432 + col0 + 4 * q;
        f32x4 acc[9];
#pragma unroll
        for (int bb = 0; bb < 9; ++bb) acc[bb] = (f32x4){0.f, 0.f, 0.f, 0.f};
#pragma unroll 4
        for (int kk = 0; kk < 64; ++kk) {
            const f32x4 w = *(const f32x4*)(wp + (size_t)kk * 18432);
#pragma unroll
            for (int bb = 0; bb < 9; ++bb) acc[bb] += w * sc[bb * 2048 + kg * 64 + kk];
        }
#pragma unroll
        for (int bb = 0; bb < 9; ++bb)
#pragma unroll
            for (int e = 0; e < 4; ++e) { float v = acc[bb][e]; v += __shfl_xor(v, 16); v += __shfl_xor(v, 32); acc[bb][e] = v; }
        __syncthreads();
        if (lane_ < 16) {
#pragma unroll
            for (int bb = 0; bb < 9; ++bb) *(LAS f32x4*)(red + (wave_ * 9 + bb) * 64 + 4 * q) = acc[bb];
        }
        __syncthreads();
        for (int t = tid_; t < 9 * 64; t += 512) { const int bb = t >> 6, ci = t & 63; float s = F.A.in[I_BMOD][layer * 18432 + col0 + ci];
#pragma unroll
            for (int w = 0; w < 8; ++w) s += red[(w * 9 + bb) * 64 + ci];
            MOD[((size_t)layer * 9 + bb) * 18432 + col0 + ci] = s; }
    }
    __syncthreads();
}
__device__ __forceinline__ void pre_pe(Frame& F) {
    const int tid_ = fresh_tid(); const int lane_ = tid_ & 63, wave_ = __builtin_amdgcn_readfirstlane(tid_ >> 6), gw_ = F.wg * NWAVES + wave_; (void)lane_; (void)gw_;
    float* PE = (float*)(F.ws + WS_PE);
    for (int i = F.wg * 512 + tid_; i < 64 * 512; i += F.G * 512) {
        const int p = i >> 9, f = i & 511;
        const float om = (float)exp2(-(double)f * (13.287712379549449 / 512.0));
        const float angf = (float)p * om; const double x = (double)angf;
        const double kf = rint(x * 0.6366197723675814);
        double r = fma(-kf, 1.5707963267948966, x); r = fma(-kf, 6.123233995736766e-17, r);
        const int k = ((int)kf) & 3; const double r2 = r * r;
        const double sp = r * (1.0 + r2 * (-1.0 / 6.0 + r2 * (1.0 / 120.0 + r2 * (-1.0 / 5040.0 + r2 * (1.0 / 362880.0 + r2 * (-1.0 / 39916800.0 + r2 * (1.0 / 6227020800.0)))))));
        const double cp = 1.0 + r2 * (-0.5 + r2 * (1.0 / 24.0 + r2 * (-1.0 / 720.0 + r2 * (1.0 / 40320.0 + r2 * (-1.0 / 3628800.0 + r2 * (1.0 / 479001600.0))))));
        const double s = (k == 0) ? sp : (k == 1) ? cp : (k == 2) ? -sp : -cp;
        const double c = (k == 0) ? cp : (k == 1) ? -sp : (k == 2) ? -cp : sp;
        PE[p * 1024 + f] = (float)s; PE[p * 1024 + 512 + f] = (float)c;
    }
}
template <int MAP> __device__ __forceinline__ int cvt_row(int n) {
    if (MAP == 1) return n < DFF ? ((n >> 7) << 8) + (n & 127) : (((n - DFF) >> 7) << 8) + 128 + ((n - DFF) & 127);
    if (MAP == 2) return n < 3072 ? n : (n < 3104 ? n + 2048 : n - 32);
    return n;
}
template <int MAP> __device__ __forceinline__ void cvt_item(const float* W, int K, int N, bf16* WT, LAS float* scr, int item, int lane) {
    const int nblk = N / 32, kb = item / nblk, nb = item % nblk, k0 = 64 * kb, n0 = 32 * nb;
#pragma unroll 8
    for (int i = 0; i < 32; ++i) { const int kk = 2 * i + (lane >> 5); scr[kk * 33 + (lane & 31)] = W[(size_t)(k0 + kk) * N + n0 + (lane & 31)]; }
    LDS_WAIT(); asm volatile("" ::: "memory");
    const int c = lane & 7;
#pragma unroll
    for (int j = 0; j < 4; ++j) { const int n = (lane >> 3) + 8 * j; const LAS float* s = scr + (8 * c) * 33 + n;
        u32x4 o; o.x = pk2(s[0 * 33], s[1 * 33]); o.y = pk2(s[2 * 33], s[3 * 33]); o.z = pk2(s[4 * 33], s[5 * 33]); o.w = pk2(s[6 * 33], s[7 * 33]);
        *(u32x4*)(WT + (size_t)cvt_row<MAP>(n0 + n) * K + k0 + 8 * c) = o; }
    LDS_WAIT(); asm volatile("" ::: "memory");
}
template <int LAYER> __device__ __forceinline__ void cvt_layer(Frame& F) {
    const int tid_ = fresh_tid(); const int lane_ = tid_ & 63, wave_ = __builtin_amdgcn_readfirstlane(tid_ >> 6), gw_ = F.wg * NWAVES + wave_; (void)lane_; (void)gw_;
    LAS float* scr = (LAS float*)(F.lds + wave_ * 16384);
    constexpr int I0 = 32 * 352, I1 = 88 * 64, I4 = LAYER == 0 ? 32 * 161 : 32 * 193, I5 = 32 * 64, I6 = LAYER == 0 ? 256 : 0;
    constexpr int NITEMS = 2 * I0 + 2 * I1 + I4 + I5 + I6;
    const float* f1i = F.A.in[I_F1WI] + (size_t)LAYER * D * 2 * DFF; const float* f1o = F.A.in[I_F1WO] + (size_t)LAYER * DFF * D;
    const float* f2i = F.A.in[I_F2WI] + (size_t)LAYER * D * 2 * DFF; const float* f2o = F.A.in[I_F2WO] + (size_t)LAYER * DFF * D;
    for (int it = gw_; it < NITEMS; it += F.NGW) {
        int r = it;
        if (r < I0) { cvt_item<1>(f1i, D, 2 * DFF, (bf16*)(F.ws + W_F1I), scr, r, lane_); continue; } r -= I0;
        if (r < I1) { cvt_item<0>(f1o, DFF, D, (bf16*)(F.ws + W_F1O), scr, r, lane_); continue; } r -= I1;
        if (r < I0) { cvt_item<1>(f2i, D, 2 * DFF, (bf16*)(F.ws + W_F2I), scr, r, lane_); continue; } r -= I0;
        if (r < I1) { cvt_item<0>(f2o, DFF, D, (bf16*)(F.ws + W_F2O), scr, r, lane_); continue; } r -= I1;
        if (r < I4) { if (LAYER == 0) cvt_item<2>(F.A.in[I_ABWI], D, 5152, (bf16*)(F.ws + W_MI), scr, r, lane_); else cvt_item<0>(F.A.in[I_MLWI], D, 6176, (bf16*)(F.ws + W_MI), scr, r, lane_); continue; } r -= I4;
        if (r < I5) { cvt_item<0>(LAYER == 0 ? F.A.in[I_ABWO] : F.A.in[I_MLWO], D, D, (bf16*)(F.ws + W_MO), scr, r, lane_); continue; } r -= I5;
        if (LAYER == 0) { const int mi = r >> 3, sub = r & 7, dir = mi >> 4, mat = (mi >> 3) & 1, n = mi & 7;
            const float* src = (mat ? F.A.in[I_RGWI] : F.A.in[I_RGWA]) + (size_t)(dir * 8 + n) * 128 * 128;
            cvt_item<0>(src, 128, 128, (bf16*)(F.ws + WS_WRG) + (size_t)mi * 128 * 128, scr, sub, lane_); }
    }
    constexpr int PR0 = LAYER == 0 ? 5152 : 6176, PR1 = LAYER == 0 ? NP0 : NP1;
    u32x4* z = (u32x4*)((bf16*)(F.ws + W_MI) + (size_t)PR0 * D);
    for (int i = F.wg * 512 + tid_; i < (PR1 - PR0) * D / 8; i += F.G * 512) z[i] = (u32x4){0u, 0u, 0u, 0u};
}

__device__ __forceinline__ float* hrow(Frame& F, int r) { return r < MC ? (float*)(F.ws + WS_HCTX) + (size_t)r * D : F.out + (size_t)(r - MC) * D; }
template <bool INIT, bool HAS_Y, bool HAS_U>
__device__ __forceinline__ void nrm_rows(Frame& F, int row_lo, int row_hi, float wgt, const float* gpost, const float* mod_g, int gate_slot,
                                         const float* gpre, const float* mod_u, int shift_slot, int scale_slot) {
    const int tid_ = fresh_tid(); const int lane_ = tid_ & 63, wave_ = __builtin_amdgcn_readfirstlane(tid_ >> 6), gw_ = F.wg * NWAVES + wave_; (void)lane_; (void)gw_;
    const float* Y = (const float*)(F.ws + WS_Y); bf16* U = (bf16*)(F.ws + WS_U); const float* PE = (const float*)(F.ws + WS_PE);
    for (int r = row_lo + gw_; r < row_hi; r += F.NGW) {
        const int bb = r < MC ? 8 : (r - MC) >> 12;
        float* hp = hrow(F, r);
        f32x4 hv[8];
        if (INIT) {
            if (r < MC) {
#pragma unroll
                for (int j = 0; j < 8; ++j) hv[j] = *(const f32x4*)(F.A.in[I_CTX] + (size_t)r * D + 256 * j + 4 * lane_);
            } else {
                const int t = (r - MC) & (SEQ - 1), prow = t >> 6, pcol = t & 63;
#pragma unroll
                for (int j = 0; j < 8; ++j) { const int d0 = 256 * j + 4 * lane_;
                    const f32x4 xv = *(const f32x4*)(F.A.in[I_X] + (size_t)(r - MC) * D + d0);
                    const f32x4 pv = j < 4 ? *(const f32x4*)(PE + prow * 1024 + d0) : *(const f32x4*)(PE + pcol * 1024 + d0 - 1024);
                    hv[j] = xv + pv; }
            }
        } else {
#pragma unroll
            for (int j = 0; j < 8; ++j) hv[j] = *(const f32x4*)(hp + 256 * j + 4 * lane_);
        }
        if (HAS_Y) {
            f32x4 yv[8]; float ss = 0.f;
#pragma unroll
            for (int j = 0; j < 8; ++j) { yv[j] = *(const f32x4*)(Y + (size_t)r * D + 256 * j + 4 * lane_); ss += (yv[j].x * yv[j].x + yv[j].y * yv[j].y) + (yv[j].z * yv[j].z + yv[j].w * yv[j].w); }
            const float r1 = rsqrtf(wave_sum(ss) * (1.0f / D) + EPS) * wgt;
#pragma unroll
            for (int j = 0; j < 8; ++j) { const int d0 = 256 * j + 4 * lane_;
                const f32x4 gp = *(const f32x4*)(gpost + d0); const f32x4 gt = *(const f32x4*)(mod_g + ((size_t)bb * 9 + gate_slot) * D + d0);
                hv[j] = hv[j] + gt * (yv[j] * r1 * gp); }
        }
        if (INIT || HAS_Y) {
#pragma unroll
            for (int j = 0; j < 8; ++j) *(f32x4*)(hp + 256 * j + 4 * lane_) = hv[j];
        }
        if (HAS_U) {
            float ss = 0.f;
#pragma unroll
            for (int j = 0; j < 8; ++j) ss += (hv[j].x * hv[j].x + hv[j].y * hv[j].y) + (hv[j].z * hv[j].z + hv[j].w * hv[j].w);
            const float r2 = rsqrtf(wave_sum(ss) * (1.0f / D) + EPS);
#pragma unroll
            for (int j = 0; j < 8; ++j) { const int d0 = 256 * j + 4 * lane_;
                const f32x4 gn = *(const f32x4*)(gpre + d0); const f32x4 sh = *(const f32x4*)(mod_u + ((size_t)bb * 9 + shift_slot) * D + d0); const f32x4 sc = *(const f32x4*)(mod_u + ((size_t)bb * 9 + scale_slot) * D + d0);
                const f32x4 u = (hv[j] * r2 * gn) * (sc + 1.0f) + sh;
                u32x2 w; w.x = pk2(u.x, u.y); w.y = pk2(u.z, u.w);
                *(u32x2*)(U + (size_t)r * D + d0) = w; }
        }
    }
}

__device__ __forceinline__ void unpack8(const u32x4 v, float (&f)[8]) { f[0] = bflo(v.x); f[1] = bfhi(v.x); f[2] = bflo(v.y); f[3] = bfhi(v.y); f[4] = bflo(v.z); f[5] = bfhi(v.z); f[6] = bflo(v.w); f[7] = bfhi(v.w); }
__device__ __forceinline__ u32x4 pack8(const float (&f)[8]) { u32x4 o; o.x = pk2(f[0], f[1]); o.y = pk2(f[2], f[3]); o.z = pk2(f[4], f[5]); o.w = pk2(f[6], f[7]); return o; }
__device__ __forceinline__ void comb0_rows(Frame& F, int row_lo, int row_hi) {
    const int tid_ = fresh_tid(); const int lane_ = tid_ & 63, wave_ = __builtin_amdgcn_readfirstlane(tid_ >> 6), gw_ = F.wg * NWAVES + wave_; (void)lane_; (void)gw_;
    const bf16* OFb = (const bf16*)(F.ws + WS_Y); const bf16* OBb = OFb + (size_t)M * 1024; const bf16* HFb = OBb + (size_t)M * 1024; const bf16* HBb = HFb + (size_t)M * 1024;
    const bf16* P = (const bf16*)(F.ws + WS_BIG); bf16* U = (bf16*)(F.ws + WS_U); const float* gg = F.A.in[I_GLANG];
    const int e0 = 16 * lane_;
    for (int r = row_lo + gw_; r < row_hi; r += F.NGW) {
#pragma unroll
        for (int part = 0; part < 2; ++part) {
            const bf16* fa = (part ? HFb : OFb) + (size_t)r * 1024 + e0; const bf16* fb = (part ? HBb : OBb) + (size_t)r * 1024 + e0;
            const bf16* gp = P + (size_t)r * NP0 + (part ? 4096 : 2048) + e0;
            float a[2][8], b8[8], g[2][8];
            unpack8(*(const u32x4*)fa, a[0]); unpack8(*(const u32x4*)(fa + 8), a[1]);
            unpack8(*(const u32x4*)fb, b8);
#pragma unroll
            for (int e = 0; e < 8; ++e) a[0][e] += b8[e];
            unpack8(*(const u32x4*)(fb + 8), b8);
#pragma unroll
            for (int e = 0; e < 8; ++e) a[1][e] += b8[e];
            unpack8(*(const u32x4*)gp, g[0]); unpack8(*(const u32x4*)(gp + 8), g[1]);
            float o[2][8];
            if (part == 0) {
                float ss = 0.f;
#pragma unroll
                for (int c = 0; c < 2; ++c)
#pragma unroll
                    for (int e = 0; e < 8; ++e) ss += a[c][e] * a[c][e];
                ss += __shfl_xor(ss, 1); ss += __shfl_xor(ss, 2); ss += __shfl_xor(ss, 4); ss += __shfl_xor(ss, 8);
                const float rr = rsqrtf(ss * (1.0f / 256.0f) + EPS);
#pragma unroll
                for (int c = 0; c < 2; ++c)
#pragma unroll
                    for (int e = 0; e < 8; ++e) o[c][e] = a[c][e] * rr * gg[(e0 & 255) + 8 * c + e] * silu_f(g[c][e]);
            } else {
#pragma unroll
                for (int c = 0; c < 2; ++c)
#pragma unroll
                    for (int e = 0; e < 8; ++e) o[c][e] = a[c][e] * gelu_tanh_f(g[c][e]);
            }
            bf16* up = U + (size_t)r * D + part * 1024 + e0;
            *(u32x4*)up = pack8(o[0]); *(u32x4*)(up + 8) = pack8(o[1]);
        }
    }
}
__device__ __forceinline__ void comb1_rows(Frame& F, int row_lo, int row_hi) {
    const int tid_ = fresh_tid(); const int lane_ = tid_ & 63, wave_ = __builtin_amdgcn_readfirstlane(tid_ >> 6), gw_ = F.wg * NWAVES + wave_; (void)lane_; (void)gw_;
    const bf16* HFb = (const bf16*)(F.ws + WS_Y); const bf16* HBb = HFb + (size_t)M * D;
    const bf16* P = (const bf16*)(F.ws + WS_BIG); bf16* U = (bf16*)(F.ws + WS_U); const float* gg = F.A.in[I_MLNG];
    const int e0 = 32 * lane_;
    for (int r = row_lo + gw_; r < row_hi; r += F.NGW) {
        float a[32]; float ss = 0.f;
#pragma unroll
        for (int c = 0; c < 4; ++c) { float x8[8], y8[8]; unpack8(*(const u32x4*)(HFb + (size_t)r * D + e0 + 8 * c), x8); unpack8(*(const u32x4*)(HBb + (size_t)r * D + e0 + 8 * c), y8);
#pragma unroll
            for (int e = 0; e < 8; ++e) { a[8 * c + e] = x8[e] + y8[e]; ss += a[8 * c + e] * a[8 * c + e]; } }
        ss += __shfl_xor(ss, 1); ss += __shfl_xor(ss, 2); ss += __shfl_xor(ss, 4);
        const float rr = rsqrtf(ss * (1.0f / 256.0f) + EPS);
#pragma unroll
        for (int c = 0; c < 4; ++c) { float g8[8], o8[8]; unpack8(*(const u32x4*)(P + (size_t)r * NP1 + 4096 + e0 + 8 * c), g8);
#pragma unroll
            for (int e = 0; e < 8; ++e) o8[e] = a[8 * c + e] * rr * gg[((e0 + 8 * c) & 255) + e] * sigmoid_f(g8[e]);
            *(u32x4*)(U + (size_t)r * D + e0 + 8 * c) = pack8(o8); }
    }
}

__device__ __forceinline__ int chunk_rlo(int b, int dir, int c) {
    return c < 4 ? b * CTXL + (dir ? (CTXL - 64 - 64 * c) : 64 * c) : MC + b * SEQ + (dir ? (SEQ - 64 - 64 * (c - 4)) : 64 * (c - 4));
}
__device__ __forceinline__ bf16x8 tr_frag(LAS unsigned char* tile, int pitch, int k0, int c0, int lane) {
    const int g = lane >> 4, q = (lane & 15) >> 2, p = lane & 3;
    LAS unsigned char* a0 = tile + (k0 + 8 * g + q) * pitch + (c0 + 4 * p) * 2;
    const bf16x4 lo = __builtin_amdgcn_ds_read_tr16_b64_v4i16((LAS bf16x4*)a0);
    const bf16x4 hi = __builtin_amdgcn_ds_read_tr16_b64_v4i16((LAS bf16x4*)(a0 + 4 * pitch));
    return __builtin_shufflevector(lo, hi, 0, 1, 2, 3, 4, 5, 6, 7);
}
__device__ __forceinline__ u32x4 scale8(const u32x4 v, float s) {
    u32x4 o; o.x = pk2(bflo(v.x) * s, bfhi(v.x) * s); o.y = pk2(bflo(v.y) * s, bfhi(v.y) * s); o.z = pk2(bflo(v.z) * s, bfhi(v.z) * s); o.w = pk2(bflo(v.w) * s, bfhi(v.w) * s); return o;
}
__device__ __forceinline__ float wave_incl_sum(float x, int lane) {
#pragma unroll
    for (int o = 1; o < 64; o <<= 1) { const float t = __shfl_up(x, o); if (lane >= o) x += t; }
    return x;
}
__device__ __forceinline__ float wave_incl_max(float x, int lane) {
#pragma unroll
    for (int o = 1; o < 64; o <<= 1) { const float t = __shfl_up(x, o); if (lane >= o) x = fmaxf(x, t); }
    return x;
}

template <int MODE>
__device__ __forceinline__ void chain_scan(LAS unsigned char* lds,
        const bf16* __restrict__ proj, const int NP, const int qcol, const int kcol, const int vcol,
        const float* __restrict__ gates, const int gcol, const int b, const int dir,
        bf16* __restrict__ outb, const int out_ld, const int ocol, const bool ctx_out,
        const float* __restrict__ w2, const float* __restrict__ ba, const float bias_i, const float bias_f) {
    const int tid = fresh_tid(); const int lane = tid & 63, wave = __builtin_amdgcn_readfirstlane(tid >> 6);
    constexpr int NVB = MODE ? 9 : 8;
    constexpr int PQ = 272, PV = 304, PP = 144;
    constexpr int O_QS = 0, O_KS = 17408, O_QH = 34816, O_KH = 52224, O_VS = 69632, O_PS = 89088, O_SB = 98304, O_SM = 137472;
    LAS float* LR = (LAS float*)(lds + O_SM);
    LAS float* TOT = (LAS float*)(lds + O_SM + 4096);
    LAS float* FIRST = (LAS float*)(lds + O_SM + 8192);
    LAS float* DEC = (LAS float*)(lds + O_SM + 8704);
    LAS float* A_ = (LAS float*)(lds + O_SM);
    LAS float* MI = A_ + 64; LAS float* WI = A_ + 128; LAS float* WK = A_ + 192; LAS float* MR = A_ + 256; LAS float* DEN = A_ + 320; LAS float* DECS = A_ + 384;
    const int fr = lane & 15, fq = lane >> 4;

    __syncthreads();
    for (int i = tid; i < (9216 + 39168) / 16; i += 512) *(LAS u32x4*)(lds + O_PS + 16 * i) = (u32x4){0u, 0u, 0u, 0u};
    if (MODE) { if (tid < 64) { *(LAS u32x4*)(lds + O_VS + tid * PV + 256) = (u32x4){0x3F80u, 0u, 0u, 0u}; *(LAS u32x4*)(lds + O_VS + tid * PV + 272) = (u32x4){0u, 0u, 0u, 0u}; } }
    f32x4 S[NVB];
#pragma unroll
    for (int v = 0; v < NVB; ++v) S[v] = (f32x4){0.f, 0.f, 0.f, 0.f};
    float mst = 0.f;
    const int dp = tid & 63, d0 = 2 * dp, jg = wave;
    f32x2 w2r[16]; f32x2 bar = (f32x2){0.f, 0.f};
    if (MODE == 0) {
#pragma unroll
        for (int r = 0; r < 16; ++r) w2r[r] = *(const f32x2*)(w2 + r * 512 + d0);
        bar = *(const f32x2*)(ba + d0);
    }
    const int sj0 = tid >> 4, sj1 = (tid + 512) >> 4, sch = tid & 15;
    u32x4 pq[2], pk[2], pv[2]; f32x4 plr = (f32x4){0.f, 0.f, 0.f, 0.f}; float pgi = 0.f, pgf = 0.f;
#define CH_PREFETCH(cc) do { const int rl_ = chunk_rlo(b, dir, (cc)); \
        { const int row_ = dir ? rl_ + 63 - sj0 : rl_ + sj0; const bf16* rp_ = proj + (size_t)row_ * NP + 8 * sch; pq[0] = *(const u32x4*)(rp_ + qcol); pk[0] = *(const u32x4*)(rp_ + kcol); pv[0] = *(const u32x4*)(rp_ + vcol); } \
        { const int row_ = dir ? rl_ + 63 - sj1 : rl_ + sj1; const bf16* rp_ = proj + (size_t)row_ * NP + 8 * sch; pq[1] = *(const u32x4*)(rp_ + qcol); pk[1] = *(const u32x4*)(rp_ + kcol); pv[1] = *(const u32x4*)(rp_ + vcol); } \
        if (MODE == 0) { if (tid < 256) { const int j_ = tid >> 2; const int row_ = dir ? rl_ + 63 - j_ : rl_ + j_; plr = *(const f32x4*)(gates + (size_t)row_ * 32 + gcol + 4 * (tid & 3)); } } \
        else { if (wave == 0) { const int row_ = dir ? rl_ + 63 - lane : rl_ + lane; pgi = gates[(size_t)row_ * 32 + gcol]; pgf = gates[(size_t)row_ * 32 + gcol + 8]; } } } while (0)
    CH_PREFETCH(0);
    for (int c = 0; c < NCH; ++c) {
        const int rl = chunk_rlo(b, dir, c);
        *(LAS u32x4*)(lds + O_QS + sj0 * PQ + 16 * sch) = pq[0]; *(LAS u32x4*)(lds + O_QS + sj1 * PQ + 16 * sch) = pq[1];
        *(LAS u32x4*)(lds + O_KS + sj0 * PQ + 16 * sch) = pk[0]; *(LAS u32x4*)(lds + O_KS + sj1 * PQ + 16 * sch) = pk[1];
        *(LAS u32x4*)(lds + O_VS + sj0 * PV + 16 * sch) = pv[0]; *(LAS u32x4*)(lds + O_VS + sj1 * PV + 16 * sch) = pv[1];
        if (MODE == 0) { if (tid < 256) *(LAS f32x4*)(LR + (tid >> 2) * 16 + 4 * (tid & 3)) = plr; }
        const float gi = pgi, gf = pgf;
        if (c + 1 < NCH) CH_PREFETCH(c + 1);
        __syncthreads();
        if (MODE == 0) {
            f32x2 cs[8]; f32x2 run = (f32x2){0.f, 0.f};
#pragma unroll
            for (int jj = 0; jj < 8; ++jj) {
                const int j = 8 * jg + jj;
                f32x2 z = bar;
#pragma unroll
                for (int r4 = 0; r4 < 4; ++r4) { const f32x4 l4 = *(const LAS f32x4*)(LR + j * 16 + 4 * r4);
                    z += w2r[4 * r4 + 0] * l4.x; z += w2r[4 * r4 + 1] * l4.y; z += w2r[4 * r4 + 2] * l4.z; z += w2r[4 * r4 + 3] * l4.w; }
                f32x2 la; la.x = fmaxf(logsig_f(z.x) * (1.0f / 16.0f), -1.0f); la.y = fmaxf(logsig_f(z.y) * (1.0f / 16.0f), -1.0f);
                run += la; cs[jj] = run;
            }
            *(LAS f32x2*)(TOT + jg * 128 + d0) = run;
            if (jg == 4) *(LAS f32x2*)(FIRST + d0) = cs[0];
            __syncthreads();
            f32x2 pre = (f32x2){0.f, 0.f}, bref = (f32x2){0.f, 0.f}, blast = (f32x2){0.f, 0.f};
#pragma unroll
            for (int g = 0; g < 8; ++g) { const f32x2 t = *(const LAS f32x2*)(TOT + g * 128 + d0); if (g < jg) pre += t; if (g < 4) bref += t; blast += t; }
            bref += *(const LAS f32x2*)(FIRST + d0);
#pragma unroll
            for (int jj = 0; jj < 8; ++jj) {
                const int j = 8 * jg + jj; const f32x2 bb = pre + cs[jj];
                const unsigned qw = *(const LAS unsigned*)(lds + O_QS + j * PQ + 4 * dp), kw = *(const LAS unsigned*)(lds + O_KS + j * PQ + 4 * dp);
                const float q0 = bflo(qw) * QSCALE, q1 = bfhi(qw) * QSCALE, k0 = bflo(kw), k1 = bfhi(kw);
                *(LAS unsigned*)(lds + O_QS + j * PQ + 4 * dp) = pk2(q0 * __expf(bb.x - bref.x), q1 * __expf(bb.y - bref.y));
                *(LAS unsigned*)(lds + O_QH + j * PQ + 4 * dp) = pk2(q0 * __expf(bb.x), q1 * __expf(bb.y));
                *(LAS unsigned*)(lds + O_KS + j * PQ + 4 * dp) = pk2(k0 * __expf(bref.x - bb.x), k1 * __expf(bref.y - bb.y));
                *(LAS unsigned*)(lds + O_KH + j * PQ + 4 * dp) = pk2(k0 * __expf(blast.x - bb.x), k1 * __expf(blast.y - bb.y));
            }
            if (jg == 0) { f32x2 dv; dv.x = __expf(blast.x); dv.y = __expf(blast.y); *(LAS f32x2*)(DEC + d0) = dv; }
        } else {
            if (wave == 0) {
                const float ipre = gi + bias_i, lf = logsig_f(gf + bias_f);
                const float bsum = wave_incl_sum(lf, lane);
                const float a = ipre - bsum;
                const float cm = wave_incl_max(a, lane);
                const float Mi = fmaxf(mst, cm);
                const float blast = __shfl(bsum, 63), M63 = __shfl(Mi, 63);
                A_[lane] = a; MI[lane] = Mi; WI[lane] = __expf(mst - Mi) * QSCALE; WK[lane] = __expf(a - M63); MR[lane] = __expf(-(bsum + Mi));
                if (lane == 0) DECS[0] = __expf(mst - M63);
                mst = blast + M63;
            }
            __syncthreads();
            { const float wi0 = WI[sj0], wi1 = WI[sj1], wk0 = WK[sj0], wk1 = WK[sj1];
              *(LAS u32x4*)(lds + O_QH + sj0 * PQ + 16 * sch) = scale8(*(const LAS u32x4*)(lds + O_QS + sj0 * PQ + 16 * sch), wi0);
              *(LAS u32x4*)(lds + O_QH + sj1 * PQ + 16 * sch) = scale8(*(const LAS u32x4*)(lds + O_QS + sj1 * PQ + 16 * sch), wi1);
              *(LAS u32x4*)(lds + O_KH + sj0 * PQ + 16 * sch) = scale8(*(const LAS u32x4*)(lds + O_KS + sj0 * PQ + 16 * sch), wk0);
              *(LAS u32x4*)(lds + O_KH + sj1 * PQ + 16 * sch) = scale8(*(const LAS u32x4*)(lds + O_KS + sj1 * PQ + 16 * sch), wk1); }
        }
        __syncthreads();
        for (int tix = wave; tix < 10; tix += 8) {
            const int ib = tix >= 6 ? 3 : (tix >= 3 ? 2 : (tix >= 1 ? 1 : 0)); const int jb = tix - ib * (ib + 1) / 2;
            f32x4 acc = (f32x4){0.f, 0.f, 0.f, 0.f};
#pragma unroll
            for (int ks = 0; ks < 4; ++ks) {
                const bf16x8 A = *(const LAS bf16x8*)(lds + O_KS + (16 * jb + fr) * PQ + (32 * ks + 8 * fq) * 2);
                const bf16x8 B = *(const LAS bf16x8*)(lds + O_QS + (16 * ib + fr) * PQ + (32 * ks + 8 * fq) * 2);
                acc = __builtin_amdgcn_mfma_f32_16x16x32_bf16(A, B, acc, 0, 0, 0);
            }
            const int i = 16 * ib + fr, j0 = 16 * jb + 4 * fq;
            float w[4];
            if (MODE) { const float Mi = MI[i];
#pragma unroll
                for (int r = 0; r < 4; ++r) w[r] = (j0 + r <= i) ? acc[r] * QSCALE * __expf(A_[j0 + r] - Mi) : 0.f;
            } else {
#pragma unroll
                for (int r = 0; r < 4; ++r) w[r] = (j0 + r <= i) ? acc[r] : 0.f;
            }
            u32x2 pw; pw.x = pk2(w[0], w[1]); pw.y = pk2(w[2], w[3]);
            *(LAS u32x2*)(lds + O_PS + i * PP + j0 * 2) = pw;
        }
        __syncthreads();
        const int ib = wave & 3, vb0 = (wave >> 2) * 4, irow = 16 * ib + fr;
        f32x4 ao[5];
#pragma unroll
        for (int v = 0; v < 5; ++v) ao[v] = (f32x4){0.f, 0.f, 0.f, 0.f};
#pragma unroll
        for (int ks = 0; ks < 2; ++ks) {
            const bf16x8 B = *(const LAS bf16x8*)(lds + O_PS + irow * PP + (32 * ks + 8 * fq) * 2);
#pragma unroll
            for (int v = 0; v < 4; ++v) { const bf16x8 A = tr_frag(lds + O_VS, PV, 32 * ks, 16 * (vb0 + v), lane); ao[v] = __builtin_amdgcn_mfma_f32_16x16x32_bf16(A, B, ao[v], 0, 0, 0); }
            if (MODE) { if (wave < 4) { const bf16x8 A = tr_frag(lds + O_VS, PV, 32 * ks, 128, lane); ao[4] = __builtin_amdgcn_mfma_f32_16x16x32_bf16(A, B, ao[4], 0, 0, 0); } }
        }
#pragma unroll
        for (int ks = 0; ks < 4; ++ks) {
            const bf16x8 B = *(const LAS bf16x8*)(lds + O_QH + irow * PQ + (32 * ks + 8 * fq) * 2);
#pragma unroll
            for (int v = 0; v < 4; ++v) { const bf16x8 A = *(const LAS bf16x8*)(lds + O_SB + (16 * (vb0 + v) + fr) * PQ + (32 * ks + 8 * fq) * 2); ao[v] = __builtin_amdgcn_mfma_f32_16x16x32_bf16(A, B, ao[v], 0, 0, 0); }
            if (MODE) { if (wave < 4) { const bf16x8 A = *(const LAS bf16x8*)(lds + O_SB + (128 + fr) * PQ + (32 * ks + 8 * fq) * 2); ao[4] = __builtin_amdgcn_mfma_f32_16x16x32_bf16(A, B, ao[4], 0, 0, 0); } }
        }
        const int db = wave;
        if (MODE == 0) { const f32x4 dec = *(const LAS f32x4*)(DEC + 16 * db + 4 * fq);
#pragma unroll
            for (int v = 0; v < NVB; ++v) S[v] = S[v] * dec;
        } else { const float dsc = DECS[0];
#pragma unroll
            for (int v = 0; v < NVB; ++v) S[v] = S[v] * dsc;
        }
#pragma unroll
        for (int ks = 0; ks < 2; ++ks) {
            const bf16x8 A = tr_frag(lds + O_KH, PQ, 32 * ks, 16 * db, lane);
#pragma unroll
            for (int v = 0; v < NVB; ++v) { const bf16x8 B = tr_frag(lds + O_VS, PV, 32 * ks, 16 * v, lane); S[v] = __builtin_amdgcn_mfma_f32_16x16x32_bf16(A, B, S[v], 0, 0, 0); }
        }
        if (MODE) { if (wave < 4 && lane < 16) DEN[16 * ib + lane] = ao[4][0]; }
        __syncthreads();
        if (ctx_out || c >= 4) {
            const int row = dir ? rl + 63 - irow : rl + irow;
            float sc = 1.0f;
            if (MODE) sc = 1.0f / fmaxf(fabsf(DEN[irow]), MR[irow]);
            bf16* op = outb + (size_t)row * out_ld + ocol + 16 * vb0 + 4 * fq;
#pragma unroll
            for (int v = 0; v < 4; ++v) { u32x2 w; w.x = pk2(ao[v][0] * sc, ao[v][1] * sc); w.y = pk2(ao[v][2] * sc, ao[v][3] * sc); *(u32x2*)(op + 16 * v) = w; }
        }
#pragma unroll
        for (int v = 0; v < NVB; ++v) { u32x2 w; w.x = pk2(S[v][0], S[v][1]); w.y = pk2(S[v][2], S[v][3]); *(LAS u32x2*)(lds + O_SB + (16 * v + fr) * PQ + (16 * db + 4 * fq) * 2) = w; }
    }
#undef CH_PREFETCH
    __syncthreads();
}

__device__ __forceinline__ void rg_chain(LAS unsigned char* lds,
        const bf16* __restrict__ proj, const int b, const int n, const int dir, const bf16* __restrict__ wrg,
        const float* __restrict__ lam, const float* __restrict__ b_a, const float* __restrict__ b_i, const float* __restrict__ conv_w, const float* __restrict__ conv_b,
        bf16* __restrict__ hout) {
    const int tid = fresh_tid(); const int lane = tid & 63, wave = __builtin_amdgcn_readfirstlane(tid >> 6);
    constexpr int O_XR = 0, O_XBF = 17408, O_XBH = 51200, O_AA = 68608, O_BX = 102400, O_CW = 136192;
    constexpr int PXF = 528, PXH = 272;
    const int fr = lane & 15, fq = lane >> 4;
    LAS float* CW = (LAS float*)(lds + O_CW);
    __syncthreads();
    for (int i = tid; i < 5 * 128; i += 512) CW[i] = i < 512 ? conv_w[(i >> 7) * 1024 + 128 * n + (i & 127)] : conv_b[128 * n + (i - 512)];
    bf16x8 Afr[2][4];
#pragma unroll
    for (int mat = 0; mat < 2; ++mat)
#pragma unroll
        for (int ks = 0; ks < 4; ++ks) Afr[mat][ks] = *(const bf16x8*)(wrg + ((size_t)((dir * 2 + mat) * 8 + n) * 128 + 16 * wave + fr) * 128 + 32 * ks + 8 * fq);
    f32x4 c8, bav, biv;
#pragma unroll
    for (int r = 0; r < 4; ++r) { const int ch = 128 * n + 16 * wave + 4 * fq + r; const float l = lam[dir * 1024 + ch];
        c8[r] = -8.0f * (fmaxf(-l, 0.f) + log1pf(expf(-fabsf(l)))); bav[r] = b_a[dir * 1024 + ch]; biv[r] = b_i[dir * 1024 + ch]; }
    float hst = 0.f;
    const int ch2 = tid & 63, tg = tid >> 6;
    u32x4 px[3];
#define RG_PREFETCH(cc) do { const int c_ = (cc); const int L_ = c_ < 4 ? CTXL : SEQ, cs_ = c_ < 4 ? c_ : c_ - 4, base_ = c_ < 4 ? b * CTXL : MC + b * SEQ; \
        const int t0_ = dir ? L_ - 64 * (cs_ + 1) : 64 * cs_; \
        _Pragma("unroll") for (int e_ = 0; e_ < 3; ++e_) { const int id_ = tid + 512 * e_, rr_ = id_ >> 4, tt_ = t0_ - 2 + rr_; \
            px[e_] = (rr_ < 67 && tt_ >= 0 && tt_ < L_) ? *(const u32x4*)(proj + (size_t)(base_ + tt_) * NP0 + 3072 + 128 * n + 8 * (id_ & 15)) : (u32x4){0u, 0u, 0u, 0u}; } } while (0)
    RG_PREFETCH(0);
    for (int c = 0; c < NCH; ++c) {
        const int L = c < 4 ? CTXL : SEQ, cs = c < 4 ? c : c - 4, base = c < 4 ? b * CTXL : MC + b * SEQ;
        const int t0 = dir ? L - 64 * (cs + 1) : 64 * cs;
#pragma unroll
        for (int e = 0; e < 3; ++e) { const int id = tid + 512 * e, rr = id >> 4; if (rr < 68) *(LAS u32x4*)(lds + O_XR + rr * 256 + 16 * (id & 15)) = px[e]; }
        if (c + 1 < NCH) RG_PREFETCH(c + 1);
        __syncthreads();
        {
            const f32x2 w0 = *(const LAS f32x2*)(CW + 0 * 128 + 2 * ch2), w1 = *(const LAS f32x2*)(CW + 1 * 128 + 2 * ch2), w2_ = *(const LAS f32x2*)(CW + 2 * 128 + 2 * ch2), w3 = *(const LAS f32x2*)(CW + 3 * 128 + 2 * ch2), cb = *(const LAS f32x2*)(CW + 512 + 2 * ch2);
            f32x2 xw[11];
#pragma unroll
            for (int rr = 0; rr < 11; ++rr) { const unsigned u = *(const LAS unsigned*)(lds + O_XR + (8 * tg + rr) * 256 + 4 * ch2); xw[rr].x = bflo(u); xw[rr].y = bfhi(u); }
#pragma unroll
            for (int jj = 0; jj < 8; ++jj) {
                f32x2 y = cb; y += xw[jj] * w0; y += xw[jj + 1] * w1; y += xw[jj + 2] * w2_; y += xw[jj + 3] * w3;
                *(LAS f32x2*)(lds + O_XBF + (8 * tg + jj) * PXF + 8 * ch2) = y;
                *(LAS unsigned*)(lds + O_XBH + (8 * tg + jj) * PXH + 4 * ch2) = pk2(y.x, y.y);
            }
        }
        __syncthreads();
#pragma unroll
        for (int tb = 0; tb < 4; ++tb) {
            f32x4 ga = (f32x4){0.f, 0.f, 0.f, 0.f}, gi = (f32x4){0.f, 0.f, 0.f, 0.f};
#pragma unroll
            for (int ks = 0; ks < 4; ++ks) { const bf16x8 B = *(const LAS bf16x8*)(lds + O_XBH + (16 * tb + fr) * PXH + (32 * ks + 8 * fq) * 2);
                ga = __builtin_amdgcn_mfma_f32_16x16x32_bf16(Afr[0][ks], B, ga, 0, 0, 0); gi = __builtin_amdgcn_mfma_f32_16x16x32_bf16(Afr[1][ks], B, gi, 0, 0, 0); }
            const int t = 16 * tb + fr;
            const f32x4 xb = *(const LAS f32x4*)(lds + O_XBF + t * PXF + (16 * wave + 4 * fq) * 4);
            f32x4 av, bx;
#pragma unroll
            for (int r = 0; r < 4; ++r) { const float rg = sigmoid_f(ga[r] + bav[r]), ig = sigmoid_f(gi[r] + biv[r]); const float la = c8[r] * rg;
                av[r] = __expf(la); bx[r] = sqrtf(-expm1f(2.0f * la)) * (ig * xb[r]); }
            *(LAS f32x4*)(lds + O_AA + t * PXF + (16 * wave + 4 * fq) * 4) = av;
            *(LAS f32x4*)(lds + O_BX + t * PXF + (16 * wave + 4 * fq) * 4) = bx;
        }
        __syncthreads();
        if (tid < 128) {
            bf16* hp = hout + (size_t)(base + t0) * 1024 + 128 * n + tid;
#pragma unroll 8
            for (int s = 0; s < 64; ++s) { const int jj = dir ? 63 - s : s;
                hst = *(const LAS float*)(lds + O_AA + jj * PXF + 4 * tid) * hst + *(const LAS float*)(lds + O_BX + jj * PXF + 4 * tid);
                hp[(size_t)jj * 1024] = (bf16)f2bf(hst); }
        }
    }
#undef RG_PREFETCH
    __syncthreads();
}

#ifndef MK_LAST_PHASE
#define MK_LAST_PHASE 24
#endif
constexpr int NPH = 24;
__global__ void __launch_bounds__(NWAVES * 64, 2) mk_fwd(Args args) {
    extern __shared__ __attribute__((aligned(16))) unsigned char lds_raw[];
    Frame F{(LAS unsigned char*)lds_raw, (int)gridDim.x, (int)blockIdx.x, (int)gridDim.x * NWAVES, args.out, args.ws, args};
    volatile LAS unsigned* MISC = (volatile LAS unsigned*)(F.lds + LDSCTL_OFF);
    for (int u = threadIdx.x; u < (LDS_BYTES - LDSCTL_OFF) / 4; u += NWAVES * 64) ((LAS unsigned*)(F.lds + LDSCTL_OFF))[u] = 0u;
    __syncthreads();
    const int lo = args.ph_lo, hi = args.ph_hi;
    const bool multi = (hi - lo) > 1;
    XcdBarrier bar; bar.bar = (unsigned*)(F.ws + WS_CTL) + CW_BAR; bar.x = 0; bar.st = nullptr;
    if (multi) bar = xcd_barrier_post((unsigned*)(F.ws + WS_CTL) + CW_BAR, MISC + 8);
#ifndef MK_OFFMASK
#define MK_OFFMASK 0x7FF
#endif
#ifndef MK_PREMASK
#define MK_PREMASK 3
#endif
#define IN(k) (lo <= (k) && (k) < hi)
#define INL(o) (((MK_OFFMASK >> (o)) & 1) && IN(pb + (o)))
#define SEAM(k) do { if (IN(k) && IN((k) + 1)) xcd_barrier(bar); } while (0)
    float* MOD = (float*)(F.ws + WS_MOD);
    bf16* U = (bf16*)(F.ws + WS_U); float* Y = (float*)(F.ws + WS_Y); bf16* BIG = (bf16*)(F.ws + WS_BIG); float* GATES = (float*)(F.ws + WS_GATES);

    if ((MK_PREMASK & 1) && IN(0)) { pre_mod(F); pre_pe(F); cvt_layer<0>(F); }
    SEAM(0);
    if ((MK_PREMASK & 2) && IN(1)) nrm_rows<true, false, true>(F, 0, M, 0.f, nullptr, nullptr, 0, F.A.in[I_NORMG], MOD, 0, 1);
    SEAM(1);
    for (int layer = 0; layer < 2; ++layer) {
        const int pb = 2 + 11 * layer; const bool last = layer == 1;
        const float* ng = F.A.in[I_NORMG] + (size_t)layer * 6 * D; const float* modl = MOD + (size_t)layer * 9 * 18432;
        const int NP = layer == 0 ? NP0 : NP1;
        const int rlo2 = last ? MC : 0;
        if (INL(0)) { pg8::Gemm g{U, (const bf16*)(F.ws + W_F1I), M, 2 * DFF, D}; pg8::StaticOrder S; S.init(M, 2 * DFF, F.G, F.wg); pg8::EpiSwiglu E{BIG, DFF};
            pg8::gemm_phase<pg8::EpiSwiglu, pg8::StaticOrder, PG8_ALIGN, PG8_SP2>(F.lds, g, S, E); }
        SEAM(pb + 0);
        if (INL(1)) { pg8::Gemm g{BIG, (const bf16*)(F.ws + W_F1O), M, D, DFF}; pg8::StaticOrder S; S.init(M, D, F.G, F.wg); pg8::EpiF32 E{Y, D};
            pg8::gemm_phase<pg8::EpiF32, pg8::StaticOrder, PG8_ALIGN, PG8_SP2>(F.lds, g, S, E); }
        SEAM(pb + 1);
        if (INL(2)) nrm_rows<false, true, true>(F, 0, M, 0.5f, ng + 1 * D, modl, 2, ng + 2 * D, modl, 3, 4);
        SEAM(pb + 2);
        if (INL(3)) { pg8::Gemm g{U, (const bf16*)(F.ws + W_MI), M, NP, D}; pg8::StaticOrder S; S.init(M, NP, F.G, F.wg); pg8::EpiProj E{BIG, NP, GATES, NP / 256 - 1};
            pg8::gemm_phase<pg8::EpiProj, pg8::StaticOrder, PG8_ALIGN, PG8_SP2>(F.lds, g, S, E); }
        SEAM(pb + 3);
        if (INL(4)) {
            if (layer == 0) {
                bf16* OFb = (bf16*)Y; bf16* OBb = OFb + (size_t)M * 1024; bf16* HFb = OBb + (size_t)M * 1024; bf16* HBb = HFb + (size_t)M * 1024;
                for (int item = F.wg; item < 256; item += F.G) {
                    if (item < 128) { const int ci = item >> 1, vh = item & 1, b = ci >> 3, h = (ci >> 1) & 3, dir = ci & 1;
                        chain_scan<0>(F.lds, BIG, NP0, h * 128, 512 + h * 128, 1024 + h * 256 + vh * 128, GATES, dir * 16, b, dir,
                                      dir ? OBb : OFb, 1024, h * 256 + vh * 128, true, F.A.in[I_WALPHA2] + (size_t)dir * 16 * 512 + h * 128, F.A.in[I_BALPHA] + dir * 512 + h * 128, 0.f, 0.f);
                    } else { const int ri = item - 128, b = ri >> 4, n = (ri >> 1) & 7, dir = ri & 1;
                        rg_chain(F.lds, BIG, b, n, dir, (const bf16*)(F.ws + WS_WRG), F.A.in[I_LAM], F.A.in[I_RGBA], F.A.in[I_RGBI], F.A.in[I_CONVW], F.A.in[I_CONVB], dir ? HBb : HFb);
                    }
                }
            } else {
                bf16* HFb = (bf16*)Y; bf16* HBb = HFb + (size_t)M * D;
                for (int item = F.wg; item < 256; item += F.G) { const int ci = item >> 1, vh = item & 1, b = ci >> 4, h = (ci >> 1) & 7, dir = ci & 1;
                    chain_scan<1>(F.lds, BIG, NP1, h * 128, 1024 + h * 128, 2048 + h * 256 + vh * 128, GATES, dir * 16 + h, b, dir,
                                  dir ? HBb : HFb, D, h * 256 + vh * 128, false, nullptr, nullptr, F.A.in[I_MLBG][dir * 16 + h], F.A.in[I_MLBG][dir * 16 + 8 + h]);
                }
            }
        }
        SEAM(pb + 4);
        if (INL(5)) { if (layer == 0) comb0_rows(F, 0, M); else comb1_rows(F, MC, M); }
        SEAM(pb + 5);
        if (INL(6)) { pg8::Gemm g{U + (size_t)rlo2 * D, (const bf16*)(F.ws + W_MO), M - rlo2, D, D}; pg8::StaticOrder S; S.init(M - rlo2, D, F.G, F.wg); pg8::EpiF32 E{Y + (size_t)rlo2 * D, D};
            pg8::gemm_phase<pg8::EpiF32, pg8::StaticOrder, PG8_ALIGN, PG8_SP2>(F.lds, g, S, E); }
        SEAM(pb + 6);
        if (INL(7)) nrm_rows<false, true, true>(F, rlo2, M, 1.0f, ng + 3 * D, modl, 5, ng + 4 * D, modl, 6, 7);
        SEAM(pb + 7);
        if (INL(8)) { pg8::Gemm g{U + (size_t)rlo2 * D, (const bf16*)(F.ws + W_F2I), M - rlo2, 2 * DFF, D}; pg8::StaticOrder S; S.init(M - rlo2, 2 * DFF, F.G, F.wg); pg8::EpiSwiglu E{BIG + (size_t)rlo2 * DFF, DFF};
            pg8::gemm_phase<pg8::EpiSwiglu, pg8::StaticOrder, PG8_ALIGN, PG8_SP2>(F.lds, g, S, E); }
        SEAM(pb + 8);
        if (INL(9)) { pg8::Gemm g{BIG + (size_t)rlo2 * DFF, (const bf16*)(F.ws + W_F2O), M - rlo2, D, DFF}; pg8::StaticOrder S; S.init(M - rlo2, D, F.G, F.wg); pg8::EpiF32 E{Y + (size_t)rlo2 * D, D};
            pg8::gemm_phase<pg8::EpiF32, pg8::StaticOrder, PG8_ALIGN, PG8_SP2>(F.lds, g, S, E); }
        SEAM(pb + 9);
        if (INL(10)) {
            if (!last) { nrm_rows<false, true, true>(F, 0, M, 0.5f, ng + 5 * D, modl, 8, F.A.in[I_NORMG] + 6 * D, MOD + (size_t)9 * 18432, 0, 1); __syncthreads(); cvt_layer<1>(F); }
            else nrm_rows<false, true, false>(F, MC, M, 0.5f, ng + 5 * D, modl, 8, nullptr, nullptr, 0, 0);
        }
        SEAM(pb + 10);
    }
#undef IN
#undef SEAM
}

extern "C" void kernel_launch(void* const* d_in, const int* in_sizes, int n_in, void* d_out, int out_size, void* d_ws, size_t ws_size, hipStream_t stream) {
    static int grid = 0;
    if (grid == 0) {
        if (n_in != 27 || out_size != MLAT * D || ws_size < WS_END) { fprintf(stderr, "kernel_launch: unexpected problem (n_in %d, out %d, ws %zu; need ws >= %zu); nothing launched\n", n_in, out_size, ws_size, (size_t)WS_END); grid = -1; return; }
        int dev = 0, cus = 0, per_cu = 0;
        if (hipGetDevice(&dev) != hipSuccess || hipDeviceGetAttribute(&cus, hipDeviceAttributeMultiprocessorCount, dev) != hipSuccess) { fprintf(stderr, "kernel_launch: device query failed\n"); grid = -1; return; }
        if (hipFuncSetAttribute((const void*)mk_fwd, hipFuncAttributeMaxDynamicSharedMemorySize, LDS_BYTES) != hipSuccess) { fprintf(stderr, "kernel_launch: hipFuncSetAttribute failed\n"); grid = -1; return; }
        if (hipOccupancyMaxActiveBlocksPerMultiprocessor(&per_cu, (const void*)mk_fwd, NWAVES * 64, LDS_BYTES) != hipSuccess || per_cu < 1)
            fprintf(stderr, "kernel_launch: note: occupancy query reports %d workgroups per CU\n", per_cu);
        (void)hipGetLastError();
        grid = cus;
    }
    if (grid < 0) return;
    if (hipMemsetAsync((char*)d_ws + WS_CTL, 0, CTL_ZERO_BYTES, stream) != hipSuccess) { fprintf(stderr, "kernel_launch: memset failed\n"); return; }
    Args a{};
    for (int i = 0; i < 27; ++i) a.in[i] = (const float*)d_in[i];
    a.out = (float*)d_out; a.ws = (unsigned char*)d_ws;
#if defined(MK_SPLIT)
    for (int p = 0; p < MK_LAST_PHASE; ++p) { a.ph_lo = p; a.ph_hi = p + 1; hipLaunchKernelGGL(mk_fwd, dim3(grid), dim3(NWAVES * 64), LDS_BYTES, stream, a); }
#else
    a.ph_lo = 0; a.ph_hi = MK_LAST_PHASE;
    hipLaunchKernelGGL(mk_fwd, dim3(grid), dim3(NWAVES * 64), LDS_BYTES, stream, a);
#endif
    const hipError_t le = hipPeekAtLastError();
    if (le != hipSuccess) fprintf(stderr, "kernel_launch: launch failed: %s\n", hipGetErrorName(le));
}
```

```cpp
#include <hip/hip_runtime.h>
#include <cstdio>
#include <cstdint>
__device__ __forceinline__ int fresh_tid() { int t = threadIdx.x; asm volatile("" : "+v"(t)); return t; }
namespace pg8 {
#define PG8_LAS __attribute__((address_space(3)))
typedef unsigned short bf16_t;
typedef short bf16x8 __attribute__((ext_vector_type(8)));
typedef float f32x4 __attribute__((ext_vector_type(4)));
typedef unsigned u32x4 __attribute__((ext_vector_type(4)));
constexpr int BM = 256, BK = 64, HALF = 128, HTB = HALF * BK * 2  , STAGE_BYTES = 8 * HTB, NXCD = 8, WGM = 8;

__host__ __device__ __forceinline__ int lds_byte(int r, int c) { const int st = (r >> 4) * 2 + (c >> 5), rr = r & 15, cc = c & 31, ob = rr * 64 + cc * 2; return st * 1024 + (ob ^ (((ob >> 9) & 1) << 5)); }
__host__ __device__ __forceinline__ void stage_rc(int b, int& R, int& C) { const int st = b / 1024, sb = b % 1024, swz = sb ^ (((sb >> 9) & 1) << 5); R = (st >> 1) * 16 + swz / 64; C = (st & 1) * 32 + (swz % 64) / 2; }
__host__ __device__ __forceinline__ int perm32(int rho) { const int n = rho >> 4, i = rho & 15; return 8 * (i >> 2) + 4 * n + (i & 3); }

struct Unit { int pm, pn; };
struct Gemm { const bf16_t* A; const bf16_t* Bt; int M, N, K; };

struct StaticOrder {
    int nM, nN, nwg, G, c;
    __host__ __device__ void init(int M, int N, int G_, int c_) { nM = M / BM; nN = N / BM; nwg = nM * nN; G = G_; c = c_; }
    __host__ __device__ bool next(int i, Unit& u) const {
        const long L = (long)i * G + c; if (L >= nwg) return false;
        int wgid = (int)L; { const int q = nwg / NXCD, r = nwg % NXCD, xcd = wgid % NXCD, off = wgid / NXCD; wgid = (xcd < r ? xcd * (q + 1) : r * (q + 1) + (xcd - r) * q) + off; }
        const int nig = WGM * nN, gid = wgid / nig, fm = gid * WGM, gsz = (nM - fm) < WGM ? (nM - fm) : WGM;
        u.pm = fm + ((wgid % nig) % gsz); u.pn = (wgid % nig) / gsz; return true;
    }
    __device__ __forceinline__ void a_ready(const Unit&) const {}
    __device__ __forceinline__ void done(const Unit&) const {}
};

__device__ __forceinline__ unsigned cvt_pk_bf16(float lo, float hi) { unsigned r; asm volatile("v_cvt_pk_bf16_f32 %0, %1, %2" : "=v"(r) : "v"(lo), "v"(hi)); return r; }
__device__ __forceinline__ float silu_f(float x) { return x * __builtin_amdgcn_rcpf(1.0f + __expf(-x)); }

struct EpiF32 {
    static constexpr bool PERM = false, AFTER_DRAIN = false;
    float* C; int ldc;
    __device__ __forceinline__ void operator()(const f32x4 (&acc)[2][2][4][2], const Unit& u, int wr, int wc, int fr, int fq) const {
        const int row0 = u.pm * BM + wr * 64 + fr, col0 = u.pn * BM + wc * 32 + 4 * fq;
#pragma unroll
        for (int ai = 0; ai < 2; ++ai)
#pragma unroll
            for (int m = 0; m < 4; ++m) { float* rowp = C + (size_t)(row0 + ai * HALF + m * 16) * ldc + col0;
#pragma unroll
                for (int bj = 0; bj < 2; ++bj)
#pragma unroll
                    for (int n = 0; n < 2; ++n) *(f32x4*)(rowp + bj * HALF + n * 16) = acc[ai][bj][m][n]; }
    }
};
struct EpiY {
    static constexpr bool PERM = true, AFTER_DRAIN = false;
    bf16_t* O; int ldc;
    __device__ __forceinline__ void operator()(const f32x4 (&acc)[2][2][4][2], const Unit& u, int wr, int wc, int fr, int fq) const {
        const int row0 = u.pm * BM + wr * 64 + fr, col0 = u.pn * BM + wc * 32 + 8 * fq;
#pragma unroll
        for (int ai = 0; ai < 2; ++ai)
#pragma unroll
            for (int m = 0; m < 4; ++m) { bf16_t* rowp = O + (size_t)(row0 + ai * HALF + m * 16) * ldc + col0;
#pragma unroll
                for (int bj = 0; bj < 2; ++bj) { const f32x4 v0 = acc[ai][bj][m][0], v1 = acc[ai][bj][m][1];
                    u32x4 w; w.x = cvt_pk_bf16(v0[0], v0[1]); w.y = cvt_pk_bf16(v0[2], v0[3]); w.z = cvt_pk_bf16(v1[0], v1[1]); w.w = cvt_pk_bf16(v1[2], v1[3]);
                    *(u32x4*)(rowp + bj * HALF) = w; } }
    }
};
struct EpiSwiglu {
    static constexpr bool PERM = true, AFTER_DRAIN = false;
    bf16_t* O; int ldc;
    __device__ __forceinline__ void operator()(const f32x4 (&acc)[2][2][4][2], const Unit& u, int wr, int wc, int fr, int fq) const {
        const int row0 = u.pm * BM + wr * 64 + fr, col0 = u.pn * HALF + wc * 32 + 8 * fq;
#pragma unroll
        for (int ai = 0; ai < 2; ++ai)
#pragma unroll
            for (int m = 0; m < 4; ++m) { bf16_t* rowp = O + (size_t)(row0 + ai * HALF + m * 16) * ldc + col0;
                const f32x4 a0 = acc[ai][0][m][0], a1 = acc[ai][0][m][1], b0 = acc[ai][1][m][0], b1 = acc[ai][1][m][1];
                f32x4 v0, v1;
#pragma unroll
                for (int j = 0; j < 4; ++j) { v0[j] = silu_f(a0[j]) * b0[j]; v1[j] = silu_f(a1[j]) * b1[j]; }
                u32x4 w; w.x = cvt_pk_bf16(v0[0], v0[1]); w.y = cvt_pk_bf16(v0[2], v0[3]); w.z = cvt_pk_bf16(v1[0], v1[1]); w.w = cvt_pk_bf16(v1[2], v1[3]);
                *(u32x4*)rowp = w; }
    }
};
struct EpiProj {
    static constexpr bool PERM = true, AFTER_DRAIN = false;
    bf16_t* O; int ldc; float* gates; int gate_pn;
    __device__ __forceinline__ void operator()(const f32x4 (&acc)[2][2][4][2], const Unit& u, int wr, int wc, int fr, int fq) const {
        const int row0 = u.pm * BM + wr * 64 + fr, col0 = u.pn * BM + wc * 32 + 8 * fq;
#pragma unroll
        for (int ai = 0; ai < 2; ++ai)
#pragma unroll
            for (int m = 0; m < 4; ++m) { bf16_t* rowp = O + (size_t)(row0 + ai * HALF + m * 16) * ldc + col0;
#pragma unroll
                for (int bj = 0; bj < 2; ++bj) { const f32x4 v0 = acc[ai][bj][m][0], v1 = acc[ai][bj][m][1];
                    u32x4 w; w.x = cvt_pk_bf16(v0[0], v0[1]); w.y = cvt_pk_bf16(v0[2], v0[3]); w.z = cvt_pk_bf16(v1[0], v1[1]); w.w = cvt_pk_bf16(v1[2], v1[3]);
                    *(u32x4*)(rowp + bj * HALF) = w; } }
        if (u.pn == gate_pn && wc == 0) {
#pragma unroll
            for (int ai = 0; ai < 2; ++ai)
#pragma unroll
                for (int m = 0; m < 4; ++m) { float* gp = gates + (size_t)(row0 + ai * HALF + m * 16) * 32 + 8 * fq;
                    *(f32x4*)gp = acc[ai][0][m][0]; *(f32x4*)(gp + 4) = acc[ai][0][m][1]; }
        }
    }
};

template <class Epi, class Sched, bool ALIGN_EPI = false, bool SP2 = false>
__device__ __forceinline__ void gemm_phase(PG8_LAS unsigned char* lds, const Gemm g, const Sched& S, const Epi& E) {
    const int tid = fresh_tid(), wid = __builtin_amdgcn_readfirstlane(tid >> 6), lane = tid & 63, wr = wid >> 2, wc = wid & 3, fr = lane & 15, fq = lane >> 4;
    const int K = g.K, nt = K / BK;
    unsigned voffA[2], voffB[2];
#pragma unroll
    for (int i = 0; i < 2; ++i) { int R, C; stage_rc(tid * 16 + i * 8192, R, C); const int Rb = Epi::PERM ? ((R & ~31) + perm32(R & 31)) : R;
        voffA[i] = (unsigned)(R * K + C) * 2u; voffB[i] = (unsigned)(Rb * K + C) * 2u; }
    const size_t kstep = (size_t)(BK * 2);
    const size_t hstep = (size_t)HALF * K * 2;
    const size_t tstep = 2 * hstep;
    const unsigned ldsw = (unsigned)wid * 1024u;
    const int aoff = lds_byte(wr * 64 + fr, fq * 8), boff = lds_byte(wc * 32 + fr, fq * 8);
#define PG8_SA(b, h) (((b) * 2 + (h)) * HTB)
#define PG8_SB(b, h) ((4 + (b) * 2 + (h)) * HTB)
#define PG8_STAGE(bufoff, gbase, voff) do { _Pragma("unroll") for (int _i = 0; _i < 2; ++_i) \
        __builtin_amdgcn_global_load_lds((const unsigned*)((const char*)(gbase) + (voff)[_i]), (PG8_LAS unsigned*)(lds + (bufoff) + ldsw + _i * 8192), 16, 0, 0); } while (0)
#define PG8_LDA(dst, b, h) do { _Pragma("unroll") for (int m = 0; m < 4; ++m) _Pragma("unroll") for (int k = 0; k < 2; ++k) dst[m][k] = *(const PG8_LAS bf16x8*)(lds + PG8_SA(b, h) + aoff + m * 2048 + k * 1024); } while (0)
#define PG8_LDB(dst, b, h) do { _Pragma("unroll") for (int n = 0; n < 2; ++n) _Pragma("unroll") for (int k = 0; k < 2; ++k) dst[n][k] = *(const PG8_LAS bf16x8*)(lds + PG8_SB(b, h) + boff + n * 2048 + k * 1024); } while (0)
#define PG8_MMA(ai, bj, At, Bt) do { __builtin_amdgcn_s_setprio(1); _Pragma("unroll") for (int m = 0; m < 4; ++m) _Pragma("unroll") for (int n = 0; n < 2; ++n) _Pragma("unroll") for (int k = 0; k < 2; ++k) \
        acc[ai][bj][m][n] = __builtin_amdgcn_mfma_f32_16x16x32_bf16(Bt[n][k], At[m][k], acc[ai][bj][m][n], 0, 0, 0); __builtin_amdgcn_s_setprio(0); } while (0)
#define PG8_WAIT_V(n) asm volatile("s_waitcnt vmcnt(" #n ")" ::: "memory")
#define PG8_WAIT_L(n) asm volatile("s_waitcnt lgkmcnt(" #n ")" ::: "memory")
#define PG8_BAR __builtin_amdgcn_s_barrier()
#define PG8_SCHED __builtin_amdgcn_sched_barrier(0)
    Unit cur, nxt; int ui = 0;
    if (!S.next(0, cur)) return;
    f32x4 acc[2][2][4][2];
#pragma unroll
    for (int a = 0; a < 2; ++a)
#pragma unroll
        for (int b = 0; b < 2; ++b)
#pragma unroll
            for (int m = 0; m < 4; ++m)
#pragma unroll
                for (int n = 0; n < 2; ++n) acc[a][b][m][n] = (f32x4){0.f, 0.f, 0.f, 0.f};
    bf16x8 At[4][2], B0[2][2], B1[2][2];
    const char* cA = (const char*)g.A + (size_t)cur.pm * tstep; const char* cB = (const char*)g.Bt + (size_t)cur.pn * tstep;
    S.a_ready(cur);
    if constexpr (SP2) {
        PG8_STAGE(PG8_SB(0, 0), cB, voffB); PG8_STAGE(PG8_SB(0, 1), cB + hstep, voffB); PG8_STAGE(PG8_SA(0, 0), cA, voffA); PG8_STAGE(PG8_SA(0, 1), cA + hstep, voffA);
        if (wr == 1) PG8_BAR;
        PG8_WAIT_V(2); PG8_BAR;
        PG8_STAGE(PG8_SB(1, 0), cB + kstep, voffB); PG8_STAGE(PG8_SA(1, 0), cA + kstep, voffA); PG8_STAGE(PG8_SB(1, 1), cB + hstep + kstep, voffB);
        PG8_WAIT_V(6); PG8_BAR;
    } else {
        PG8_STAGE(PG8_SB(0, 0), cB, voffB); PG8_STAGE(PG8_SA(0, 0), cA, voffA); PG8_STAGE(PG8_SB(0, 1), cB + hstep, voffB); PG8_STAGE(PG8_SA(0, 1), cA + hstep, voffA);
        if (wr == 1) PG8_BAR;
        PG8_WAIT_V(4); PG8_BAR;
        PG8_STAGE(PG8_SB(1, 0), cB + kstep, voffB); PG8_STAGE(PG8_SA(1, 0), cA + kstep, voffA); PG8_STAGE(PG8_SB(1, 1), cB + hstep + kstep, voffB);
        PG8_WAIT_V(6); PG8_BAR;
    }
    for (;;) {
        const bool has_next = S.next(ui + 1, nxt);
        const char* nA = has_next ? (const char*)g.A + (size_t)nxt.pm * tstep : cA; const char* nB = has_next ? (const char*)g.Bt + (size_t)nxt.pn * tstep : cB;
        for (int t = 0; t < nt; t += 2) {
            const bool last = (t == nt - 2);
            const char* a1 = cA + (size_t)(t + 1) * kstep;
            const char* a2 = last ? nA : cA + (size_t)(t + 2) * kstep; const char* b2 = last ? nB : cB + (size_t)(t + 2) * kstep;
            const char* a3 = a2 + kstep; const char* b3 = b2 + kstep;
            if (last && has_next) S.a_ready(nxt);
            if constexpr (SP2) {
            PG8_LDB(B0, 0, 0); PG8_LDB(B1, 0, 1); PG8_SCHED; PG8_LDA(At, 0, 0); PG8_STAGE(PG8_SA(1, 1), a1 + hstep, voffA);
            PG8_WAIT_V(8); PG8_WAIT_L(0); PG8_BAR; PG8_MMA(0, 0, At, B0); PG8_MMA(0, 1, At, B1); PG8_BAR; PG8_SCHED;
            PG8_LDA(At, 0, 1); PG8_STAGE(PG8_SB(0, 0), b2, voffB); PG8_STAGE(PG8_SB(0, 1), b2 + hstep, voffB); PG8_STAGE(PG8_SA(0, 0), a2, voffA);
            PG8_WAIT_V(8); PG8_WAIT_L(0); PG8_BAR; PG8_MMA(1, 0, At, B0); PG8_MMA(1, 1, At, B1); PG8_BAR; PG8_SCHED;
            PG8_LDB(B0, 1, 0); PG8_LDB(B1, 1, 1); PG8_SCHED; PG8_LDA(At, 1, 0); PG8_STAGE(PG8_SA(0, 1), a2 + hstep, voffA);
            PG8_WAIT_V(8); PG8_WAIT_L(0); PG8_BAR; PG8_MMA(0, 0, At, B0); PG8_MMA(0, 1, At, B1); PG8_BAR; PG8_SCHED;
            PG8_LDA(At, 1, 1); PG8_STAGE(PG8_SB(1, 0), b3, voffB); PG8_STAGE(PG8_SB(1, 1), b3 + hstep, voffB); PG8_STAGE(PG8_SA(1, 0), a3, voffA);
            PG8_WAIT_V(8); PG8_WAIT_L(0); PG8_BAR; PG8_MMA(1, 0, At, B0); PG8_MMA(1, 1, At, B1); PG8_BAR; PG8_SCHED;
            } else {
            PG8_LDB(B0, 0, 0); PG8_SCHED; PG8_LDA(At, 0, 0); PG8_STAGE(PG8_SA(1, 1), a1 + hstep, voffA);
            PG8_WAIT_L(8); PG8_BAR; PG8_WAIT_L(0); PG8_MMA(0, 0, At, B0); PG8_BAR; PG8_SCHED;
            PG8_LDB(B1, 0, 1); PG8_STAGE(PG8_SB(0, 0), b2, voffB);
            PG8_BAR; PG8_WAIT_L(0); PG8_MMA(0, 1, At, B1); PG8_BAR;
            PG8_LDA(At, 0, 1); PG8_STAGE(PG8_SA(0, 0), a2, voffA);
            PG8_BAR; PG8_WAIT_L(0); PG8_MMA(1, 0, At, B0); PG8_BAR; PG8_SCHED;
            PG8_STAGE(PG8_SB(0, 1), b2 + hstep, voffB);
            PG8_WAIT_V(6); PG8_BAR; PG8_MMA(1, 1, At, B1); PG8_BAR;
            PG8_LDB(B0, 1, 0); PG8_SCHED; PG8_LDA(At, 1, 0); PG8_STAGE(PG8_SA(0, 1), a2 + hstep, voffA);
            PG8_WAIT_L(8); PG8_BAR; PG8_WAIT_L(0); PG8_MMA(0, 0, At, B0); PG8_BAR; PG8_SCHED;
            PG8_LDB(B1, 1, 1); PG8_STAGE(PG8_SB(1, 0), b3, voffB);
            PG8_BAR; PG8_WAIT_L(0); PG8_MMA(0, 1, At, B1); PG8_BAR;
            PG8_LDA(At, 1, 1); PG8_STAGE(PG8_SA(1, 0), a3, voffA);
            PG8_BAR; PG8_WAIT_L(0); PG8_MMA(1, 0, At, B0); PG8_BAR; PG8_SCHED;
            PG8_STAGE(PG8_SB(1, 1), b3 + hstep, voffB);
            PG8_WAIT_V(6); PG8_BAR; PG8_MMA(1, 1, At, B1); PG8_BAR;
            }
        }
        if constexpr (ALIGN_EPI) { if (wr == 0) PG8_BAR; }
        if constexpr (!Epi::AFTER_DRAIN) { E(acc, cur, wr, wc, fr, fq); S.done(cur); }
        if (!has_next) break;
#pragma unroll
        for (int a = 0; a < 2; ++a)
#pragma unroll
            for (int b = 0; b < 2; ++b)
#pragma unroll
                for (int m = 0; m < 4; ++m)
#pragma unroll
                    for (int n = 0; n < 2; ++n) acc[a][b][m][n] = (f32x4){0.f, 0.f, 0.f, 0.f};
        cur = nxt; cA = nA; cB = nB; ++ui;
        if constexpr (ALIGN_EPI) { if (wr == 1) PG8_BAR; }
    }
    PG8_WAIT_V(0);
    if constexpr (!ALIGN_EPI) { if (wr == 0) PG8_BAR; }
    PG8_BAR;
    if constexpr (Epi::AFTER_DRAIN) { E.fused(acc, cur, wr, wc, fr, fq, lds, wid, lane); S.done(cur); }
#undef PG8_SA
#undef PG8_SB
#undef PG8_STAGE
#undef PG8_LDA
#undef PG8_LDB
#undef PG8_MMA
#undef PG8_WAIT_V
#undef PG8_WAIT_L
#undef PG8_BAR
#undef PG8_SCHED
}
}

#ifndef PG8_SP2
#define PG8_SP2 true
#endif
#ifndef PG8_ALIGN
#define PG8_ALIGN true
#endif

constexpr int NWAVES = 8;
constexpr int D = 2048, NB = 8, SEQ = 4096, CTXL = 256, DFF = 5632, NMOD = 9;
constexpr int MC = NB * CTXL;
constexpr int MLAT = NB * SEQ;
constexpr int M = MC + MLAT;
constexpr int NP0 = 5376, NP1 = 6400;
constexpr int NCH = (CTXL + SEQ) / 64;
constexpr float EPS = 1e-6f;
constexpr float QSCALE = 0.08838834764831845f;

constexpr size_t MiB = 1u << 20;
constexpr size_t WS_CTL = 0, CTL_ZERO_BYTES = 1 * MiB;
constexpr size_t WS_MOD = 1 * MiB;
constexpr size_t WS_GATES = 3 * MiB;
constexpr size_t WS_WRG = 8 * MiB;
constexpr size_t WS_PE = 9 * MiB;
constexpr size_t WS_HCTX = 10 * MiB;
constexpr size_t WS_W = 26 * MiB;
constexpr size_t W_F1I = WS_W, W_F1O = W_F1I + 44 * MiB, W_F2I = W_F1O + 22 * MiB, W_F2O = W_F2I + 44 * MiB, W_MI = W_F2O + 22 * MiB, W_MO = W_MI + 25 * MiB;
constexpr size_t WS_U = 192 * MiB;
constexpr size_t WS_Y = 328 * MiB;
constexpr size_t WS_BIG = 600 * MiB;
constexpr size_t WS_END = 1025 * MiB;
static_assert(W_MO + 8 * MiB <= WS_U && WS_U + (size_t)M * D * 2 <= WS_Y && WS_Y + (size_t)M * D * 4 <= WS_BIG && WS_BIG + (size_t)M * NP1 * 2 <= WS_END, "ws map");
constexpr int CW_BAR = 4096;

constexpr int SCR_BYTES = 151552;
constexpr int LDSCTL_OFF = SCR_BYTES;
constexpr int LDS_BYTES = 155648;

#define GAS __attribute__((address_space(1)))
#define LAS __attribute__((address_space(3)))
typedef unsigned short bf16;
typedef float f32x4 __attribute__((ext_vector_type(4)));
typedef float f32x2 __attribute__((ext_vector_type(2)));
typedef short bf16x8 __attribute__((ext_vector_type(8)));
typedef short bf16x4 __attribute__((ext_vector_type(4)));
typedef unsigned u32x4 __attribute__((ext_vector_type(4)));
typedef unsigned u32x2 __attribute__((ext_vector_type(2)));
#define LDS_WAIT() asm volatile("s_waitcnt lgkmcnt(0)" ::: "memory")
__device__ __forceinline__ unsigned f2bf(float f) { unsigned u = __builtin_bit_cast(unsigned, f); return (u + 0x7fffu + ((u >> 16) & 1u)) >> 16; }
__device__ __forceinline__ unsigned pk2(float lo, float hi) { return pg8::cvt_pk_bf16(lo, hi); }
__device__ __forceinline__ float bflo(unsigned w) { return __uint_as_float(w << 16); }
__device__ __forceinline__ float bfhi(unsigned w) { return __uint_as_float(w & 0xffff0000u); }
__device__ __forceinline__ float wave_sum(float v) {
#pragma unroll
    for (int o = 1; o < 64; o <<= 1) v += __shfl_xor(v, o);
    return v;
}
__device__ __forceinline__ float sigmoid_f(float x) { return __builtin_amdgcn_rcpf(1.0f + __expf(-x)); }
__device__ __forceinline__ float silu_f(float x) { return x * sigmoid_f(x); }
__device__ __forceinline__ float logsig_f(float z) { return fminf(z, 0.f) - __logf(1.0f + __expf(-fabsf(z))); }
__device__ __forceinline__ float gelu_tanh_f(float x) { const float u = 0.7978845608028654f * (x + 0.044715f * x * x * x); const float t = 1.0f - 2.0f * __builtin_amdgcn_rcpf(1.0f + __expf(2.0f * u)); return 0.5f * x * (1.0f + t); }

#define XB_TMO      128
#define XB_XCNT(j)  (256  + 64 * (j))
#define XB_XSUB(j)  (1280 + 64 * (j))
#define XB_XGEN(j)  (2304 + 64 * (j))
#define XB_TOP      3328
#define XB_TOPGEN   3392
#define XCD_BAR_WORDS 3456
#define XB_SPIN_CAP (1u << 18)

__device__ __forceinline__ unsigned xb_ld(unsigned* p)              { return __hip_atomic_load(p, __ATOMIC_RELAXED, __HIP_MEMORY_SCOPE_AGENT); }
__device__ __forceinline__ unsigned xb_add(unsigned* p, unsigned v) { return __hip_atomic_fetch_add(p, v, __ATOMIC_RELAXED, __HIP_MEMORY_SCOPE_AGENT); }
__device__ __forceinline__ unsigned xb_xcc_id() { return (unsigned)__builtin_amdgcn_s_getreg((3 << 11) | 20) & 0xFu; }
#define XB_SPIN(cond, bar) do { unsigned _sp = 0; while (cond) { __builtin_amdgcn_s_sleep(1); \
    if ((++_sp & 255u) == 0u) { if (xb_ld(&(bar)[XB_TMO])) break; if (_sp > XB_SPIN_CAP) { atomicAdd(&(bar)[XB_TMO], 1u); break; } } } } while (0)

struct XcdBarrier {
    unsigned* bar; unsigned x;
    volatile LAS unsigned* st;
};

__device__ __forceinline__ XcdBarrier xcd_barrier_post(unsigned* bar, volatile LAS unsigned* st) {
    XcdBarrier b; b.bar = bar; b.x = xb_xcc_id(); b.st = st;
    if (threadIdx.x == 0) (void)xb_add(&bar[XB_XCNT(b.x)], 1u);
    return b;
}
__device__ __forceinline__ void xcd_barrier_complete(unsigned* bar, unsigned x, unsigned& nloc, unsigned& nx) {
    const unsigned G = gridDim.x * gridDim.y * gridDim.z;
    unsigned sum, cnt, mine, sp = 0u;
    for (;;) {
        sum = 0u; cnt = 0u; mine = 0u;
#pragma unroll
        for (unsigned j = 0; j < 16; ++j) { const unsigned c = xb_ld(&bar[XB_XCNT(j)]); sum += c; cnt += (c > 0u) ? 1u : 0u; mine = (j == x) ? c : mine; }
        if (sum == G) break;
        __builtin_amdgcn_s_sleep(1);
        if ((++sp & 255u) == 0u) { if (xb_ld(&bar[XB_TMO])) break; if (sp > XB_SPIN_CAP) { atomicAdd(&bar[XB_TMO], 1u); break; } }
    }
    nloc = mine > 0u ? mine : 1u; nx = cnt > 0u ? cnt : 1u;
}

__device__ __forceinline__ void xcd_barrier(const XcdBarrier& b) {
    asm volatile("s_waitcnt vmcnt(0)" ::: "memory");
    __syncthreads();
    if (threadIdx.x == 0) {
        unsigned* bar = b.bar;
        __builtin_amdgcn_s_waitcnt(0);
        unsigned nloc = b.st[0], nx = b.st[1];
        if (nloc == 0u) { xcd_barrier_complete(bar, b.x, nloc, nx); b.st[0] = nloc; b.st[1] = nx; }
        const unsigned old = xb_add(&bar[XB_XSUB(b.x)], 1u);
        const unsigned gen = old / nloc;
        if (old + 1u == (gen + 1u) * nloc) {
            __builtin_amdgcn_fence(__ATOMIC_RELEASE, "agent");
            asm volatile("s_waitcnt vmcnt(0)" ::: "memory");
            const unsigned og = xb_add(&bar[XB_TOP], 1u);
            const unsigned tg = og / nx;
            if (og + 1u == (tg + 1u) * nx) xb_add(&bar[XB_TOPGEN], 1u);
            else XB_SPIN(xb_ld(&bar[XB_TOPGEN]) == tg, bar);
            __builtin_amdgcn_fence(__ATOMIC_ACQUIRE, "agent");
            xb_add(&bar[XB_XGEN(b.x)], 1u);
            asm volatile("s_waitcnt vmcnt(0)" ::: "memory");
        } else {
            XB_SPIN(xb_ld(&bar[XB_XGEN(b.x)]) == gen, bar);
            __builtin_amdgcn_fence(__ATOMIC_ACQUIRE, "agent");
            asm volatile("s_waitcnt vmcnt(0)" ::: "memory");
        }
    }
    __syncthreads();
}

struct Args { const float* in[27]; float* out; unsigned char* ws; int ph_lo, ph_hi; };
struct Frame {
    LAS unsigned char* lds;
    int G, wg, NGW;
    float* out; unsigned char* ws;
    const Args& A;
};
enum { I_X = 0, I_C, I_CTX, I_CCTX, I_WMOD, I_BMOD, I_NORMG, I_F1WI, I_F1WO, I_F2WI, I_F2WO, I_ABWI, I_WALPHA2, I_BALPHA, I_GLANG, I_CONVW, I_CONVB, I_RGWA, I_RGBA, I_RGWI, I_RGBI, I_LAM, I_ABWO, I_MLWI, I_MLBG, I_MLNG, I_MLWO };

__device__ __forceinline__ void pre_mod(Frame& F) {
    const int tid_ = fresh_tid(); const int lane_ = tid_ & 63, wave_ = __builtin_amdgcn_readfirstlane(tid_ >> 6), gw_ = F.wg * NWAVES + wave_; (void)lane_; (void)gw_;
    LAS float* sc = (LAS float*)F.lds;
    LAS float* red = (LAS float*)(F.lds + 9 * 2048 * 4);
    for (int i = tid_; i < 9 * 2048; i += 512) { const int bb = i >> 11, k = i & 2047; const float v = bb < 8 ? F.A.in[I_C][bb * 2048 + k] : F.A.in[I_CCTX][k]; sc[i] = v * (1.0f / (1.0f + expf(-v))); }
    __syncthreads();
    float* MOD = (float*)(F.ws + WS_MOD);
    const int q = tid_ & 15, kg = tid_ >> 4;
    for (int item = F.wg; item < 2 * 288; item += F.G) {
        const int layer = item / 288, col0 = (item % 288) * 64;
        const float* wp = F.A.in[I_WMOD] + ((size_t)layer * 2048 + (size_t)kg * 64) * 18432 + col0 + 4 * q;
        f32x4 acc[9];
#pragma unroll
        for (int bb = 0; bb < 9; ++bb) acc[bb] = (f32x4){0.f, 0.f, 0.f, 0.f};
#pragma unroll 4
        for (int kk = 0; kk < 64; ++kk) {
            const f32x4 w = *(const f32x4*)(wp + (size_t)kk * 18432);
#pragma unroll
            for (int bb = 0; bb < 9; ++bb) acc[bb] += w * sc[bb * 2048 + kg * 64 + kk];
        }
#pragma unroll
        for (int bb = 0; bb < 9; ++bb)
#pragma unroll
            for (int e = 0; e < 4; ++e) { float v = acc[bb][e]; v += __shfl_xor(v, 16); v += __shfl_xor(v, 32); acc[bb][e] = v; }
        __syncthreads();
        if (lane_ < 16) {
#pragma unroll
            for (int bb = 0; bb < 9; ++bb) *(LAS f32x4*)(red + (wave_ * 9 + bb) * 64 + 4 * q) = acc[bb];
        }
        __syncthreads();
        for (int t = tid_; t < 9 * 64; t += 512) { const int bb = t >> 6, ci = t & 63; float s = F.A.in[I_BMOD][layer * 18432 + col0 + ci];
#pragma unroll
            for (int w = 0; w < 8; ++w) s += red[(w * 9 + bb) * 64 + ci];
            MOD[((size_t)layer * 9 + bb) * 18432 + col0 + ci] = s; }
    }
    __syncthreads();
}
__device__ __forceinline__ void pre_pe(Frame& F) {
    const int tid_ = fresh_tid(); const int lane_ = tid_ & 63, wave_ = __builtin_amdgcn_readfirstlane(tid_ >> 6), gw_ = F.wg * NWAVES + wave_; (void)lane_; (void)gw_;
    float* PE = (float*)(F.ws + WS_PE);
    for (int i = F.wg * 512 + tid_; i < 64 * 512; i += F.G * 512) {
        const int p = i >> 9, f = i & 511;
        const float om = (float)exp2(-(double)f * (13.287712379549449 / 512.0));
        const float angf = (float)p * om; const double x = (double)angf;
        const double kf = rint(x * 0.6366197723675814);
        double r = fma(-kf, 1.5707963267948966, x); r = fma(-kf, 6.123233995736766e-17, r);
        const int k = ((int)kf) & 3; const double r2 = r * r;
        const double sp = r * (1.0 + r2 * (-1.0 / 6.0 + r2 * (1.0 / 120.0 + r2 * (-1.0 / 5040.0 + r2 * (1.0 / 362880.0 + r2 * (-1.0 / 39916800.0 + r2 * (1.0 / 6227020800.0)))))));
        const double cp = 1.0 + r2 * (-0.5 + r2 * (1.0 / 24.0 + r2 * (-1.0 / 720.0 + r2 * (1.0 / 40320.0 + r2 * (-1.0 / 3628800.0 + r2 * (1.0 / 479001600.0))))));
        const double s = (k == 0) ? sp : (k == 1) ? cp : (k == 2) ? -sp : -cp;
        const double c = (k == 0) ? cp : (k == 1) ? -sp : (k == 2) ? -cp : sp;
        PE[p * 1024 + f] = (float)s; PE[p * 1024 + 512 + f] = (float)c;
    }
}
template <int MAP> __device__ __forceinline__ int cvt_row(int n) {
    if (MAP == 1) return n < DFF ? ((n >> 7) << 8) + (n & 127) : (((n - DFF) >> 7) << 8) + 128 + ((n - DFF) & 127);
    if (MAP == 2) return n < 3072 ? n : (n < 3104 ? n + 2048 : n - 32);
    return n;
}
template <int MAP> __device__ __forceinline__ void cvt_item(const float* W, int K, int N, bf16* WT, LAS float* scr, int item, int lane) {
    const int nblk = N / 32, kb = item / nblk, nb = item % nblk, k0 = 64 * kb, n0 = 32 * nb;
#pragma unroll 8
    for (int i = 0; i < 32; ++i) { const int kk = 2 * i + (lane >> 5); scr[kk * 33 + (lane & 31)] = W[(size_t)(k0 + kk) * N + n0 + (lane & 31)]; }
    LDS_WAIT(); asm volatile("" ::: "memory");
    const int c = lane & 7;
#pragma unroll
    for (int j = 0; j < 4; ++j) { const int n = (lane >> 3) + 8 * j; const LAS float* s = scr + (8 * c) * 33 + n;
        u32x4 o; o.x = pk2(s[0 * 33], s[1 * 33]); o.y = pk2(s[2 * 33], s[3 * 33]); o.z = pk2(s[4 * 33], s[5 * 33]); o.w = pk2(s[6 * 33], s[7 * 33]);
        *(u32x4*)(WT + (size_t)cvt_row<MAP>(n0 + n) * K + k0 + 8 * c) = o; }
    LDS_WAIT(); asm volatile("" ::: "memory");
}
template <int LAYER> __device__ __forceinline__ void cvt_layer(Frame& F) {
    const int tid_ = fresh_tid(); const int lane_ = tid_ & 63, wave_ = __builtin_amdgcn_readfirstlane(tid_ >> 6), gw_ = F.wg * NWAVES + wave_; (void)lane_; (void)gw_;
    LAS float* scr = (LAS float*)(F.lds + wave_ * 16384);
    constexpr int I0 = 32 * 352, I1 = 88 * 64, I4 = LAYER == 0 ? 32 * 161 : 32 * 193, I5 = 32 * 64, I6 = LAYER == 0 ? 256 : 0;
    constexpr int NITEMS = 2 * I0 + 2 * I1 + I4 + I5 + I6;
    const float* f1i = F.A.in[I_F1WI] + (size_t)LAYER * D * 2 * DFF; const float* f1o = F.A.in[I_F1WO] + (size_t)LAYER * DFF * D;
    const float* f2i = F.A.in[I_F2WI] + (size_t)LAYER * D * 2 * DFF; const float* f2o = F.A.in[I_F2WO] + (size_t)LAYER * DFF * D;
    for (int it = gw_; it < NITEMS; it += F.NGW) {
        int r = it;
        if (r < I0) { cvt_item<1>(f1i, D, 2 * DFF, (bf16*)(F.ws + W_F1I), scr, r, lane_); continue; } r -= I0;
        if (r < I1) { cvt_item<0>(f1o, DFF, D, (bf16*)(F.ws + W_F1O), scr, r, lane_); continue; } r -= I1;
        if (r < I0) { cvt_item<1>(f2i, D, 2 * DFF, (bf16*)(F.ws + W_F2I), scr, r, lane_); continue; } r -= I0;
        if (r < I1) { cvt_item<0>(f2o, DFF, D, (bf16*)(F.ws + W_F2O), scr, r, lane_); continue; } r -= I1;
        if (r < I4) { if (LAYER == 0) cvt_item<2>(F.A.in[I_ABWI], D, 5152, (bf16*)(F.ws + W_MI), scr, r, lane_); else cvt_item<0>(F.A.in[I_MLWI], D, 6176, (bf16*)(F.ws + W_MI), scr, r, lane_); continue; } r -= I4;
        if (r < I5) { cvt_item<0>(LAYER == 0 ? F.A.in[I_ABWO] : F.A.in[I_MLWO], D, D, (bf16*)(F.ws + W_MO), scr, r, lane_); continue; } r -= I5;
        if (LAYER == 0) { const int mi = r >> 3, sub = r & 7, dir = mi >> 4, mat = (mi >> 3) & 1, n = mi & 7;
            const float* src = (mat ? F.A.in[I_RGWI] : F.A.in[I_RGWA]) + (size_t)(dir * 8 + n) * 128 * 128;
            cvt_item<0>(src, 128, 128, (bf16*)(F.ws + WS_WRG) + (size_t)mi * 128 * 128, scr, sub, lane_); }
    }
    constexpr int PR0 = LAYER == 0 ? 5152 : 6176, PR1 = LAYER == 0 ? NP0 : NP1;
    u32x4* z = (u32x4*)((bf16*)(F.ws + W_MI) + (size_t)PR0 * D);
    for (int i = F.wg * 512 + tid_; i < (PR1 - PR0) * D / 8; i += F.G * 512) z[i] = (u32x4){0u, 0u, 0u, 0u};
}

__device__ __forceinline__ float* hrow(Frame& F, int r) { return r < MC ? (float*)(F.ws + WS_HCTX) + (size_t)r * D : F.out + (size_t)(r - MC) * D; }
template <bool INIT, bool HAS_Y, bool HAS_U>
__device__ __forceinline__ void nrm_rows(Frame& F, int row_lo, int row_hi, float wgt, const float* gpost, const float* mod_g, int gate_slot,
                                         const float* gpre, const float* mod_u, int shift_slot, int scale_slot) {
    const int tid_ = fresh_tid(); const int lane_ = tid_ & 63, wave_ = __builtin_amdgcn_readfirstlane(tid_ >> 6);
    constexpr int R = 8;
    const bf16* Yb = (const bf16*)(F.ws + WS_Y); bf16* U = (bf16*)(F.ws + WS_U); const float* PE = (const float*)(F.ws + WS_PE);
    LAS float* PS = (LAS float*)F.lds;
    const int col = 256 * wave_ + 4 * lane_;
    const int nblk = (row_hi - row_lo) / R;
    int cur_bb = -1;
    f32x4 gp = (f32x4){0.f, 0.f, 0.f, 0.f}, gt = gp, gn = gp, sh = gp, sc = gp;
    if (HAS_Y) gp = *(const f32x4*)(gpost + col);
    if (HAS_U) gn = *(const f32x4*)(gpre + col);
    __syncthreads();
    for (int blk = F.wg; blk < nblk; blk += F.G) {
        const int r0 = row_lo + blk * R;
        const int bb = r0 < MC ? 8 : (r0 - MC) >> 12;
        if (bb != cur_bb) { cur_bb = bb;
            if (HAS_Y) gt = *(const f32x4*)(mod_g + ((size_t)bb * 9 + gate_slot) * D + col);
            if (HAS_U) { sh = *(const f32x4*)(mod_u + ((size_t)bb * 9 + shift_slot) * D + col); sc = *(const f32x4*)(mod_u + ((size_t)bb * 9 + scale_slot) * D + col) + 1.0f; } }
        f32x4 hv[R];
#pragma unroll
        for (int i = 0; i < R; ++i) { const int r = r0 + i;
            if (INIT) {
                if (r < MC) hv[i] = *(const f32x4*)(F.A.in[I_CTX] + (size_t)r * D + col);
                else { const int t = (r - MC) & (SEQ - 1), prow = t >> 6, pcol = t & 63;
                    const f32x4 xv = *(const f32x4*)(F.A.in[I_X] + (size_t)(r - MC) * D + col);
                    const f32x4 pv = col < 1024 ? *(const f32x4*)(PE + prow * 1024 + col) : *(const f32x4*)(PE + pcol * 1024 + col - 1024);
                    hv[i] = xv + pv; }
            } else hv[i] = *(const f32x4*)(hrow(F, r) + col);
        }
        if (HAS_Y) {
            f32x4 yv[R];
#pragma unroll
            for (int i = 0; i < R; ++i) { const u32x2 w = *(const u32x2*)(Yb + (size_t)(r0 + i) * D + col); yv[i] = (f32x4){bflo(w.x), bfhi(w.x), bflo(w.y), bfhi(w.y)}; }
#pragma unroll
            for (int i = 0; i < R; ++i) { const float ss = wave_sum((yv[i].x * yv[i].x + yv[i].y * yv[i].y) + (yv[i].z * yv[i].z + yv[i].w * yv[i].w)); if (lane_ == 0) PS[i * 8 + wave_] = ss; }
            asm volatile("s_waitcnt lgkmcnt(0)" ::: "memory"); __builtin_amdgcn_s_barrier(); asm volatile("" ::: "memory");
#pragma unroll
            for (int i = 0; i < R; ++i) { const f32x4 p0 = *(const LAS f32x4*)(PS + i * 8), p1 = *(const LAS f32x4*)(PS + i * 8 + 4);
                const float tot = ((p0.x + p0.y) + (p0.z + p0.w)) + ((p1.x + p1.y) + (p1.z + p1.w));
                const float r1 = rsqrtf(tot * (1.0f / D) + EPS) * wgt;
                hv[i] = hv[i] + gt * (yv[i] * r1 * gp); }
        }
        if (INIT || HAS_Y) {
#pragma unroll
            for (int i = 0; i < R; ++i) *(f32x4*)(hrow(F, r0 + i) + col) = hv[i];
        }
        if (HAS_U) {
#pragma unroll
            for (int i = 0; i < R; ++i) { const float ss = wave_sum((hv[i].x * hv[i].x + hv[i].y * hv[i].y) + (hv[i].z * hv[i].z + hv[i].w * hv[i].w)); if (lane_ == 0) PS[64 + i * 8 + wave_] = ss; }
            asm volatile("s_waitcnt lgkmcnt(0)" ::: "memory"); __builtin_amdgcn_s_barrier(); asm volatile("" ::: "memory");
#pragma unroll
            for (int i = 0; i < R; ++i) { const f32x4 p0 = *(const LAS f32x4*)(PS + 64 + i * 8), p1 = *(const LAS f32x4*)(PS + 64 + i * 8 + 4);
                const float tot = ((p0.x + p0.y) + (p0.z + p0.w)) + ((p1.x + p1.y) + (p1.z + p1.w));
                const float r2 = rsqrtf(tot * (1.0f / D) + EPS);
                const f32x4 u = (hv[i] * r2 * gn) * sc + sh;
                u32x2 w; w.x = pk2(u.x, u.y); w.y = pk2(u.z, u.w);
                *(u32x2*)(U + (size_t)(r0 + i) * D + col) = w; }
        }
        if (!HAS_Y || !HAS_U) { asm volatile("s_waitcnt lgkmcnt(0)" ::: "memory"); __builtin_amdgcn_s_barrier(); asm volatile("" ::: "memory"); }
    }
    __syncthreads();
}

__device__ __forceinline__ void unpack8(const u32x4 v, float (&f)[8]) { f[0] = bflo(v.x); f[1] = bfhi(v.x); f[2] = bflo(v.y); f[3] = bfhi(v.y); f[4] = bflo(v.z); f[5] = bfhi(v.z); f[6] = bflo(v.w); f[7] = bfhi(v.w); }
__device__ __forceinline__ u32x4 pack8(const float (&f)[8]) { u32x4 o; o.x = pk2(f[0], f[1]); o.y = pk2(f[2], f[3]); o.z = pk2(f[4], f[5]); o.w = pk2(f[6], f[7]); return o; }
__device__ __forceinline__ void comb0_rows(Frame& F, int row_lo, int row_hi) {
    const int tid_ = fresh_tid(); const int lane_ = tid_ & 63, wave_ = __builtin_amdgcn_readfirstlane(tid_ >> 6), gw_ = F.wg * NWAVES + wave_; (void)lane_; (void)gw_;
    const bf16* OFb = (const bf16*)(F.ws + WS_Y); const bf16* OBb = OFb + (size_t)M * 1024; const bf16* HFb = OBb + (size_t)M * 1024; const bf16* HBb = HFb + (size_t)M * 1024;
    const bf16* P = (const bf16*)(F.ws + WS_BIG); bf16* U = (bf16*)(F.ws + WS_U); const float* gg = F.A.in[I_GLANG];
    const int e0 = 16 * lane_;
    for (int r = row_lo + gw_; r < row_hi; r += F.NGW) {
#pragma unroll
        for (int part = 0; part < 2; ++part) {
            const bf16* fa = (part ? HFb : OFb) + (size_t)r * 1024 + e0; const bf16* fb = (part ? HBb : OBb) + (size_t)r * 1024 + e0;
            const bf16* gp = P + (size_t)r * NP0 + (part ? 4096 : 2048) + e0;
            float a[2][8], b8[8], g[2][8];
            unpack8(*(const u32x4*)fa, a[0]); unpack8(*(const u32x4*)(fa + 8), a[1]);
            unpack8(*(const u32x4*)fb, b8);
#pragma unroll
            for (int e = 0; e < 8; ++e) a[0][e] += b8[e];
            unpack8(*(const u32x4*)(fb + 8), b8);
#pragma unroll
            for (int e = 0; e < 8; ++e) a[1][e] += b8[e];
            unpack8(*(const u32x4*)gp, g[0]); unpack8(*(const u32x4*)(gp + 8), g[1]);
            float o[2][8];
            if (part == 0) {
                float ss = 0.f;
#pragma unroll
                for (int c = 0; c < 2; ++c)
#pragma unroll
                    for (int e = 0; e < 8; ++e) ss += a[c][e] * a[c][e];
                ss += __shfl_xor(ss, 1); ss += __shfl_xor(ss, 2); ss += __shfl_xor(ss, 4); ss += __shfl_xor(ss, 8);
                const float rr = rsqrtf(ss * (1.0f / 256.0f) + EPS);
#pragma unroll
                for (int c = 0; c < 2; ++c)
#pragma unroll
                    for (int e = 0; e < 8; ++e) o[c][e] = a[c][e] * rr * gg[(e0 & 255) + 8 * c + e] * silu_f(g[c][e]);
            } else {
#pragma unroll
                for (int c = 0; c < 2; ++c)
#pragma unroll
                    for (int e = 0; e < 8; ++e) o[c][e] = a[c][e] * gelu_tanh_f(g[c][e]);
            }
            bf16* up = U + (size_t)r * D + part * 1024 + e0;
            *(u32x4*)up = pack8(o[0]); *(u32x4*)(up + 8) = pack8(o[1]);
        }
    }
}
__device__ __forceinline__ void comb1_rows(Frame& F, int row_lo, int row_hi) {
    const int tid_ = fresh_tid(); const int lane_ = tid_ & 63, wave_ = __builtin_amdgcn_readfirstlane(tid_ >> 6), gw_ = F.wg * NWAVES + wave_; (void)lane_; (void)gw_;
    const bf16* HFb = (const bf16*)(F.ws + WS_Y); const bf16* HBb = HFb + (size_t)M * D;
    const bf16* P = (const bf16*)(F.ws + WS_BIG); bf16* U = (bf16*)(F.ws + WS_U); const float* gg = F.A.in[I_MLNG];
    const int e0 = 32 * lane_;
    for (int r = row_lo + gw_; r < row_hi; r += F.NGW) {
        float a[32]; float ss = 0.f;
#pragma unroll
        for (int c = 0; c < 4; ++c) { float x8[8], y8[8]; unpack8(*(const u32x4*)(HFb + (size_t)r * D + e0 + 8 * c), x8); unpack8(*(const u32x4*)(HBb + (size_t)r * D + e0 + 8 * c), y8);
#pragma unroll
            for (int e = 0; e < 8; ++e) { a[8 * c + e] = x8[e] + y8[e]; ss += a[8 * c + e] * a[8 * c + e]; } }
        ss += __shfl_xor(ss, 1); ss += __shfl_xor(ss, 2); ss += __shfl_xor(ss, 4);
        const float rr = rsqrtf(ss * (1.0f / 256.0f) + EPS);
#pragma unroll
        for (int c = 0; c < 4; ++c) { float g8[8], o8[8]; unpack8(*(const u32x4*)(P + (size_t)r * NP1 + 4096 + e0 + 8 * c), g8);
#pragma unroll
            for (int e = 0; e < 8; ++e) o8[e] = a[8 * c + e] * rr * gg[((e0 + 8 * c) & 255) + e] * sigmoid_f(g8[e]);
            *(u32x4*)(U + (size_t)r * D + e0 + 8 * c) = pack8(o8); }
    }
}

#define WG_BAR() do { asm volatile("s_waitcnt lgkmcnt(0)" ::: "memory"); __builtin_amdgcn_s_barrier(); asm volatile("" ::: "memory"); } while (0)
__device__ __forceinline__ int chunk_rlo(int b, int dir, int c) {
    return c < 4 ? b * CTXL + (dir ? (CTXL - 64 - 64 * c) : 64 * c) : MC + b * SEQ + (dir ? (SEQ - 64 - 64 * (c - 4)) : 64 * (c - 4));
}
__device__ __forceinline__ bf16x8 tr_frag(LAS unsigned char* tile, int pitch, int k0, int c0, int lane) {
    const int g = lane >> 4, q = (lane & 15) >> 2, p = lane & 3;
    LAS unsigned char* a0 = tile + (k0 + 8 * g + q) * pitch + (c0 + 4 * p) * 2;
    const bf16x4 lo = __builtin_amdgcn_ds_read_tr16_b64_v4i16((LAS bf16x4*)a0);
    const bf16x4 hi = __builtin_amdgcn_ds_read_tr16_b64_v4i16((LAS bf16x4*)(a0 + 4 * pitch));
    return __builtin_shufflevector(lo, hi, 0, 1, 2, 3, 4, 5, 6, 7);
}
__device__ __forceinline__ u32x4 scale8(const u32x4 v, float s) {
    u32x4 o; o.x = pk2(bflo(v.x) * s, bfhi(v.x) * s); o.y = pk2(bflo(v.y) * s, bfhi(v.y) * s); o.z = pk2(bflo(v.z) * s, bfhi(v.z) * s); o.w = pk2(bflo(v.w) * s, bfhi(v.w) * s); return o;
}
__device__ __forceinline__ float wave_incl_sum(float x, int lane) {
#pragma unroll
    for (int o = 1; o < 64; o <<= 1) { const float t = __shfl_up(x, o); if (lane >= o) x += t; }
    return x;
}
__device__ __forceinline__ float wave_incl_max(float x, int lane) {
#pragma unroll
    for (int o = 1; o < 64; o <<= 1) { const float t = __shfl_up(x, o); if (lane >= o) x = fmaxf(x, t); }
    return x;
}

template <int MODE>
__device__ __forceinline__ void chain_scan(LAS unsigned char* lds,
        const bf16* __restrict__ proj, const int NP, const int qcol, const int kcol, const int vcol,
        const float* __restrict__ gates, const int gcol, const int b, const int dir,
        bf16* __restrict__ outb, const int out_ld, const int ocol, const bool ctx_out,
        const float* __restrict__ w2, const float* __restrict__ ba, const float bias_i, const float bias_f) {
    const int tid = fresh_tid(); const int lane = tid & 63, wave = __builtin_amdgcn_readfirstlane(tid >> 6);
    constexpr int NVB = MODE ? 9 : 8;
    constexpr int PQ = 272, PV = 304, PP = 144;
    constexpr int O_QS = 0, O_KS = 17408, O_QH = 34816, O_KH = 52224, O_VS = 69632, O_PS = 89088, O_SB = 98304, O_SM = 137472;
    LAS float* LR = (LAS float*)(lds + O_SM);
    LAS float* TOT = (LAS float*)(lds + O_SM + 4096);
    LAS float* FIRST = (LAS float*)(lds + O_SM + 8192);
    LAS float* DEC = (LAS float*)(lds + O_SM + 8704);
    LAS float* A_ = (LAS float*)(lds + O_SM);
    LAS float* MI = A_ + 64; LAS float* WI = A_ + 128; LAS float* WK = A_ + 192; LAS float* MR = A_ + 256; LAS float* DEN = A_ + 320; LAS float* DECS = A_ + 384;
    const int fr = lane & 15, fq = lane >> 4;

    __syncthreads();
    for (int i = tid; i < (9216 + 39168) / 16; i += 512) *(LAS u32x4*)(lds + O_PS + 16 * i) = (u32x4){0u, 0u, 0u, 0u};
    if (MODE) { if (tid < 64) { *(LAS u32x4*)(lds + O_VS + tid * PV + 256) = (u32x4){0x3F80u, 0u, 0u, 0u}; *(LAS u32x4*)(lds + O_VS + tid * PV + 272) = (u32x4){0u, 0u, 0u, 0u}; } }
    f32x4 S[NVB];
#pragma unroll
    for (int v = 0; v < NVB; ++v) S[v] = (f32x4){0.f, 0.f, 0.f, 0.f};
    float mst = 0.f;
    const int dp = tid & 63, d0 = 2 * dp, jg = wave;
    f32x2 w2r[16]; f32x2 bar = (f32x2){0.f, 0.f};
    if (MODE == 0) {
#pragma unroll
        for (int r = 0; r < 16; ++r) w2r[r] = *(const f32x2*)(w2 + r * 512 + d0);
        bar = *(const f32x2*)(ba + d0);
    }
    const int sj0 = tid >> 4, sj1 = (tid + 512) >> 4, sch = tid & 15;
    u32x4 pq[2], pk[2], pv[2]; f32x4 plr = (f32x4){0.f, 0.f, 0.f, 0.f}; float pgi = 0.f, pgf = 0.f;
#define CH_PREFETCH(cc) do { const int rl_ = chunk_rlo(b, dir, (cc)); \
        { const int row_ = dir ? rl_ + 63 - sj0 : rl_ + sj0; const bf16* rp_ = proj + (size_t)row_ * NP + 8 * sch; pq[0] = *(const u32x4*)(rp_ + qcol); pk[0] = *(const u32x4*)(rp_ + kcol); pv[0] = *(const u32x4*)(rp_ + vcol); } \
        { const int row_ = dir ? rl_ + 63 - sj1 : rl_ + sj1; const bf16* rp_ = proj + (size_t)row_ * NP + 8 * sch; pq[1] = *(const u32x4*)(rp_ + qcol); pk[1] = *(const u32x4*)(rp_ + kcol); pv[1] = *(const u32x4*)(rp_ + vcol); } \
        if (MODE == 0) { if (tid < 256) { const int j_ = tid >> 2; const int row_ = dir ? rl_ + 63 - j_ : rl_ + j_; plr = *(const f32x4*)(gates + (size_t)row_ * 32 + gcol + 4 * (tid & 3)); } } \
        else { if (wave == 0) { const int row_ = dir ? rl_ + 63 - lane : rl_ + lane; pgi = gates[(size_t)row_ * 32 + gcol]; pgf = gates[(size_t)row_ * 32 + gcol + 8]; } } } while (0)
    CH_PREFETCH(0);
    for (int c = 0; c < NCH; ++c) {
        const int rl = chunk_rlo(b, dir, c);
        *(LAS u32x4*)(lds + O_QS + sj0 * PQ + 16 * sch) = pq[0]; *(LAS u32x4*)(lds + O_QS + sj1 * PQ + 16 * sch) = pq[1];
        *(LAS u32x4*)(lds + O_KS + sj0 * PQ + 16 * sch) = pk[0]; *(LAS u32x4*)(lds + O_KS + sj1 * PQ + 16 * sch) = pk[1];
        *(LAS u32x4*)(lds + O_VS + sj0 * PV + 16 * sch) = pv[0]; *(LAS u32x4*)(lds + O_VS + sj1 * PV + 16 * sch) = pv[1];
        if (MODE == 0) { if (tid < 256) *(LAS f32x4*)(LR + (tid >> 2) * 16 + 4 * (tid & 3)) = plr; }
        const float gi = pgi, gf = pgf;
        if (c + 1 < NCH) CH_PREFETCH(c + 1);
        WG_BAR();
        if (MODE == 0) {
            f32x2 cs[8]; f32x2 run = (f32x2){0.f, 0.f};
#pragma unroll
            for (int jj = 0; jj < 8; ++jj) {
                const int j = 8 * jg + jj;
                f32x2 z = bar;
#pragma unroll
                for (int r4 = 0; r4 < 4; ++r4) { const f32x4 l4 = *(const LAS f32x4*)(LR + j * 16 + 4 * r4);
                    z += w2r[4 * r4 + 0] * l4.x; z += w2r[4 * r4 + 1] * l4.y; z += w2r[4 * r4 + 2] * l4.z; z += w2r[4 * r4 + 3] * l4.w; }
                f32x2 la; la.x = fmaxf(logsig_f(z.x) * (1.0f / 16.0f), -1.0f); la.y = fmaxf(logsig_f(z.y) * (1.0f / 16.0f), -1.0f);
                run += la; cs[jj] = run;
            }
            *(LAS f32x2*)(TOT + jg * 128 + d0) = run;
            if (jg == 4) *(LAS f32x2*)(FIRST + d0) = cs[0];
            WG_BAR();
            f32x2 pre = (f32x2){0.f, 0.f}, bref = (f32x2){0.f, 0.f}, blast = (f32x2){0.f, 0.f};
#pragma unroll
            for (int g = 0; g < 8; ++g) { const f32x2 t = *(const LAS f32x2*)(TOT + g * 128 + d0); if (g < jg) pre += t; if (g < 4) bref += t; blast += t; }
            bref += *(const LAS f32x2*)(FIRST + d0);
#pragma unroll
            for (int jj = 0; jj < 8; ++jj) {
                const int j = 8 * jg + jj; const f32x2 bb = pre + cs[jj];
                const unsigned qw = *(const LAS unsigned*)(lds + O_QS + j * PQ + 4 * dp), kw = *(const LAS unsigned*)(lds + O_KS + j * PQ + 4 * dp);
                const float q0 = bflo(qw) * QSCALE, q1 = bfhi(qw) * QSCALE, k0 = bflo(kw), k1 = bfhi(kw);
                *(LAS unsigned*)(lds + O_QS + j * PQ + 4 * dp) = pk2(q0 * __expf(bb.x - bref.x), q1 * __expf(bb.y - bref.y));
                *(LAS unsigned*)(lds + O_QH + j * PQ + 4 * dp) = pk2(q0 * __expf(bb.x), q1 * __expf(bb.y));
                *(LAS unsigned*)(lds + O_KS + j * PQ + 4 * dp) = pk2(k0 * __expf(bref.x - bb.x), k1 * __expf(bref.y - bb.y));
                *(LAS unsigned*)(lds + O_KH + j * PQ + 4 * dp) = pk2(k0 * __expf(blast.x - bb.x), k1 * __expf(blast.y - bb.y));
            }
            if (jg == 0) { f32x2 dv; dv.x = __expf(blast.x); dv.y = __expf(blast.y); *(LAS f32x2*)(DEC + d0) = dv; }
        } else {
            if (wave == 0) {
                const float ipre = gi + bias_i, lf = logsig_f(gf + bias_f);
                const float bsum = wave_incl_sum(lf, lane);
                const float a = ipre - bsum;
                const float cm = wave_incl_max(a, lane);
                const float Mi = fmaxf(mst, cm);
                const float blast = __shfl(bsum, 63), M63 = __shfl(Mi, 63);
                A_[lane] = a; MI[lane] = Mi; WI[lane] = __expf(mst - Mi) * QSCALE; WK[lane] = __expf(a - M63); MR[lane] = __expf(-(bsum + Mi));
                if (lane == 0) DECS[0] = __expf(mst - M63);
                mst = blast + M63;
            }
            WG_BAR();
            { const float wi0 = WI[sj0], wi1 = WI[sj1], wk0 = WK[sj0], wk1 = WK[sj1];
              *(LAS u32x4*)(lds + O_QH + sj0 * PQ + 16 * sch) = scale8(*(const LAS u32x4*)(lds + O_QS + sj0 * PQ + 16 * sch), wi0);
              *(LAS u32x4*)(lds + O_QH + sj1 * PQ + 16 * sch) = scale8(*(const LAS u32x4*)(lds + O_QS + sj1 * PQ + 16 * sch), wi1);
              *(LAS u32x4*)(lds + O_KH + sj0 * PQ + 16 * sch) = scale8(*(const LAS u32x4*)(lds + O_KS + sj0 * PQ + 16 * sch), wk0);
              *(LAS u32x4*)(lds + O_KH + sj1 * PQ + 16 * sch) = scale8(*(const LAS u32x4*)(lds + O_KS + sj1 * PQ + 16 * sch), wk1); }
        }
        WG_BAR();
        for (int tix = wave; tix < 10; tix += 8) {
            const int ib = tix >= 6 ? 3 : (tix >= 3 ? 2 : (tix >= 1 ? 1 : 0)); const int jb = tix - ib * (ib + 1) / 2;
            f32x4 acc = (f32x4){0.f, 0.f, 0.f, 0.f};
#pragma unroll
            for (int ks = 0; ks < 4; ++ks) {
                const bf16x8 A = *(const LAS bf16x8*)(lds + O_KS + (16 * jb + fr) * PQ + (32 * ks + 8 * fq) * 2);
                const bf16x8 B = *(const LAS bf16x8*)(lds + O_QS + (16 * ib + fr) * PQ + (32 * ks + 8 * fq) * 2);
                acc = __builtin_amdgcn_mfma_f32_16x16x32_bf16(A, B, acc, 0, 0, 0);
            }
            const int i = 16 * ib + fr, j0 = 16 * jb + 4 * fq;
            float w[4];
            if (MODE) { const float Mi = MI[i];
#pragma unroll
                for (int r = 0; r < 4; ++r) w[r] = (j0 + r <= i) ? acc[r] * QSCALE * __expf(A_[j0 + r] - Mi) : 0.f;
            } else {
#pragma unroll
                for (int r = 0; r < 4; ++r) w[r] = (j0 + r <= i) ? acc[r] : 0.f;
            }
            u32x2 pw; pw.x = pk2(w[0], w[1]); pw.y = pk2(w[2], w[3]);
            *(LAS u32x2*)(lds + O_PS + i * PP + j0 * 2) = pw;
        }
        WG_BAR();
        const int ib = wave & 3, vb0 = (wave >> 2) * 4, irow = 16 * ib + fr;
        f32x4 ao[5];
#pragma unroll
        for (int v = 0; v < 5; ++v) ao[v] = (f32x4){0.f, 0.f, 0.f, 0.f};
#pragma unroll
        for (int ks = 0; ks < 2; ++ks) {
            const bf16x8 B = *(const LAS bf16x8*)(lds + O_PS + irow * PP + (32 * ks + 8 * fq) * 2);
#pragma unroll
            for (int v = 0; v < 4; ++v) { const bf16x8 A = tr_frag(lds + O_VS, PV, 32 * ks, 16 * (vb0 + v), lane); ao[v] = __builtin_amdgcn_mfma_f32_16x16x32_bf16(A, B, ao[v], 0, 0, 0); }
            if (MODE) { if (wave < 4) { const bf16x8 A = tr_frag(lds + O_VS, PV, 32 * ks, 128, lane); ao[4] = __builtin_amdgcn_mfma_f32_16x16x32_bf16(A, B, ao[4], 0, 0, 0); } }
        }
#pragma unroll
        for (int ks = 0; ks < 4; ++ks) {
            const bf16x8 B = *(const LAS bf16x8*)(lds + O_QH + irow * PQ + (32 * ks + 8 * fq) * 2);
#pragma unroll
            for (int v = 0; v < 4; ++v) { const bf16x8 A = *(const LAS bf16x8*)(lds + O_SB + (16 * (vb0 + v) + fr) * PQ + (32 * ks + 8 * fq) * 2); ao[v] = __builtin_amdgcn_mfma_f32_16x16x32_bf16(A, B, ao[v], 0, 0, 0); }
            if (MODE) { if (wave < 4) { const bf16x8 A = *(const LAS bf16x8*)(lds + O_SB + (128 + fr) * PQ + (32 * ks + 8 * fq) * 2); ao[4] = __builtin_amdgcn_mfma_f32_16x16x32_bf16(A, B, ao[4], 0, 0, 0); } }
        }
        const int db = wave;
        if (MODE == 0) { const f32x4 dec = *(const LAS f32x4*)(DEC + 16 * db + 4 * fq);
#pragma unroll
            for (int v = 0; v < NVB; ++v) S[v] = S[v] * dec;
        } else { const float dsc = DECS[0];
#pragma unroll
            for (int v = 0; v < NVB; ++v) S[v] = S[v] * dsc;
        }
#pragma unroll
        for (int ks = 0; ks < 2; ++ks) {
            const bf16x8 A = tr_frag(lds + O_KH, PQ, 32 * ks, 16 * db, lane);
#pragma unroll
            for (int v = 0; v < NVB; ++v) { const bf16x8 B = tr_frag(lds + O_VS, PV, 32 * ks, 16 * v, lane); S[v] = __builtin_amdgcn_mfma_f32_16x16x32_bf16(A, B, S[v], 0, 0, 0); }
        }
        if (MODE) { if (wave < 4 && lane < 16) DEN[16 * ib + lane] = ao[4][0]; }
        WG_BAR();
        if (ctx_out || c >= 4) {
            const int row = dir ? rl + 63 - irow : rl + irow;
            float sc = 1.0f;
            if (MODE) sc = 1.0f / fmaxf(fabsf(DEN[irow]), MR[irow]);
            bf16* op = outb + (size_t)row * out_ld + ocol + 16 * vb0 + 4 * fq;
#pragma unroll
            for (int v = 0; v < 4; ++v) { u32x2 w; w.x = pk2(ao[v][0] * sc, ao[v][1] * sc); w.y = pk2(ao[v][2] * sc, ao[v][3] * sc); *(u32x2*)(op + 16 * v) = w; }
        }
#pragma unroll
        for (int v = 0; v < NVB; ++v) { u32x2 w; w.x = pk2(S[v][0], S[v][1]); w.y = pk2(S[v][2], S[v][3]); *(LAS u32x2*)(lds + O_SB + (16 * v + fr) * PQ + (16 * db + 4 * fq) * 2) = w; }
    }
#undef CH_PREFETCH
    __syncthreads();
}

__device__ __forceinline__ void rg_chain(LAS unsigned char* lds,
        const bf16* __restrict__ proj, const int b, const int n, const int dir, const bf16* __restrict__ wrg,
        const float* __restrict__ lam, const float* __restrict__ b_a, const float* __restrict__ b_i, const float* __restrict__ conv_w, const float* __restrict__ conv_b,
        bf16* __restrict__ hout) {
    const int tid = fresh_tid(); const int lane = tid & 63, wave = __builtin_amdgcn_readfirstlane(tid >> 6);
    constexpr int O_XR = 0, O_XBF = 17408, O_XBH = 51200, O_AA = 68608, O_BX = 102400, O_CW = 136192;
    constexpr int PXF = 528, PXH = 272;
    const int fr = lane & 15, fq = lane >> 4;
    LAS float* CW = (LAS float*)(lds + O_CW);
    __syncthreads();
    for (int i = tid; i < 5 * 128; i += 512) CW[i] = i < 512 ? conv_w[(i >> 7) * 1024 + 128 * n + (i & 127)] : conv_b[128 * n + (i - 512)];
    bf16x8 Afr[2][4];
#pragma unroll
    for (int mat = 0; mat < 2; ++mat)
#pragma unroll
        for (int ks = 0; ks < 4; ++ks) Afr[mat][ks] = *(const bf16x8*)(wrg + ((size_t)((dir * 2 + mat) * 8 + n) * 128 + 16 * wave + fr) * 128 + 32 * ks + 8 * fq);
    f32x4 c8, bav, biv;
#pragma unroll
    for (int r = 0; r < 4; ++r) { const int ch = 128 * n + 16 * wave + 4 * fq + r; const float l = lam[dir * 1024 + ch];
        c8[r] = -8.0f * (fmaxf(-l, 0.f) + log1pf(expf(-fabsf(l)))); bav[r] = b_a[dir * 1024 + ch]; biv[r] = b_i[dir * 1024 + ch]; }
    float hst = 0.f;
    const int ch2 = tid & 63, tg = tid >> 6;
    u32x4 px[3];
#define RG_PREFETCH(cc) do { const int c_ = (cc); const int L_ = c_ < 4 ? CTXL : SEQ, cs_ = c_ < 4 ? c_ : c_ - 4, base_ = c_ < 4 ? b * CTXL : MC + b * SEQ; \
        const int t0_ = dir ? L_ - 64 * (cs_ + 1) : 64 * cs_; \
        _Pragma("unroll") for (int e_ = 0; e_ < 3; ++e_) { const int id_ = tid + 512 * e_, rr_ = id_ >> 4, tt_ = t0_ - 2 + rr_; \
            px[e_] = (rr_ < 67 && tt_ >= 0 && tt_ < L_) ? *(const u32x4*)(proj + (size_t)(base_ + tt_) * NP0 + 3072 + 128 * n + 8 * (id_ & 15)) : (u32x4){0u, 0u, 0u, 0u}; } } while (0)
    RG_PREFETCH(0);
    for (int c = 0; c < NCH; ++c) {
        const int L = c < 4 ? CTXL : SEQ, cs = c < 4 ? c : c - 4, base = c < 4 ? b * CTXL : MC + b * SEQ;
        const int t0 = dir ? L - 64 * (cs + 1) : 64 * cs;
#pragma unroll
        for (int e = 0; e < 3; ++e) { const int id = tid + 512 * e, rr = id >> 4; if (rr < 68) *(LAS u32x4*)(lds + O_XR + rr * 256 + 16 * (id & 15)) = px[e]; }
        if (c + 1 < NCH) RG_PREFETCH(c + 1);
        WG_BAR();
        {
            const f32x2 w0 = *(const LAS f32x2*)(CW + 0 * 128 + 2 * ch2), w1 = *(const LAS f32x2*)(CW + 1 * 128 + 2 * ch2), w2_ = *(const LAS f32x2*)(CW + 2 * 128 + 2 * ch2), w3 = *(const LAS f32x2*)(CW + 3 * 128 + 2 * ch2), cb = *(const LAS f32x2*)(CW + 512 + 2 * ch2);
            f32x2 xw[11];
#pragma unroll
            for (int rr = 0; rr < 11; ++rr) { const unsigned u = *(const LAS unsigned*)(lds + O_XR + (8 * tg + rr) * 256 + 4 * ch2); xw[rr].x = bflo(u); xw[rr].y = bfhi(u); }
#pragma unroll
            for (int jj = 0; jj < 8; ++jj) {
                f32x2 y = cb; y += xw[jj] * w0; y += xw[jj + 1] * w1; y += xw[jj + 2] * w2_; y += xw[jj + 3] * w3;
                *(LAS f32x2*)(lds + O_XBF + (8 * tg + jj) * PXF + 8 * ch2) = y;
                *(LAS unsigned*)(lds + O_XBH + (8 * tg + jj) * PXH + 4 * ch2) = pk2(y.x, y.y);
            }
        }
        WG_BAR();
#pragma unroll
        for (int tb = 0; tb < 4; ++tb) {
            f32x4 ga = (f32x4){0.f, 0.f, 0.f, 0.f}, gi = (f32x4){0.f, 0.f, 0.f, 0.f};
#pragma unroll
            for (int ks = 0; ks < 4; ++ks) { const bf16x8 B = *(const LAS bf16x8*)(lds + O_XBH + (16 * tb + fr) * PXH + (32 * ks + 8 * fq) * 2);
                ga = __builtin_amdgcn_mfma_f32_16x16x32_bf16(Afr[0][ks], B, ga, 0, 0, 0); gi = __builtin_amdgcn_mfma_f32_16x16x32_bf16(Afr[1][ks], B, gi, 0, 0, 0); }
            const int t = 16 * tb + fr;
            const f32x4 xb = *(const LAS f32x4*)(lds + O_XBF + t * PXF + (16 * wave + 4 * fq) * 4);
            f32x4 av, bx;
#pragma unroll
            for (int r = 0; r < 4; ++r) { const float rg = sigmoid_f(ga[r] + bav[r]), ig = sigmoid_f(gi[r] + biv[r]); const float la = c8[r] * rg;
                av[r] = __expf(la); bx[r] = sqrtf(-expm1f(2.0f * la)) * (ig * xb[r]); }
            *(LAS f32x4*)(lds + O_AA + t * PXF + (16 * wave + 4 * fq) * 4) = av;
            *(LAS f32x4*)(lds + O_BX + t * PXF + (16 * wave + 4 * fq) * 4) = bx;
        }
        WG_BAR();
        if (tid < 128) {
            bf16* hp = hout + (size_t)(base + t0) * 1024 + 128 * n + tid;
#pragma unroll 8
            for (int s = 0; s < 64; ++s) { const int jj = dir ? 63 - s : s;
                hst = *(const LAS float*)(lds + O_AA + jj * PXF + 4 * tid) * hst + *(const LAS float*)(lds + O_BX + jj * PXF + 4 * tid);
                hp[(size_t)jj * 1024] = (bf16)f2bf(hst); }
        }
    }
#undef RG_PREFETCH
    __syncthreads();
}

#ifndef MK_LAST_PHASE
#define MK_LAST_PHASE 24
#endif
constexpr int NPH = 24;
__global__ void __launch_bounds__(NWAVES * 64, 2) mk_fwd(Args args) {
    extern __shared__ __attribute__((aligned(16))) unsigned char lds_raw[];
    Frame F{(LAS unsigned char*)lds_raw, (int)gridDim.x, (int)blockIdx.x, (int)gridDim.x * NWAVES, args.out, args.ws, args};
    volatile LAS unsigned* MISC = (volatile LAS unsigned*)(F.lds + LDSCTL_OFF);
    for (int u = threadIdx.x; u < (LDS_BYTES - LDSCTL_OFF) / 4; u += NWAVES * 64) ((LAS unsigned*)(F.lds + LDSCTL_OFF))[u] = 0u;
    __syncthreads();
    const int lo = args.ph_lo, hi = args.ph_hi;
    const bool multi = (hi - lo) > 1;
    XcdBarrier bar; bar.bar = (unsigned*)(F.ws + WS_CTL) + CW_BAR; bar.x = 0; bar.st = nullptr;
    if (multi) bar = xcd_barrier_post((unsigned*)(F.ws + WS_CTL) + CW_BAR, MISC + 8);
#ifndef MK_REP_GEMM
#define MK_REP_GEMM 1
#endif
#ifndef MK_REP_SCAN
#define MK_REP_SCAN 1
#endif
#ifndef MK_REP_COMB
#define MK_REP_COMB 1
#endif
#ifndef MK_OFFMASK
#define MK_OFFMASK 0x7FF
#endif
#ifndef MK_PREMASK
#define MK_PREMASK 3
#endif
#define IN(k) (lo <= (k) && (k) < hi)
#define INL(o) (((MK_OFFMASK >> (o)) & 1) && IN(pb + (o)))
#define SEAM(k) do { if (IN(k) && IN((k) + 1)) xcd_barrier(bar); } while (0)
    float* MOD = (float*)(F.ws + WS_MOD);
    bf16* U = (bf16*)(F.ws + WS_U); bf16* Yb = (bf16*)(F.ws + WS_Y); float* Y = (float*)(F.ws + WS_Y); bf16* BIG = (bf16*)(F.ws + WS_BIG); float* GATES = (float*)(F.ws + WS_GATES);

    if ((MK_PREMASK & 1) && IN(0)) { pre_mod(F); pre_pe(F); cvt_layer<0>(F); }
    SEAM(0);
    if ((MK_PREMASK & 2) && IN(1)) nrm_rows<true, false, true>(F, 0, M, 0.f, nullptr, nullptr, 0, F.A.in[I_NORMG], MOD, 0, 1);
    SEAM(1);
    for (int layer = 0; layer < 2; ++layer) {
        const int pb = 2 + 11 * layer; const bool last = layer == 1;
        const float* ng = F.A.in[I_NORMG] + (size_t)layer * 6 * D; const float* modl = MOD + (size_t)layer * 9 * 18432;
        const int NP = layer == 0 ? NP0 : NP1;
        const int rlo2 = last ? MC : 0;
        if (INL(0)) { pg8::Gemm g{U, (const bf16*)(F.ws + W_F1I), M, 2 * DFF, D}; pg8::StaticOrder S; S.init(M, 2 * DFF, F.G, F.wg); pg8::EpiSwiglu E{BIG, DFF};
            for (int rep_ = 0; rep_ < MK_REP_GEMM; ++rep_) pg8::gemm_phase<pg8::EpiSwiglu, pg8::StaticOrder, PG8_ALIGN, PG8_SP2>(F.lds, g, S, E); }
        SEAM(pb + 0);
        if (INL(1)) { pg8::Gemm g{BIG, (const bf16*)(F.ws + W_F1O), M, D, DFF}; pg8::StaticOrder S; S.init(M, D, F.G, F.wg); pg8::EpiY E{Yb, D};
            for (int rep_ = 0; rep_ < MK_REP_GEMM; ++rep_) pg8::gemm_phase<pg8::EpiY, pg8::StaticOrder, PG8_ALIGN, PG8_SP2>(F.lds, g, S, E); }
        SEAM(pb + 1);
        if (INL(2)) nrm_rows<false, true, true>(F, 0, M, 0.5f, ng + 1 * D, modl, 2, ng + 2 * D, modl, 3, 4);
        SEAM(pb + 2);
        if (INL(3)) { pg8::Gemm g{U, (const bf16*)(F.ws + W_MI), M, NP, D}; pg8::StaticOrder S; S.init(M, NP, F.G, F.wg); pg8::EpiProj E{BIG, NP, GATES, NP / 256 - 1};
            for (int rep_ = 0; rep_ < MK_REP_GEMM; ++rep_) pg8::gemm_phase<pg8::EpiProj, pg8::StaticOrder, PG8_ALIGN, PG8_SP2>(F.lds, g, S, E); }
        SEAM(pb + 3);
        if (INL(4)) {
            if (layer == 0) {
                bf16* OFb = (bf16*)Y; bf16* OBb = OFb + (size_t)M * 1024; bf16* HFb = OBb + (size_t)M * 1024; bf16* HBb = HFb + (size_t)M * 1024;
                for (int item = F.wg; item < 256 * MK_REP_SCAN; item += F.G) { const int item_ = item; (void)item_;
                    if ((item & 255) < 128) { const int ci = (item & 255) >> 1, vh = item & 1, b = ci >> 3, h = (ci >> 1) & 3, dir = ci & 1;
                        chain_scan<0>(F.lds, BIG, NP0, h * 128, 512 + h * 128, 1024 + h * 256 + vh * 128, GATES, dir * 16, b, dir,
                                      dir ? OBb : OFb, 1024, h * 256 + vh * 128, true, F.A.in[I_WALPHA2] + (size_t)dir * 16 * 512 + h * 128, F.A.in[I_BALPHA] + dir * 512 + h * 128, 0.f, 0.f);
                    } else { const int ri = (item & 255) - 128, b = ri >> 4, n = (ri >> 1) & 7, dir = ri & 1;
                        rg_chain(F.lds, BIG, b, n, dir, (const bf16*)(F.ws + WS_WRG), F.A.in[I_LAM], F.A.in[I_RGBA], F.A.in[I_RGBI], F.A.in[I_CONVW], F.A.in[I_CONVB], dir ? HBb : HFb);
                    }
                }
            } else {
                bf16* HFb = (bf16*)Y; bf16* HBb = HFb + (size_t)M * D;
                for (int item = F.wg; item < 256 * MK_REP_SCAN; item += F.G) { const int ci = (item & 255) >> 1, vh = item & 1, b = ci >> 4, h = (ci >> 1) & 7, dir = ci & 1;
                    chain_scan<1>(F.lds, BIG, NP1, h * 128, 1024 + h * 128, 2048 + h * 256 + vh * 128, GATES, dir * 16 + h, b, dir,
                                  dir ? HBb : HFb, D, h * 256 + vh * 128, false, nullptr, nullptr, F.A.in[I_MLBG][dir * 16 + h], F.A.in[I_MLBG][dir * 16 + 8 + h]);
                }
            }
        }
        SEAM(pb + 4);
        if (INL(5)) { for (int rep_ = 0; rep_ < MK_REP_COMB; ++rep_) { if (layer == 0) comb0_rows(F, 0, M); else comb1_rows(F, MC, M); } }
        SEAM(pb + 5);
        if (INL(6)) { pg8::Gemm g{U + (size_t)rlo2 * D, (const bf16*)(F.ws + W_MO), M - rlo2, D, D}; pg8::StaticOrder S; S.init(M - rlo2, D, F.G, F.wg); pg8::EpiY E{Yb + (size_t)rlo2 * D, D};
            for (int rep_ = 0; rep_ < MK_REP_GEMM; ++rep_) pg8::gemm_phase<pg8::EpiY, pg8::StaticOrder, PG8_ALIGN, PG8_SP2>(F.lds, g, S, E); }
        SEAM(pb + 6);
        if (INL(7)) nrm_rows<false, true, true>(F, rlo2, M, 1.0f, ng + 3 * D, modl, 5, ng + 4 * D, modl, 6, 7);
        SEAM(pb + 7);
        if (INL(8)) { pg8::Gemm g{U + (size_t)rlo2 * D, (const bf16*)(F.ws + W_F2I), M - rlo2, 2 * DFF, D}; pg8::StaticOrder S; S.init(M - rlo2, 2 * DFF, F.G, F.wg); pg8::EpiSwiglu E{BIG + (size_t)rlo2 * DFF, DFF};
            for (int rep_ = 0; rep_ < MK_REP_GEMM; ++rep_) pg8::gemm_phase<pg8::EpiSwiglu, pg8::StaticOrder, PG8_ALIGN, PG8_SP2>(F.lds, g, S, E); }
        SEAM(pb + 8);
        if (INL(9)) { pg8::Gemm g{BIG + (size_t)rlo2 * DFF, (const bf16*)(F.ws + W_F2O), M - rlo2, D, DFF}; pg8::StaticOrder S; S.init(M - rlo2, D, F.G, F.wg); pg8::EpiY E{Yb + (size_t)rlo2 * D, D};
            for (int rep_ = 0; rep_ < MK_REP_GEMM; ++rep_) pg8::gemm_phase<pg8::EpiY, pg8::StaticOrder, PG8_ALIGN, PG8_SP2>(F.lds, g, S, E); }
        SEAM(pb + 9);
        if (INL(10)) {
            if (!last) { nrm_rows<false, true, true>(F, 0, M, 0.5f, ng + 5 * D, modl, 8, F.A.in[I_NORMG] + 6 * D, MOD + (size_t)9 * 18432, 0, 1); __syncthreads(); cvt_layer<1>(F); }
            else nrm_rows<false, true, false>(F, MC, M, 0.5f, ng + 5 * D, modl, 8, nullptr, nullptr, 0, 0);
        }
        SEAM(pb + 10);
    }
#undef IN
#undef SEAM
}

extern "C" void kernel_launch(void* const* d_in, const int* in_sizes, int n_in, void* d_out, int out_size, void* d_ws, size_t ws_size, hipStream_t stream) {
    static int grid = 0;
    if (grid == 0) {
        if (n_in != 27 || out_size != MLAT * D || ws_size < WS_END) { fprintf(stderr, "kernel_launch: unexpected problem (n_in %d, out %d, ws %zu; need ws >= %zu); nothing launched\n", n_in, out_size, ws_size, (size_t)WS_END); grid = -1; return; }
        int dev = 0, cus = 0, per_cu = 0;
        if (hipGetDevice(&dev) != hipSuccess || hipDeviceGetAttribute(&cus, hipDeviceAttributeMultiprocessorCount, dev) != hipSuccess) { fprintf(stderr, "kernel_launch: device query failed\n"); grid = -1; return; }
        if (hipFuncSetAttribute((const void*)mk_fwd, hipFuncAttributeMaxDynamicSharedMemorySize, LDS_BYTES) != hipSuccess) { fprintf(stderr, "kernel_launch: hipFuncSetAttribute failed\n"); grid = -1; return; }
        if (hipOccupancyMaxActiveBlocksPerMultiprocessor(&per_cu, (const void*)mk_fwd, NWAVES * 64, LDS_BYTES) != hipSuccess || per_cu < 1)
            fprintf(stderr, "kernel_launch: note: occupancy query reports %d workgroups per CU\n", per_cu);
        (void)hipGetLastError();
        grid = cus;
    }
    if (grid < 0) return;
    if (hipMemsetAsync((char*)d_ws + WS_CTL, 0, CTL_ZERO_BYTES, stream) != hipSuccess) { fprintf(stderr, "kernel_launch: memset failed\n"); return; }
    Args a{};
    for (int i = 0; i < 27; ++i) a.in[i] = (const float*)d_in[i];
    a.out = (float*)d_out; a.ws = (unsigned char*)d_ws;
#if defined(MK_SPLIT)
    for (int p = 0; p < MK_LAST_PHASE; ++p) { a.ph_lo = p; a.ph_hi = p + 1; hipLaunchKernelGGL(mk_fwd, dim3(grid), dim3(NWAVES * 64), LDS_BYTES, stream, a); }
#else
    a.ph_lo = 0; a.ph_hi = MK_LAST_PHASE;
    hipLaunchKernelGGL(mk_fwd, dim3(grid), dim3(NWAVES * 64), LDS_BYTES, stream, a);
#endif
    const hipError_t le = hipPeekAtLastError();
    if (le != hipSuccess) fprintf(stderr, "kernel_launch: launch failed: %s\n", hipGetErrorName(le));
}
```

```cpp
#include <hip/hip_runtime.h>
#include <cstdio>
#include <cstdint>
__device__ __forceinline__ int fresh_tid() { int t = threadIdx.x; asm volatile("" : "+v"(t)); return t; }
namespace pg8 {
#define PG8_LAS __attribute__((address_space(3)))
typedef unsigned short bf16_t;
typedef short bf16x8 __attribute__((ext_vector_type(8)));
typedef float f32x4 __attribute__((ext_vector_type(4)));
typedef unsigned u32x4 __attribute__((ext_vector_type(4)));
constexpr int BM = 256, BK = 64, HALF = 128, HTB = HALF * BK * 2  , STAGE_BYTES = 8 * HTB, NXCD = 8, WGM = 8;

__host__ __device__ __forceinline__ int lds_byte(int r, int c) { const int st = (r >> 4) * 2 + (c >> 5), rr = r & 15, cc = c & 31, ob = rr * 64 + cc * 2; return st * 1024 + (ob ^ (((ob >> 9) & 1) << 5)); }
__host__ __device__ __forceinline__ void stage_rc(int b, int& R, int& C) { const int st = b / 1024, sb = b % 1024, swz = sb ^ (((sb >> 9) & 1) << 5); R = (st >> 1) * 16 + swz / 64; C = (st & 1) * 32 + (swz % 64) / 2; }
__host__ __device__ __forceinline__ int perm32(int rho) { const int n = rho >> 4, i = rho & 15; return 8 * (i >> 2) + 4 * n + (i & 3); }

struct Unit { int pm, pn, pk, koff, nt; };
struct Gemm { const bf16_t* A; const bf16_t* Bt; int M, N, K; };

struct StaticOrder {
    int nM, nN, nwg, G, c, nt, pm0;
    __host__ __device__ void init(int M, int N, int G_, int c_, int K_ = 0, int pm0_ = 0) { nM = M / BM; nN = N / BM; nwg = nM * nN; G = G_; c = c_; nt = K_ / BK; pm0 = pm0_; }
    __host__ __device__ bool next(int i, Unit& u) const {
        const long L = (long)i * G + c; if (L >= nwg) return false;
        int wgid = (int)L; { const int q = nwg / NXCD, r = nwg % NXCD, xcd = wgid % NXCD, off = wgid / NXCD; wgid = (xcd < r ? xcd * (q + 1) : r * (q + 1) + (xcd - r) * q) + off; }
        const int nig = WGM * nN, gid = wgid / nig, fm = gid * WGM, gsz = (nM - fm) < WGM ? (nM - fm) : WGM;
        u.pm = pm0 + fm + ((wgid % nig) % gsz); u.pn = (wgid % nig) / gsz; u.pk = 0; u.koff = 0; u.nt = nt; return true;
    }
    __device__ __forceinline__ void a_ready(const Unit&) const {}
    __device__ __forceinline__ void done(const Unit&) const {}
};
struct MixedOrder : StaticOrder {
    int nMs, nS, nwgS, nts;
    __host__ __device__ void init(int M, int N, int G_, int c_, int K_, int pm0_, int Ms, int nS_) { StaticOrder::init(M, N, G_, c_, K_, pm0_); nMs = Ms / BM; nS = nS_; nwgS = nMs * nN * nS; nts = K_ / BK / nS_; }
    __host__ __device__ bool next(int i, Unit& u) const {
        const long L = (long)i * G + c; if (L < nwg) return StaticOrder::next(i, u);
        const int l = (int)(L - nwg); if (l >= nwgS) return false;
        u.pk = l % nS; const int t = l / nS; u.pm = t % nMs; u.pn = t / nMs; u.koff = u.pk * nts * BK; u.nt = nts; return true;
    }
};

__device__ __forceinline__ unsigned cvt_pk_bf16(float lo, float hi) { unsigned r; asm volatile("v_cvt_pk_bf16_f32 %0, %1, %2" : "=v"(r) : "v"(lo), "v"(hi)); return r; }
__device__ __forceinline__ float silu_f(float x) { return x * __builtin_amdgcn_rcpf(1.0f + __expf(-x)); }

struct EpiF32 {
    static constexpr bool PERM = false, AFTER_DRAIN = false;
    float* C; int ldc;
    __device__ __forceinline__ void operator()(const f32x4 (&acc)[2][2][4][2], const Unit& u, int wr, int wc, int fr, int fq) const {
        const int row0 = u.pm * BM + wr * 64 + fr, col0 = u.pn * BM + wc * 32 + 4 * fq;
#pragma unroll
        for (int ai = 0; ai < 2; ++ai)
#pragma unroll
            for (int m = 0; m < 4; ++m) { float* rowp = C + (size_t)(row0 + ai * HALF + m * 16) * ldc + col0;
#pragma unroll
                for (int bj = 0; bj < 2; ++bj)
#pragma unroll
                    for (int n = 0; n < 2; ++n) *(f32x4*)(rowp + bj * HALF + n * 16) = acc[ai][bj][m][n]; }
    }
};
struct EpiY {
    static constexpr bool PERM = true, AFTER_DRAIN = false;
    bf16_t* O; int ldc; float* P; size_t split_stride; int nt_full;
    __device__ __forceinline__ void operator()(const f32x4 (&acc)[2][2][4][2], const Unit& u, int wr, int wc, int fr, int fq) const {
        const int row0 = u.pm * BM + wr * 64 + fr, col0 = u.pn * BM + wc * 32 + 8 * fq;
        if (u.nt == nt_full) {
#pragma unroll
            for (int ai = 0; ai < 2; ++ai)
#pragma unroll
                for (int m = 0; m < 4; ++m) { bf16_t* rowp = O + (size_t)(row0 + ai * HALF + m * 16) * ldc + col0;
#pragma unroll
                    for (int bj = 0; bj < 2; ++bj) { const f32x4 v0 = acc[ai][bj][m][0], v1 = acc[ai][bj][m][1];
                        u32x4 w; w.x = cvt_pk_bf16(v0[0], v0[1]); w.y = cvt_pk_bf16(v0[2], v0[3]); w.z = cvt_pk_bf16(v1[0], v1[1]); w.w = cvt_pk_bf16(v1[2], v1[3]);
                        *(u32x4*)(rowp + bj * HALF) = w; } }
        } else {
            float* Pb = P + (size_t)u.pk * split_stride;
#pragma unroll
            for (int ai = 0; ai < 2; ++ai)
#pragma unroll
                for (int m = 0; m < 4; ++m) { float* rowp = Pb + (size_t)(row0 + ai * HALF + m * 16) * ldc + col0;
#pragma unroll
                    for (int bj = 0; bj < 2; ++bj) { *(f32x4*)(rowp + bj * HALF) = acc[ai][bj][m][0]; *(f32x4*)(rowp + bj * HALF + 4) = acc[ai][bj][m][1]; } }
        }
    }
};
struct EpiSwiglu {
    static constexpr bool PERM = true, AFTER_DRAIN = false;
    bf16_t* O; int ldc;
    __device__ __forceinline__ void operator()(const f32x4 (&acc)[2][2][4][2], const Unit& u, int wr, int wc, int fr, int fq) const {
        const int row0 = u.pm * BM + wr * 64 + fr, col0 = u.pn * HALF + wc * 32 + 8 * fq;
#pragma unroll
        for (int ai = 0; ai < 2; ++ai)
#pragma unroll
            for (int m = 0; m < 4; ++m) { bf16_t* rowp = O + (size_t)(row0 + ai * HALF + m * 16) * ldc + col0;
                const f32x4 a0 = acc[ai][0][m][0], a1 = acc[ai][0][m][1], b0 = acc[ai][1][m][0], b1 = acc[ai][1][m][1];
                f32x4 v0, v1;
#pragma unroll
                for (int j = 0; j < 4; ++j) { v0[j] = silu_f(a0[j]) * b0[j]; v1[j] = silu_f(a1[j]) * b1[j]; }
                u32x4 w; w.x = cvt_pk_bf16(v0[0], v0[1]); w.y = cvt_pk_bf16(v0[2], v0[3]); w.z = cvt_pk_bf16(v1[0], v1[1]); w.w = cvt_pk_bf16(v1[2], v1[3]);
                *(u32x4*)rowp = w; }
    }
};
struct EpiProj {
    static constexpr bool PERM = true, AFTER_DRAIN = false;
    bf16_t* O; int ldc; float* gates; int gate_pn;
    __device__ __forceinline__ void operator()(const f32x4 (&acc)[2][2][4][2], const Unit& u, int wr, int wc, int fr, int fq) const {
        const int row0 = u.pm * BM + wr * 64 + fr, col0 = u.pn * BM + wc * 32 + 8 * fq;
#pragma unroll
        for (int ai = 0; ai < 2; ++ai)
#pragma unroll
            for (int m = 0; m < 4; ++m) { bf16_t* rowp = O + (size_t)(row0 + ai * HALF + m * 16) * ldc + col0;
#pragma unroll
                for (int bj = 0; bj < 2; ++bj) { const f32x4 v0 = acc[ai][bj][m][0], v1 = acc[ai][bj][m][1];
                    u32x4 w; w.x = cvt_pk_bf16(v0[0], v0[1]); w.y = cvt_pk_bf16(v0[2], v0[3]); w.z = cvt_pk_bf16(v1[0], v1[1]); w.w = cvt_pk_bf16(v1[2], v1[3]);
                    *(u32x4*)(rowp + bj * HALF) = w; } }
        if (u.pn == gate_pn && wc == 0) {
#pragma unroll
            for (int ai = 0; ai < 2; ++ai)
#pragma unroll
                for (int m = 0; m < 4; ++m) { float* gp = gates + (size_t)(row0 + ai * HALF + m * 16) * 32 + 8 * fq;
                    *(f32x4*)gp = acc[ai][0][m][0]; *(f32x4*)(gp + 4) = acc[ai][0][m][1]; }
        }
    }
};

template <class Epi, class Sched, bool ALIGN_EPI = false, bool SP2 = false>
__device__ __forceinline__ void gemm_phase(PG8_LAS unsigned char* lds, const Gemm g, const Sched& S, const Epi& E) {
    const int tid = fresh_tid(), wid = __builtin_amdgcn_readfirstlane(tid >> 6), lane = tid & 63, wr = wid >> 2, wc = wid & 3, fr = lane & 15, fq = lane >> 4;
    const int ld = g.K;
    unsigned voffA[2], voffB[2];
#pragma unroll
    for (int i = 0; i < 2; ++i) { int R, C; stage_rc(tid * 16 + i * 8192, R, C); const int Rb = Epi::PERM ? ((R & ~31) + perm32(R & 31)) : R;
        voffA[i] = (unsigned)(R * ld + C) * 2u; voffB[i] = (unsigned)(Rb * ld + C) * 2u; }
    const size_t kstep = (size_t)(BK * 2);
    const size_t hstep = (size_t)HALF * ld * 2;
    const size_t tstep = 2 * hstep;
    const unsigned ldsw = (unsigned)wid * 1024u;
    const int aoff = lds_byte(wr * 64 + fr, fq * 8), boff = lds_byte(wc * 32 + fr, fq * 8);
#define PG8_SA(b, h) (((b) * 2 + (h)) * HTB)
#define PG8_SB(b, h) ((4 + (b) * 2 + (h)) * HTB)
#define PG8_STAGE(bufoff, gbase, voff) do { _Pragma("unroll") for (int _i = 0; _i < 2; ++_i) \
        __builtin_amdgcn_global_load_lds((const unsigned*)((const char*)(gbase) + (voff)[_i]), (PG8_LAS unsigned*)(lds + (bufoff) + ldsw + _i * 8192), 16, 0, 0); } while (0)
#define PG8_LDA(dst, b, h) do { _Pragma("unroll") for (int m = 0; m < 4; ++m) _Pragma("unroll") for (int k = 0; k < 2; ++k) dst[m][k] = *(const PG8_LAS bf16x8*)(lds + PG8_SA(b, h) + aoff + m * 2048 + k * 1024); } while (0)
#define PG8_LDB(dst, b, h) do { _Pragma("unroll") for (int n = 0; n < 2; ++n) _Pragma("unroll") for (int k = 0; k < 2; ++k) dst[n][k] = *(const PG8_LAS bf16x8*)(lds + PG8_SB(b, h) + boff + n * 2048 + k * 1024); } while (0)
#define PG8_MMA(ai, bj, At, Bt) do { __builtin_amdgcn_s_setprio(1); _Pragma("unroll") for (int m = 0; m < 4; ++m) _Pragma("unroll") for (int n = 0; n < 2; ++n) _Pragma("unroll") for (int k = 0; k < 2; ++k) \
        acc[ai][bj][m][n] = __builtin_amdgcn_mfma_f32_16x16x32_bf16(Bt[n][k], At[m][k], acc[ai][bj][m][n], 0, 0, 0); __builtin_amdgcn_s_setprio(0); } while (0)
#define PG8_WAIT_V(n) asm volatile("s_waitcnt vmcnt(" #n ")" ::: "memory")
#define PG8_WAIT_L(n) asm volatile("s_waitcnt lgkmcnt(" #n ")" ::: "memory")
#define PG8_BAR __builtin_amdgcn_s_barrier()
#define PG8_SCHED __builtin_amdgcn_sched_barrier(0)
    Unit cur, nxt; int ui = 0;
    if (!S.next(0, cur)) return;
    int nt = cur.nt;
    f32x4 acc[2][2][4][2];
#pragma unroll
    for (int a = 0; a < 2; ++a)
#pragma unroll
        for (int b = 0; b < 2; ++b)
#pragma unroll
            for (int m = 0; m < 4; ++m)
#pragma unroll
                for (int n = 0; n < 2; ++n) acc[a][b][m][n] = (f32x4){0.f, 0.f, 0.f, 0.f};
    bf16x8 At[4][2], B0[2][2], B1[2][2];
    const char* cA = (const char*)g.A + (size_t)cur.pm * tstep + (size_t)cur.koff * 2; const char* cB = (const char*)g.Bt + (size_t)cur.pn * tstep + (size_t)cur.koff * 2;
    S.a_ready(cur);
    if constexpr (SP2) {
        PG8_STAGE(PG8_SB(0, 0), cB, voffB); PG8_STAGE(PG8_SB(0, 1), cB + hstep, voffB); PG8_STAGE(PG8_SA(0, 0), cA, voffA); PG8_STAGE(PG8_SA(0, 1), cA + hstep, voffA);
        if (wr == 1) PG8_BAR;
        PG8_WAIT_V(2); PG8_BAR;
        PG8_STAGE(PG8_SB(1, 0), cB + kstep, voffB); PG8_STAGE(PG8_SA(1, 0), cA + kstep, voffA); PG8_STAGE(PG8_SB(1, 1), cB + hstep + kstep, voffB);
        PG8_WAIT_V(6); PG8_BAR;
    } else {
        PG8_STAGE(PG8_SB(0, 0), cB, voffB); PG8_STAGE(PG8_SA(0, 0), cA, voffA); PG8_STAGE(PG8_SB(0, 1), cB + hstep, voffB); PG8_STAGE(PG8_SA(0, 1), cA + hstep, voffA);
        if (wr == 1) PG8_BAR;
        PG8_WAIT_V(4); PG8_BAR;
        PG8_STAGE(PG8_SB(1, 0), cB + kstep, voffB); PG8_STAGE(PG8_SA(1, 0), cA + kstep, voffA); PG8_STAGE(PG8_SB(1, 1), cB + hstep + kstep, voffB);
        PG8_WAIT_V(6); PG8_BAR;
    }
    for (;;) {
        const bool has_next = S.next(ui + 1, nxt);
        const char* nA = has_next ? (const char*)g.A + (size_t)nxt.pm * tstep + (size_t)nxt.koff * 2 : cA; const char* nB = has_next ? (const char*)g.Bt + (size_t)nxt.pn * tstep + (size_t)nxt.koff * 2 : cB;
        for (int t = 0; t < nt; t += 2) {
            const bool last = (t == nt - 2);
            const char* a1 = cA + (size_t)(t + 1) * kstep;
            const char* a2 = last ? nA : cA + (size_t)(t + 2) * kstep; const char* b2 = last ? nB : cB + (size_t)(t + 2) * kstep;
            const char* a3 = a2 + kstep; const char* b3 = b2 + kstep;
            if (last && has_next) S.a_ready(nxt);
            if constexpr (SP2) {
            PG8_LDB(B0, 0, 0); PG8_LDB(B1, 0, 1); PG8_SCHED; PG8_LDA(At, 0, 0); PG8_STAGE(PG8_SA(1, 1), a1 + hstep, voffA);
            PG8_WAIT_V(8); PG8_WAIT_L(0); PG8_BAR; PG8_MMA(0, 0, At, B0); PG8_MMA(0, 1, At, B1); PG8_BAR; PG8_SCHED;
            PG8_LDA(At, 0, 1); PG8_STAGE(PG8_SB(0, 0), b2, voffB); PG8_STAGE(PG8_SB(0, 1), b2 + hstep, voffB); PG8_STAGE(PG8_SA(0, 0), a2, voffA);
            PG8_WAIT_V(8); PG8_WAIT_L(0); PG8_BAR; PG8_MMA(1, 0, At, B0); PG8_MMA(1, 1, At, B1); PG8_BAR; PG8_SCHED;
            PG8_LDB(B0, 1, 0); PG8_LDB(B1, 1, 1); PG8_SCHED; PG8_LDA(At, 1, 0); PG8_STAGE(PG8_SA(0, 1), a2 + hstep, voffA);
            PG8_WAIT_V(8); PG8_WAIT_L(0); PG8_BAR; PG8_MMA(0, 0, At, B0); PG8_MMA(0, 1, At, B1); PG8_BAR; PG8_SCHED;
            PG8_LDA(At, 1, 1); PG8_STAGE(PG8_SB(1, 0), b3, voffB); PG8_STAGE(PG8_SB(1, 1), b3 + hstep, voffB); PG8_STAGE(PG8_SA(1, 0), a3, voffA);
            PG8_WAIT_V(8); PG8_WAIT_L(0); PG8_BAR; PG8_MMA(1, 0, At, B0); PG8_MMA(1, 1, At, B1); PG8_BAR; PG8_SCHED;
            } else {
            PG8_LDB(B0, 0, 0); PG8_SCHED; PG8_LDA(At, 0, 0); PG8_STAGE(PG8_SA(1, 1), a1 + hstep, voffA);
            PG8_WAIT_L(8); PG8_BAR; PG8_WAIT_L(0); PG8_MMA(0, 0, At, B0); PG8_BAR; PG8_SCHED;
            PG8_LDB(B1, 0, 1); PG8_STAGE(PG8_SB(0, 0), b2, voffB);
            PG8_BAR; PG8_WAIT_L(0); PG8_MMA(0, 1, At, B1); PG8_BAR;
            PG8_LDA(At, 0, 1); PG8_STAGE(PG8_SA(0, 0), a2, voffA);
            PG8_BAR; PG8_WAIT_L(0); PG8_MMA(1, 0, At, B0); PG8_BAR; PG8_SCHED;
            PG8_STAGE(PG8_SB(0, 1), b2 + hstep, voffB);
            PG8_WAIT_V(6); PG8_BAR; PG8_MMA(1, 1, At, B1); PG8_BAR;
            PG8_LDB(B0, 1, 0); PG8_SCHED; PG8_LDA(At, 1, 0); PG8_STAGE(PG8_SA(0, 1), a2 + hstep, voffA);
            PG8_WAIT_L(8); PG8_BAR; PG8_WAIT_L(0); PG8_MMA(0, 0, At, B0); PG8_BAR; PG8_SCHED;
            PG8_LDB(B1, 1, 1); PG8_STAGE(PG8_SB(1, 0), b3, voffB);
            PG8_BAR; PG8_WAIT_L(0); PG8_MMA(0, 1, At, B1); PG8_BAR;
            PG8_LDA(At, 1, 1); PG8_STAGE(PG8_SA(1, 0), a3, voffA);
            PG8_BAR; PG8_WAIT_L(0); PG8_MMA(1, 0, At, B0); PG8_BAR; PG8_SCHED;
            PG8_STAGE(PG8_SB(1, 1), b3 + hstep, voffB);
            PG8_WAIT_V(6); PG8_BAR; PG8_MMA(1, 1, At, B1); PG8_BAR;
            }
        }
        if constexpr (ALIGN_EPI) { if (wr == 0) PG8_BAR; }
        if constexpr (!Epi::AFTER_DRAIN) { E(acc, cur, wr, wc, fr, fq); S.done(cur); }
        if (!has_next) break;
#pragma unroll
        for (int a = 0; a < 2; ++a)
#pragma unroll
            for (int b = 0; b < 2; ++b)
#pragma unroll
                for (int m = 0; m < 4; ++m)
#pragma unroll
                    for (int n = 0; n < 2; ++n) acc[a][b][m][n] = (f32x4){0.f, 0.f, 0.f, 0.f};
        cur = nxt; cA = nA; cB = nB; ++ui; nt = cur.nt;
        if constexpr (ALIGN_EPI) { if (wr == 1) PG8_BAR; }
    }
    PG8_WAIT_V(0);
    if constexpr (!ALIGN_EPI) { if (wr == 0) PG8_BAR; }
    PG8_BAR;
    if constexpr (Epi::AFTER_DRAIN) { E.fused(acc, cur, wr, wc, fr, fq, lds, wid, lane); S.done(cur); }
#undef PG8_SA
#undef PG8_SB
#undef PG8_STAGE
#undef PG8_LDA
#undef PG8_LDB
#undef PG8_MMA
#undef PG8_WAIT_V
#undef PG8_WAIT_L
#undef PG8_BAR
#undef PG8_SCHED
}
}

#ifndef PG8_SP2
#define PG8_SP2 true
#endif
#ifndef PG8_ALIGN
#define PG8_ALIGN true
#endif

constexpr int NWAVES = 8;
constexpr int D = 2048, NB = 8, SEQ = 4096, CTXL = 256, DFF = 5632, NMOD = 9;
constexpr int MC = NB * CTXL;
constexpr int MLAT = NB * SEQ;
constexpr int M = MC + MLAT;
constexpr int NP0 = 5376, NP1 = 6400;
constexpr int NCH = (CTXL + SEQ) / 64;
constexpr float EPS = 1e-6f;
constexpr float QSCALE = 0.08838834764831845f;

constexpr size_t MiB = 1u << 20;
constexpr size_t WS_CTL = 0, CTL_ZERO_BYTES = 1 * MiB;
constexpr size_t WS_MOD = 1 * MiB;
constexpr size_t WS_GATES = 3 * MiB;
constexpr size_t WS_WRG = 8 * MiB;
constexpr size_t WS_PE = 9 * MiB;
constexpr size_t WS_HCTX = 10 * MiB;
constexpr size_t WS_W = 26 * MiB;
constexpr size_t W_F1I = WS_W, W_F1O = W_F1I + 44 * MiB, W_F2I = W_F1O + 22 * MiB, W_F2O = W_F2I + 44 * MiB, W_MI = W_F2O + 22 * MiB, W_MO = W_MI + 25 * MiB;
constexpr size_t WS_U = 192 * MiB;
constexpr size_t WS_Y = 328 * MiB;
constexpr size_t WS_BIG = 600 * MiB;
constexpr size_t WS_YC = 1025 * MiB;
constexpr size_t WS_END = 1089 * MiB;
static_assert(W_MO + 8 * MiB <= WS_U && WS_U + (size_t)M * D * 2 <= WS_Y && WS_Y + (size_t)M * D * 4 <= WS_BIG && WS_BIG + (size_t)M * NP1 * 2 <= WS_YC && WS_YC + (size_t)4 * MC * D * 4 <= WS_END, "ws map");
constexpr int CW_BAR = 4096;

constexpr int SCR_BYTES = 151552;
constexpr int LDSCTL_OFF = SCR_BYTES;
constexpr int LDS_BYTES = 155648;

#define GAS __attribute__((address_space(1)))
#define LAS __attribute__((address_space(3)))
typedef unsigned short bf16;
typedef float f32x4 __attribute__((ext_vector_type(4)));
typedef float f32x2 __attribute__((ext_vector_type(2)));
typedef short bf16x8 __attribute__((ext_vector_type(8)));
typedef short bf16x4 __attribute__((ext_vector_type(4)));
typedef unsigned u32x4 __attribute__((ext_vector_type(4)));
typedef unsigned u32x2 __attribute__((ext_vector_type(2)));
#define LDS_WAIT() asm volatile("s_waitcnt lgkmcnt(0)" ::: "memory")
__device__ __forceinline__ unsigned f2bf(float f) { unsigned u = __builtin_bit_cast(unsigned, f); return (u + 0x7fffu + ((u >> 16) & 1u)) >> 16; }
__device__ __forceinline__ unsigned pk2(float lo, float hi) { return pg8::cvt_pk_bf16(lo, hi); }
__device__ __forceinline__ float bflo(unsigned w) { return __uint_as_float(w << 16); }
__device__ __forceinline__ float bfhi(unsigned w) { return __uint_as_float(w & 0xffff0000u); }
__device__ __forceinline__ float wave_sum(float v) {
#pragma unroll
    for (int o = 1; o < 64; o <<= 1) v += __shfl_xor(v, o);
    return v;
}
__device__ __forceinline__ float sigmoid_f(float x) { return __builtin_amdgcn_rcpf(1.0f + __expf(-x)); }
__device__ __forceinline__ float silu_f(float x) { return x * sigmoid_f(x); }
__device__ __forceinline__ float logsig_f(float z) { return fminf(z, 0.f) - __logf(1.0f + __expf(-fabsf(z))); }
__device__ __forceinline__ float gelu_tanh_f(float x) { const float u = 0.7978845608028654f * (x + 0.044715f * x * x * x); const float t = 1.0f - 2.0f * __builtin_amdgcn_rcpf(1.0f + __expf(2.0f * u)); return 0.5f * x * (1.0f + t); }

#define XB_TMO      128
#define XB_XCNT(j)  (256  + 64 * (j))
#define XB_XSUB(j)  (1280 + 64 * (j))
#define XB_XGEN(j)  (2304 + 64 * (j))
#define XB_TOP      3328
#define XB_TOPGEN   3392
#define XCD_BAR_WORDS 3456
#define XB_SPIN_CAP (1u << 18)

__device__ __forceinline__ unsigned xb_ld(unsigned* p)              { return __hip_atomic_load(p, __ATOMIC_RELAXED, __HIP_MEMORY_SCOPE_AGENT); }
__device__ __forceinline__ unsigned xb_add(unsigned* p, unsigned v) { return __hip_atomic_fetch_add(p, v, __ATOMIC_RELAXED, __HIP_MEMORY_SCOPE_AGENT); }
__device__ __forceinline__ unsigned xb_xcc_id() { return (unsigned)__builtin_amdgcn_s_getreg((3 << 11) | 20) & 0xFu; }
#define XB_SPIN(cond, bar) do { unsigned _sp = 0; while (cond) { __builtin_amdgcn_s_sleep(1); \
    if ((++_sp & 255u) == 0u) { if (xb_ld(&(bar)[XB_TMO])) break; if (_sp > XB_SPIN_CAP) { atomicAdd(&(bar)[XB_TMO], 1u); break; } } } } while (0)

struct XcdBarrier {
    unsigned* bar; unsigned x;
    volatile LAS unsigned* st;
};

__device__ __forceinline__ XcdBarrier xcd_barrier_post(unsigned* bar, volatile LAS unsigned* st) {
    XcdBarrier b; b.bar = bar; b.x = xb_xcc_id(); b.st = st;
    if (threadIdx.x == 0) (void)xb_add(&bar[XB_XCNT(b.x)], 1u);
    return b;
}
__device__ __forceinline__ void xcd_barrier_complete(unsigned* bar, unsigned x, unsigned& nloc, unsigned& nx) {
    const unsigned G = gridDim.x * gridDim.y * gridDim.z;
    unsigned sum, cnt, mine, sp = 0u;
    for (;;) {
        sum = 0u; cnt = 0u; mine = 0u;
#pragma unroll
        for (unsigned j = 0; j < 16; ++j) { const unsigned c = xb_ld(&bar[XB_XCNT(j)]); sum += c; cnt += (c > 0u) ? 1u : 0u; mine = (j == x) ? c : mine; }
        if (sum == G) break;
        __builtin_amdgcn_s_sleep(1);
        if ((++sp & 255u) == 0u) { if (xb_ld(&bar[XB_TMO])) break; if (sp > XB_SPIN_CAP) { atomicAdd(&bar[XB_TMO], 1u); break; } }
    }
    nloc = mine > 0u ? mine : 1u; nx = cnt > 0u ? cnt : 1u;
}

__device__ __forceinline__ void xcd_barrier(const XcdBarrier& b) {
    asm volatile("s_waitcnt vmcnt(0)" ::: "memory");
    __syncthreads();
    if (threadIdx.x == 0) {
        unsigned* bar = b.bar;
        __builtin_amdgcn_s_waitcnt(0);
        unsigned nloc = b.st[0], nx = b.st[1];
        if (nloc == 0u) { xcd_barrier_complete(bar, b.x, nloc, nx); b.st[0] = nloc; b.st[1] = nx; }
        const unsigned old = xb_add(&bar[XB_XSUB(b.x)], 1u);
        const unsigned gen = old / nloc;
        if (old + 1u == (gen + 1u) * nloc) {
            __builtin_amdgcn_fence(__ATOMIC_RELEASE, "agent");
            asm volatile("s_waitcnt vmcnt(0)" ::: "memory");
            const unsigned og = xb_add(&bar[XB_TOP], 1u);
            const unsigned tg = og / nx;
            if (og + 1u == (tg + 1u) * nx) xb_add(&bar[XB_TOPGEN], 1u);
            else XB_SPIN(xb_ld(&bar[XB_TOPGEN]) == tg, bar);
            __builtin_amdgcn_fence(__ATOMIC_ACQUIRE, "agent");
            xb_add(&bar[XB_XGEN(b.x)], 1u);
            asm volatile("s_waitcnt vmcnt(0)" ::: "memory");
        } else {
            XB_SPIN(xb_ld(&bar[XB_XGEN(b.x)]) == gen, bar);
            __builtin_amdgcn_fence(__ATOMIC_ACQUIRE, "agent");
            asm volatile("s_waitcnt vmcnt(0)" ::: "memory");
        }
    }
    __syncthreads();
}

struct Args { const float* in[27]; float* out; unsigned char* ws; int ph_lo, ph_hi; };
struct Frame {
    LAS unsigned char* lds;
    int G, wg, NGW;
    float* out; unsigned char* ws;
    const Args& A;
};
enum { I_X = 0, I_C, I_CTX, I_CCTX, I_WMOD, I_BMOD, I_NORMG, I_F1WI, I_F1WO, I_F2WI, I_F2WO, I_ABWI, I_WALPHA2, I_BALPHA, I_GLANG, I_CONVW, I_CONVB, I_RGWA, I_RGBA, I_RGWI, I_RGBI, I_LAM, I_ABWO, I_MLWI, I_MLBG, I_MLNG, I_MLWO };

__device__ __forceinline__ void pre_mod(Frame& F) {
    const int tid_ = fresh_tid(); const int lane_ = tid_ & 63, wave_ = __builtin_amdgcn_readfirstlane(tid_ >> 6), gw_ = F.wg * NWAVES + wave_; (void)lane_; (void)gw_;
    LAS float* sc = (LAS float*)F.lds;
    LAS float* red = (LAS float*)(F.lds + 9 * 2048 * 4);
    for (int i = tid_; i < 9 * 2048; i += 512) { const int bb = i >> 11, k = i & 2047; const float v = bb < 8 ? F.A.in[I_C][bb * 2048 + k] : F.A.in[I_CCTX][k]; sc[i] = v * (1.0f / (1.0f + expf(-v))); }
    __syncthreads();
    float* MOD = (float*)(F.ws + WS_MOD);
    const int q = tid_ & 15, kg = tid_ >> 4;
    for (int item = F.wg; item < 2 * 288; item += F.G) {
        const int layer = item / 288, col0 = (item % 288) * 64;
        const float* wp = F.A.in[I_WMOD] + ((size_t)layer * 2048 + (size_t)kg * 64) * 18432 + col0 + 4 * q;
        f32x4 acc[9];
#pragma unroll
        for (int bb = 0; bb < 9; ++bb) acc[bb] = (f32x4){0.f, 0.f, 0.f, 0.f};
#pragma unroll 4
        for (int kk = 0; kk < 64; ++kk) {
            const f32x4 w = *(const f32x4*)(wp + (size_t)kk * 18432);
#pragma unroll
            for (int bb = 0; bb < 9; ++bb) acc[bb] += w * sc[bb * 2048 + kg * 64 + kk];
        }
#pragma unroll
        for (int bb = 0; bb < 9; ++bb)
#pragma unroll
            for (int e = 0; e < 4; ++e) { float v = acc[bb][e]; v += __shfl_xor(v, 16); v += __shfl_xor(v, 32); acc[bb][e] = v; }
        __syncthreads();
        if (lane_ < 16) {
#pragma unroll
            for (int bb = 0; bb < 9; ++bb) *(LAS f32x4*)(red + (wave_ * 9 + bb) * 64 + 4 * q) = acc[bb];
        }
        __syncthreads();
        for (int t = tid_; t < 9 * 64; t += 512) { const int bb = t >> 6, ci = t & 63; float s = F.A.in[I_BMOD][layer * 18432 + col0 + ci];
#pragma unroll
            for (int w = 0; w < 8; ++w) s += red[(w * 9 + bb) * 64 + ci];
            MOD[((size_t)layer * 9 + bb) * 18432 + col0 + ci] = s; }
    }
    __syncthreads();
}
__device__ __forceinline__ void pre_pe(Frame& F) {
    const int tid_ = fresh_tid(); const int lane_ = tid_ & 63, wave_ = __builtin_amdgcn_readfirstlane(tid_ >> 6), gw_ = F.wg * NWAVES + wave_; (void)lane_; (void)gw_;
    float* PE = (float*)(F.ws + WS_PE);
    for (int i = F.wg * 512 + tid_; i < 64 * 512; i += F.G * 512) {
        const int p = i >> 9, f = i & 511;
        const float om = (float)exp2(-(double)f * (13.287712379549449 / 512.0));
        const float angf = (float)p * om; const double x = (double)angf;
        const double kf = rint(x * 0.6366197723675814);
        double r = fma(-kf, 1.5707963267948966, x); r = fma(-kf, 6.123233995736766e-17, r);
        const int k = ((int)kf) & 3; const double r2 = r * r;
        const double sp = r * (1.0 + r2 * (-1.0 / 6.0 + r2 * (1.0 / 120.0 + r2 * (-1.0 / 5040.0 + r2 * (1.0 / 362880.0 + r2 * (-1.0 / 39916800.0 + r2 * (1.0 / 6227020800.0)))))));
        const double cp = 1.0 + r2 * (-0.5 + r2 * (1.0 / 24.0 + r2 * (-1.0 / 720.0 + r2 * (1.0 / 40320.0 + r2 * (-1.0 / 3628800.0 + r2 * (1.0 / 479001600.0))))));
        const double s = (k == 0) ? sp : (k == 1) ? cp : (k == 2) ? -sp : -cp;
        const double c = (k == 0) ? cp : (k == 1) ? -sp : (k == 2) ? -cp : sp;
        PE[p * 1024 + f] = (float)s; PE[p * 1024 + 512 + f] = (float)c;
    }
}
template <int MAP> __device__ __forceinline__ int cvt_row(int n) {
    if (MAP == 1) return n < DFF ? ((n >> 7) << 8) + (n & 127) : (((n - DFF) >> 7) << 8) + 128 + ((n - DFF) & 127);
    if (MAP == 2) return n < 3072 ? n : (n < 3104 ? n + 2048 : n - 32);
    return n;
}
template <int MAP> __device__ __forceinline__ void cvt_item(const float* W, int K, int N, bf16* WT, LAS float* scr, int item, int lane) {
    const int nblk = N / 32, kb = item / nblk, nb = item % nblk, k0 = 64 * kb, n0 = 32 * nb;
#pragma unroll 8
    for (int i = 0; i < 32; ++i) { const int kk = 2 * i + (lane >> 5); scr[kk * 33 + (lane & 31)] = W[(size_t)(k0 + kk) * N + n0 + (lane & 31)]; }
    LDS_WAIT(); asm volatile("" ::: "memory");
    const int c = lane & 7;
#pragma unroll
    for (int j = 0; j < 4; ++j) { const int n = (lane >> 3) + 8 * j; const LAS float* s = scr + (8 * c) * 33 + n;
        u32x4 o; o.x = pk2(s[0 * 33], s[1 * 33]); o.y = pk2(s[2 * 33], s[3 * 33]); o.z = pk2(s[4 * 33], s[5 * 33]); o.w = pk2(s[6 * 33], s[7 * 33]);
        *(u32x4*)(WT + (size_t)cvt_row<MAP>(n0 + n) * K + k0 + 8 * c) = o; }
    LDS_WAIT(); asm volatile("" ::: "memory");
}
template <int LAYER> __device__ __forceinline__ void cvt_layer(Frame& F) {
    const int tid_ = fresh_tid(); const int lane_ = tid_ & 63, wave_ = __builtin_amdgcn_readfirstlane(tid_ >> 6), gw_ = F.wg * NWAVES + wave_; (void)lane_; (void)gw_;
    LAS float* scr = (LAS float*)(F.lds + wave_ * 16384);
    constexpr int I0 = 32 * 352, I1 = 88 * 64, I4 = LAYER == 0 ? 32 * 161 : 32 * 193, I5 = 32 * 64, I6 = LAYER == 0 ? 256 : 0;
    constexpr int NITEMS = 2 * I0 + 2 * I1 + I4 + I5 + I6;
    const float* f1i = F.A.in[I_F1WI] + (size_t)LAYER * D * 2 * DFF; const float* f1o = F.A.in[I_F1WO] + (size_t)LAYER * DFF * D;
    const float* f2i = F.A.in[I_F2WI] + (size_t)LAYER * D * 2 * DFF; const float* f2o = F.A.in[I_F2WO] + (size_t)LAYER * DFF * D;
    for (int it = gw_; it < NITEMS; it += F.NGW) {
        int r = it;
        if (r < I0) { cvt_item<1>(f1i, D, 2 * DFF, (bf16*)(F.ws + W_F1I), scr, r, lane_); continue; } r -= I0;
        if (r < I1) { cvt_item<0>(f1o, DFF, D, (bf16*)(F.ws + W_F1O), scr, r, lane_); continue; } r -= I1;
        if (r < I0) { cvt_item<1>(f2i, D, 2 * DFF, (bf16*)(F.ws + W_F2I), scr, r, lane_); continue; } r -= I0;
        if (r < I1) { cvt_item<0>(f2o, DFF, D, (bf16*)(F.ws + W_F2O), scr, r, lane_); continue; } r -= I1;
        if (r < I4) { if (LAYER == 0) cvt_item<2>(F.A.in[I_ABWI], D, 5152, (bf16*)(F.ws + W_MI), scr, r, lane_); else cvt_item<0>(F.A.in[I_MLWI], D, 6176, (bf16*)(F.ws + W_MI), scr, r, lane_); continue; } r -= I4;
        if (r < I5) { cvt_item<0>(LAYER == 0 ? F.A.in[I_ABWO] : F.A.in[I_MLWO], D, D, (bf16*)(F.ws + W_MO), scr, r, lane_); continue; } r -= I5;
        if (LAYER == 0) { const int mi = r >> 3, sub = r & 7, dir = mi >> 4, mat = (mi >> 3) & 1, n = mi & 7;
            const float* src = (mat ? F.A.in[I_RGWI] : F.A.in[I_RGWA]) + (size_t)(dir * 8 + n) * 128 * 128;
            cvt_item<0>(src, 128, 128, (bf16*)(F.ws + WS_WRG) + (size_t)mi * 128 * 128, scr, sub, lane_); }
    }
    constexpr int PR0 = LAYER == 0 ? 5152 : 6176, PR1 = LAYER == 0 ? NP0 : NP1;
    u32x4* z = (u32x4*)((bf16*)(F.ws + W_MI) + (size_t)PR0 * D);
    for (int i = F.wg * 512 + tid_; i < (PR1 - PR0) * D / 8; i += F.G * 512) z[i] = (u32x4){0u, 0u, 0u, 0u};
}

__device__ __forceinline__ float* hrow(Frame& F, int r) { return r < MC ? (float*)(F.ws + WS_HCTX) + (size_t)r * D : F.out + (size_t)(r - MC) * D; }
template <bool INIT, bool HAS_Y, bool HAS_U>
__device__ __forceinline__ void nrm_rows(Frame& F, int row_lo, int row_hi, float wgt, const float* gpost, const float* mod_g, int gate_slot,
                                         const float* gpre, const float* mod_u, int shift_slot, int scale_slot) {
    const int tid_ = fresh_tid(); const int lane_ = tid_ & 63, wave_ = __builtin_amdgcn_readfirstlane(tid_ >> 6);
    constexpr int R = 8;
    const bf16* Yb = (const bf16*)(F.ws + WS_Y); bf16* U = (bf16*)(F.ws + WS_U); const float* PE = (const float*)(F.ws + WS_PE);
    LAS float* PS = (LAS float*)F.lds;
    const int col = 256 * wave_ + 4 * lane_;
    const int nblk = (row_hi - row_lo) / R;
    int cur_bb = -1;
    f32x4 gp = (f32x4){0.f, 0.f, 0.f, 0.f}, gt = gp, gn = gp, sh = gp, sc = gp;
    if (HAS_Y) gp = *(const f32x4*)(gpost + col);
    if (HAS_U) gn = *(const f32x4*)(gpre + col);
    __syncthreads();
    for (int blk = F.wg; blk < nblk; blk += F.G) {
        const int r0 = row_lo + blk * R;
        const int bb = r0 < MC ? 8 : (r0 - MC) >> 12;
        if (bb != cur_bb) { cur_bb = bb;
            if (HAS_Y) gt = *(const f32x4*)(mod_g + ((size_t)bb * 9 + gate_slot) * D + col);
            if (HAS_U) { sh = *(const f32x4*)(mod_u + ((size_t)bb * 9 + shift_slot) * D + col); sc = *(const f32x4*)(mod_u + ((size_t)bb * 9 + scale_slot) * D + col) + 1.0f; } }
        f32x4 hv[R];
#pragma unroll
        for (int i = 0; i < R; ++i) { const int r = r0 + i;
            if (INIT) {
                if (r < MC) hv[i] = *(const f32x4*)(F.A.in[I_CTX] + (size_t)r * D + col);
                else { const int t = (r - MC) & (SEQ - 1), prow = t >> 6, pcol = t & 63;
                    const f32x4 xv = *(const f32x4*)(F.A.in[I_X] + (size_t)(r - MC) * D + col);
                    const f32x4 pv = col < 1024 ? *(const f32x4*)(PE + prow * 1024 + col) : *(const f32x4*)(PE + pcol * 1024 + col - 1024);
                    hv[i] = xv + pv; }
            } else hv[i] = *(const f32x4*)(hrow(F, r) + col);
        }
        if (HAS_Y) {
            f32x4 yv[R];
#pragma unroll
            for (int i = 0; i < R; ++i) {
                if (r0 < MC) { const float* yc = (const float*)(F.ws + WS_YC) + (size_t)(r0 + i) * D + col;
                    yv[i] = (*(const f32x4*)yc + *(const f32x4*)(yc + (size_t)MC * D)) + (*(const f32x4*)(yc + (size_t)2 * MC * D) + *(const f32x4*)(yc + (size_t)3 * MC * D)); }
                else { const u32x2 w = *(const u32x2*)(Yb + (size_t)(r0 + i) * D + col); yv[i] = (f32x4){bflo(w.x), bfhi(w.x), bflo(w.y), bfhi(w.y)}; } }
#pragma unroll
            for (int i = 0; i < R; ++i) { const float ss = wave_sum((yv[i].x * yv[i].x + yv[i].y * yv[i].y) + (yv[i].z * yv[i].z + yv[i].w * yv[i].w)); if (lane_ == 0) PS[i * 8 + wave_] = ss; }
            asm volatile("s_waitcnt lgkmcnt(0)" ::: "memory"); __builtin_amdgcn_s_barrier(); asm volatile("" ::: "memory");
#pragma unroll
            for (int i = 0; i < R; ++i) { const f32x4 p0 = *(const LAS f32x4*)(PS + i * 8), p1 = *(const LAS f32x4*)(PS + i * 8 + 4);
                const float tot = ((p0.x + p0.y) + (p0.z + p0.w)) + ((p1.x + p1.y) + (p1.z + p1.w));
                const float r1 = rsqrtf(tot * (1.0f / D) + EPS) * wgt;
                hv[i] = hv[i] + gt * (yv[i] * r1 * gp); }
        }
        if (INIT || HAS_Y) {
#pragma unroll
            for (int i = 0; i < R; ++i) *(f32x4*)(hrow(F, r0 + i) + col) = hv[i];
        }
        if (HAS_U) {
#pragma unroll
            for (int i = 0; i < R; ++i) { const float ss = wave_sum((hv[i].x * hv[i].x + hv[i].y * hv[i].y) + (hv[i].z * hv[i].z + hv[i].w * hv[i].w)); if (lane_ == 0) PS[64 + i * 8 + wave_] = ss; }
            asm volatile("s_waitcnt lgkmcnt(0)" ::: "memory"); __builtin_amdgcn_s_barrier(); asm volatile("" ::: "memory");
#pragma unroll
            for (int i = 0; i < R; ++i) { const f32x4 p0 = *(const LAS f32x4*)(PS + 64 + i * 8), p1 = *(const LAS f32x4*)(PS + 64 + i * 8 + 4);
                const float tot = ((p0.x + p0.y) + (p0.z + p0.w)) + ((p1.x + p1.y) + (p1.z + p1.w));
                const float r2 = rsqrtf(tot * (1.0f / D) + EPS);
                const f32x4 u = (hv[i] * r2 * gn) * sc + sh;
                u32x2 w; w.x = pk2(u.x, u.y); w.y = pk2(u.z, u.w);
                *(u32x2*)(U + (size_t)(r0 + i) * D + col) = w; }
        }
        if (!HAS_Y || !HAS_U) { asm volatile("s_waitcnt lgkmcnt(0)" ::: "memory"); __builtin_amdgcn_s_barrier(); asm volatile("" ::: "memory"); }
    }
    __syncthreads();
}

__device__ __forceinline__ void unpack8(const u32x4 v, float (&f)[8]) { f[0] = bflo(v.x); f[1] = bfhi(v.x); f[2] = bflo(v.y); f[3] = bfhi(v.y); f[4] = bflo(v.z); f[5] = bfhi(v.z); f[6] = bflo(v.w); f[7] = bfhi(v.w); }
__device__ __forceinline__ u32x4 pack8(const float (&f)[8]) { u32x4 o; o.x = pk2(f[0], f[1]); o.y = pk2(f[2], f[3]); o.z = pk2(f[4], f[5]); o.w = pk2(f[6], f[7]); return o; }
__device__ __forceinline__ void comb0_rows(Frame& F, int row_lo, int row_hi) {
    const int tid_ = fresh_tid(); const int lane_ = tid_ & 63, wave_ = __builtin_amdgcn_readfirstlane(tid_ >> 6), gw_ = F.wg * NWAVES + wave_; (void)lane_; (void)gw_;
    const bf16* OFb = (const bf16*)(F.ws + WS_Y); const bf16* OBb = OFb + (size_t)M * 1024; const bf16* HFb = OBb + (size_t)M * 1024; const bf16* HBb = HFb + (size_t)M * 1024;
    const bf16* P = (const bf16*)(F.ws + WS_BIG); bf16* U = (bf16*)(F.ws + WS_U); const float* gg = F.A.in[I_GLANG];
    const int e0 = 16 * lane_;
    for (int r = row_lo + gw_; r < row_hi; r += F.NGW) {
#pragma unroll
        for (int part = 0; part < 2; ++part) {
            const bf16* fa = (part ? HFb : OFb) + (size_t)r * 1024 + e0; const bf16* fb = (part ? HBb : OBb) + (size_t)r * 1024 + e0;
            const bf16* gp = P + (size_t)r * NP0 + (part ? 4096 : 2048) + e0;
            float a[2][8], b8[8], g[2][8];
            unpack8(*(const u32x4*)fa, a[0]); unpack8(*(const u32x4*)(fa + 8), a[1]);
            unpack8(*(const u32x4*)fb, b8);
#pragma unroll
            for (int e = 0; e < 8; ++e) a[0][e] += b8[e];
            unpack8(*(const u32x4*)(fb + 8), b8);
#pragma unroll
            for (int e = 0; e < 8; ++e) a[1][e] += b8[e];
            unpack8(*(const u32x4*)gp, g[0]); unpack8(*(const u32x4*)(gp + 8), g[1]);
            float o[2][8];
            if (part == 0) {
                float ss = 0.f;
#pragma unroll
                for (int c = 0; c < 2; ++c)
#pragma unroll
                    for (int e = 0; e < 8; ++e) ss += a[c][e] * a[c][e];
                ss += __shfl_xor(ss, 1); ss += __shfl_xor(ss, 2); ss += __shfl_xor(ss, 4); ss += __shfl_xor(ss, 8);
                const float rr = rsqrtf(ss * (1.0f / 256.0f) + EPS);
#pragma unroll
                for (int c = 0; c < 2; ++c)
#pragma unroll
                    for (int e = 0; e < 8; ++e) o[c][e] = a[c][e] * rr * gg[(e0 & 255) + 8 * c + e] * silu_f(g[c][e]);
            } else {
#pragma unroll
                for (int c = 0; c < 2; ++c)
#pragma unroll
                    for (int e = 0; e < 8; ++e) o[c][e] = a[c][e] * gelu_tanh_f(g[c][e]);
            }
            bf16* up = U + (size_t)r * D + part * 1024 + e0;
            *(u32x4*)up = pack8(o[0]); *(u32x4*)(up + 8) = pack8(o[1]);
        }
    }
}
__device__ __forceinline__ void comb1_rows(Frame& F, int row_lo, int row_hi) {
    const int tid_ = fresh_tid(); const int lane_ = tid_ & 63, wave_ = __builtin_amdgcn_readfirstlane(tid_ >> 6), gw_ = F.wg * NWAVES + wave_; (void)lane_; (void)gw_;
    const bf16* HFb = (const bf16*)(F.ws + WS_Y); const bf16* HBb = HFb + (size_t)M * D;
    const bf16* P = (const bf16*)(F.ws + WS_BIG); bf16* U = (bf16*)(F.ws + WS_U); const float* gg = F.A.in[I_MLNG];
    const int e0 = 32 * lane_;
    for (int r = row_lo + gw_; r < row_hi; r += F.NGW) {
        float a[32]; float ss = 0.f;
#pragma unroll
        for (int c = 0; c < 4; ++c) { float x8[8], y8[8]; unpack8(*(const u32x4*)(HFb + (size_t)r * D + e0 + 8 * c), x8); unpack8(*(const u32x4*)(HBb + (size_t)r * D + e0 + 8 * c), y8);
#pragma unroll
            for (int e = 0; e < 8; ++e) { a[8 * c + e] = x8[e] + y8[e]; ss += a[8 * c + e] * a[8 * c + e]; } }
        ss += __shfl_xor(ss, 1); ss += __shfl_xor(ss, 2); ss += __shfl_xor(ss, 4);
        const float rr = rsqrtf(ss * (1.0f / 256.0f) + EPS);
#pragma unroll
        for (int c = 0; c < 4; ++c) { float g8[8], o8[8]; unpack8(*(const u32x4*)(P + (size_t)r * NP1 + 4096 + e0 + 8 * c), g8);
#pragma unroll
            for (int e = 0; e < 8; ++e) o8[e] = a[8 * c + e] * rr * gg[((e0 + 8 * c) & 255) + e] * sigmoid_f(g8[e]);
            *(u32x4*)(U + (size_t)r * D + e0 + 8 * c) = pack8(o8); }
    }
}

#define WG_BAR() do { asm volatile("s_waitcnt lgkmcnt(0)" ::: "memory"); __builtin_amdgcn_s_barrier(); asm volatile("" ::: "memory"); } while (0)
__device__ __forceinline__ int chunk_rlo(int b, int dir, int c) {
    return c < 4 ? b * CTXL + (dir ? (CTXL - 64 - 64 * c) : 64 * c) : MC + b * SEQ + (dir ? (SEQ - 64 - 64 * (c - 4)) : 64 * (c - 4));
}
__device__ __forceinline__ bf16x8 tr_frag(LAS unsigned char* tile, int pitch, int k0, int c0, int lane) {
    const int g = lane >> 4, q = (lane & 15) >> 2, p = lane & 3;
    LAS unsigned char* a0 = tile + (k0 + 8 * g + q) * pitch + (c0 + 4 * p) * 2;
    const bf16x4 lo = __builtin_amdgcn_ds_read_tr16_b64_v4i16((LAS bf16x4*)a0);
    const bf16x4 hi = __builtin_amdgcn_ds_read_tr16_b64_v4i16((LAS bf16x4*)(a0 + 4 * pitch));
    return __builtin_shufflevector(lo, hi, 0, 1, 2, 3, 4, 5, 6, 7);
}
__device__ __forceinline__ u32x4 scale8(const u32x4 v, float s) {
    u32x4 o; o.x = pk2(bflo(v.x) * s, bfhi(v.x) * s); o.y = pk2(bflo(v.y) * s, bfhi(v.y) * s); o.z = pk2(bflo(v.z) * s, bfhi(v.z) * s); o.w = pk2(bflo(v.w) * s, bfhi(v.w) * s); return o;
}
__device__ __forceinline__ float wave_incl_sum(float x, int lane) {
#pragma unroll
    for (int o = 1; o < 64; o <<= 1) { const float t = __shfl_up(x, o); if (lane >= o) x += t; }
    return x;
}
__device__ __forceinline__ float wave_incl_max(float x, int lane) {
#pragma unroll
    for (int o = 1; o < 64; o <<= 1) { const float t = __shfl_up(x, o); if (lane >= o) x = fmaxf(x, t); }
    return x;
}

template <int MODE>
__device__ __forceinline__ void chain_scan(LAS unsigned char* lds,
        const bf16* __restrict__ proj, const int NP, const int qcol, const int kcol, const int vcol,
        const float* __restrict__ gates, const int gcol, const int b, const int dir,
        bf16* __restrict__ outb, const int out_ld, const int ocol, const bool ctx_out,
        const float* __restrict__ w2, const float* __restrict__ ba, const float bias_i, const float bias_f) {
    const int tid = fresh_tid(); const int lane = tid & 63, wave = __builtin_amdgcn_readfirstlane(tid >> 6);
    constexpr int NVB = MODE ? 9 : 8;
    constexpr int PQ = 272, PV = 304, PP = 144;
    constexpr int O_QS = 0, O_KS = 17408, O_QH = 34816, O_KH = 52224, O_VS = 69632, O_PS = 89088, O_SB = 98304, O_SM = 137472;
    LAS float* LR = (LAS float*)(lds + O_SM);
    LAS float* TOT = (LAS float*)(lds + O_SM + 4096);
    LAS float* FIRST = (LAS float*)(lds + O_SM + 8192);
    LAS float* DEC = (LAS float*)(lds + O_SM + 8704);
    LAS float* A_ = (LAS float*)(lds + O_SM);
    LAS float* MI = A_ + 64; LAS float* WI = A_ + 128; LAS float* WK = A_ + 192; LAS float* MR = A_ + 256; LAS float* DEN = A_ + 320; LAS float* DECS = A_ + 384;
    const int fr = lane & 15, fq = lane >> 4;

    __syncthreads();
    for (int i = tid; i < (9216 + 39168) / 16; i += 512) *(LAS u32x4*)(lds + O_PS + 16 * i) = (u32x4){0u, 0u, 0u, 0u};
    if (MODE) { if (tid < 64) { *(LAS u32x4*)(lds + O_VS + tid * PV + 256) = (u32x4){0x3F80u, 0u, 0u, 0u}; *(LAS u32x4*)(lds + O_VS + tid * PV + 272) = (u32x4){0u, 0u, 0u, 0u}; } }
    f32x4 S[NVB];
#pragma unroll
    for (int v = 0; v < NVB; ++v) S[v] = (f32x4){0.f, 0.f, 0.f, 0.f};
    float mst = 0.f;
    const int dp = tid & 63, d0 = 2 * dp, jg = wave;
    f32x2 w2r[16]; f32x2 bar = (f32x2){0.f, 0.f};
    if (MODE == 0) {
#pragma unroll
        for (int r = 0; r < 16; ++r) w2r[r] = *(const f32x2*)(w2 + r * 512 + d0);
        bar = *(const f32x2*)(ba + d0);
    }
    const int sj0 = tid >> 4, sj1 = (tid + 512) >> 4, sch = tid & 15;
    u32x4 pq[2], pk[2], pv[2]; f32x2 plr = (f32x2){0.f, 0.f}; float pgi = 0.f, pgf = 0.f;
#define CH_PREFETCH(cc) do { const int rl_ = chunk_rlo(b, dir, (cc)); \
        { const int row_ = dir ? rl_ + 63 - sj0 : rl_ + sj0; const bf16* rp_ = proj + (size_t)row_ * NP + 8 * sch; pq[0] = *(const u32x4*)(rp_ + qcol); pk[0] = *(const u32x4*)(rp_ + kcol); pv[0] = *(const u32x4*)(rp_ + vcol); } \
        { const int row_ = dir ? rl_ + 63 - sj1 : rl_ + sj1; const bf16* rp_ = proj + (size_t)row_ * NP + 8 * sch; pq[1] = *(const u32x4*)(rp_ + qcol); pk[1] = *(const u32x4*)(rp_ + kcol); pv[1] = *(const u32x4*)(rp_ + vcol); } \
        if (MODE == 0) { const int j_ = 8 * wave + (lane >> 3); const int row_ = dir ? rl_ + 63 - j_ : rl_ + j_; plr = *(const f32x2*)(gates + (size_t)row_ * 32 + gcol + 2 * (lane & 7)); } \
        else { if (wave == 0) { const int row_ = dir ? rl_ + 63 - lane : rl_ + lane; pgi = gates[(size_t)row_ * 32 + gcol]; pgf = gates[(size_t)row_ * 32 + gcol + 8]; } } } while (0)
    CH_PREFETCH(0);
    for (int c = 0; c < NCH; ++c) {
        const int rl = chunk_rlo(b, dir, c);
        *(LAS u32x4*)(lds + O_QS + sj0 * PQ + 16 * sch) = pq[0]; *(LAS u32x4*)(lds + O_QS + sj1 * PQ + 16 * sch) = pq[1];
        *(LAS u32x4*)(lds + O_KS + sj0 * PQ + 16 * sch) = pk[0]; *(LAS u32x4*)(lds + O_KS + sj1 * PQ + 16 * sch) = pk[1];
        *(LAS u32x4*)(lds + O_VS + sj0 * PV + 16 * sch) = pv[0]; *(LAS u32x4*)(lds + O_VS + sj1 * PV + 16 * sch) = pv[1];
        const f32x2 lrc = plr; const float gi = pgi, gf = pgf;
        if (c + 1 < NCH) CH_PREFETCH(c + 1);
        WG_BAR();
        if (MODE == 0) {
            f32x2 cs[8]; f32x2 run = (f32x2){0.f, 0.f};
#pragma unroll
            for (int jj = 0; jj < 8; ++jj) {
                f32x2 z = bar;
#pragma unroll
                for (int r2 = 0; r2 < 8; ++r2) { const float l0 = __int_as_float(__builtin_amdgcn_readlane(__float_as_int(lrc.x), 8 * jj + r2)), l1 = __int_as_float(__builtin_amdgcn_readlane(__float_as_int(lrc.y), 8 * jj + r2));
                    z += w2r[2 * r2] * l0; z += w2r[2 * r2 + 1] * l1; }
                f32x2 la; la.x = fmaxf(logsig_f(z.x) * (1.0f / 16.0f), -1.0f); la.y = fmaxf(logsig_f(z.y) * (1.0f / 16.0f), -1.0f);
                run += la; cs[jj] = run;
            }
            *(LAS f32x2*)(TOT + jg * 128 + d0) = run;
            if (jg == 4) *(LAS f32x2*)(FIRST + d0) = cs[0];
            WG_BAR();
            f32x2 pre = (f32x2){0.f, 0.f}, bref = (f32x2){0.f, 0.f}, blast = (f32x2){0.f, 0.f};
#pragma unroll
            for (int g = 0; g < 8; ++g) { const f32x2 t = *(const LAS f32x2*)(TOT + g * 128 + d0); if (g < jg) pre += t; if (g < 4) bref += t; blast += t; }
            bref += *(const LAS f32x2*)(FIRST + d0);
            f32x2 e1, e2; e1.x = __expf(bref.x); e1.y = __expf(bref.y); e2.x = __expf(blast.x - bref.x); e2.y = __expf(blast.y - bref.y);
            unsigned qw[8], kw[8];
#pragma unroll
            for (int jj = 0; jj < 8; ++jj) { const int j = 8 * jg + jj; qw[jj] = *(const LAS unsigned*)(lds + O_QS + j * PQ + 4 * dp); kw[jj] = *(const LAS unsigned*)(lds + O_KS + j * PQ + 4 * dp); }
#pragma unroll
            for (int jj = 0; jj < 8; ++jj) {
                const int j = 8 * jg + jj; const f32x2 bb = pre + cs[jj];
                f32x2 ef, er; ef.x = __expf(bb.x - bref.x); ef.y = __expf(bb.y - bref.y); er.x = __builtin_amdgcn_rcpf(ef.x); er.y = __builtin_amdgcn_rcpf(ef.y);
                f32x2 qv, kv; qv.x = bflo(qw[jj]) * QSCALE; qv.y = bfhi(qw[jj]) * QSCALE; kv.x = bflo(kw[jj]); kv.y = bfhi(kw[jj]);
                const f32x2 qt = qv * ef, kt = kv * er, qh = qt * e1, kh = kt * e2;
                *(LAS unsigned*)(lds + O_QS + j * PQ + 4 * dp) = pk2(qt.x, qt.y);
                *(LAS unsigned*)(lds + O_QH + j * PQ + 4 * dp) = pk2(qh.x, qh.y);
                *(LAS unsigned*)(lds + O_KS + j * PQ + 4 * dp) = pk2(kt.x, kt.y);
                *(LAS unsigned*)(lds + O_KH + j * PQ + 4 * dp) = pk2(kh.x, kh.y);
            }
            if (jg == 0) { f32x2 dv; dv.x = __expf(blast.x); dv.y = __expf(blast.y); *(LAS f32x2*)(DEC + d0) = dv; }
        } else {
            if (wave == 0) {
                const float ipre = gi + bias_i, lf = logsig_f(gf + bias_f);
                const float bsum = wave_incl_sum(lf, lane);
                const float a = ipre - bsum;
                const float cm = wave_incl_max(a, lane);
                const float Mi = fmaxf(mst, cm);
                const float blast = __shfl(bsum, 63), M63 = __shfl(Mi, 63);
                A_[lane] = a; MI[lane] = Mi; WI[lane] = __expf(mst - Mi) * QSCALE; WK[lane] = __expf(a - M63); MR[lane] = __expf(-(bsum + Mi));
                if (lane == 0) DECS[0] = __expf(mst - M63);
                mst = blast + M63;
            }
            WG_BAR();
            { const float wi0 = WI[sj0], wi1 = WI[sj1], wk0 = WK[sj0], wk1 = WK[sj1];
              *(LAS u32x4*)(lds + O_QH + sj0 * PQ + 16 * sch) = scale8(*(const LAS u32x4*)(lds + O_QS + sj0 * PQ + 16 * sch), wi0);
              *(LAS u32x4*)(lds + O_QH + sj1 * PQ + 16 * sch) = scale8(*(const LAS u32x4*)(lds + O_QS + sj1 * PQ + 16 * sch), wi1);
              *(LAS u32x4*)(lds + O_KH + sj0 * PQ + 16 * sch) = scale8(*(const LAS u32x4*)(lds + O_KS + sj0 * PQ + 16 * sch), wk0);
              *(LAS u32x4*)(lds + O_KH + sj1 * PQ + 16 * sch) = scale8(*(const LAS u32x4*)(lds + O_KS + sj1 * PQ + 16 * sch), wk1); }
        }
        WG_BAR();
        for (int tix = wave; tix < 10; tix += 8) {
            const int ib = tix >= 6 ? 3 : (tix >= 3 ? 2 : (tix >= 1 ? 1 : 0)); const int jb = tix - ib * (ib + 1) / 2;
            f32x4 acc = (f32x4){0.f, 0.f, 0.f, 0.f};
            bf16x8 Ak[4], Bq[4];
#pragma unroll
            for (int ks = 0; ks < 4; ++ks) { Ak[ks] = *(const LAS bf16x8*)(lds + O_KS + (16 * jb + fr) * PQ + (32 * ks + 8 * fq) * 2); Bq[ks] = *(const LAS bf16x8*)(lds + O_QS + (16 * ib + fr) * PQ + (32 * ks + 8 * fq) * 2); }
#pragma unroll
            for (int ks = 0; ks < 4; ++ks) acc = __builtin_amdgcn_mfma_f32_16x16x32_bf16(Ak[ks], Bq[ks], acc, 0, 0, 0);
            const int i = 16 * ib + fr, j0 = 16 * jb + 4 * fq;
            float w[4];
            if (MODE) { const float Mi = MI[i];
#pragma unroll
                for (int r = 0; r < 4; ++r) w[r] = (j0 + r <= i) ? acc[r] * QSCALE * __expf(A_[j0 + r] - Mi) : 0.f;
            } else {
#pragma unroll
                for (int r = 0; r < 4; ++r) w[r] = (j0 + r <= i) ? acc[r] : 0.f;
            }
            u32x2 pw; pw.x = pk2(w[0], w[1]); pw.y = pk2(w[2], w[3]);
            *(LAS u32x2*)(lds + O_PS + i * PP + j0 * 2) = pw;
        }
        WG_BAR();
        const int ib = wave & 3, vb0 = (wave >> 2) * 4, irow = 16 * ib + fr;
        f32x4 ao[5];
#pragma unroll
        for (int v = 0; v < 5; ++v) ao[v] = (f32x4){0.f, 0.f, 0.f, 0.f};
        {
            bf16x8 Bp[2], Av[2][5];
#pragma unroll
            for (int ks = 0; ks < 2; ++ks) { Bp[ks] = *(const LAS bf16x8*)(lds + O_PS + irow * PP + (32 * ks + 8 * fq) * 2);
#pragma unroll
                for (int v = 0; v < 4; ++v) Av[ks][v] = tr_frag(lds + O_VS, PV, 32 * ks, 16 * (vb0 + v), lane);
                if (MODE) Av[ks][4] = tr_frag(lds + O_VS, PV, 32 * ks, 128, lane); }
#pragma unroll
            for (int ks = 0; ks < 2; ++ks) {
#pragma unroll
                for (int v = 0; v < 4; ++v) ao[v] = __builtin_amdgcn_mfma_f32_16x16x32_bf16(Av[ks][v], Bp[ks], ao[v], 0, 0, 0);
                if (MODE) { if (wave < 4) ao[4] = __builtin_amdgcn_mfma_f32_16x16x32_bf16(Av[ks][4], Bp[ks], ao[4], 0, 0, 0); } }
        }
#pragma unroll
        for (int kh = 0; kh < 2; ++kh) {
            bf16x8 Bq[2], As[2][5];
#pragma unroll
            for (int k2 = 0; k2 < 2; ++k2) { const int ks = 2 * kh + k2; Bq[k2] = *(const LAS bf16x8*)(lds + O_QH + irow * PQ + (32 * ks + 8 * fq) * 2);
#pragma unroll
                for (int v = 0; v < 4; ++v) As[k2][v] = *(const LAS bf16x8*)(lds + O_SB + (16 * (vb0 + v) + fr) * PQ + (32 * ks + 8 * fq) * 2);
                if (MODE) As[k2][4] = *(const LAS bf16x8*)(lds + O_SB + (128 + fr) * PQ + (32 * ks + 8 * fq) * 2); }
#pragma unroll
            for (int k2 = 0; k2 < 2; ++k2) {
#pragma unroll
                for (int v = 0; v < 4; ++v) ao[v] = __builtin_amdgcn_mfma_f32_16x16x32_bf16(As[k2][v], Bq[k2], ao[v], 0, 0, 0);
                if (MODE) { if (wave < 4) ao[4] = __builtin_amdgcn_mfma_f32_16x16x32_bf16(As[k2][4], Bq[k2], ao[4], 0, 0, 0); } }
        }
        const int db = wave;
        if (MODE == 0) { const f32x4 dec = *(const LAS f32x4*)(DEC + 16 * db + 4 * fq);
#pragma unroll
            for (int v = 0; v < NVB; ++v) S[v] = S[v] * dec;
        } else { const float dsc = DECS[0];
#pragma unroll
            for (int v = 0; v < NVB; ++v) S[v] = S[v] * dsc;
        }
#pragma unroll
        for (int ks = 0; ks < 2; ++ks) {
            const bf16x8 A = tr_frag(lds + O_KH, PQ, 32 * ks, 16 * db, lane);
#pragma unroll
            for (int v = 0; v < NVB; ++v) { const bf16x8 B = tr_frag(lds + O_VS, PV, 32 * ks, 16 * v, lane); S[v] = __builtin_amdgcn_mfma_f32_16x16x32_bf16(A, B, S[v], 0, 0, 0); }
        }
        if (MODE) { if (wave < 4 && lane < 16) DEN[16 * ib + lane] = ao[4][0]; }
        WG_BAR();
        if (ctx_out || c >= 4) {
            const int row = dir ? rl + 63 - irow : rl + irow;
            float sc = 1.0f;
            if (MODE) sc = 1.0f / fmaxf(fabsf(DEN[irow]), MR[irow]);
            bf16* op = outb + (size_t)row * out_ld + ocol + 16 * vb0 + 4 * fq;
#pragma unroll
            for (int v = 0; v < 4; ++v) { u32x2 w; w.x = pk2(ao[v][0] * sc, ao[v][1] * sc); w.y = pk2(ao[v][2] * sc, ao[v][3] * sc); *(u32x2*)(op + 16 * v) = w; }
        }
#pragma unroll
        for (int v = 0; v < NVB; ++v) { u32x2 w; w.x = pk2(S[v][0], S[v][1]); w.y = pk2(S[v][2], S[v][3]); *(LAS u32x2*)(lds + O_SB + (16 * v + fr) * PQ + (16 * db + 4 * fq) * 2) = w; }
    }
#undef CH_PREFETCH
    __syncthreads();
}

__device__ __forceinline__ void rg_chain(LAS unsigned char* lds,
        const bf16* __restrict__ proj, const int b, const int n, const int dir, const bf16* __restrict__ wrg,
        const float* __restrict__ lam, const float* __restrict__ b_a, const float* __restrict__ b_i, const float* __restrict__ conv_w, const float* __restrict__ conv_b,
        bf16* __restrict__ hout) {
    const int tid = fresh_tid(); const int lane = tid & 63, wave = __builtin_amdgcn_readfirstlane(tid >> 6);
    constexpr int O_XR = 0, O_XBF = 17408, O_XBH = 51200, O_AA = 68608, O_BX = 102400, O_CW = 136192;
    constexpr int PXF = 528, PXH = 272;
    const int fr = lane & 15, fq = lane >> 4;
    LAS float* CW = (LAS float*)(lds + O_CW);
    __syncthreads();
    for (int i = tid; i < 5 * 128; i += 512) CW[i] = i < 512 ? conv_w[(i >> 7) * 1024 + 128 * n + (i & 127)] : conv_b[128 * n + (i - 512)];
    bf16x8 Afr[2][4];
#pragma unroll
    for (int mat = 0; mat < 2; ++mat)
#pragma unroll
        for (int ks = 0; ks < 4; ++ks) Afr[mat][ks] = *(const bf16x8*)(wrg + ((size_t)((dir * 2 + mat) * 8 + n) * 128 + 16 * wave + fr) * 128 + 32 * ks + 8 * fq);
    f32x4 c8, bav, biv;
#pragma unroll
    for (int r = 0; r < 4; ++r) { const int ch = 128 * n + 16 * wave + 4 * fq + r; const float l = lam[dir * 1024 + ch];
        c8[r] = -8.0f * (fmaxf(-l, 0.f) + log1pf(expf(-fabsf(l)))); bav[r] = b_a[dir * 1024 + ch]; biv[r] = b_i[dir * 1024 + ch]; }
    float hst = 0.f;
    const int ch2 = tid & 63, tg = tid >> 6;
    u32x4 px[3];
#define RG_PREFETCH(cc) do { const int c_ = (cc); const int L_ = c_ < 4 ? CTXL : SEQ, cs_ = c_ < 4 ? c_ : c_ - 4, base_ = c_ < 4 ? b * CTXL : MC + b * SEQ; \
        const int t0_ = dir ? L_ - 64 * (cs_ + 1) : 64 * cs_; \
        _Pragma("unroll") for (int e_ = 0; e_ < 3; ++e_) { const int id_ = tid + 512 * e_, rr_ = id_ >> 4, tt_ = t0_ - 2 + rr_; \
            px[e_] = (rr_ < 67 && tt_ >= 0 && tt_ < L_) ? *(const u32x4*)(proj + (size_t)(base_ + tt_) * NP0 + 3072 + 128 * n + 8 * (id_ & 15)) : (u32x4){0u, 0u, 0u, 0u}; } } while (0)
    RG_PREFETCH(0);
    for (int c = 0; c < NCH; ++c) {
        const int L = c < 4 ? CTXL : SEQ, cs = c < 4 ? c : c - 4, base = c < 4 ? b * CTXL : MC + b * SEQ;
        const int t0 = dir ? L - 64 * (cs + 1) : 64 * cs;
#pragma unroll
        for (int e = 0; e < 3; ++e) { const int id = tid + 512 * e, rr = id >> 4; if (rr < 68) *(LAS u32x4*)(lds + O_XR + rr * 256 + 16 * (id & 15)) = px[e]; }
        if (c + 1 < NCH) RG_PREFETCH(c + 1);
        WG_BAR();
        {
            const f32x2 w0 = *(const LAS f32x2*)(CW + 0 * 128 + 2 * ch2), w1 = *(const LAS f32x2*)(CW + 1 * 128 + 2 * ch2), w2_ = *(const LAS f32x2*)(CW + 2 * 128 + 2 * ch2), w3 = *(const LAS f32x2*)(CW + 3 * 128 + 2 * ch2), cb = *(const LAS f32x2*)(CW + 512 + 2 * ch2);
            f32x2 xw[11];
#pragma unroll
            for (int rr = 0; rr < 11; ++rr) { const unsigned u = *(const LAS unsigned*)(lds + O_XR + (8 * tg + rr) * 256 + 4 * ch2); xw[rr].x = bflo(u); xw[rr].y = bfhi(u); }
#pragma unroll
            for (int jj = 0; jj < 8; ++jj) {
                f32x2 y = cb; y += xw[jj] * w0; y += xw[jj + 1] * w1; y += xw[jj + 2] * w2_; y += xw[jj + 3] * w3;
                *(LAS f32x2*)(lds + O_XBF + (8 * tg + jj) * PXF + 8 * ch2) = y;
                *(LAS unsigned*)(lds + O_XBH + (8 * tg + jj) * PXH + 4 * ch2) = pk2(y.x, y.y);
            }
        }
        WG_BAR();
#pragma unroll
        for (int tb = 0; tb < 4; ++tb) {
            f32x4 ga = (f32x4){0.f, 0.f, 0.f, 0.f}, gi = (f32x4){0.f, 0.f, 0.f, 0.f};
            bf16x8 Bx[4];
#pragma unroll
            for (int ks = 0; ks < 4; ++ks) Bx[ks] = *(const LAS bf16x8*)(lds + O_XBH + (16 * tb + fr) * PXH + (32 * ks + 8 * fq) * 2);
#pragma unroll
            for (int ks = 0; ks < 4; ++ks) { ga = __builtin_amdgcn_mfma_f32_16x16x32_bf16(Afr[0][ks], Bx[ks], ga, 0, 0, 0); gi = __builtin_amdgcn_mfma_f32_16x16x32_bf16(Afr[1][ks], Bx[ks], gi, 0, 0, 0); }
            const int t = 16 * tb + fr;
            const f32x4 xb = *(const LAS f32x4*)(lds + O_XBF + t * PXF + (16 * wave + 4 * fq) * 4);
            f32x4 av, bx;
#pragma unroll
            for (int r = 0; r < 4; ++r) { const float rg = sigmoid_f(ga[r] + bav[r]), ig = sigmoid_f(gi[r] + biv[r]); const float la = c8[r] * rg;
                av[r] = __expf(la); bx[r] = sqrtf(-expm1f(2.0f * la)) * (ig * xb[r]); }
            *(LAS f32x4*)(lds + O_AA + t * PXF + (16 * wave + 4 * fq) * 4) = av;
            *(LAS f32x4*)(lds + O_BX + t * PXF + (16 * wave + 4 * fq) * 4) = bx;
        }
        WG_BAR();
        if (tid < 128) {
            bf16* hp = hout + (size_t)(base + t0) * 1024 + 128 * n + tid;
            for (int s8 = 0; s8 < 64; s8 += 8) {
                float av8[8], bx8[8];
#pragma unroll
                for (int e = 0; e < 8; ++e) { const int jj = dir ? 63 - (s8 + e) : s8 + e; av8[e] = *(const LAS float*)(lds + O_AA + jj * PXF + 4 * tid); bx8[e] = *(const LAS float*)(lds + O_BX + jj * PXF + 4 * tid); }
#pragma unroll
                for (int e = 0; e < 8; ++e) { const int jj = dir ? 63 - (s8 + e) : s8 + e; hst = av8[e] * hst + bx8[e]; hp[(size_t)jj * 1024] = (bf16)f2bf(hst); }
            }
        }
    }
#undef RG_PREFETCH
    __syncthreads();
}

#ifndef MK_REP_SCAN
#define MK_REP_SCAN 1
#endif
#ifndef MK_LAST_PHASE
#define MK_LAST_PHASE 24
#endif
constexpr int NPH = 24;
__global__ void __launch_bounds__(NWAVES * 64, 2) mk_fwd(Args args) {
    extern __shared__ __attribute__((aligned(16))) unsigned char lds_raw[];
    Frame F{(LAS unsigned char*)lds_raw, (int)gridDim.x, (int)blockIdx.x, (int)gridDim.x * NWAVES, args.out, args.ws, args};
    volatile LAS unsigned* MISC = (volatile LAS unsigned*)(F.lds + LDSCTL_OFF);
    for (int u = threadIdx.x; u < (LDS_BYTES - LDSCTL_OFF) / 4; u += NWAVES * 64) ((LAS unsigned*)(F.lds + LDSCTL_OFF))[u] = 0u;
    __syncthreads();
    const int lo = args.ph_lo, hi = args.ph_hi;
    const bool multi = (hi - lo) > 1;
    XcdBarrier bar; bar.bar = (unsigned*)(F.ws + WS_CTL) + CW_BAR; bar.x = 0; bar.st = nullptr;
    if (multi) bar = xcd_barrier_post((unsigned*)(F.ws + WS_CTL) + CW_BAR, MISC + 8);
#ifndef MK_REP_GEMM
#define MK_REP_GEMM 1
#endif
#ifndef MK_REP_SCAN
#define MK_REP_SCAN 1
#endif
#ifndef MK_REP_COMB
#define MK_REP_COMB 1
#endif
#ifndef MK_OFFMASK
#define MK_OFFMASK 0x7FF
#endif
#ifndef MK_PREMASK
#define MK_PREMASK 3
#endif
#define IN(k) (lo <= (k) && (k) < hi)
#define INL(o) (((MK_OFFMASK >> (o)) & 1) && IN(pb + (o)))
#define SEAM(k) do { if (IN(k) && IN((k) + 1)) xcd_barrier(bar); } while (0)
    float* MOD = (float*)(F.ws + WS_MOD);
    bf16* U = (bf16*)(F.ws + WS_U); bf16* Yb = (bf16*)(F.ws + WS_Y); float* Y = (float*)(F.ws + WS_Y); float* YC = (float*)(F.ws + WS_YC); bf16* BIG = (bf16*)(F.ws + WS_BIG); float* GATES = (float*)(F.ws + WS_GATES);

    if ((MK_PREMASK & 1) && IN(0)) { pre_mod(F); pre_pe(F); cvt_layer<0>(F); }
    SEAM(0);
    if ((MK_PREMASK & 2) && IN(1)) nrm_rows<true, false, true>(F, 0, M, 0.f, nullptr, nullptr, 0, F.A.in[I_NORMG], MOD, 0, 1);
    SEAM(1);
    for (int layer = 0; layer < 2; ++layer) {
        const int pb = 2 + 11 * layer; const bool last = layer == 1;
        const float* ng = F.A.in[I_NORMG] + (size_t)layer * 6 * D; const float* modl = MOD + (size_t)layer * 9 * 18432;
        const int NP = layer == 0 ? NP0 : NP1;
        const int rlo2 = last ? MC : 0;
        if (INL(0)) { pg8::Gemm g{U, (const bf16*)(F.ws + W_F1I), M, 2 * DFF, D}; pg8::StaticOrder S; S.init(M, 2 * DFF, F.G, F.wg, D); pg8::EpiSwiglu E{BIG, DFF};
            for (int rep_ = 0; rep_ < MK_REP_GEMM; ++rep_) pg8::gemm_phase<pg8::EpiSwiglu, pg8::StaticOrder, PG8_ALIGN, PG8_SP2>(F.lds, g, S, E); }
        SEAM(pb + 0);
        if (INL(1)) {
            pg8::Gemm g{BIG, (const bf16*)(F.ws + W_F1O), M, D, DFF}; pg8::MixedOrder S; S.init(MLAT, D, F.G, F.wg, DFF, MC / 256, true ? MC : 0, 4);
            pg8::EpiY E{Yb, D, YC, (size_t)MC * D, DFF / 64};
            for (int rep_ = 0; rep_ < MK_REP_GEMM; ++rep_) pg8::gemm_phase<pg8::EpiY, pg8::MixedOrder, PG8_ALIGN, PG8_SP2>(F.lds, g, S, E);
        }
        SEAM(pb + 1);
        if (INL(2)) nrm_rows<false, true, true>(F, 0, M, 0.5f, ng + 1 * D, modl, 2, ng + 2 * D, modl, 3, 4);
        SEAM(pb + 2);
        if (INL(3)) { pg8::Gemm g{U, (const bf16*)(F.ws + W_MI), M, NP, D}; pg8::StaticOrder S; S.init(M, NP, F.G, F.wg, D); pg8::EpiProj E{BIG, NP, GATES, NP / 256 - 1};
            for (int rep_ = 0; rep_ < MK_REP_GEMM; ++rep_) pg8::gemm_phase<pg8::EpiProj, pg8::StaticOrder, PG8_ALIGN, PG8_SP2>(F.lds, g, S, E); }
        SEAM(pb + 3);
        if (INL(4)) {
            if (layer == 0) {
                bf16* OFb = (bf16*)Y; bf16* OBb = OFb + (size_t)M * 1024; bf16* HFb = OBb + (size_t)M * 1024; bf16* HBb = HFb + (size_t)M * 1024;
                for (int item = F.wg; item < 256 * MK_REP_SCAN; item += F.G) {
                    if ((item & 255) < 128) {
#ifndef MK_NO_GLA
                        const int ci = (item & 255) >> 1, vh = item & 1, b = ci >> 3, h = (ci >> 1) & 3, dir = ci & 1;
                        chain_scan<0>(F.lds, BIG, NP0, h * 128, 512 + h * 128, 1024 + h * 256 + vh * 128, GATES, dir * 16, b, dir,
                                      dir ? OBb : OFb, 1024, h * 256 + vh * 128, true, F.A.in[I_WALPHA2] + (size_t)dir * 16 * 512 + h * 128, F.A.in[I_BALPHA] + dir * 512 + h * 128, 0.f, 0.f);
#endif
                    } else {
#ifndef MK_NO_RG
                        const int ri = (item & 255) - 128, b = ri >> 4, n = (ri >> 1) & 7, dir = ri & 1;
                        rg_chain(F.lds, BIG, b, n, dir, (const bf16*)(F.ws + WS_WRG), F.A.in[I_LAM], F.A.in[I_RGBA], F.A.in[I_RGBI], F.A.in[I_CONVW], F.A.in[I_CONVB], dir ? HBb : HFb);
#endif
                    }
                }
            } else {
#ifndef MK_NO_ML
                bf16* HFb = (bf16*)Y; bf16* HBb = HFb + (size_t)M * D;
                for (int item = F.wg; item < 256 * MK_REP_SCAN; item += F.G) { const int ci = (item & 255) >> 1, vh = item & 1, b = ci >> 4, h = (ci >> 1) & 7, dir = ci & 1;
                    chain_scan<1>(F.lds, BIG, NP1, h * 128, 1024 + h * 128, 2048 + h * 256 + vh * 128, GATES, dir * 16 + h, b, dir,
                                  dir ? HBb : HFb, D, h * 256 + vh * 128, false, nullptr, nullptr, F.A.in[I_MLBG][dir * 16 + h], F.A.in[I_MLBG][dir * 16 + 8 + h]);
                }
#endif
            }
        }
        SEAM(pb + 4);
        if (INL(5)) { for (int rep_ = 0; rep_ < MK_REP_COMB; ++rep_) { if (layer == 0) comb0_rows(F, 0, M); else comb1_rows(F, MC, M); } }
        SEAM(pb + 5);
        if (INL(6)) {
            pg8::Gemm g{U, (const bf16*)(F.ws + W_MO), M, D, D}; pg8::MixedOrder S; S.init(MLAT, D, F.G, F.wg, D, MC / 256, !last ? MC : 0, 4);
            pg8::EpiY E{Yb, D, YC, (size_t)MC * D, D / 64};
            for (int rep_ = 0; rep_ < MK_REP_GEMM; ++rep_) pg8::gemm_phase<pg8::EpiY, pg8::MixedOrder, PG8_ALIGN, PG8_SP2>(F.lds, g, S, E);
        }
        SEAM(pb + 6);
        if (INL(7)) nrm_rows<false, true, true>(F, rlo2, M, 1.0f, ng + 3 * D, modl, 5, ng + 4 * D, modl, 6, 7);
        SEAM(pb + 7);
        if (INL(8)) { pg8::Gemm g{U + (size_t)rlo2 * D, (const bf16*)(F.ws + W_F2I), M - rlo2, 2 * DFF, D}; pg8::StaticOrder S; S.init(M - rlo2, 2 * DFF, F.G, F.wg, D); pg8::EpiSwiglu E{BIG + (size_t)rlo2 * DFF, DFF};
            for (int rep_ = 0; rep_ < MK_REP_GEMM; ++rep_) pg8::gemm_phase<pg8::EpiSwiglu, pg8::StaticOrder, PG8_ALIGN, PG8_SP2>(F.lds, g, S, E); }
        SEAM(pb + 8);
        if (INL(9)) {
            pg8::Gemm g{BIG, (const bf16*)(F.ws + W_F2O), M, D, DFF}; pg8::MixedOrder S; S.init(MLAT, D, F.G, F.wg, DFF, MC / 256, !last ? MC : 0, 4);
            pg8::EpiY E{Yb, D, YC, (size_t)MC * D, DFF / 64};
            for (int rep_ = 0; rep_ < MK_REP_GEMM; ++rep_) pg8::gemm_phase<pg8::EpiY, pg8::MixedOrder, PG8_ALIGN, PG8_SP2>(F.lds, g, S, E);
        }
        SEAM(pb + 9);
        if (INL(10)) {
            if (!last) { nrm_rows<false, true, true>(F, 0, M, 0.5f, ng + 5 * D, modl, 8, F.A.in[I_NORMG] + 6 * D, MOD + (size_t)9 * 18432, 0, 1); __syncthreads(); cvt_layer<1>(F); }
            else nrm_rows<false, true, false>(F, MC, M, 0.5f, ng + 5 * D, modl, 8, nullptr, nullptr, 0, 0);
        }
        SEAM(pb + 10);
    }
#undef IN
#undef SEAM
}

extern "C" void kernel_launch(void* const* d_in, const int* in_sizes, int n_in, void* d_out, int out_size, void* d_ws, size_t ws_size, hipStream_t stream) {
    static int grid = 0;
    if (grid == 0) {
        if (n_in != 27 || out_size != MLAT * D || ws_size < WS_END) { fprintf(stderr, "kernel_launch: unexpected problem (n_in %d, out %d, ws %zu; need ws >= %zu); nothing launched\n", n_in, out_size, ws_size, (size_t)WS_END); grid = -1; return; }
        int dev = 0, cus = 0, per_cu = 0;
        if (hipGetDevice(&dev) != hipSuccess || hipDeviceGetAttribute(&cus, hipDeviceAttributeMultiprocessorCount, dev) != hipSuccess) { fprintf(stderr, "kernel_launch: device query failed\n"); grid = -1; return; }
        if (hipFuncSetAttribute((const void*)mk_fwd, hipFuncAttributeMaxDynamicSharedMemorySize, LDS_BYTES) != hipSuccess) { fprintf(stderr, "kernel_launch: hipFuncSetAttribute failed\n"); grid = -1; return; }
        if (hipOccupancyMaxActiveBlocksPerMultiprocessor(&per_cu, (const void*)mk_fwd, NWAVES * 64, LDS_BYTES) != hipSuccess || per_cu < 1)
            fprintf(stderr, "kernel_launch: note: occupancy query reports %d workgroups per CU\n", per_cu);
        (void)hipGetLastError();
        grid = cus;
    }
    if (grid < 0) return;
    if (hipMemsetAsync((char*)d_ws + WS_CTL, 0, CTL_ZERO_BYTES, stream) != hipSuccess) { fprintf(stderr, "kernel_launch: memset failed\n"); return; }
    Args a{};
    for (int i = 0; i < 27; ++i) a.in[i] = (const float*)d_in[i];
    a.out = (float*)d_out; a.ws = (unsigned char*)d_ws;
#if defined(MK_SPLIT)
    for (int p = 0; p < MK_LAST_PHASE; ++p) { a.ph_lo = p; a.ph_hi = p + 1; hipLaunchKernelGGL(mk_fwd, dim3(grid), dim3(NWAVES * 64), LDS_BYTES, stream, a); }
#else
    a.ph_lo = 0; a.ph_hi = MK_LAST_PHASE;
    hipLaunchKernelGGL(mk_fwd, dim3(grid), dim3(NWAVES * 64), LDS_BYTES, stream, a);
#endif
    const hipError_t le = hipPeekAtLastError();
    if (le != hipSuccess) fprintf(stderr, "kernel_launch: launch failed: %s\n", hipGetErrorName(le));
}
```

```cpp
#include <hip/hip_runtime.h>
#include <cstdio>
#include <cstdint>
__device__ __forceinline__ int fresh_tid() { int t = threadIdx.x; asm volatile("" : "+v"(t)); return t; }
namespace pg8 {
#define PG8_LAS __attribute__((address_space(3)))
typedef unsigned short bf16_t;
typedef short bf16x8 __attribute__((ext_vector_type(8)));
typedef float f32x4 __attribute__((ext_vector_type(4)));
typedef unsigned u32x4 __attribute__((ext_vector_type(4)));
constexpr int BM = 256, BK = 64, HALF = 128, HTB = HALF * BK * 2  , STAGE_BYTES = 8 * HTB, NXCD = 8, WGM = 8;

__host__ __device__ __forceinline__ int lds_byte(int r, int c) { const int st = (r >> 4) * 2 + (c >> 5), rr = r & 15, cc = c & 31, ob = rr * 64 + cc * 2; return st * 1024 + (ob ^ (((ob >> 9) & 1) << 5)); }
__host__ __device__ __forceinline__ void stage_rc(int b, int& R, int& C) { const int st = b / 1024, sb = b % 1024, swz = sb ^ (((sb >> 9) & 1) << 5); R = (st >> 1) * 16 + swz / 64; C = (st & 1) * 32 + (swz % 64) / 2; }
__host__ __device__ __forceinline__ int perm32(int rho) { const int n = rho >> 4, i = rho & 15; return 8 * (i >> 2) + 4 * n + (i & 3); }

struct Unit { int pm, pn, pk, koff, nt; };
struct Gemm { const bf16_t* A; const bf16_t* Bt; int M, N, K; };

struct StaticOrder {
    int nM, nN, nwg, G, c, nt, pm0, nx;
    __host__ __device__ void init(int M, int N, int G_, int c_, int K_ = 0, int pm0_ = 0, int nx_ = NXCD) { nM = M / BM; nN = N / BM; nwg = nM * nN; G = G_; c = c_; nt = K_ / BK; pm0 = pm0_; nx = nx_; }
    __host__ __device__ bool next(int i, Unit& u) const {
        const long L = (long)i * G + c; if (L >= nwg) return false;
        int wgid = (int)L; { const int q = nwg / nx, r = nwg % nx, xcd = wgid % nx, off = wgid / nx; wgid = (xcd < r ? xcd * (q + 1) : r * (q + 1) + (xcd - r) * q) + off; }
        const int nig = WGM * nN, gid = wgid / nig, fm = gid * WGM, gsz = (nM - fm) < WGM ? (nM - fm) : WGM;
        u.pm = pm0 + fm + ((wgid % nig) % gsz); u.pn = (wgid % nig) / gsz; u.pk = 0; u.koff = 0; u.nt = nt; return true;
    }
    __device__ __forceinline__ void a_ready(const Unit&) const {}
    __device__ __forceinline__ void done(const Unit&) const {}
};
struct MixedOrder : StaticOrder {
    int nMs, nS, nwgS, nts;
    __host__ __device__ void init(int M, int N, int G_, int c_, int K_, int pm0_, int Ms, int nS_, int nx_ = NXCD) { StaticOrder::init(M, N, G_, c_, K_, pm0_, nx_); nMs = Ms / BM; nS = nS_; nwgS = nMs * nN * nS; nts = K_ / BK / nS_; }
    __host__ __device__ bool next(int i, Unit& u) const {
        const long L = (long)i * G + c; if (L < nwg) return StaticOrder::next(i, u);
        const int l = (int)(L - nwg); if (l >= nwgS) return false;
        u.pk = l % nS; const int t = l / nS; u.pm = t % nMs; u.pn = t / nMs; u.koff = u.pk * nts * BK; u.nt = nts; return true;
    }
};

__device__ __forceinline__ unsigned cvt_pk_bf16(float lo, float hi) { unsigned r; asm volatile("v_cvt_pk_bf16_f32 %0, %1, %2" : "=v"(r) : "v"(lo), "v"(hi)); return r; }
__device__ __forceinline__ float silu_f(float x) { return x * __builtin_amdgcn_rcpf(1.0f + __expf(-x)); }

struct EpiF32 {
    static constexpr bool PERM = false, AFTER_DRAIN = false;
    float* C; int ldc;
    __device__ __forceinline__ void operator()(const f32x4 (&acc)[2][2][4][2], const Unit& u, int wr, int wc, int fr, int fq) const {
        const int row0 = u.pm * BM + wr * 64 + fr, col0 = u.pn * BM + wc * 32 + 4 * fq;
#pragma unroll
        for (int ai = 0; ai < 2; ++ai)
#pragma unroll
            for (int m = 0; m < 4; ++m) { float* rowp = C + (size_t)(row0 + ai * HALF + m * 16) * ldc + col0;
#pragma unroll
                for (int bj = 0; bj < 2; ++bj)
#pragma unroll
                    for (int n = 0; n < 2; ++n) *(f32x4*)(rowp + bj * HALF + n * 16) = acc[ai][bj][m][n]; }
    }
};
struct EpiY {
    static constexpr bool PERM = true, AFTER_DRAIN = false;
    bf16_t* O; int ldc; float* P; size_t split_stride; int nt_full;
    __device__ __forceinline__ void operator()(const f32x4 (&acc)[2][2][4][2], const Unit& u, int wr, int wc, int fr, int fq) const {
        const int row0 = u.pm * BM + wr * 64 + fr, col0 = u.pn * BM + wc * 32 + 8 * fq;
        if (u.nt == nt_full) {
#pragma unroll
            for (int ai = 0; ai < 2; ++ai)
#pragma unroll
                for (int m = 0; m < 4; ++m) { bf16_t* rowp = O + (size_t)(row0 + ai * HALF + m * 16) * ldc + col0;
#pragma unroll
                    for (int bj = 0; bj < 2; ++bj) { const f32x4 v0 = acc[ai][bj][m][0], v1 = acc[ai][bj][m][1];
                        u32x4 w; w.x = cvt_pk_bf16(v0[0], v0[1]); w.y = cvt_pk_bf16(v0[2], v0[3]); w.z = cvt_pk_bf16(v1[0], v1[1]); w.w = cvt_pk_bf16(v1[2], v1[3]);
                        *(u32x4*)(rowp + bj * HALF) = w; } }
        } else {
            float* Pb = P + (size_t)u.pk * split_stride;
#pragma unroll
            for (int ai = 0; ai < 2; ++ai)
#pragma unroll
                for (int m = 0; m < 4; ++m) { float* rowp = Pb + (size_t)(row0 + ai * HALF + m * 16) * ldc + col0;
#pragma unroll
                    for (int bj = 0; bj < 2; ++bj) { *(f32x4*)(rowp + bj * HALF) = acc[ai][bj][m][0]; *(f32x4*)(rowp + bj * HALF + 4) = acc[ai][bj][m][1]; } }
        }
    }
};
struct EpiSwiglu {
    static constexpr bool PERM = true, AFTER_DRAIN = false;
    bf16_t* O; int ldc;
    __device__ __forceinline__ void operator()(const f32x4 (&acc)[2][2][4][2], const Unit& u, int wr, int wc, int fr, int fq) const {
        const int row0 = u.pm * BM + wr * 64 + fr, col0 = u.pn * HALF + wc * 32 + 8 * fq;
#pragma unroll
        for (int ai = 0; ai < 2; ++ai)
#pragma unroll
            for (int m = 0; m < 4; ++m) { bf16_t* rowp = O + (size_t)(row0 + ai * HALF + m * 16) * ldc + col0;
                const f32x4 a0 = acc[ai][0][m][0], a1 = acc[ai][0][m][1], b0 = acc[ai][1][m][0], b1 = acc[ai][1][m][1];
                f32x4 v0, v1;
#pragma unroll
                for (int j = 0; j < 4; ++j) { v0[j] = silu_f(a0[j]) * b0[j]; v1[j] = silu_f(a1[j]) * b1[j]; }
                u32x4 w; w.x = cvt_pk_bf16(v0[0], v0[1]); w.y = cvt_pk_bf16(v0[2], v0[3]); w.z = cvt_pk_bf16(v1[0], v1[1]); w.w = cvt_pk_bf16(v1[2], v1[3]);
                *(u32x4*)rowp = w; }
    }
};
struct EpiProj {
    static constexpr bool PERM = true, AFTER_DRAIN = false;
    bf16_t* O; int ldc; float* gates; int gate_pn;
    __device__ __forceinline__ void operator()(const f32x4 (&acc)[2][2][4][2], const Unit& u, int wr, int wc, int fr, int fq) const {
        const int row0 = u.pm * BM + wr * 64 + fr, col0 = u.pn * BM + wc * 32 + 8 * fq;
#pragma unroll
        for (int ai = 0; ai < 2; ++ai)
#pragma unroll
            for (int m = 0; m < 4; ++m) { bf16_t* rowp = O + (size_t)(row0 + ai * HALF + m * 16) * ldc + col0;
#pragma unroll
                for (int bj = 0; bj < 2; ++bj) { const f32x4 v0 = acc[ai][bj][m][0], v1 = acc[ai][bj][m][1];
                    u32x4 w; w.x = cvt_pk_bf16(v0[0], v0[1]); w.y = cvt_pk_bf16(v0[2], v0[3]); w.z = cvt_pk_bf16(v1[0], v1[1]); w.w = cvt_pk_bf16(v1[2], v1[3]);
                    *(u32x4*)(rowp + bj * HALF) = w; } }
        if (u.pn == gate_pn && wc == 0) {
#pragma unroll
            for (int ai = 0; ai < 2; ++ai)
#pragma unroll
                for (int m = 0; m < 4; ++m) { float* gp = gates + (size_t)(row0 + ai * HALF + m * 16) * 32 + 8 * fq;
                    *(f32x4*)gp = acc[ai][0][m][0]; *(f32x4*)(gp + 4) = acc[ai][0][m][1]; }
        }
    }
};

template <class Epi, class Sched, bool ALIGN_EPI = false, bool SP2 = false>
__device__ __forceinline__ void gemm_phase(PG8_LAS unsigned char* lds, const Gemm g, const Sched& S, const Epi& E) {
    const int tid = fresh_tid(), wid = __builtin_amdgcn_readfirstlane(tid >> 6), lane = tid & 63, wr = wid >> 2, wc = wid & 3, fr = lane & 15, fq = lane >> 4;
    const int ld = g.K;
    unsigned voffA[2], voffB[2];
#pragma unroll
    for (int i = 0; i < 2; ++i) { int R, C; stage_rc(tid * 16 + i * 8192, R, C); const int Rb = Epi::PERM ? ((R & ~31) + perm32(R & 31)) : R;
        voffA[i] = (unsigned)(R * ld + C) * 2u; voffB[i] = (unsigned)(Rb * ld + C) * 2u; }
    const size_t kstep = (size_t)(BK * 2);
    const size_t hstep = (size_t)HALF * ld * 2;
    const size_t tstep = 2 * hstep;
    const unsigned ldsw = (unsigned)wid * 1024u;
    const int aoff = lds_byte(wr * 64 + fr, fq * 8), boff = lds_byte(wc * 32 + fr, fq * 8);
#define PG8_SA(b, h) (((b) * 2 + (h)) * HTB)
#define PG8_SB(b, h) ((4 + (b) * 2 + (h)) * HTB)
#define PG8_STAGE(bufoff, gbase, voff) do { _Pragma("unroll") for (int _i = 0; _i < 2; ++_i) \
        __builtin_amdgcn_global_load_lds((const unsigned*)((const char*)(gbase) + (voff)[_i]), (PG8_LAS unsigned*)(lds + (bufoff) + ldsw + _i * 8192), 16, 0, 0); } while (0)
#define PG8_LDA(dst, b, h) do { _Pragma("unroll") for (int m = 0; m < 4; ++m) _Pragma("unroll") for (int k = 0; k < 2; ++k) dst[m][k] = *(const PG8_LAS bf16x8*)(lds + PG8_SA(b, h) + aoff + m * 2048 + k * 1024); } while (0)
#define PG8_LDB(dst, b, h) do { _Pragma("unroll") for (int n = 0; n < 2; ++n) _Pragma("unroll") for (int k = 0; k < 2; ++k) dst[n][k] = *(const PG8_LAS bf16x8*)(lds + PG8_SB(b, h) + boff + n * 2048 + k * 1024); } while (0)
#define PG8_MMA(ai, bj, At, Bt) do { __builtin_amdgcn_s_setprio(1); _Pragma("unroll") for (int m = 0; m < 4; ++m) _Pragma("unroll") for (int n = 0; n < 2; ++n) _Pragma("unroll") for (int k = 0; k < 2; ++k) \
        acc[ai][bj][m][n] = __builtin_amdgcn_mfma_f32_16x16x32_bf16(Bt[n][k], At[m][k], acc[ai][bj][m][n], 0, 0, 0); __builtin_amdgcn_s_setprio(0); } while (0)
#define PG8_WAIT_V(n) asm volatile("s_waitcnt vmcnt(" #n ")" ::: "memory")
#define PG8_WAIT_L(n) asm volatile("s_waitcnt lgkmcnt(" #n ")" ::: "memory")
#define PG8_BAR __builtin_amdgcn_s_barrier()
#define PG8_SCHED __builtin_amdgcn_sched_barrier(0)
    Unit cur, nxt; int ui = 0;
    if (!S.next(0, cur)) return;
    int nt = cur.nt;
    f32x4 acc[2][2][4][2];
#pragma unroll
    for (int a = 0; a < 2; ++a)
#pragma unroll
        for (int b = 0; b < 2; ++b)
#pragma unroll
            for (int m = 0; m < 4; ++m)
#pragma unroll
                for (int n = 0; n < 2; ++n) acc[a][b][m][n] = (f32x4){0.f, 0.f, 0.f, 0.f};
    bf16x8 At[4][2], B0[2][2], B1[2][2];
    const char* cA = (const char*)g.A + (size_t)cur.pm * tstep + (size_t)cur.koff * 2; const char* cB = (const char*)g.Bt + (size_t)cur.pn * tstep + (size_t)cur.koff * 2;
    S.a_ready(cur);
    if constexpr (SP2) {
        PG8_STAGE(PG8_SB(0, 0), cB, voffB); PG8_STAGE(PG8_SB(0, 1), cB + hstep, voffB); PG8_STAGE(PG8_SA(0, 0), cA, voffA); PG8_STAGE(PG8_SA(0, 1), cA + hstep, voffA);
        if (wr == 1) PG8_BAR;
        PG8_WAIT_V(2); PG8_BAR;
        PG8_STAGE(PG8_SB(1, 0), cB + kstep, voffB); PG8_STAGE(PG8_SA(1, 0), cA + kstep, voffA); PG8_STAGE(PG8_SB(1, 1), cB + hstep + kstep, voffB);
        PG8_WAIT_V(6); PG8_BAR;
    } else {
        PG8_STAGE(PG8_SB(0, 0), cB, voffB); PG8_STAGE(PG8_SA(0, 0), cA, voffA); PG8_STAGE(PG8_SB(0, 1), cB + hstep, voffB); PG8_STAGE(PG8_SA(0, 1), cA + hstep, voffA);
        if (wr == 1) PG8_BAR;
        PG8_WAIT_V(4); PG8_BAR;
        PG8_STAGE(PG8_SB(1, 0), cB + kstep, voffB); PG8_STAGE(PG8_SA(1, 0), cA + kstep, voffA); PG8_STAGE(PG8_SB(1, 1), cB + hstep + kstep, voffB);
        PG8_WAIT_V(6); PG8_BAR;
    }
    for (;;) {
        const bool has_next = S.next(ui + 1, nxt);
        const char* nA = has_next ? (const char*)g.A + (size_t)nxt.pm * tstep + (size_t)nxt.koff * 2 : cA; const char* nB = has_next ? (const char*)g.Bt + (size_t)nxt.pn * tstep + (size_t)nxt.koff * 2 : cB;
        for (int t = 0; t < nt; t += 2) {
            const bool last = (t == nt - 2);
            const char* a1 = cA + (size_t)(t + 1) * kstep;
            const char* a2 = last ? nA : cA + (size_t)(t + 2) * kstep; const char* b2 = last ? nB : cB + (size_t)(t + 2) * kstep;
            const char* a3 = a2 + kstep; const char* b3 = b2 + kstep;
            if (last && has_next) S.a_ready(nxt);
            if constexpr (SP2) {
            PG8_LDB(B0, 0, 0); PG8_LDB(B1, 0, 1); PG8_SCHED; PG8_LDA(At, 0, 0); PG8_STAGE(PG8_SA(1, 1), a1 + hstep, voffA);
            PG8_WAIT_V(8); PG8_WAIT_L(0); PG8_BAR; PG8_MMA(0, 0, At, B0); PG8_MMA(0, 1, At, B1); PG8_BAR; PG8_SCHED;
            PG8_LDA(At, 0, 1); PG8_STAGE(PG8_SB(0, 0), b2, voffB); PG8_STAGE(PG8_SB(0, 1), b2 + hstep, voffB); PG8_STAGE(PG8_SA(0, 0), a2, voffA);
            PG8_WAIT_V(8); PG8_WAIT_L(0); PG8_BAR; PG8_MMA(1, 0, At, B0); PG8_MMA(1, 1, At, B1); PG8_BAR; PG8_SCHED;
            PG8_LDB(B0, 1, 0); PG8_LDB(B1, 1, 1); PG8_SCHED; PG8_LDA(At, 1, 0); PG8_STAGE(PG8_SA(0, 1), a2 + hstep, voffA);
            PG8_WAIT_V(8); PG8_WAIT_L(0); PG8_BAR; PG8_MMA(0, 0, At, B0); PG8_MMA(0, 1, At, B1); PG8_BAR; PG8_SCHED;
            PG8_LDA(At, 1, 1); PG8_STAGE(PG8_SB(1, 0), b3, voffB); PG8_STAGE(PG8_SB(1, 1), b3 + hstep, voffB); PG8_STAGE(PG8_SA(1, 0), a3, voffA);
            PG8_WAIT_V(8); PG8_WAIT_L(0); PG8_BAR; PG8_MMA(1, 0, At, B0); PG8_MMA(1, 1, At, B1); PG8_BAR; PG8_SCHED;
            } else {
            PG8_LDB(B0, 0, 0); PG8_SCHED; PG8_LDA(At, 0, 0); PG8_STAGE(PG8_SA(1, 1), a1 + hstep, voffA);
            PG8_WAIT_L(8); PG8_BAR; PG8_WAIT_L(0); PG8_MMA(0, 0, At, B0); PG8_BAR; PG8_SCHED;
            PG8_LDB(B1, 0, 1); PG8_STAGE(PG8_SB(0, 0), b2, voffB);
            PG8_BAR; PG8_WAIT_L(0); PG8_MMA(0, 1, At, B1); PG8_BAR;
            PG8_LDA(At, 0, 1); PG8_STAGE(PG8_SA(0, 0), a2, voffA);
            PG8_BAR; PG8_WAIT_L(0); PG8_MMA(1, 0, At, B0); PG8_BAR; PG8_SCHED;
            PG8_STAGE(PG8_SB(0, 1), b2 + hstep, voffB);
            PG8_WAIT_V(6); PG8_BAR; PG8_MMA(1, 1, At, B1); PG8_BAR;
            PG8_LDB(B0, 1, 0); PG8_SCHED; PG8_LDA(At, 1, 0); PG8_STAGE(PG8_SA(0, 1), a2 + hstep, voffA);
            PG8_WAIT_L(8); PG8_BAR; PG8_WAIT_L(0); PG8_MMA(0, 0, At, B0); PG8_BAR; PG8_SCHED;
            PG8_LDB(B1, 1, 1); PG8_STAGE(PG8_SB(1, 0), b3, voffB);
            PG8_BAR; PG8_WAIT_L(0); PG8_MMA(0, 1, At, B1); PG8_BAR;
            PG8_LDA(At, 1, 1); PG8_STAGE(PG8_SA(1, 0), a3, voffA);
            PG8_BAR; PG8_WAIT_L(0); PG8_MMA(1, 0, At, B0); PG8_BAR; PG8_SCHED;
            PG8_STAGE(PG8_SB(1, 1), b3 + hstep, voffB);
            PG8_WAIT_V(6); PG8_BAR; PG8_MMA(1, 1, At, B1); PG8_BAR;
            }
        }
        if constexpr (ALIGN_EPI) { if (wr == 0) PG8_BAR; }
        if constexpr (!Epi::AFTER_DRAIN) { E(acc, cur, wr, wc, fr, fq); S.done(cur); }
        if (!has_next) break;
#pragma unroll
        for (int a = 0; a < 2; ++a)
#pragma unroll
            for (int b = 0; b < 2; ++b)
#pragma unroll
                for (int m = 0; m < 4; ++m)
#pragma unroll
                    for (int n = 0; n < 2; ++n) acc[a][b][m][n] = (f32x4){0.f, 0.f, 0.f, 0.f};
        cur = nxt; cA = nA; cB = nB; ++ui; nt = cur.nt;
        if constexpr (ALIGN_EPI) { if (wr == 1) PG8_BAR; }
    }
    PG8_WAIT_V(0);
    if constexpr (!ALIGN_EPI) { if (wr == 0) PG8_BAR; }
    PG8_BAR;
    if constexpr (Epi::AFTER_DRAIN) { E.fused(acc, cur, wr, wc, fr, fq, lds, wid, lane); S.done(cur); }
#undef PG8_SA
#undef PG8_SB
#undef PG8_STAGE
#undef PG8_LDA
#undef PG8_LDB
#undef PG8_MMA
#undef PG8_WAIT_V
#undef PG8_WAIT_L
#undef PG8_BAR
#undef PG8_SCHED
}
}

#ifndef PG8_SP2
#define PG8_SP2 true
#endif
#ifndef PG8_ALIGN
#define PG8_ALIGN true
#endif

constexpr int NWAVES = 8;
constexpr int D = 2048, NB = 8, SEQ = 4096, CTXL = 256, DFF = 5632, NMOD = 9;
constexpr int NGRP = 2, NBG = NB / NGRP;
constexpr int MC = NBG * CTXL;
constexpr int MLAT = NBG * SEQ;
constexpr int M = MC + MLAT;
constexpr int NP0 = 5376, NP1 = 6400;
constexpr int NCH = (CTXL + SEQ) / 64;
constexpr int KSPLIT = 4;
constexpr float EPS = 1e-6f;
constexpr float QSCALE = 0.08838834764831845f;

constexpr size_t MiB = 1u << 20;
constexpr size_t WS_CTL = 0, CTL_ZERO_BYTES = 1 * MiB;
constexpr size_t WS_MOD = 1 * MiB;
constexpr size_t WS_GATES = 3 * MiB, GATES_G = (size_t)M * 32 * 4;
constexpr size_t WS_WRG = 8 * MiB;
constexpr size_t WS_PE = 9 * MiB;
constexpr size_t WS_HCTX = 10 * MiB;
constexpr size_t WS_W = 26 * MiB, W_LAYER = 165 * MiB;
constexpr size_t W_F1I = 0, W_F1O = W_F1I + 44 * MiB, W_F2I = W_F1O + 22 * MiB, W_F2O = W_F2I + 44 * MiB, W_MI = W_F2O + 22 * MiB, W_MO = W_MI + 25 * MiB;
constexpr size_t WS_U = 356 * MiB, U_G = (size_t)M * D * 2;
constexpr size_t WS_Y = 492 * MiB, Y_G = (size_t)M * D * 4;
constexpr size_t WS_BIG = 764 * MiB, BIG_G = (size_t)M * NP1 * 2;
constexpr size_t YC_OFF = (size_t)M * D * 2;
constexpr size_t WS_END = 1189 * MiB;
static_assert(W_MO + 8 * MiB <= W_LAYER && WS_W + 2 * W_LAYER <= WS_U && WS_U + NGRP * U_G <= WS_Y && WS_Y + NGRP * Y_G <= WS_BIG && WS_BIG + NGRP * BIG_G <= WS_END, "ws map");
static_assert(YC_OFF + (size_t)KSPLIT * MC * D * 4 <= Y_G && WS_GATES + NGRP * GATES_G <= WS_WRG, "ws map (group blocks)");
constexpr int CW_BAR = 4096;
constexpr int CW_W1READY = 64;

constexpr int SCR_BYTES = 151552;
constexpr int LDSCTL_OFF = SCR_BYTES;
constexpr int LDS_BYTES = 155648;

#define GAS __attribute__((address_space(1)))
#define LAS __attribute__((address_space(3)))
typedef unsigned short bf16;
typedef float f32x4 __attribute__((ext_vector_type(4)));
typedef float f32x2 __attribute__((ext_vector_type(2)));
typedef short bf16x8 __attribute__((ext_vector_type(8)));
typedef short bf16x4 __attribute__((ext_vector_type(4)));
typedef unsigned u32x4 __attribute__((ext_vector_type(4)));
typedef unsigned u32x2 __attribute__((ext_vector_type(2)));
#define LDS_WAIT() asm volatile("s_waitcnt lgkmcnt(0)" ::: "memory")
__device__ __forceinline__ unsigned f2bf(float f) { unsigned u = __builtin_bit_cast(unsigned, f); return (u + 0x7fffu + ((u >> 16) & 1u)) >> 16; }
__device__ __forceinline__ unsigned pk2(float lo, float hi) { return pg8::cvt_pk_bf16(lo, hi); }
__device__ __forceinline__ float bflo(unsigned w) { return __uint_as_float(w << 16); }
__device__ __forceinline__ float bfhi(unsigned w) { return __uint_as_float(w & 0xffff0000u); }
__device__ __forceinline__ float wave_sum(float v) {
#pragma unroll
    for (int o = 1; o < 64; o <<= 1) v += __shfl_xor(v, o);
    return v;
}
__device__ __forceinline__ float sigmoid_f(float x) { return __builtin_amdgcn_rcpf(1.0f + __expf(-x)); }
__device__ __forceinline__ float silu_f(float x) { return x * sigmoid_f(x); }
__device__ __forceinline__ float logsig_f(float z) { return fminf(z, 0.f) - __logf(1.0f + __expf(-fabsf(z))); }
__device__ __forceinline__ float gelu_tanh_f(float x) { const float u = 0.7978845608028654f * (x + 0.044715f * x * x * x); const float t = 1.0f - 2.0f * __builtin_amdgcn_rcpf(1.0f + __expf(2.0f * u)); return 0.5f * x * (1.0f + t); }

#define XB_TMO      128
#define XB_XCNT(j)  (256  + 64 * (j))
#define XB_XSUB(j)  (1280 + 64 * (j))
#define XB_XGEN(j)  (2304 + 64 * (j))
#define XB_TOP      3328
#define XB_TOPGEN   3392
#define XCD_BAR_WORDS 3456
#define XB_SPIN_CAP (1u << 18)

__device__ __forceinline__ unsigned xb_ld(unsigned* p)              { return __hip_atomic_load(p, __ATOMIC_RELAXED, __HIP_MEMORY_SCOPE_AGENT); }
__device__ __forceinline__ unsigned xb_add(unsigned* p, unsigned v) { return __hip_atomic_fetch_add(p, v, __ATOMIC_RELAXED, __HIP_MEMORY_SCOPE_AGENT); }
__device__ __forceinline__ unsigned xb_xcc_id() { return (unsigned)__builtin_amdgcn_s_getreg((3 << 11) | 20) & 0xFu; }
#define XB_SPIN(cond, bar) do { unsigned _sp = 0; while (cond) { __builtin_amdgcn_s_sleep(1); \
    if ((++_sp & 255u) == 0u) { if (xb_ld(&(bar)[XB_TMO])) break; if (_sp > XB_SPIN_CAP) { atomicAdd(&(bar)[XB_TMO], 1u); break; } } } } while (0)

struct XcdBarrier {
    unsigned* bar; unsigned x; unsigned ntot;
    volatile LAS unsigned* st;
};

__device__ __forceinline__ XcdBarrier xcd_barrier_post(unsigned* bar, volatile LAS unsigned* st, unsigned ntot) {
    XcdBarrier b; b.bar = bar; b.x = xb_xcc_id(); b.st = st; b.ntot = ntot;
    if (threadIdx.x == 0) (void)xb_add(&bar[XB_XCNT(b.x)], 1u);
    return b;
}
__device__ __forceinline__ void xcd_barrier_complete(unsigned* bar, unsigned x, unsigned G, unsigned& nloc, unsigned& nx) {
    unsigned sum, cnt, mine, sp = 0u;
    for (;;) {
        sum = 0u; cnt = 0u; mine = 0u;
#pragma unroll
        for (unsigned j = 0; j < 16; ++j) { const unsigned c = xb_ld(&bar[XB_XCNT(j)]); sum += c; cnt += (c > 0u) ? 1u : 0u; mine = (j == x) ? c : mine; }
        if (sum == G) break;
        __builtin_amdgcn_s_sleep(1);
        if ((++sp & 255u) == 0u) { if (xb_ld(&bar[XB_TMO])) break; if (sp > XB_SPIN_CAP) { atomicAdd(&bar[XB_TMO], 1u); break; } }
    }
    nloc = mine > 0u ? mine : 1u; nx = cnt > 0u ? cnt : 1u;
}

__device__ __forceinline__ void xcd_barrier(const XcdBarrier& b) {
    asm volatile("s_waitcnt vmcnt(0)" ::: "memory");
    __syncthreads();
    if (threadIdx.x == 0) {
        unsigned* bar = b.bar;
        __builtin_amdgcn_s_waitcnt(0);
        unsigned nloc = b.st[0], nx = b.st[1];
        if (nloc == 0u) { xcd_barrier_complete(bar, b.x, b.ntot, nloc, nx); b.st[0] = nloc; b.st[1] = nx; }
        const unsigned old = xb_add(&bar[XB_XSUB(b.x)], 1u);
        const unsigned gen = old / nloc;
        if (old + 1u == (gen + 1u) * nloc) {
            __builtin_amdgcn_fence(__ATOMIC_RELEASE, "agent");
            asm volatile("s_waitcnt vmcnt(0)" ::: "memory");
            const unsigned og = xb_add(&bar[XB_TOP], 1u);
            const unsigned tg = og / nx;
            if (og + 1u == (tg + 1u) * nx) xb_add(&bar[XB_TOPGEN], 1u);
            else XB_SPIN(xb_ld(&bar[XB_TOPGEN]) == tg, bar);
            __builtin_amdgcn_fence(__ATOMIC_ACQUIRE, "agent");
            xb_add(&bar[XB_XGEN(b.x)], 1u);
            asm volatile("s_waitcnt vmcnt(0)" ::: "memory");
        } else {
            XB_SPIN(xb_ld(&bar[XB_XGEN(b.x)]) == gen, bar);
            __builtin_amdgcn_fence(__ATOMIC_ACQUIRE, "agent");
            asm volatile("s_waitcnt vmcnt(0)" ::: "memory");
        }
    }
    __syncthreads();
}

struct Args { const float* in[27]; float* out; unsigned char* ws; int ph_lo, ph_hi; };
struct Frame {
    LAS unsigned char* lds;
    int G, wg, NGW;
    int grp;
    float* out; unsigned char* ws;
    const Args& A;
};
__device__ __forceinline__ bf16* gU(const Frame& F) { return (bf16*)(F.ws + WS_U + (size_t)F.grp * U_G); }
__device__ __forceinline__ bf16* gY(const Frame& F) { return (bf16*)(F.ws + WS_Y + (size_t)F.grp * Y_G); }
__device__ __forceinline__ bf16* gBIG(const Frame& F) { return (bf16*)(F.ws + WS_BIG + (size_t)F.grp * BIG_G); }
__device__ __forceinline__ float* gYC(const Frame& F) { return (float*)(F.ws + WS_Y + (size_t)F.grp * Y_G + YC_OFF); }
__device__ __forceinline__ float* gGATES(const Frame& F) { return (float*)(F.ws + WS_GATES + (size_t)F.grp * GATES_G); }
enum { I_X = 0, I_C, I_CTX, I_CCTX, I_WMOD, I_BMOD, I_NORMG, I_F1WI, I_F1WO, I_F2WI, I_F2WO, I_ABWI, I_WALPHA2, I_BALPHA, I_GLANG, I_CONVW, I_CONVB, I_RGWA, I_RGBA, I_RGWI, I_RGBI, I_LAM, I_ABWO, I_MLWI, I_MLBG, I_MLNG, I_MLWO };

__device__ __forceinline__ void pre_mod(Frame& F) {
    const int tid_ = fresh_tid(); const int lane_ = tid_ & 63, wave_ = __builtin_amdgcn_readfirstlane(tid_ >> 6), gw_ = F.wg * NWAVES + wave_; (void)lane_; (void)gw_;
    LAS float* sc = (LAS float*)F.lds;
    LAS float* red = (LAS float*)(F.lds + 9 * 2048 * 4);
    for (int i = tid_; i < 9 * 2048; i += 512) { const int bb = i >> 11, k = i & 2047; const float v = bb < 8 ? F.A.in[I_C][bb * 2048 + k] : F.A.in[I_CCTX][k]; sc[i] = v * (1.0f / (1.0f + expf(-v))); }
    __syncthreads();
    float* MOD = (float*)(F.ws + WS_MOD);
    const int q = tid_ & 15, kg = tid_ >> 4;
    for (int item = F.wg; item < 2 * 288; item += F.G) {
        const int layer = item / 288, col0 = (item % 288) * 64;
        const float* wp = F.A.in[I_WMOD] + ((size_t)layer * 2048 + (size_t)kg * 64) * 18432 + col0 + 4 * q;
        f32x4 acc[9];
#pragma unroll
        for (int bb = 0; bb < 9; ++bb) acc[bb] = (f32x4){0.f, 0.f, 0.f, 0.f};
#pragma unroll 4
        for (int kk = 0; kk < 64; ++kk) {
            const f32x4 w = *(const f32x4*)(wp + (size_t)kk * 18432);
#pragma unroll
            for (int bb = 0; bb < 9; ++bb) acc[bb] += w * sc[bb * 2048 + kg * 64 + kk];
        }
#pragma unroll
        for (int bb = 0; bb < 9; ++bb)
#pragma unroll
            for (int e = 0; e < 4; ++e) { float v = acc[bb][e]; v += __shfl_xor(v, 16); v += __shfl_xor(v, 32); acc[bb][e] = v; }
        __syncthreads();
        if (lane_ < 16) {
#pragma unroll
            for (int bb = 0; bb < 9; ++bb) *(LAS f32x4*)(red + (wave_ * 9 + bb) * 64 + 4 * q) = acc[bb];
        }
        __syncthreads();
        for (int t = tid_; t < 9 * 64; t += 512) { const int bb = t >> 6, ci = t & 63; float s = F.A.in[I_BMOD][layer * 18432 + col0 + ci];
#pragma unroll
            for (int w = 0; w < 8; ++w) s += red[(w * 9 + bb) * 64 + ci];
            MOD[((size_t)layer * 9 + bb) * 18432 + col0 + ci] = s; }
    }
    __syncthreads();
}
__device__ __forceinline__ void pre_pe(Frame& F) {
    const int tid_ = fresh_tid(); const int lane_ = tid_ & 63, wave_ = __builtin_amdgcn_readfirstlane(tid_ >> 6), gw_ = F.wg * NWAVES + wave_; (void)lane_; (void)gw_;
    float* PE = (float*)(F.ws + WS_PE);
    for (int i = F.wg * 512 + tid_; i < 64 * 512; i += F.G * 512) {
        const int p = i >> 9, f = i & 511;
        const float om = (float)exp2(-(double)f * (13.287712379549449 / 512.0));
        const float angf = (float)p * om; const double x = (double)angf;
        const double kf = rint(x * 0.6366197723675814);
        double r = fma(-kf, 1.5707963267948966, x); r = fma(-kf, 6.123233995736766e-17, r);
        const int k = ((int)kf) & 3; const double r2 = r * r;
        const double sp = r * (1.0 + r2 * (-1.0 / 6.0 + r2 * (1.0 / 120.0 + r2 * (-1.0 / 5040.0 + r2 * (1.0 / 362880.0 + r2 * (-1.0 / 39916800.0 + r2 * (1.0 / 6227020800.0)))))));
        const double cp = 1.0 + r2 * (-0.5 + r2 * (1.0 / 24.0 + r2 * (-1.0 / 720.0 + r2 * (1.0 / 40320.0 + r2 * (-1.0 / 3628800.0 + r2 * (1.0 / 479001600.0))))));
        const double s = (k == 0) ? sp : (k == 1) ? cp : (k == 2) ? -sp : -cp;
        const double c = (k == 0) ? cp : (k == 1) ? -sp : (k == 2) ? -cp : sp;
        PE[p * 1024 + f] = (float)s; PE[p * 1024 + 512 + f] = (float)c;
    }
}
template <int MAP> __device__ __forceinline__ int cvt_row(int n) {
    if (MAP == 1) return n < DFF ? ((n >> 7) << 8) + (n & 127) : (((n - DFF) >> 7) << 8) + 128 + ((n - DFF) & 127);
    if (MAP == 2) return n < 3072 ? n : (n < 3104 ? n + 2048 : n - 32);
    return n;
}
template <int MAP> __device__ __forceinline__ void cvt_item(const float* W, int K, int N, bf16* WT, LAS float* scr, int item, int lane) {
    const int nblk = N / 32, kb = item / nblk, nb = item % nblk, k0 = 64 * kb, n0 = 32 * nb;
#pragma unroll 8
    for (int i = 0; i < 32; ++i) { const int kk = 2 * i + (lane >> 5); scr[kk * 33 + (lane & 31)] = W[(size_t)(k0 + kk) * N + n0 + (lane & 31)]; }
    LDS_WAIT(); asm volatile("" ::: "memory");
    const int c = lane & 7;
#pragma unroll
    for (int j = 0; j < 4; ++j) { const int n = (lane >> 3) + 8 * j; const LAS float* s = scr + (8 * c) * 33 + n;
        u32x4 o; o.x = pk2(s[0 * 33], s[1 * 33]); o.y = pk2(s[2 * 33], s[3 * 33]); o.z = pk2(s[4 * 33], s[5 * 33]); o.w = pk2(s[6 * 33], s[7 * 33]);
        *(u32x4*)(WT + (size_t)cvt_row<MAP>(n0 + n) * K + k0 + 8 * c) = o; }
    LDS_WAIT(); asm volatile("" ::: "memory");
}
template <int LAYER> __device__ __forceinline__ void cvt_layer(Frame& F) {
    const int tid_ = fresh_tid(); const int lane_ = tid_ & 63, wave_ = __builtin_amdgcn_readfirstlane(tid_ >> 6), gw_ = F.wg * NWAVES + wave_; (void)lane_; (void)gw_;
    LAS float* scr = (LAS float*)(F.lds + wave_ * 16384);
    constexpr int I0 = 32 * 352, I1 = 88 * 64, I4 = LAYER == 0 ? 32 * 161 : 32 * 193, I5 = 32 * 64, I6 = LAYER == 0 ? 256 : 0;
    constexpr int NITEMS = 2 * I0 + 2 * I1 + I4 + I5 + I6;
    const float* f1i = F.A.in[I_F1WI] + (size_t)LAYER * D * 2 * DFF; const float* f1o = F.A.in[I_F1WO] + (size_t)LAYER * DFF * D;
    const float* f2i = F.A.in[I_F2WI] + (size_t)LAYER * D * 2 * DFF; const float* f2o = F.A.in[I_F2WO] + (size_t)LAYER * DFF * D;
    for (int it = gw_; it < NITEMS; it += F.NGW) {
        int r = it;
        if (r < I0) { cvt_item<1>(f1i, D, 2 * DFF, (bf16*)(F.ws + WS_W + LAYER * W_LAYER + W_F1I), scr, r, lane_); continue; } r -= I0;
        if (r < I1) { cvt_item<0>(f1o, DFF, D, (bf16*)(F.ws + WS_W + LAYER * W_LAYER + W_F1O), scr, r, lane_); continue; } r -= I1;
        if (r < I0) { cvt_item<1>(f2i, D, 2 * DFF, (bf16*)(F.ws + WS_W + LAYER * W_LAYER + W_F2I), scr, r, lane_); continue; } r -= I0;
        if (r < I1) { cvt_item<0>(f2o, DFF, D, (bf16*)(F.ws + WS_W + LAYER * W_LAYER + W_F2O), scr, r, lane_); continue; } r -= I1;
        if (r < I4) { if (LAYER == 0) cvt_item<2>(F.A.in[I_ABWI], D, 5152, (bf16*)(F.ws + WS_W + LAYER * W_LAYER + W_MI), scr, r, lane_); else cvt_item<0>(F.A.in[I_MLWI], D, 6176, (bf16*)(F.ws + WS_W + LAYER * W_LAYER + W_MI), scr, r, lane_); continue; } r -= I4;
        if (r < I5) { cvt_item<0>(LAYER == 0 ? F.A.in[I_ABWO] : F.A.in[I_MLWO], D, D, (bf16*)(F.ws + WS_W + LAYER * W_LAYER + W_MO), scr, r, lane_); continue; } r -= I5;
        if (LAYER == 0) { const int mi = r >> 3, sub = r & 7, dir = mi >> 4, mat = (mi >> 3) & 1, n = mi & 7;
            const float* src = (mat ? F.A.in[I_RGWI] : F.A.in[I_RGWA]) + (size_t)(dir * 8 + n) * 128 * 128;
            cvt_item<0>(src, 128, 128, (bf16*)(F.ws + WS_WRG) + (size_t)mi * 128 * 128, scr, sub, lane_); }
    }
    constexpr int PR0 = LAYER == 0 ? 5152 : 6176, PR1 = LAYER == 0 ? NP0 : NP1;
    u32x4* z = (u32x4*)((bf16*)(F.ws + WS_W + LAYER * W_LAYER + W_MI) + (size_t)PR0 * D);
    for (int i = F.wg * 512 + tid_; i < (PR1 - PR0) * D / 8; i += F.G * 512) z[i] = (u32x4){0u, 0u, 0u, 0u};
}

__device__ __forceinline__ float* hrow(Frame& F, int r) { return r < MC ? (float*)(F.ws + WS_HCTX) + (size_t)(r + F.grp * MC) * D : F.out + (size_t)((r - MC) + F.grp * MLAT) * D; }
template <bool INIT, bool HAS_Y, bool HAS_U>
__device__ __forceinline__ void nrm_rows(Frame& F, int row_lo, int row_hi, float wgt, const float* gpost, const float* mod_g, int gate_slot,
                                         const float* gpre, const float* mod_u, int shift_slot, int scale_slot) {
    const int tid_ = fresh_tid(); const int lane_ = tid_ & 63, wave_ = __builtin_amdgcn_readfirstlane(tid_ >> 6);
    constexpr int R = 8;
    const bf16* Yb = gY(F); bf16* U = gU(F); const float* PE = (const float*)(F.ws + WS_PE);
    LAS float* PS = (LAS float*)F.lds;
    const int col = 256 * wave_ + 4 * lane_;
    const int nblk = (row_hi - row_lo) / R;
    int cur_bb = -1;
    f32x4 gp = (f32x4){0.f, 0.f, 0.f, 0.f}, gt = gp, gn = gp, sh = gp, sc = gp;
    if (HAS_Y) gp = *(const f32x4*)(gpost + col);
    if (HAS_U) gn = *(const f32x4*)(gpre + col);
    __syncthreads();
    for (int blk = F.wg; blk < nblk; blk += F.G) {
        const int r0 = row_lo + blk * R;
        const int bb = r0 < MC ? 8 : F.grp * NBG + ((r0 - MC) >> 12);
        if (bb != cur_bb) { cur_bb = bb;
            if (HAS_Y) gt = *(const f32x4*)(mod_g + ((size_t)bb * 9 + gate_slot) * D + col);
            if (HAS_U) { sh = *(const f32x4*)(mod_u + ((size_t)bb * 9 + shift_slot) * D + col); sc = *(const f32x4*)(mod_u + ((size_t)bb * 9 + scale_slot) * D + col) + 1.0f; } }
        f32x4 hv[R];
#pragma unroll
        for (int i = 0; i < R; ++i) { const int r = r0 + i;
            if (INIT) {
                if (r < MC) hv[i] = *(const f32x4*)(F.A.in[I_CTX] + (size_t)(r + F.grp * MC) * D + col);
                else { const int t = (r - MC) & (SEQ - 1), prow = t >> 6, pcol = t & 63;
                    const f32x4 xv = *(const f32x4*)(F.A.in[I_X] + (size_t)((r - MC) + F.grp * MLAT) * D + col);
                    const f32x4 pv = col < 1024 ? *(const f32x4*)(PE + prow * 1024 + col) : *(const f32x4*)(PE + pcol * 1024 + col - 1024);
                    hv[i] = xv + pv; }
            } else hv[i] = *(const f32x4*)(hrow(F, r) + col);
        }
        if (HAS_Y) {
            f32x4 yv[R];
#pragma unroll
            for (int i = 0; i < R; ++i) {
                if (r0 < MC) { const float* yc = gYC(F) + (size_t)(r0 + i) * D + col;
                    f32x4 s = *(const f32x4*)yc;
#pragma unroll
                    for (int k = 1; k < KSPLIT; ++k) s = s + *(const f32x4*)(yc + (size_t)k * MC * D);
                    yv[i] = s; }
                else { const u32x2 w = *(const u32x2*)(Yb + (size_t)(r0 + i) * D + col); yv[i] = (f32x4){bflo(w.x), bfhi(w.x), bflo(w.y), bfhi(w.y)}; } }
#pragma unroll
            for (int i = 0; i < R; ++i) { const float ss = wave_sum((yv[i].x * yv[i].x + yv[i].y * yv[i].y) + (yv[i].z * yv[i].z + yv[i].w * yv[i].w)); if (lane_ == 0) PS[i * 8 + wave_] = ss; }
            asm volatile("s_waitcnt lgkmcnt(0)" ::: "memory"); __builtin_amdgcn_s_barrier(); asm volatile("" ::: "memory");
#pragma unroll
            for (int i = 0; i < R; ++i) { const f32x4 p0 = *(const LAS f32x4*)(PS + i * 8), p1 = *(const LAS f32x4*)(PS + i * 8 + 4);
                const float tot = ((p0.x + p0.y) + (p0.z + p0.w)) + ((p1.x + p1.y) + (p1.z + p1.w));
                const float r1 = rsqrtf(tot * (1.0f / D) + EPS) * wgt;
                hv[i] = hv[i] + gt * (yv[i] * r1 * gp); }
        }
        if (INIT || HAS_Y) {
#pragma unroll
            for (int i = 0; i < R; ++i) *(f32x4*)(hrow(F, r0 + i) + col) = hv[i];
        }
        if (HAS_U) {
#pragma unroll
            for (int i = 0; i < R; ++i) { const float ss = wave_sum((hv[i].x * hv[i].x + hv[i].y * hv[i].y) + (hv[i].z * hv[i].z + hv[i].w * hv[i].w)); if (lane_ == 0) PS[64 + i * 8 + wave_] = ss; }
            asm volatile("s_waitcnt lgkmcnt(0)" ::: "memory"); __builtin_amdgcn_s_barrier(); asm volatile("" ::: "memory");
#pragma unroll
            for (int i = 0; i < R; ++i) { const f32x4 p0 = *(const LAS f32x4*)(PS + 64 + i * 8), p1 = *(const LAS f32x4*)(PS + 64 + i * 8 + 4);
                const float tot = ((p0.x + p0.y) + (p0.z + p0.w)) + ((p1.x + p1.y) + (p1.z + p1.w));
                const float r2 = rsqrtf(tot * (1.0f / D) + EPS);
                const f32x4 u = (hv[i] * r2 * gn) * sc + sh;
                u32x2 w; w.x = pk2(u.x, u.y); w.y = pk2(u.z, u.w);
                *(u32x2*)(U + (size_t)(r0 + i) * D + col) = w; }
        }
        if (!HAS_Y || !HAS_U) { asm volatile("s_waitcnt lgkmcnt(0)" ::: "memory"); __builtin_amdgcn_s_barrier(); asm volatile("" ::: "memory"); }
    }
    __syncthreads();
}

__device__ __forceinline__ void unpack8(const u32x4 v, float (&f)[8]) { f[0] = bflo(v.x); f[1] = bfhi(v.x); f[2] = bflo(v.y); f[3] = bfhi(v.y); f[4] = bflo(v.z); f[5] = bfhi(v.z); f[6] = bflo(v.w); f[7] = bfhi(v.w); }
__device__ __forceinline__ u32x4 pack8(const float (&f)[8]) { u32x4 o; o.x = pk2(f[0], f[1]); o.y = pk2(f[2], f[3]); o.z = pk2(f[4], f[5]); o.w = pk2(f[6], f[7]); return o; }
__device__ __forceinline__ void comb0_rows(Frame& F, int row_lo, int row_hi) {
    const int tid_ = fresh_tid(); const int lane_ = tid_ & 63, wave_ = __builtin_amdgcn_readfirstlane(tid_ >> 6), gw_ = F.wg * NWAVES + wave_; (void)lane_; (void)gw_;
    const bf16* OFb = gY(F); const bf16* OBb = OFb + (size_t)M * 1024; const bf16* HFb = OBb + (size_t)M * 1024; const bf16* HBb = HFb + (size_t)M * 1024;
    const bf16* P = gBIG(F); bf16* U = gU(F); const float* gg = F.A.in[I_GLANG];
    const int e0 = 16 * lane_;
    for (int r = row_lo + gw_; r < row_hi; r += F.NGW) {
#pragma unroll
        for (int part = 0; part < 2; ++part) {
            const bf16* fa = (part ? HFb : OFb) + (size_t)r * 1024 + e0; const bf16* fb = (part ? HBb : OBb) + (size_t)r * 1024 + e0;
            const bf16* gp = P + (size_t)r * NP0 + (part ? 4096 : 2048) + e0;
            float a[2][8], b8[8], g[2][8];
            unpack8(*(const u32x4*)fa, a[0]); unpack8(*(const u32x4*)(fa + 8), a[1]);
            unpack8(*(const u32x4*)fb, b8);
#pragma unroll
            for (int e = 0; e < 8; ++e) a[0][e] += b8[e];
            unpack8(*(const u32x4*)(fb + 8), b8);
#pragma unroll
            for (int e = 0; e < 8; ++e) a[1][e] += b8[e];
            unpack8(*(const u32x4*)gp, g[0]); unpack8(*(const u32x4*)(gp + 8), g[1]);
            float o[2][8];
            if (part == 0) {
                float ss = 0.f;
#pragma unroll
                for (int c = 0; c < 2; ++c)
#pragma unroll
                    for (int e = 0; e < 8; ++e) ss += a[c][e] * a[c][e];
                ss += __shfl_xor(ss, 1); ss += __shfl_xor(ss, 2); ss += __shfl_xor(ss, 4); ss += __shfl_xor(ss, 8);
                const float rr = rsqrtf(ss * (1.0f / 256.0f) + EPS);
#pragma unroll
                for (int c = 0; c < 2; ++c)
#pragma unroll
                    for (int e = 0; e < 8; ++e) o[c][e] = a[c][e] * rr * gg[(e0 & 255) + 8 * c + e] * silu_f(g[c][e]);
            } else {
#pragma unroll
                for (int c = 0; c < 2; ++c)
#pragma unroll
                    for (int e = 0; e < 8; ++e) o[c][e] = a[c][e] * gelu_tanh_f(g[c][e]);
            }
            bf16* up = U + (size_t)r * D + part * 1024 + e0;
            *(u32x4*)up = pack8(o[0]); *(u32x4*)(up + 8) = pack8(o[1]);
        }
    }
}
__device__ __forceinline__ void comb1_rows(Frame& F, int row_lo, int row_hi) {
    const int tid_ = fresh_tid(); const int lane_ = tid_ & 63, wave_ = __builtin_amdgcn_readfirstlane(tid_ >> 6), gw_ = F.wg * NWAVES + wave_; (void)lane_; (void)gw_;
    const bf16* HFb = gY(F); const bf16* HBb = HFb + (size_t)M * D;
    const bf16* P = gBIG(F); bf16* U = gU(F); const float* gg = F.A.in[I_MLNG];
    const int e0 = 32 * lane_;
    for (int r = row_lo + gw_; r < row_hi; r += F.NGW) {
        float a[32]; float ss = 0.f;
#pragma unroll
        for (int c = 0; c < 4; ++c) { float x8[8], y8[8]; unpack8(*(const u32x4*)(HFb + (size_t)r * D + e0 + 8 * c), x8); unpack8(*(const u32x4*)(HBb + (size_t)r * D + e0 + 8 * c), y8);
#pragma unroll
            for (int e = 0; e < 8; ++e) { a[8 * c + e] = x8[e] + y8[e]; ss += a[8 * c + e] * a[8 * c + e]; } }
        ss += __shfl_xor(ss, 1); ss += __shfl_xor(ss, 2); ss += __shfl_xor(ss, 4);
        const float rr = rsqrtf(ss * (1.0f / 256.0f) + EPS);
#pragma unroll
        for (int c = 0; c < 4; ++c) { float g8[8], o8[8]; unpack8(*(const u32x4*)(P + (size_t)r * NP1 + 4096 + e0 + 8 * c), g8);
#pragma unroll
            for (int e = 0; e < 8; ++e) o8[e] = a[8 * c + e] * rr * gg[((e0 + 8 * c) & 255) + e] * sigmoid_f(g8[e]);
            *(u32x4*)(U + (size_t)r * D + e0 + 8 * c) = pack8(o8); }
    }
}

#define WG_BAR() do { asm volatile("s_waitcnt lgkmcnt(0)" ::: "memory"); __builtin_amdgcn_s_barrier(); asm volatile("" ::: "memory"); } while (0)
__device__ __forceinline__ int chunk_rlo(int b, int dir, int c) {
    return c < 4 ? b * CTXL + (dir ? (CTXL - 64 - 64 * c) : 64 * c) : MC + b * SEQ + (dir ? (SEQ - 64 - 64 * (c - 4)) : 64 * (c - 4));
}
__device__ __forceinline__ bf16x8 tr_frag(LAS unsigned char* tile, int pitch, int k0, int c0, int lane) {
    const int g = lane >> 4, q = (lane & 15) >> 2, p = lane & 3;
    LAS unsigned char* a0 = tile + (k0 + 8 * g + q) * pitch + (c0 + 4 * p) * 2;
    const bf16x4 lo = __builtin_amdgcn_ds_read_tr16_b64_v4i16((LAS bf16x4*)a0);
    const bf16x4 hi = __builtin_amdgcn_ds_read_tr16_b64_v4i16((LAS bf16x4*)(a0 + 4 * pitch));
    return __builtin_shufflevector(lo, hi, 0, 1, 2, 3, 4, 5, 6, 7);
}
__device__ __forceinline__ u32x4 scale8(const u32x4 v, float s) {
    u32x4 o; o.x = pk2(bflo(v.x) * s, bfhi(v.x) * s); o.y = pk2(bflo(v.y) * s, bfhi(v.y) * s); o.z = pk2(bflo(v.z) * s, bfhi(v.z) * s); o.w = pk2(bflo(v.w) * s, bfhi(v.w) * s); return o;
}
__device__ __forceinline__ float wave_incl_sum(float x, int lane) {
#pragma unroll
    for (int o = 1; o < 64; o <<= 1) { const float t = __shfl_up(x, o); if (lane >= o) x += t; }
    return x;
}
__device__ __forceinline__ float wave_incl_max(float x, int lane) {
#pragma unroll
    for (int o = 1; o < 64; o <<= 1) { const float t = __shfl_up(x, o); if (lane >= o) x = fmaxf(x, t); }
    return x;
}

template <int MODE>
__device__ __forceinline__ void chain_scan(LAS unsigned char* lds,
        const bf16* __restrict__ proj, const int NP, const int qcol, const int kcol, const int vcol,
        const float* __restrict__ gates, const int gcol, const int b, const int dir,
        bf16* __restrict__ outb, const int out_ld, const int ocol, const bool ctx_out,
        const float* __restrict__ w2, const float* __restrict__ ba, const float bias_i, const float bias_f) {
    const int tid = fresh_tid(); const int lane = tid & 63, wave = __builtin_amdgcn_readfirstlane(tid >> 6);
    constexpr int NVB = MODE ? 9 : 8;
    constexpr int PQ = 272, PV = 304, PP = 144;
    constexpr int O_QS = 0, O_KS = 17408, O_QH = 34816, O_KH = 52224, O_VS = 69632, O_PS = 89088, O_SB = 98304, O_SM = 137472;
    LAS float* LR = (LAS float*)(lds + O_SM);
    LAS float* TOT = (LAS float*)(lds + O_SM + 4096);
    LAS float* FIRST = (LAS float*)(lds + O_SM + 8192);
    LAS float* DEC = (LAS float*)(lds + O_SM + 8704);
    LAS float* A_ = (LAS float*)(lds + O_SM);
    LAS float* MI = A_ + 64; LAS float* WI = A_ + 128; LAS float* WK = A_ + 192; LAS float* MR = A_ + 256; LAS float* DEN = A_ + 320; LAS float* DECS = A_ + 384;
    const int fr = lane & 15, fq = lane >> 4;

    __syncthreads();
    for (int i = tid; i < (9216 + 39168) / 16; i += 512) *(LAS u32x4*)(lds + O_PS + 16 * i) = (u32x4){0u, 0u, 0u, 0u};
    if (MODE) { if (tid < 64) { *(LAS u32x4*)(lds + O_VS + tid * PV + 256) = (u32x4){0x3F80u, 0u, 0u, 0u}; *(LAS u32x4*)(lds + O_VS + tid * PV + 272) = (u32x4){0u, 0u, 0u, 0u}; } }
    f32x4 S[NVB];
#pragma unroll
    for (int v = 0; v < NVB; ++v) S[v] = (f32x4){0.f, 0.f, 0.f, 0.f};
    float mst = 0.f;
    const int dp = tid & 63, d0 = 2 * dp, jg = wave;
    f32x2 w2r[16]; f32x2 bar = (f32x2){0.f, 0.f};
    if (MODE == 0) {
#pragma unroll
        for (int r = 0; r < 16; ++r) w2r[r] = *(const f32x2*)(w2 + r * 512 + d0);
        bar = *(const f32x2*)(ba + d0);
    }
    const int sj0 = tid >> 4, sj1 = (tid + 512) >> 4, sch = tid & 15;
    u32x4 pq[2], pk[2], pv[2]; f32x2 plr = (f32x2){0.f, 0.f}; float pgi = 0.f, pgf = 0.f;
#define CH_PREFETCH(cc) do { const int rl_ = chunk_rlo(b, dir, (cc)); \
        { const int row_ = dir ? rl_ + 63 - sj0 : rl_ + sj0; const bf16* rp_ = proj + (size_t)row_ * NP + 8 * sch; pq[0] = *(const u32x4*)(rp_ + qcol); pk[0] = *(const u32x4*)(rp_ + kcol); pv[0] = *(const u32x4*)(rp_ + vcol); } \
        { const int row_ = dir ? rl_ + 63 - sj1 : rl_ + sj1; const bf16* rp_ = proj + (size_t)row_ * NP + 8 * sch; pq[1] = *(const u32x4*)(rp_ + qcol); pk[1] = *(const u32x4*)(rp_ + kcol); pv[1] = *(const u32x4*)(rp_ + vcol); } \
        if (MODE == 0) { const int j_ = 8 * wave + (lane >> 3); const int row_ = dir ? rl_ + 63 - j_ : rl_ + j_; plr = *(const f32x2*)(gates + (size_t)row_ * 32 + gcol + 2 * (lane & 7)); } \
        else { if (wave == 0) { const int row_ = dir ? rl_ + 63 - lane : rl_ + lane; pgi = gates[(size_t)row_ * 32 + gcol]; pgf = gates[(size_t)row_ * 32 + gcol + 8]; } } } while (0)
    CH_PREFETCH(0);
    for (int c = 0; c < NCH; ++c) {
        const int rl = chunk_rlo(b, dir, c);
        *(LAS u32x4*)(lds + O_QS + sj0 * PQ + 16 * sch) = pq[0]; *(LAS u32x4*)(lds + O_QS + sj1 * PQ + 16 * sch) = pq[1];
        *(LAS u32x4*)(lds + O_KS + sj0 * PQ + 16 * sch) = pk[0]; *(LAS u32x4*)(lds + O_KS + sj1 * PQ + 16 * sch) = pk[1];
        *(LAS u32x4*)(lds + O_VS + sj0 * PV + 16 * sch) = pv[0]; *(LAS u32x4*)(lds + O_VS + sj1 * PV + 16 * sch) = pv[1];
        const f32x2 lrc = plr; const float gi = pgi, gf = pgf;
        if (c + 1 < NCH) CH_PREFETCH(c + 1);
        WG_BAR();
        if (MODE == 0) {
            f32x2 cs[8]; f32x2 run = (f32x2){0.f, 0.f};
#pragma unroll
            for (int jj = 0; jj < 8; ++jj) {
                f32x2 z = bar;
#pragma unroll
                for (int r2 = 0; r2 < 8; ++r2) { const float l0 = __int_as_float(__builtin_amdgcn_readlane(__float_as_int(lrc.x), 8 * jj + r2)), l1 = __int_as_float(__builtin_amdgcn_readlane(__float_as_int(lrc.y), 8 * jj + r2));
                    z += w2r[2 * r2] * l0; z += w2r[2 * r2 + 1] * l1; }
                f32x2 la; la.x = fmaxf(logsig_f(z.x) * (1.0f / 16.0f), -1.0f); la.y = fmaxf(logsig_f(z.y) * (1.0f / 16.0f), -1.0f);
                run += la; cs[jj] = run;
            }
            *(LAS f32x2*)(TOT + jg * 128 + d0) = run;
            if (jg == 4) *(LAS f32x2*)(FIRST + d0) = cs[0];
            WG_BAR();
            f32x2 pre = (f32x2){0.f, 0.f}, bref = (f32x2){0.f, 0.f}, blast = (f32x2){0.f, 0.f};
#pragma unroll
            for (int g = 0; g < 8; ++g) { const f32x2 t = *(const LAS f32x2*)(TOT + g * 128 + d0); if (g < jg) pre += t; if (g < 4) bref += t; blast += t; }
            bref += *(const LAS f32x2*)(FIRST + d0);
            f32x2 e1, e2; e1.x = __expf(bref.x); e1.y = __expf(bref.y); e2.x = __expf(blast.x - bref.x); e2.y = __expf(blast.y - bref.y);
            unsigned qw[8], kw[8];
#pragma unroll
            for (int jj = 0; jj < 8; ++jj) { const int j = 8 * jg + jj; qw[jj] = *(const LAS unsigned*)(lds + O_QS + j * PQ + 4 * dp); kw[jj] = *(const LAS unsigned*)(lds + O_KS + j * PQ + 4 * dp); }
#pragma unroll
            for (int jj = 0; jj < 8; ++jj) {
                const int j = 8 * jg + jj; const f32x2 bb = pre + cs[jj];
                f32x2 ef, er; ef.x = __expf(bb.x - bref.x); ef.y = __expf(bb.y - bref.y); er.x = __builtin_amdgcn_rcpf(ef.x); er.y = __builtin_amdgcn_rcpf(ef.y);
                f32x2 qv, kv; qv.x = bflo(qw[jj]) * QSCALE; qv.y = bfhi(qw[jj]) * QSCALE; kv.x = bflo(kw[jj]); kv.y = bfhi(kw[jj]);
                const f32x2 qt = qv * ef, kt = kv * er, qh = qt * e1, kh = kt * e2;
                *(LAS unsigned*)(lds + O_QS + j * PQ + 4 * dp) = pk2(qt.x, qt.y);
                *(LAS unsigned*)(lds + O_QH + j * PQ + 4 * dp) = pk2(qh.x, qh.y);
                *(LAS unsigned*)(lds + O_KS + j * PQ + 4 * dp) = pk2(kt.x, kt.y);
                *(LAS unsigned*)(lds + O_KH + j * PQ + 4 * dp) = pk2(kh.x, kh.y);
            }
            if (jg == 0) { f32x2 dv; dv.x = __expf(blast.x); dv.y = __expf(blast.y); *(LAS f32x2*)(DEC + d0) = dv; }
        } else {
            if (wave == 0) {
                const float ipre = gi + bias_i, lf = logsig_f(gf + bias_f);
                const float bsum = wave_incl_sum(lf, lane);
                const float a = ipre - bsum;
                const float cm = wave_incl_max(a, lane);
                const float Mi = fmaxf(mst, cm);
                const float blast = __shfl(bsum, 63), M63 = __shfl(Mi, 63);
                A_[lane] = a; MI[lane] = Mi; WI[lane] = __expf(mst - Mi) * QSCALE; WK[lane] = __expf(a - M63); MR[lane] = __expf(-(bsum + Mi));
                if (lane == 0) DECS[0] = __expf(mst - M63);
                mst = blast + M63;
            }
            WG_BAR();
            { const float wi0 = WI[sj0], wi1 = WI[sj1], wk0 = WK[sj0], wk1 = WK[sj1];
              *(LAS u32x4*)(lds + O_QH + sj0 * PQ + 16 * sch) = scale8(*(const LAS u32x4*)(lds + O_QS + sj0 * PQ + 16 * sch), wi0);
              *(LAS u32x4*)(lds + O_QH + sj1 * PQ + 16 * sch) = scale8(*(const LAS u32x4*)(lds + O_QS + sj1 * PQ + 16 * sch), wi1);
              *(LAS u32x4*)(lds + O_KH + sj0 * PQ + 16 * sch) = scale8(*(const LAS u32x4*)(lds + O_KS + sj0 * PQ + 16 * sch), wk0);
              *(LAS u32x4*)(lds + O_KH + sj1 * PQ + 16 * sch) = scale8(*(const LAS u32x4*)(lds + O_KS + sj1 * PQ + 16 * sch), wk1); }
        }
        WG_BAR();
        for (int tix = wave; tix < 10; tix += 8) {
            const int ib = tix >= 6 ? 3 : (tix >= 3 ? 2 : (tix >= 1 ? 1 : 0)); const int jb = tix - ib * (ib + 1) / 2;
            f32x4 acc = (f32x4){0.f, 0.f, 0.f, 0.f};
            bf16x8 Ak[4], Bq[4];
#pragma unroll
            for (int ks = 0; ks < 4; ++ks) { Ak[ks] = *(const LAS bf16x8*)(lds + O_KS + (16 * jb + fr) * PQ + (32 * ks + 8 * fq) * 2); Bq[ks] = *(const LAS bf16x8*)(lds + O_QS + (16 * ib + fr) * PQ + (32 * ks + 8 * fq) * 2); }
#pragma unroll
            for (int ks = 0; ks < 4; ++ks) acc = __builtin_amdgcn_mfma_f32_16x16x32_bf16(Ak[ks], Bq[ks], acc, 0, 0, 0);
            const int i = 16 * ib + fr, j0 = 16 * jb + 4 * fq;
            float w[4];
            if (MODE) { const float Mi = MI[i];
#pragma unroll
                for (int r = 0; r < 4; ++r) w[r] = (j0 + r <= i) ? acc[r] * QSCALE * __expf(A_[j0 + r] - Mi) : 0.f;
            } else {
#pragma unroll
                for (int r = 0; r < 4; ++r) w[r] = (j0 + r <= i) ? acc[r] : 0.f;
            }
            u32x2 pw; pw.x = pk2(w[0], w[1]); pw.y = pk2(w[2], w[3]);
            *(LAS u32x2*)(lds + O_PS + i * PP + j0 * 2) = pw;
        }
        WG_BAR();
        const int ib = wave & 3, vb0 = (wave >> 2) * 4, irow = 16 * ib + fr;
        f32x4 ao[5];
#pragma unroll
        for (int v = 0; v < 5; ++v) ao[v] = (f32x4){0.f, 0.f, 0.f, 0.f};
        {
            bf16x8 Bp[2], Av[2][5];
#pragma unroll
            for (int ks = 0; ks < 2; ++ks) { Bp[ks] = *(const LAS bf16x8*)(lds + O_PS + irow * PP + (32 * ks + 8 * fq) * 2);
#pragma unroll
                for (int v = 0; v < 4; ++v) Av[ks][v] = tr_frag(lds + O_VS, PV, 32 * ks, 16 * (vb0 + v), lane);
                if (MODE) Av[ks][4] = tr_frag(lds + O_VS, PV, 32 * ks, 128, lane); }
#pragma unroll
            for (int ks = 0; ks < 2; ++ks) {
#pragma unroll
                for (int v = 0; v < 4; ++v) ao[v] = __builtin_amdgcn_mfma_f32_16x16x32_bf16(Av[ks][v], Bp[ks], ao[v], 0, 0, 0);
                if (MODE) { if (wave < 4) ao[4] = __builtin_amdgcn_mfma_f32_16x16x32_bf16(Av[ks][4], Bp[ks], ao[4], 0, 0, 0); } }
        }
#pragma unroll
        for (int kh = 0; kh < 2; ++kh) {
            bf16x8 Bq[2], As[2][5];
#pragma unroll
            for (int k2 = 0; k2 < 2; ++k2) { const int ks = 2 * kh + k2; Bq[k2] = *(const LAS bf16x8*)(lds + O_QH + irow * PQ + (32 * ks + 8 * fq) * 2);
#pragma unroll
                for (int v = 0; v < 4; ++v) As[k2][v] = *(const LAS bf16x8*)(lds + O_SB + (16 * (vb0 + v) + fr) * PQ + (32 * ks + 8 * fq) * 2);
                if (MODE) As[k2][4] = *(const LAS bf16x8*)(lds + O_SB + (128 + fr) * PQ + (32 * ks + 8 * fq) * 2); }
#pragma unroll
            for (int k2 = 0; k2 < 2; ++k2) {
#pragma unroll
                for (int v = 0; v < 4; ++v) ao[v] = __builtin_amdgcn_mfma_f32_16x16x32_bf16(As[k2][v], Bq[k2], ao[v], 0, 0, 0);
                if (MODE) { if (wave < 4) ao[4] = __builtin_amdgcn_mfma_f32_16x16x32_bf16(As[k2][4], Bq[k2], ao[4], 0, 0, 0); } }
        }
        const int db = wave;
        if (MODE == 0) { const f32x4 dec = *(const LAS f32x4*)(DEC + 16 * db + 4 * fq);
#pragma unroll
            for (int v = 0; v < NVB; ++v) S[v] = S[v] * dec;
        } else { const float dsc = DECS[0];
#pragma unroll
            for (int v = 0; v < NVB; ++v) S[v] = S[v] * dsc;
        }
#pragma unroll
        for (int ks = 0; ks < 2; ++ks) {
            const bf16x8 A = tr_frag(lds + O_KH, PQ, 32 * ks, 16 * db, lane);
#pragma unroll
            for (int v = 0; v < NVB; ++v) { const bf16x8 B = tr_frag(lds + O_VS, PV, 32 * ks, 16 * v, lane); S[v] = __builtin_amdgcn_mfma_f32_16x16x32_bf16(A, B, S[v], 0, 0, 0); }
        }
        if (MODE) { if (wave < 4 && lane < 16) DEN[16 * ib + lane] = ao[4][0]; }
        WG_BAR();
        if (ctx_out || c >= 4) {
            const int row = dir ? rl + 63 - irow : rl + irow;
            float sc = 1.0f;
            if (MODE) sc = 1.0f / fmaxf(fabsf(DEN[irow]), MR[irow]);
            bf16* op = outb + (size_t)row * out_ld + ocol + 16 * vb0 + 4 * fq;
#pragma unroll
            for (int v = 0; v < 4; ++v) { u32x2 w; w.x = pk2(ao[v][0] * sc, ao[v][1] * sc); w.y = pk2(ao[v][2] * sc, ao[v][3] * sc); *(u32x2*)(op + 16 * v) = w; }
        }
#pragma unroll
        for (int v = 0; v < NVB; ++v) { u32x2 w; w.x = pk2(S[v][0], S[v][1]); w.y = pk2(S[v][2], S[v][3]); *(LAS u32x2*)(lds + O_SB + (16 * v + fr) * PQ + (16 * db + 4 * fq) * 2) = w; }
    }
#undef CH_PREFETCH
    __syncthreads();
}

__device__ __forceinline__ void rg_chain(LAS unsigned char* lds,
        const bf16* __restrict__ proj, const int b, const int n, const int dir, const bf16* __restrict__ wrg,
        const float* __restrict__ lam, const float* __restrict__ b_a, const float* __restrict__ b_i, const float* __restrict__ conv_w, const float* __restrict__ conv_b,
        bf16* __restrict__ hout) {
    const int tid = fresh_tid(); const int lane = tid & 63, wave = __builtin_amdgcn_readfirstlane(tid >> 6);
    constexpr int O_XR = 0, O_XBF = 17408, O_XBH = 51200, O_AA = 68608, O_BX = 102400, O_CW = 136192;
    constexpr int PXF = 528, PXH = 272;
    const int fr = lane & 15, fq = lane >> 4;
    LAS float* CW = (LAS float*)(lds + O_CW);
    __syncthreads();
    for (int i = tid; i < 5 * 128; i += 512) CW[i] = i < 512 ? conv_w[(i >> 7) * 1024 + 128 * n + (i & 127)] : conv_b[128 * n + (i - 512)];
    bf16x8 Afr[2][4];
#pragma unroll
    for (int mat = 0; mat < 2; ++mat)
#pragma unroll
        for (int ks = 0; ks < 4; ++ks) Afr[mat][ks] = *(const bf16x8*)(wrg + ((size_t)((dir * 2 + mat) * 8 + n) * 128 + 16 * wave + fr) * 128 + 32 * ks + 8 * fq);
    f32x4 c8, bav, biv;
#pragma unroll
    for (int r = 0; r < 4; ++r) { const int ch = 128 * n + 16 * wave + 4 * fq + r; const float l = lam[dir * 1024 + ch];
        c8[r] = -8.0f * (fmaxf(-l, 0.f) + log1pf(expf(-fabsf(l)))); bav[r] = b_a[dir * 1024 + ch]; biv[r] = b_i[dir * 1024 + ch]; }
    float hst = 0.f;
    const int ch2 = tid & 63, tg = tid >> 6;
    u32x4 px[3];
#define RG_PREFETCH(cc) do { const int c_ = (cc); const int L_ = c_ < 4 ? CTXL : SEQ, cs_ = c_ < 4 ? c_ : c_ - 4, base_ = c_ < 4 ? b * CTXL : MC + b * SEQ; \
        const int t0_ = dir ? L_ - 64 * (cs_ + 1) : 64 * cs_; \
        _Pragma("unroll") for (int e_ = 0; e_ < 3; ++e_) { const int id_ = tid + 512 * e_, rr_ = id_ >> 4, tt_ = t0_ - 2 + rr_; \
            px[e_] = (rr_ < 67 && tt_ >= 0 && tt_ < L_) ? *(const u32x4*)(proj + (size_t)(base_ + tt_) * NP0 + 3072 + 128 * n + 8 * (id_ & 15)) : (u32x4){0u, 0u, 0u, 0u}; } } while (0)
    RG_PREFETCH(0);
    for (int c = 0; c < NCH; ++c) {
        const int L = c < 4 ? CTXL : SEQ, cs = c < 4 ? c : c - 4, base = c < 4 ? b * CTXL : MC + b * SEQ;
        const int t0 = dir ? L - 64 * (cs + 1) : 64 * cs;
#pragma unroll
        for (int e = 0; e < 3; ++e) { const int id = tid + 512 * e, rr = id >> 4; if (rr < 68) *(LAS u32x4*)(lds + O_XR + rr * 256 + 16 * (id & 15)) = px[e]; }
        if (c + 1 < NCH) RG_PREFETCH(c + 1);
        WG_BAR();
        {
            const f32x2 w0 = *(const LAS f32x2*)(CW + 0 * 128 + 2 * ch2), w1 = *(const LAS f32x2*)(CW + 1 * 128 + 2 * ch2), w2_ = *(const LAS f32x2*)(CW + 2 * 128 + 2 * ch2), w3 = *(const LAS f32x2*)(CW + 3 * 128 + 2 * ch2), cb = *(const LAS f32x2*)(CW + 512 + 2 * ch2);
            f32x2 xw[11];
#pragma unroll
            for (int rr = 0; rr < 11; ++rr) { const unsigned u = *(const LAS unsigned*)(lds + O_XR + (8 * tg + rr) * 256 + 4 * ch2); xw[rr].x = bflo(u); xw[rr].y = bfhi(u); }
#pragma unroll
            for (int jj = 0; jj < 8; ++jj) {
                f32x2 y = cb; y += xw[jj] * w0; y += xw[jj + 1] * w1; y += xw[jj + 2] * w2_; y += xw[jj + 3] * w3;
                *(LAS f32x2*)(lds + O_XBF + (8 * tg + jj) * PXF + 8 * ch2) = y;
                *(LAS unsigned*)(lds + O_XBH + (8 * tg + jj) * PXH + 4 * ch2) = pk2(y.x, y.y);
            }
        }
        WG_BAR();
#pragma unroll
        for (int tb = 0; tb < 4; ++tb) {
            f32x4 ga = (f32x4){0.f, 0.f, 0.f, 0.f}, gi = (f32x4){0.f, 0.f, 0.f, 0.f};
            bf16x8 Bx[4];
#pragma unroll
            for (int ks = 0; ks < 4; ++ks) Bx[ks] = *(const LAS bf16x8*)(lds + O_XBH + (16 * tb + fr) * PXH + (32 * ks + 8 * fq) * 2);
#pragma unroll
            for (int ks = 0; ks < 4; ++ks) { ga = __builtin_amdgcn_mfma_f32_16x16x32_bf16(Afr[0][ks], Bx[ks], ga, 0, 0, 0); gi = __builtin_amdgcn_mfma_f32_16x16x32_bf16(Afr[1][ks], Bx[ks], gi, 0, 0, 0); }
            const int t = 16 * tb + fr;
            const f32x4 xb = *(const LAS f32x4*)(lds + O_XBF + t * PXF + (16 * wave + 4 * fq) * 4);
            f32x4 av, bx;
#pragma unroll
            for (int r = 0; r < 4; ++r) { const float rg = sigmoid_f(ga[r] + bav[r]), ig = sigmoid_f(gi[r] + biv[r]); const float la = c8[r] * rg;
                av[r] = __expf(la); bx[r] = sqrtf(-expm1f(2.0f * la)) * (ig * xb[r]); }
            *(LAS f32x4*)(lds + O_AA + t * PXF + (16 * wave + 4 * fq) * 4) = av;
            *(LAS f32x4*)(lds + O_BX + t * PXF + (16 * wave + 4 * fq) * 4) = bx;
        }
        WG_BAR();
        if (tid < 128) {
            bf16* hp = hout + (size_t)(base + t0) * 1024 + 128 * n + tid;
            for (int s8 = 0; s8 < 64; s8 += 8) {
                float av8[8], bx8[8];
#pragma unroll
                for (int e = 0; e < 8; ++e) { const int jj = dir ? 63 - (s8 + e) : s8 + e; av8[e] = *(const LAS float*)(lds + O_AA + jj * PXF + 4 * tid); bx8[e] = *(const LAS float*)(lds + O_BX + jj * PXF + 4 * tid); }
#pragma unroll
                for (int e = 0; e < 8; ++e) { const int jj = dir ? 63 - (s8 + e) : s8 + e; hst = av8[e] * hst + bx8[e]; hp[(size_t)jj * 1024] = (bf16)f2bf(hst); }
            }
        }
    }
#undef RG_PREFETCH
    __syncthreads();
}

#ifndef MK_LAST_PHASE
#define MK_LAST_PHASE 24
#endif
constexpr int NPH = 24;
__global__ void __launch_bounds__(NWAVES * 64, 2) mk_fwd(Args args) {
    extern __shared__ __attribute__((aligned(16))) unsigned char lds_raw[];
    const int GA = (int)gridDim.x, bx = (int)blockIdx.x;
    const int grp = (bx >> 2) & 1, gi = ((bx >> 3) << 2) | (bx & 3), GG = GA >> 1;
    Frame FA{(LAS unsigned char*)lds_raw, GA, bx, GA * NWAVES, 0, args.out, args.ws, args};
    Frame F{(LAS unsigned char*)lds_raw, GG, gi, GG * NWAVES, grp, args.out, args.ws, args};
    volatile LAS unsigned* MISC = (volatile LAS unsigned*)(F.lds + LDSCTL_OFF);
    for (int u = threadIdx.x; u < (LDS_BYTES - LDSCTL_OFF) / 4; u += NWAVES * 64) ((LAS unsigned*)(F.lds + LDSCTL_OFF))[u] = 0u;
    __syncthreads();
    const int lo = args.ph_lo, hi = args.ph_hi;
    unsigned* ctl = (unsigned*)(F.ws + WS_CTL);
    XcdBarrier barA = xcd_barrier_post(ctl + CW_BAR, MISC + 8, (unsigned)GA);
    XcdBarrier barG = xcd_barrier_post(ctl + CW_BAR + (1 + grp) * XCD_BAR_WORDS, MISC + 12, (unsigned)GG);
#ifndef MK_REP_GEMM
#define MK_REP_GEMM 1
#endif
#ifndef MK_REP_SCAN
#define MK_REP_SCAN 1
#endif
#ifndef MK_REP_COMB
#define MK_REP_COMB 1
#endif
#ifndef MK_REP_CVT
#define MK_REP_CVT 1
#endif
#ifndef MK_OFFMASK
#define MK_OFFMASK 0x7FF
#endif
#ifndef MK_PREMASK
#define MK_PREMASK 3
#endif
#define IN(k) (lo <= (k) && (k) < hi)
#define INL(o) (((MK_OFFMASK >> (o)) & 1) && IN(pb + (o)))
#define SEAM(k) do { if (IN(k) && IN((k) + 1)) xcd_barrier(barG); } while (0)
    float* MOD = (float*)(F.ws + WS_MOD);
    bf16* U = gU(F); bf16* Yb = gY(F); bf16* BIG = gBIG(F); float* GATES = gGATES(F); float* YC = gYC(F);

    if ((MK_PREMASK & 1) && IN(0)) { pre_mod(FA); pre_pe(FA); for (int rep_ = 0; rep_ < MK_REP_CVT; ++rep_) cvt_layer<0>(FA); }
    if (IN(0) && IN(1)) xcd_barrier(barA);
    if ((MK_PREMASK & 2) && IN(1)) {
        if (grp == 1) {
            for (int rep_ = 0; rep_ < MK_REP_CVT; ++rep_) cvt_layer<1>(F);
            xcd_barrier(barG);
            if (gi == 0 && threadIdx.x == 0) __hip_atomic_store(ctl + CW_W1READY, 1u, __ATOMIC_RELAXED, __HIP_MEMORY_SCOPE_AGENT);
        }
        nrm_rows<true, false, true>(F, 0, M, 0.f, nullptr, nullptr, 0, F.A.in[I_NORMG], MOD, 0, 1);
    }
    SEAM(1);
    for (int layer = 0; layer < 2; ++layer) {
        const int pb = 2 + 11 * layer; const bool last = layer == 1;
        const float* ng = F.A.in[I_NORMG] + (size_t)layer * 6 * D; const float* modl = MOD + (size_t)layer * 9 * 18432;
        const int NP = layer == 0 ? NP0 : NP1;
        const int rlo2 = last ? MC : 0;
        const unsigned char* W = F.ws + WS_W + (size_t)layer * W_LAYER;
        if (layer == 1 && IN(pb)) {
            if (threadIdx.x == 0) { unsigned sp = 0; while (__hip_atomic_load(ctl + CW_W1READY, __ATOMIC_RELAXED, __HIP_MEMORY_SCOPE_AGENT) == 0u) { __builtin_amdgcn_s_sleep(4); if (++sp > (1u << 22)) { atomicAdd(ctl + CW_BAR + XB_TMO, 1u); break; } }
                __builtin_amdgcn_fence(__ATOMIC_ACQUIRE, "agent"); asm volatile("s_waitcnt vmcnt(0)" ::: "memory"); }
            __syncthreads();
        }
        if (INL(0)) { pg8::Gemm g{U, (const bf16*)(W + W_F1I), M, 2 * DFF, D}; pg8::StaticOrder S; S.init(M, 2 * DFF, F.G, F.wg, D, 0, 4); pg8::EpiSwiglu E{BIG, DFF};
            for (int rep_ = 0; rep_ < MK_REP_GEMM; ++rep_) pg8::gemm_phase<pg8::EpiSwiglu, pg8::StaticOrder, PG8_ALIGN, PG8_SP2>(F.lds, g, S, E); }
        SEAM(pb + 0);
        if (INL(1)) {
            pg8::Gemm g{BIG, (const bf16*)(W + W_F1O), M, D, DFF}; pg8::MixedOrder S; S.init(MLAT, D, F.G, F.wg, DFF, MC / 256, MC, KSPLIT, 4);
            pg8::EpiY E{Yb, D, YC, (size_t)MC * D, DFF / 64};
            for (int rep_ = 0; rep_ < MK_REP_GEMM; ++rep_) pg8::gemm_phase<pg8::EpiY, pg8::MixedOrder, PG8_ALIGN, PG8_SP2>(F.lds, g, S, E);
        }
        SEAM(pb + 1);
        if (INL(2)) nrm_rows<false, true, true>(F, 0, M, 0.5f, ng + 1 * D, modl, 2, ng + 2 * D, modl, 3, 4);
        SEAM(pb + 2);
        if (INL(3)) { pg8::Gemm g{U, (const bf16*)(W + W_MI), M, NP, D}; pg8::StaticOrder S; S.init(M, NP, F.G, F.wg, D, 0, 4); pg8::EpiProj E{BIG, NP, GATES, NP / 256 - 1};
            for (int rep_ = 0; rep_ < MK_REP_GEMM; ++rep_) pg8::gemm_phase<pg8::EpiProj, pg8::StaticOrder, PG8_ALIGN, PG8_SP2>(F.lds, g, S, E); }
        SEAM(pb + 3);
        if (INL(4)) {
            if (layer == 0) {
                bf16* OFb = Yb; bf16* OBb = OFb + (size_t)M * 1024; bf16* HFb = OBb + (size_t)M * 1024; bf16* HBb = HFb + (size_t)M * 1024;
                for (int item = F.wg; item < 128 * MK_REP_SCAN; item += F.G) { const int it = item & 127;
                    if (it < 64) { const int ci = it >> 1, vh = it & 1, b = ci >> 3, h = (ci >> 1) & 3, dir = ci & 1;
                        chain_scan<0>(F.lds, BIG, NP0, h * 128, 512 + h * 128, 1024 + h * 256 + vh * 128, GATES, dir * 16, b, dir,
                                      dir ? OBb : OFb, 1024, h * 256 + vh * 128, true, F.A.in[I_WALPHA2] + (size_t)dir * 16 * 512 + h * 128, F.A.in[I_BALPHA] + dir * 512 + h * 128, 0.f, 0.f);
                    } else { const int ri = it - 64, b = ri >> 4, n = (ri >> 1) & 7, dir = ri & 1;
                        rg_chain(F.lds, BIG, b, n, dir, (const bf16*)(F.ws + WS_WRG), F.A.in[I_LAM], F.A.in[I_RGBA], F.A.in[I_RGBI], F.A.in[I_CONVW], F.A.in[I_CONVB], dir ? HBb : HFb);
                    }
                }
            } else {
                bf16* HFb = Yb; bf16* HBb = HFb + (size_t)M * D;
                for (int item = F.wg; item < 128 * MK_REP_SCAN; item += F.G) { const int it = item & 127; const int ci = it >> 1, vh = it & 1, b = ci >> 4, h = (ci >> 1) & 7, dir = ci & 1;
                    chain_scan<1>(F.lds, BIG, NP1, h * 128, 1024 + h * 128, 2048 + h * 256 + vh * 128, GATES, dir * 16 + h, b, dir,
                                  dir ? HBb : HFb, D, h * 256 + vh * 128, false, nullptr, nullptr, F.A.in[I_MLBG][dir * 16 + h], F.A.in[I_MLBG][dir * 16 + 8 + h]);
                }
            }
        }
        SEAM(pb + 4);
        if (INL(5)) { for (int rep_ = 0; rep_ < MK_REP_COMB; ++rep_) { if (layer == 0) comb0_rows(F, 0, M); else comb1_rows(F, MC, M); } }
        SEAM(pb + 5);
        if (INL(6)) {
            pg8::Gemm g{U, (const bf16*)(W + W_MO), M, D, D}; pg8::MixedOrder S; S.init(MLAT, D, F.G, F.wg, D, MC / 256, last ? 0 : MC, KSPLIT, 4);
            pg8::EpiY E{Yb, D, YC, (size_t)MC * D, D / 64};
            for (int rep_ = 0; rep_ < MK_REP_GEMM; ++rep_) pg8::gemm_phase<pg8::EpiY, pg8::MixedOrder, PG8_ALIGN, PG8_SP2>(F.lds, g, S, E);
        }
        SEAM(pb + 6);
        if (INL(7)) nrm_rows<false, true, true>(F, rlo2, M, 1.0f, ng + 3 * D, modl, 5, ng + 4 * D, modl, 6, 7);
        SEAM(pb + 7);
        if (INL(8)) { pg8::Gemm g{U + (size_t)rlo2 * D, (const bf16*)(W + W_F2I), M - rlo2, 2 * DFF, D}; pg8::StaticOrder S; S.init(M - rlo2, 2 * DFF, F.G, F.wg, D, 0, 4); pg8::EpiSwiglu E{BIG + (size_t)rlo2 * DFF, DFF};
            for (int rep_ = 0; rep_ < MK_REP_GEMM; ++rep_) pg8::gemm_phase<pg8::EpiSwiglu, pg8::StaticOrder, PG8_ALIGN, PG8_SP2>(F.lds, g, S, E); }
        SEAM(pb + 8);
        if (INL(9)) {
            pg8::Gemm g{BIG, (const bf16*)(W + W_F2O), M, D, DFF}; pg8::MixedOrder S; S.init(MLAT, D, F.G, F.wg, DFF, MC / 256, last ? 0 : MC, KSPLIT, 4);
            pg8::EpiY E{Yb, D, YC, (size_t)MC * D, DFF / 64};
            for (int rep_ = 0; rep_ < MK_REP_GEMM; ++rep_) pg8::gemm_phase<pg8::EpiY, pg8::MixedOrder, PG8_ALIGN, PG8_SP2>(F.lds, g, S, E);
        }
        SEAM(pb + 9);
        if (INL(10)) {
            if (!last) nrm_rows<false, true, true>(F, 0, M, 0.5f, ng + 5 * D, modl, 8, F.A.in[I_NORMG] + 6 * D, MOD + (size_t)9 * 18432, 0, 1);
            else nrm_rows<false, true, false>(F, MC, M, 0.5f, ng + 5 * D, modl, 8, nullptr, nullptr, 0, 0);
        }
        SEAM(pb + 10);
    }
#undef IN
#undef SEAM
}

extern "C" void kernel_launch(void* const* d_in, const int* in_sizes, int n_in, void* d_out, int out_size, void* d_ws, size_t ws_size, hipStream_t stream) {
    static int grid = 0;
    if (grid == 0) {
        if (n_in != 27 || out_size != NB * SEQ * D || ws_size < WS_END) { fprintf(stderr, "kernel_launch: unexpected problem (n_in %d, out %d, ws %zu; need ws >= %zu); nothing launched\n", n_in, out_size, ws_size, (size_t)WS_END); grid = -1; return; }
        int dev = 0, cus = 0, per_cu = 0;
        if (hipGetDevice(&dev) != hipSuccess || hipDeviceGetAttribute(&cus, hipDeviceAttributeMultiprocessorCount, dev) != hipSuccess) { fprintf(stderr, "kernel_launch: device query failed\n"); grid = -1; return; }
        if (hipFuncSetAttribute((const void*)mk_fwd, hipFuncAttributeMaxDynamicSharedMemorySize, LDS_BYTES) != hipSuccess) { fprintf(stderr, "kernel_launch: hipFuncSetAttribute failed\n"); grid = -1; return; }
        if (hipOccupancyMaxActiveBlocksPerMultiprocessor(&per_cu, (const void*)mk_fwd, NWAVES * 64, LDS_BYTES) != hipSuccess || per_cu < 1)
            fprintf(stderr, "kernel_launch: note: occupancy query reports %d workgroups per CU\n", per_cu);
        (void)hipGetLastError();
        grid = cus;
        if (grid % 8 != 0) { fprintf(stderr, "kernel_launch: %d CUs; this kernel splits the grid into two groups of whole XCD octets and needs a multiple of 16; nothing launched\n", cus); grid = -1; return; }
    }
    if (grid < 0) return;
    if (hipMemsetAsync((char*)d_ws + WS_CTL, 0, CTL_ZERO_BYTES, stream) != hipSuccess) { fprintf(stderr, "kernel_launch: memset failed\n"); return; }
    Args a{};
    for (int i = 0; i < 27; ++i) a.in[i] = (const float*)d_in[i];
    a.out = (float*)d_out; a.ws = (unsigned char*)d_ws;
    a.ph_lo = 0; a.ph_hi = MK_LAST_PHASE;
    hipLaunchKernelGGL(mk_fwd, dim3(grid), dim3(NWAVES * 64), LDS_BYTES, stream, a);
    const hipError_t le = hipPeekAtLastError();
    if (le != hipSuccess) fprintf(stderr, "kernel_launch: launch failed: %s\n", hipGetErrorName(le));
}
```

```cpp
#include <hip/hip_runtime.h>
#include <cstdio>
#include <cstdint>
__device__ __forceinline__ int fresh_tid() { int t = threadIdx.x; asm volatile("" : "+v"(t)); return t; }
namespace pg8 {
#define PG8_LAS __attribute__((address_space(3)))
typedef unsigned short bf16_t;
typedef short bf16x8 __attribute__((ext_vector_type(8)));
typedef float f32x4 __attribute__((ext_vector_type(4)));
typedef unsigned u32x4 __attribute__((ext_vector_type(4)));
constexpr int BM = 256, BK = 64, HALF = 128, HTB = HALF * BK * 2  , STAGE_BYTES = 8 * HTB, NXCD = 8, WGM = 8;

__host__ __device__ __forceinline__ int lds_byte(int r, int c) { const int st = (r >> 4) * 2 + (c >> 5), rr = r & 15, cc = c & 31, ob = rr * 64 + cc * 2; return st * 1024 + (ob ^ (((ob >> 9) & 1) << 5)); }
__host__ __device__ __forceinline__ void stage_rc(int b, int& R, int& C) { const int st = b / 1024, sb = b % 1024, swz = sb ^ (((sb >> 9) & 1) << 5); R = (st >> 1) * 16 + swz / 64; C = (st & 1) * 32 + (swz % 64) / 2; }
__host__ __device__ __forceinline__ int perm32(int rho) { const int n = rho >> 4, i = rho & 15; return 8 * (i >> 2) + 4 * n + (i & 3); }

struct Unit { int pm, pn, pk, koff, nt; };
struct Gemm { const bf16_t* A; const bf16_t* Bt; int M, N, K; };

struct StaticOrder {
    int nM, nN, nwg, G, c, nt, pm0, nx;
    __host__ __device__ void init(int M, int N, int G_, int c_, int K_ = 0, int pm0_ = 0, int nx_ = NXCD) { nM = M / BM; nN = N / BM; nwg = nM * nN; G = G_; c = c_; nt = K_ / BK; pm0 = pm0_; nx = nx_; }
    __host__ __device__ bool next(int i, Unit& u) const {
        const long L = (long)i * G + c; if (L >= nwg) return false;
        int wgid = (int)L; { const int q = nwg / nx, r = nwg % nx, xcd = wgid % nx, off = wgid / nx; wgid = (xcd < r ? xcd * (q + 1) : r * (q + 1) + (xcd - r) * q) + off; }
        const int nig = WGM * nN, gid = wgid / nig, fm = gid * WGM, gsz = (nM - fm) < WGM ? (nM - fm) : WGM;
        u.pm = pm0 + fm + ((wgid % nig) % gsz); u.pn = (wgid % nig) / gsz; u.pk = 0; u.koff = 0; u.nt = nt; return true;
    }
    __device__ __forceinline__ void a_ready(const Unit&) const {}
    __device__ __forceinline__ void done(const Unit&) const {}
};
struct MixedOrder : StaticOrder {
    int nMs, nS, nwgS, nts;
    __host__ __device__ void init(int M, int N, int G_, int c_, int K_, int pm0_, int Ms, int nS_, int nx_ = NXCD) { StaticOrder::init(M, N, G_, c_, K_, pm0_, nx_); nMs = Ms / BM; nS = nS_; nwgS = nMs * nN * nS; nts = K_ / BK / nS_; }
    __host__ __device__ bool next(int i, Unit& u) const {
        const long L = (long)i * G + c; if (L < nwg) return StaticOrder::next(i, u);
        const int l = (int)(L - nwg); if (l >= nwgS) return false;
        u.pk = l % nS; const int t = l / nS; u.pm = t % nMs; u.pn = t / nMs; u.koff = u.pk * nts * BK; u.nt = nts; return true;
    }
};

__device__ __forceinline__ unsigned cvt_pk_bf16(float lo, float hi) { unsigned r; asm volatile("v_cvt_pk_bf16_f32 %0, %1, %2" : "=v"(r) : "v"(lo), "v"(hi)); return r; }
__device__ __forceinline__ float silu_f(float x) { return x * __builtin_amdgcn_rcpf(1.0f + __expf(-x)); }

struct EpiF32 {
    static constexpr bool PERM = false, AFTER_DRAIN = false;
    float* C; int ldc;
    __device__ __forceinline__ void operator()(const f32x4 (&acc)[2][2][4][2], const Unit& u, int wr, int wc, int fr, int fq) const {
        const int row0 = u.pm * BM + wr * 64 + fr, col0 = u.pn * BM + wc * 32 + 4 * fq;
#pragma unroll
        for (int ai = 0; ai < 2; ++ai)
#pragma unroll
            for (int m = 0; m < 4; ++m) { float* rowp = C + (size_t)(row0 + ai * HALF + m * 16) * ldc + col0;
#pragma unroll
                for (int bj = 0; bj < 2; ++bj)
#pragma unroll
                    for (int n = 0; n < 2; ++n) *(f32x4*)(rowp + bj * HALF + n * 16) = acc[ai][bj][m][n]; }
    }
};
struct EpiY {
    static constexpr bool PERM = true, AFTER_DRAIN = false;
    bf16_t* O; int ldc; float* P; size_t split_stride; int nt_full;
    __device__ __forceinline__ void operator()(const f32x4 (&acc)[2][2][4][2], const Unit& u, int wr, int wc, int fr, int fq) const {
        const int row0 = u.pm * BM + wr * 64 + fr, col0 = u.pn * BM + wc * 32 + 8 * fq;
        if (u.nt == nt_full) {
#pragma unroll
            for (int ai = 0; ai < 2; ++ai)
#pragma unroll
                for (int m = 0; m < 4; ++m) { bf16_t* rowp = O + (size_t)(row0 + ai * HALF + m * 16) * ldc + col0;
#pragma unroll
                    for (int bj = 0; bj < 2; ++bj) { const f32x4 v0 = acc[ai][bj][m][0], v1 = acc[ai][bj][m][1];
                        u32x4 w; w.x = cvt_pk_bf16(v0[0], v0[1]); w.y = cvt_pk_bf16(v0[2], v0[3]); w.z = cvt_pk_bf16(v1[0], v1[1]); w.w = cvt_pk_bf16(v1[2], v1[3]);
                        *(u32x4*)(rowp + bj * HALF) = w; } }
        } else {
            float* Pb = P + (size_t)u.pk * split_stride;
#pragma unroll
            for (int ai = 0; ai < 2; ++ai)
#pragma unroll
                for (int m = 0; m < 4; ++m) { float* rowp = Pb + (size_t)(row0 + ai * HALF + m * 16) * ldc + col0;
#pragma unroll
                    for (int bj = 0; bj < 2; ++bj) { *(f32x4*)(rowp + bj * HALF) = acc[ai][bj][m][0]; *(f32x4*)(rowp + bj * HALF + 4) = acc[ai][bj][m][1]; } }
        }
    }
};
struct EpiSwiglu {
    static constexpr bool PERM = true, AFTER_DRAIN = false;
    bf16_t* O; int ldc;
    __device__ __forceinline__ void operator()(const f32x4 (&acc)[2][2][4][2], const Unit& u, int wr, int wc, int fr, int fq) const {
        const int row0 = u.pm * BM + wr * 64 + fr, col0 = u.pn * HALF + wc * 32 + 8 * fq;
#pragma unroll
        for (int ai = 0; ai < 2; ++ai)
#pragma unroll
            for (int m = 0; m < 4; ++m) { bf16_t* rowp = O + (size_t)(row0 + ai * HALF + m * 16) * ldc + col0;
                const f32x4 a0 = acc[ai][0][m][0], a1 = acc[ai][0][m][1], b0 = acc[ai][1][m][0], b1 = acc[ai][1][m][1];
                f32x4 v0, v1;
#pragma unroll
                for (int j = 0; j < 4; ++j) { v0[j] = silu_f(a0[j]) * b0[j]; v1[j] = silu_f(a1[j]) * b1[j]; }
                u32x4 w; w.x = cvt_pk_bf16(v0[0], v0[1]); w.y = cvt_pk_bf16(v0[2], v0[3]); w.z = cvt_pk_bf16(v1[0], v1[1]); w.w = cvt_pk_bf16(v1[2], v1[3]);
                *(u32x4*)rowp = w; }
    }
};
struct EpiProj {
    static constexpr bool PERM = true, AFTER_DRAIN = false;
    bf16_t* O; int ldc; float* gates; int gate_pn;
    __device__ __forceinline__ void operator()(const f32x4 (&acc)[2][2][4][2], const Unit& u, int wr, int wc, int fr, int fq) const {
        const int row0 = u.pm * BM + wr * 64 + fr, col0 = u.pn * BM + wc * 32 + 8 * fq;
#pragma unroll
        for (int ai = 0; ai < 2; ++ai)
#pragma unroll
            for (int m = 0; m < 4; ++m) { bf16_t* rowp = O + (size_t)(row0 + ai * HALF + m * 16) * ldc + col0;
#pragma unroll
                for (int bj = 0; bj < 2; ++bj) { const f32x4 v0 = acc[ai][bj][m][0], v1 = acc[ai][bj][m][1];
                    u32x4 w; w.x = cvt_pk_bf16(v0[0], v0[1]); w.y = cvt_pk_bf16(v0[2], v0[3]); w.z = cvt_pk_bf16(v1[0], v1[1]); w.w = cvt_pk_bf16(v1[2], v1[3]);
                    *(u32x4*)(rowp + bj * HALF) = w; } }
        if (u.pn == gate_pn && wc == 0) {
#pragma unroll
            for (int ai = 0; ai < 2; ++ai)
#pragma unroll
                for (int m = 0; m < 4; ++m) { float* gp = gates + (size_t)(row0 + ai * HALF + m * 16) * 32 + 8 * fq;
                    *(f32x4*)gp = acc[ai][0][m][0]; *(f32x4*)(gp + 4) = acc[ai][0][m][1]; }
        }
    }
};

template <class Epi, class Sched, bool ALIGN_EPI = false, bool SP2 = false>
__device__ __forceinline__ void gemm_phase(PG8_LAS unsigned char* lds, const Gemm g, const Sched& S, const Epi& E) {
    const int tid = fresh_tid(), wid = __builtin_amdgcn_readfirstlane(tid >> 6), lane = tid & 63, wr = wid >> 2, wc = wid & 3, fr = lane & 15, fq = lane >> 4;
    const int ld = g.K;
    unsigned voffA[2], voffB[2];
#pragma unroll
    for (int i = 0; i < 2; ++i) { int R, C; stage_rc(tid * 16 + i * 8192, R, C); const int Rb = Epi::PERM ? ((R & ~31) + perm32(R & 31)) : R;
        voffA[i] = (unsigned)(R * ld + C) * 2u; voffB[i] = (unsigned)(Rb * ld + C) * 2u; }
    const size_t kstep = (size_t)(BK * 2);
    const size_t hstep = (size_t)HALF * ld * 2;
    const size_t tstep = 2 * hstep;
    const unsigned ldsw = (unsigned)wid * 1024u;
    const int aoff = lds_byte(wr * 64 + fr, fq * 8), boff = lds_byte(wc * 32 + fr, fq * 8);
#define PG8_SA(b, h) (((b) * 2 + (h)) * HTB)
#define PG8_SB(b, h) ((4 + (b) * 2 + (h)) * HTB)
#define PG8_STAGE(bufoff, gbase, voff) do { _Pragma("unroll") for (int _i = 0; _i < 2; ++_i) \
        __builtin_amdgcn_global_load_lds((const unsigned*)((const char*)(gbase) + (voff)[_i]), (PG8_LAS unsigned*)(lds + (bufoff) + ldsw + _i * 8192), 16, 0, 0); } while (0)
#define PG8_LDA(dst, b, h) do { _Pragma("unroll") for (int m = 0; m < 4; ++m) _Pragma("unroll") for (int k = 0; k < 2; ++k) dst[m][k] = *(const PG8_LAS bf16x8*)(lds + PG8_SA(b, h) + aoff + m * 2048 + k * 1024); } while (0)
#define PG8_LDB(dst, b, h) do { _Pragma("unroll") for (int n = 0; n < 2; ++n) _Pragma("unroll") for (int k = 0; k < 2; ++k) dst[n][k] = *(const PG8_LAS bf16x8*)(lds + PG8_SB(b, h) + boff + n * 2048 + k * 1024); } while (0)
#define PG8_MMA(ai, bj, At, Bt) do { __builtin_amdgcn_s_setprio(1); _Pragma("unroll") for (int m = 0; m < 4; ++m) _Pragma("unroll") for (int n = 0; n < 2; ++n) _Pragma("unroll") for (int k = 0; k < 2; ++k) \
        acc[ai][bj][m][n] = __builtin_amdgcn_mfma_f32_16x16x32_bf16(Bt[n][k], At[m][k], acc[ai][bj][m][n], 0, 0, 0); __builtin_amdgcn_s_setprio(0); } while (0)
#define PG8_WAIT_V(n) asm volatile("s_waitcnt vmcnt(" #n ")" ::: "memory")
#define PG8_WAIT_L(n) asm volatile("s_waitcnt lgkmcnt(" #n ")" ::: "memory")
#define PG8_BAR __builtin_amdgcn_s_barrier()
#define PG8_SCHED __builtin_amdgcn_sched_barrier(0)
    Unit cur, nxt; int ui = 0;
    if (!S.next(0, cur)) return;
    int nt = cur.nt;
    f32x4 acc[2][2][4][2];
#pragma unroll
    for (int a = 0; a < 2; ++a)
#pragma unroll
        for (int b = 0; b < 2; ++b)
#pragma unroll
            for (int m = 0; m < 4; ++m)
#pragma unroll
                for (int n = 0; n < 2; ++n) acc[a][b][m][n] = (f32x4){0.f, 0.f, 0.f, 0.f};
    bf16x8 At[4][2], B0[2][2], B1[2][2];
    const char* cA = (const char*)g.A + (size_t)cur.pm * tstep + (size_t)cur.koff * 2; const char* cB = (const char*)g.Bt + (size_t)cur.pn * tstep + (size_t)cur.koff * 2;
    S.a_ready(cur);
    if constexpr (SP2) {
        PG8_STAGE(PG8_SB(0, 0), cB, voffB); PG8_STAGE(PG8_SB(0, 1), cB + hstep, voffB); PG8_STAGE(PG8_SA(0, 0), cA, voffA); PG8_STAGE(PG8_SA(0, 1), cA + hstep, voffA);
        if (wr == 1) PG8_BAR;
        PG8_WAIT_V(2); PG8_BAR;
        PG8_STAGE(PG8_SB(1, 0), cB + kstep, voffB); PG8_STAGE(PG8_SA(1, 0), cA + kstep, voffA); PG8_STAGE(PG8_SB(1, 1), cB + hstep + kstep, voffB);
        PG8_WAIT_V(6); PG8_BAR;
    } else {
        PG8_STAGE(PG8_SB(0, 0), cB, voffB); PG8_STAGE(PG8_SA(0, 0), cA, voffA); PG8_STAGE(PG8_SB(0, 1), cB + hstep, voffB); PG8_STAGE(PG8_SA(0, 1), cA + hstep, voffA);
        if (wr == 1) PG8_BAR;
        PG8_WAIT_V(4); PG8_BAR;
        PG8_STAGE(PG8_SB(1, 0), cB + kstep, voffB); PG8_STAGE(PG8_SA(1, 0), cA + kstep, voffA); PG8_STAGE(PG8_SB(1, 1), cB + hstep + kstep, voffB);
        PG8_WAIT_V(6); PG8_BAR;
    }
    for (;;) {
        const bool has_next = S.next(ui + 1, nxt);
        const char* nA = has_next ? (const char*)g.A + (size_t)nxt.pm * tstep + (size_t)nxt.koff * 2 : cA; const char* nB = has_next ? (const char*)g.Bt + (size_t)nxt.pn * tstep + (size_t)nxt.koff * 2 : cB;
        for (int t = 0; t < nt; t += 2) {
            const bool last = (t == nt - 2);
            const char* a1 = cA + (size_t)(t + 1) * kstep;
            const char* a2 = last ? nA : cA + (size_t)(t + 2) * kstep; const char* b2 = last ? nB : cB + (size_t)(t + 2) * kstep;
            const char* a3 = a2 + kstep; const char* b3 = b2 + kstep;
            if (last && has_next) S.a_ready(nxt);
            if constexpr (SP2) {
            PG8_LDB(B0, 0, 0); PG8_LDB(B1, 0, 1); PG8_SCHED; PG8_LDA(At, 0, 0); PG8_STAGE(PG8_SA(1, 1), a1 + hstep, voffA);
            PG8_WAIT_V(8); PG8_WAIT_L(0); PG8_BAR; PG8_MMA(0, 0, At, B0); PG8_MMA(0, 1, At, B1); PG8_BAR; PG8_SCHED;
            PG8_LDA(At, 0, 1); PG8_STAGE(PG8_SB(0, 0), b2, voffB); PG8_STAGE(PG8_SB(0, 1), b2 + hstep, voffB); PG8_STAGE(PG8_SA(0, 0), a2, voffA);
            PG8_WAIT_V(8); PG8_WAIT_L(0); PG8_BAR; PG8_MMA(1, 0, At, B0); PG8_MMA(1, 1, At, B1); PG8_BAR; PG8_SCHED;
            PG8_LDB(B0, 1, 0); PG8_LDB(B1, 1, 1); PG8_SCHED; PG8_LDA(At, 1, 0); PG8_STAGE(PG8_SA(0, 1), a2 + hstep, voffA);
            PG8_WAIT_V(8); PG8_WAIT_L(0); PG8_BAR; PG8_MMA(0, 0, At, B0); PG8_MMA(0, 1, At, B1); PG8_BAR; PG8_SCHED;
            PG8_LDA(At, 1, 1); PG8_STAGE(PG8_SB(1, 0), b3, voffB); PG8_STAGE(PG8_SB(1, 1), b3 + hstep, voffB); PG8_STAGE(PG8_SA(1, 0), a3, voffA);
            PG8_WAIT_V(8); PG8_WAIT_L(0); PG8_BAR; PG8_MMA(1, 0, At, B0); PG8_MMA(1, 1, At, B1); PG8_BAR; PG8_SCHED;
            } else {
            PG8_LDB(B0, 0, 0); PG8_SCHED; PG8_LDA(At, 0, 0); PG8_STAGE(PG8_SA(1, 1), a1 + hstep, voffA);
            PG8_WAIT_L(8); PG8_BAR; PG8_WAIT_L(0); PG8_MMA(0, 0, At, B0); PG8_BAR; PG8_SCHED;
            PG8_LDB(B1, 0, 1); PG8_STAGE(PG8_SB(0, 0), b2, voffB);
            PG8_BAR; PG8_WAIT_L(0); PG8_MMA(0, 1, At, B1); PG8_BAR;
            PG8_LDA(At, 0, 1); PG8_STAGE(PG8_SA(0, 0), a2, voffA);
            PG8_BAR; PG8_WAIT_L(0); PG8_MMA(1, 0, At, B0); PG8_BAR; PG8_SCHED;
            PG8_STAGE(PG8_SB(0, 1), b2 + hstep, voffB);
            PG8_WAIT_V(6); PG8_BAR; PG8_MMA(1, 1, At, B1); PG8_BAR;
            PG8_LDB(B0, 1, 0); PG8_SCHED; PG8_LDA(At, 1, 0); PG8_STAGE(PG8_SA(0, 1), a2 + hstep, voffA);
            PG8_WAIT_L(8); PG8_BAR; PG8_WAIT_L(0); PG8_MMA(0, 0, At, B0); PG8_BAR; PG8_SCHED;
            PG8_LDB(B1, 1, 1); PG8_STAGE(PG8_SB(1, 0), b3, voffB);
            PG8_BAR; PG8_WAIT_L(0); PG8_MMA(0, 1, At, B1); PG8_BAR;
            PG8_LDA(At, 1, 1); PG8_STAGE(PG8_SA(1, 0), a3, voffA);
            PG8_BAR; PG8_WAIT_L(0); PG8_MMA(1, 0, At, B0); PG8_BAR; PG8_SCHED;
            PG8_STAGE(PG8_SB(1, 1), b3 + hstep, voffB);
            PG8_WAIT_V(6); PG8_BAR; PG8_MMA(1, 1, At, B1); PG8_BAR;
            }
        }
        if constexpr (ALIGN_EPI) { if (wr == 0) PG8_BAR; }
        if constexpr (!Epi::AFTER_DRAIN) { E(acc, cur, wr, wc, fr, fq); S.done(cur); }
        if (!has_next) break;
#pragma unroll
        for (int a = 0; a < 2; ++a)
#pragma unroll
            for (int b = 0; b < 2; ++b)
#pragma unroll
                for (int m = 0; m < 4; ++m)
#pragma unroll
                    for (int n = 0; n < 2; ++n) acc[a][b][m][n] = (f32x4){0.f, 0.f, 0.f, 0.f};
        cur = nxt; cA = nA; cB = nB; ++ui; nt = cur.nt;
        if constexpr (ALIGN_EPI) { if (wr == 1) PG8_BAR; }
    }
    PG8_WAIT_V(0);
    if constexpr (!ALIGN_EPI) { if (wr == 0) PG8_BAR; }
    PG8_BAR;
    if constexpr (Epi::AFTER_DRAIN) { E.fused(acc, cur, wr, wc, fr, fq, lds, wid, lane); S.done(cur); }
#undef PG8_SA
#undef PG8_SB
#undef PG8_STAGE
#undef PG8_LDA
#undef PG8_LDB
#undef PG8_MMA
#undef PG8_WAIT_V
#undef PG8_WAIT_L
#undef PG8_BAR
#undef PG8_SCHED
}
}

#ifndef PG8_SP2
#define PG8_SP2 true
#endif
#ifndef PG8_ALIGN
#define PG8_ALIGN true
#endif

constexpr int NWAVES = 8;
constexpr int D = 2048, NB = 8, SEQ = 4096, CTXL = 256, DFF = 5632, NMOD = 9;
constexpr int NGRP = 2, NBG = NB / NGRP;
constexpr int MC = NBG * CTXL;
constexpr int MLAT = NBG * SEQ;
constexpr int M = MC + MLAT;
constexpr int NP0 = 5376, NP1 = 6400;
constexpr int NCH = (CTXL + SEQ) / 64;
constexpr int KSPLIT = 4;
constexpr float EPS = 1e-6f;
constexpr float QSCALE = 0.08838834764831845f;

constexpr size_t MiB = 1u << 20;
constexpr size_t WS_CTL = 0, CTL_ZERO_BYTES = 1 * MiB;
constexpr size_t WS_MOD = 1 * MiB;
constexpr size_t WS_GATES = 3 * MiB, GATES_G = (size_t)M * 32 * 4;
constexpr size_t WS_WRG = 8 * MiB;
constexpr size_t WS_PE = 9 * MiB;
constexpr size_t WS_HCTX = 10 * MiB;
constexpr size_t WS_W = 26 * MiB, W_LAYER = 165 * MiB;
constexpr size_t W_F1I = 0, W_F1O = W_F1I + 44 * MiB, W_F2I = W_F1O + 22 * MiB, W_F2O = W_F2I + 44 * MiB, W_MI = W_F2O + 22 * MiB, W_MO = W_MI + 25 * MiB;
constexpr size_t WS_U = 356 * MiB, U_G = (size_t)M * D * 2;
constexpr size_t WS_Y = 492 * MiB, Y_G = (size_t)M * D * 4;
constexpr size_t WS_BIG = 764 * MiB, BIG_G = (size_t)M * NP1 * 2;
constexpr size_t YC_OFF = (size_t)M * D * 2;
constexpr size_t WS_END = 1189 * MiB;
static_assert(W_MO + 8 * MiB <= W_LAYER && WS_W + 2 * W_LAYER <= WS_U && WS_U + NGRP * U_G <= WS_Y && WS_Y + NGRP * Y_G <= WS_BIG && WS_BIG + NGRP * BIG_G <= WS_END, "ws map");
static_assert(YC_OFF + (size_t)KSPLIT * MC * D * 4 <= Y_G && WS_GATES + NGRP * GATES_G <= WS_WRG, "ws map (group blocks)");
constexpr int CW_BAR = 4096;
constexpr int CW_W1READY = 64;

constexpr int SCR_BYTES = 151552;
constexpr int LDSCTL_OFF = SCR_BYTES;
constexpr int LDS_BYTES = 155648;

#define GAS __attribute__((address_space(1)))
#define LAS __attribute__((address_space(3)))
typedef unsigned short bf16;
typedef float f32x4 __attribute__((ext_vector_type(4)));
typedef float f32x2 __attribute__((ext_vector_type(2)));
typedef short bf16x8 __attribute__((ext_vector_type(8)));
typedef short bf16x4 __attribute__((ext_vector_type(4)));
typedef unsigned u32x4 __attribute__((ext_vector_type(4)));
typedef unsigned u32x2 __attribute__((ext_vector_type(2)));
#define LDS_WAIT() asm volatile("s_waitcnt lgkmcnt(0)" ::: "memory")
__device__ __forceinline__ unsigned f2bf(float f) { unsigned u = __builtin_bit_cast(unsigned, f); return (u + 0x7fffu + ((u >> 16) & 1u)) >> 16; }
__device__ __forceinline__ unsigned pk2(float lo, float hi) { return pg8::cvt_pk_bf16(lo, hi); }
__device__ __forceinline__ float bflo(unsigned w) { return __uint_as_float(w << 16); }
__device__ __forceinline__ float bfhi(unsigned w) { return __uint_as_float(w & 0xffff0000u); }
__device__ __forceinline__ float wave_sum(float v) {
#pragma unroll
    for (int o = 1; o < 64; o <<= 1) v += __shfl_xor(v, o);
    return v;
}
__device__ __forceinline__ float sigmoid_f(float x) { return __builtin_amdgcn_rcpf(1.0f + __expf(-x)); }
__device__ __forceinline__ float silu_f(float x) { return x * sigmoid_f(x); }
__device__ __forceinline__ float logsig_f(float z) { return fminf(z, 0.f) - __logf(1.0f + __expf(-fabsf(z))); }
__device__ __forceinline__ float gelu_tanh_f(float x) { const float u = 0.7978845608028654f * (x + 0.044715f * x * x * x); const float t = 1.0f - 2.0f * __builtin_amdgcn_rcpf(1.0f + __expf(2.0f * u)); return 0.5f * x * (1.0f + t); }

#define XB_TMO      128
#define XB_XCNT(j)  (256  + 64 * (j))
#define XB_XSUB(j)  (1280 + 64 * (j))
#define XB_XGEN(j)  (2304 + 64 * (j))
#define XB_TOP      3328
#define XB_TOPGEN   3392
#define XCD_BAR_WORDS 3456
#define XB_SPIN_CAP (1u << 18)

__device__ __forceinline__ unsigned xb_ld(unsigned* p)              { return __hip_atomic_load(p, __ATOMIC_RELAXED, __HIP_MEMORY_SCOPE_AGENT); }
__device__ __forceinline__ unsigned xb_add(unsigned* p, unsigned v) { return __hip_atomic_fetch_add(p, v, __ATOMIC_RELAXED, __HIP_MEMORY_SCOPE_AGENT); }
__device__ __forceinline__ unsigned xb_xcc_id() { return (unsigned)__builtin_amdgcn_s_getreg((3 << 11) | 20) & 0xFu; }
#define XB_SPIN(cond, bar) do { unsigned _sp = 0; while (cond) { __builtin_amdgcn_s_sleep(1); \
    if ((++_sp & 255u) == 0u) { if (xb_ld(&(bar)[XB_TMO])) break; if (_sp > XB_SPIN_CAP) { atomicAdd(&(bar)[XB_TMO], 1u); break; } } } } while (0)

struct XcdBarrier {
    unsigned* bar; unsigned x; unsigned ntot;
    volatile LAS unsigned* st;
};

__device__ __forceinline__ XcdBarrier xcd_barrier_post(unsigned* bar, volatile LAS unsigned* st, unsigned ntot) {
    XcdBarrier b; b.bar = bar; b.x = xb_xcc_id(); b.st = st; b.ntot = ntot;
    if (threadIdx.x == 0) (void)xb_add(&bar[XB_XCNT(b.x)], 1u);
    return b;
}
__device__ __forceinline__ void xcd_barrier_complete(unsigned* bar, unsigned x, unsigned G, unsigned& nloc, unsigned& nx) {
    unsigned sum, cnt, mine, sp = 0u;
    for (;;) {
        sum = 0u; cnt = 0u; mine = 0u;
#pragma unroll
        for (unsigned j = 0; j < 16; ++j) { const unsigned c = xb_ld(&bar[XB_XCNT(j)]); sum += c; cnt += (c > 0u) ? 1u : 0u; mine = (j == x) ? c : mine; }
        if (sum == G) break;
        __builtin_amdgcn_s_sleep(1);
        if ((++sp & 255u) == 0u) { if (xb_ld(&bar[XB_TMO])) break; if (sp > XB_SPIN_CAP) { atomicAdd(&bar[XB_TMO], 1u); break; } }
    }
    nloc = mine > 0u ? mine : 1u; nx = cnt > 0u ? cnt : 1u;
}

__device__ __forceinline__ void xcd_barrier(const XcdBarrier& b) {
    asm volatile("s_waitcnt vmcnt(0)" ::: "memory");
    __syncthreads();
    if (threadIdx.x == 0) {
        unsigned* bar = b.bar;
        __builtin_amdgcn_s_waitcnt(0);
        unsigned nloc = b.st[0], nx = b.st[1];
        if (nloc == 0u) { xcd_barrier_complete(bar, b.x, b.ntot, nloc, nx); b.st[0] = nloc; b.st[1] = nx; }
        const unsigned old = xb_add(&bar[XB_XSUB(b.x)], 1u);
        const unsigned gen = old / nloc;
        if (old + 1u == (gen + 1u) * nloc) {
            __builtin_amdgcn_fence(__ATOMIC_RELEASE, "agent");
            asm volatile("s_waitcnt vmcnt(0)" ::: "memory");
            const unsigned og = xb_add(&bar[XB_TOP], 1u);
            const unsigned tg = og / nx;
            if (og + 1u == (tg + 1u) * nx) xb_add(&bar[XB_TOPGEN], 1u);
            else XB_SPIN(xb_ld(&bar[XB_TOPGEN]) == tg, bar);
            __builtin_amdgcn_fence(__ATOMIC_ACQUIRE, "agent");
            xb_add(&bar[XB_XGEN(b.x)], 1u);
            asm volatile("s_waitcnt vmcnt(0)" ::: "memory");
        } else {
            XB_SPIN(xb_ld(&bar[XB_XGEN(b.x)]) == gen, bar);
            __builtin_amdgcn_fence(__ATOMIC_ACQUIRE, "agent");
            asm volatile("s_waitcnt vmcnt(0)" ::: "memory");
        }
    }
    __syncthreads();
}

struct Args { const float* in[27]; float* out; unsigned char* ws; int ph_lo, ph_hi; };
struct Frame {
    LAS unsigned char* lds;
    int G, wg, NGW;
    int grp;
    float* out; unsigned char* ws;
    const Args& A;
};
__device__ __forceinline__ bf16* gU(const Frame& F) { return (bf16*)(F.ws + WS_U + (size_t)F.grp * U_G); }
__device__ __forceinline__ bf16* gY(const Frame& F) { return (bf16*)(F.ws + WS_Y + (size_t)F.grp * Y_G); }
__device__ __forceinline__ bf16* gBIG(const Frame& F) { return (bf16*)(F.ws + WS_BIG + (size_t)F.grp * BIG_G); }
__device__ __forceinline__ float* gYC(const Frame& F) { return (float*)(F.ws + WS_Y + (size_t)F.grp * Y_G + YC_OFF); }
__device__ __forceinline__ float* gGATES(const Frame& F) { return (float*)(F.ws + WS_GATES + (size_t)F.grp * GATES_G); }
enum { I_X = 0, I_C, I_CTX, I_CCTX, I_WMOD, I_BMOD, I_NORMG, I_F1WI, I_F1WO, I_F2WI, I_F2WO, I_ABWI, I_WALPHA2, I_BALPHA, I_GLANG, I_CONVW, I_CONVB, I_RGWA, I_RGBA, I_RGWI, I_RGBI, I_LAM, I_ABWO, I_MLWI, I_MLBG, I_MLNG, I_MLWO };

__device__ __forceinline__ void pre_mod(Frame& F) {
    const int tid_ = fresh_tid(); const int lane_ = tid_ & 63, wave_ = __builtin_amdgcn_readfirstlane(tid_ >> 6), gw_ = F.wg * NWAVES + wave_; (void)lane_; (void)gw_;
    LAS float* sc = (LAS float*)F.lds;
    LAS float* red = (LAS float*)(F.lds + 9 * 2048 * 4);
    for (int i = tid_; i < 9 * 2048; i += 512) { const int bb = i >> 11, k = i & 2047; const float v = bb < 8 ? F.A.in[I_C][bb * 2048 + k] : F.A.in[I_CCTX][k]; sc[i] = v * (1.0f / (1.0f + expf(-v))); }
    __syncthreads();
    float* MOD = (float*)(F.ws + WS_MOD);
    const int q = tid_ & 15, kg = tid_ >> 4;
    for (int item = F.wg; item < 2 * 288; item += F.G) {
        const int layer = item / 288, col0 = (item % 288) * 64;
        const float* wp = F.A.in[I_WMOD] + ((size_t)layer * 2048 + (size_t)kg * 64) * 18432 + col0 + 4 * q;
        f32x4 acc[9];
#pragma unroll
        for (int bb = 0; bb < 9; ++bb) acc[bb] = (f32x4){0.f, 0.f, 0.f, 0.f};
#pragma unroll 4
        for (int kk = 0; kk < 64; ++kk) {
            const f32x4 w = *(const f32x4*)(wp + (size_t)kk * 18432);
#pragma unroll
            for (int bb = 0; bb < 9; ++bb) acc[bb] += w * sc[bb * 2048 + kg * 64 + kk];
        }
#pragma unroll
        for (int bb = 0; bb < 9; ++bb)
#pragma unroll
            for (int e = 0; e < 4; ++e) { float v = acc[bb][e]; v += __shfl_xor(v, 16); v += __shfl_xor(v, 32); acc[bb][e] = v; }
        __syncthreads();
        if (lane_ < 16) {
#pragma unroll
            for (int bb = 0; bb < 9; ++bb) *(LAS f32x4*)(red + (wave_ * 9 + bb) * 64 + 4 * q) = acc[bb];
        }
        __syncthreads();
        for (int t = tid_; t < 9 * 64; t += 512) { const int bb = t >> 6, ci = t & 63; float s = F.A.in[I_BMOD][layer * 18432 + col0 + ci];
#pragma unroll
            for (int w = 0; w < 8; ++w) s += red[(w * 9 + bb) * 64 + ci];
            MOD[((size_t)layer * 9 + bb) * 18432 + col0 + ci] = s; }
    }
    __syncthreads();
}
__device__ __forceinline__ void pre_pe(Frame& F) {
    const int tid_ = fresh_tid(); const int lane_ = tid_ & 63, wave_ = __builtin_amdgcn_readfirstlane(tid_ >> 6), gw_ = F.wg * NWAVES + wave_; (void)lane_; (void)gw_;
    float* PE = (float*)(F.ws + WS_PE);
    for (int i = F.wg * 512 + tid_; i < 64 * 512; i += F.G * 512) {
        const int p = i >> 9, f = i & 511;
        const float om = (float)exp2(-(double)f * (13.287712379549449 / 512.0));
        const float angf = (float)p * om; const double x = (double)angf;
        const double kf = rint(x * 0.6366197723675814);
        double r = fma(-kf, 1.5707963267948966, x); r = fma(-kf, 6.123233995736766e-17, r);
        const int k = ((int)kf) & 3; const double r2 = r * r;
        const double sp = r * (1.0 + r2 * (-1.0 / 6.0 + r2 * (1.0 / 120.0 + r2 * (-1.0 / 5040.0 + r2 * (1.0 / 362880.0 + r2 * (-1.0 / 39916800.0 + r2 * (1.0 / 6227020800.0)))))));
        const double cp = 1.0 + r2 * (-0.5 + r2 * (1.0 / 24.0 + r2 * (-1.0 / 720.0 + r2 * (1.0 / 40320.0 + r2 * (-1.0 / 3628800.0 + r2 * (1.0 / 479001600.0))))));
        const double s = (k == 0) ? sp : (k == 1) ? cp : (k == 2) ? -sp : -cp;
        const double c = (k == 0) ? cp : (k == 1) ? -sp : (k == 2) ? -cp : sp;
        PE[p * 1024 + f] = (float)s; PE[p * 1024 + 512 + f] = (float)c;
    }
}
template <int MAP> __device__ __forceinline__ int cvt_row(int n) {
    if (MAP == 1) return n < DFF ? ((n >> 7) << 8) + (n & 127) : (((n - DFF) >> 7) << 8) + 128 + ((n - DFF) & 127);
    if (MAP == 2) return n < 3072 ? n : (n < 3104 ? n + 2048 : n - 32);
    return n;
}
template <int MAP> __device__ __forceinline__ void cvt_item(const float* W, int K, int N, bf16* WT, LAS float* scr, int item, int lane) {
    const int nblk = N / 32, kb = item / nblk, nb = item % nblk, k0 = 64 * kb, n0 = 32 * nb;
#pragma unroll 8
    for (int i = 0; i < 32; ++i) { const int kk = 2 * i + (lane >> 5); scr[kk * 33 + (lane & 31)] = W[(size_t)(k0 + kk) * N + n0 + (lane & 31)]; }
    LDS_WAIT(); asm volatile("" ::: "memory");
    const int c = lane & 7;
#pragma unroll
    for (int j = 0; j < 4; ++j) { const int n = (lane >> 3) + 8 * j; const LAS float* s = scr + (8 * c) * 33 + n;
        u32x4 o; o.x = pk2(s[0 * 33], s[1 * 33]); o.y = pk2(s[2 * 33], s[3 * 33]); o.z = pk2(s[4 * 33], s[5 * 33]); o.w = pk2(s[6 * 33], s[7 * 33]);
        *(u32x4*)(WT + (size_t)cvt_row<MAP>(n0 + n) * K + k0 + 8 * c) = o; }
    LDS_WAIT(); asm volatile("" ::: "memory");
}
template <int LAYER> __device__ __forceinline__ void cvt_layer(Frame& F, int pct_lo = 0, int pct_hi = 100) {
    const int tid_ = fresh_tid(); const int lane_ = tid_ & 63, wave_ = __builtin_amdgcn_readfirstlane(tid_ >> 6), gw_ = F.wg * NWAVES + wave_; (void)lane_; (void)gw_;
    LAS float* scr = (LAS float*)(F.lds + wave_ * 16384);
    constexpr int I0 = 32 * 352, I1 = 88 * 64, I4 = LAYER == 0 ? 32 * 161 : 32 * 193, I5 = 32 * 64, I6 = LAYER == 0 ? 256 : 0;
    constexpr int NITEMS = 2 * I0 + 2 * I1 + I4 + I5 + I6;
    const float* f1i = F.A.in[I_F1WI] + (size_t)LAYER * D * 2 * DFF; const float* f1o = F.A.in[I_F1WO] + (size_t)LAYER * DFF * D;
    const float* f2i = F.A.in[I_F2WI] + (size_t)LAYER * D * 2 * DFF; const float* f2o = F.A.in[I_F2WO] + (size_t)LAYER * DFF * D;
    const int it_lo = (int)((long)NITEMS * pct_lo / 100), it_hi = (int)((long)NITEMS * pct_hi / 100);
    for (int it = it_lo + gw_; it < it_hi; it += F.NGW) {
        int r = it;
        if (r < I0) { cvt_item<1>(f1i, D, 2 * DFF, (bf16*)(F.ws + WS_W + LAYER * W_LAYER + W_F1I), scr, r, lane_); continue; } r -= I0;
        if (r < I1) { cvt_item<0>(f1o, DFF, D, (bf16*)(F.ws + WS_W + LAYER * W_LAYER + W_F1O), scr, r, lane_); continue; } r -= I1;
        if (r < I0) { cvt_item<1>(f2i, D, 2 * DFF, (bf16*)(F.ws + WS_W + LAYER * W_LAYER + W_F2I), scr, r, lane_); continue; } r -= I0;
        if (r < I1) { cvt_item<0>(f2o, DFF, D, (bf16*)(F.ws + WS_W + LAYER * W_LAYER + W_F2O), scr, r, lane_); continue; } r -= I1;
        if (r < I4) { if (LAYER == 0) cvt_item<2>(F.A.in[I_ABWI], D, 5152, (bf16*)(F.ws + WS_W + LAYER * W_LAYER + W_MI), scr, r, lane_); else cvt_item<0>(F.A.in[I_MLWI], D, 6176, (bf16*)(F.ws + WS_W + LAYER * W_LAYER + W_MI), scr, r, lane_); continue; } r -= I4;
        if (r < I5) { cvt_item<0>(LAYER == 0 ? F.A.in[I_ABWO] : F.A.in[I_MLWO], D, D, (bf16*)(F.ws + WS_W + LAYER * W_LAYER + W_MO), scr, r, lane_); continue; } r -= I5;
        if (LAYER == 0) { const int mi = r >> 3, sub = r & 7, dir = mi >> 4, mat = (mi >> 3) & 1, n = mi & 7;
            const float* src = (mat ? F.A.in[I_RGWI] : F.A.in[I_RGWA]) + (size_t)(dir * 8 + n) * 128 * 128;
            cvt_item<0>(src, 128, 128, (bf16*)(F.ws + WS_WRG) + (size_t)mi * 128 * 128, scr, sub, lane_); }
    }
    constexpr int PR0 = LAYER == 0 ? 5152 : 6176, PR1 = LAYER == 0 ? NP0 : NP1;
    u32x4* z = (u32x4*)((bf16*)(F.ws + WS_W + LAYER * W_LAYER + W_MI) + (size_t)PR0 * D);
    if (pct_hi == 100) for (int i = F.wg * 512 + tid_; i < (PR1 - PR0) * D / 8; i += F.G * 512) z[i] = (u32x4){0u, 0u, 0u, 0u};
}

__device__ __forceinline__ float* hrow(Frame& F, int r) { return r < MC ? (float*)(F.ws + WS_HCTX) + (size_t)(r + F.grp * MC) * D : F.out + (size_t)((r - MC) + F.grp * MLAT) * D; }
template <bool INIT, bool HAS_Y, bool HAS_U>
__device__ __forceinline__ void nrm_rows(Frame& F, int row_lo, int row_hi, float wgt, const float* gpost, const float* mod_g, int gate_slot,
                                         const float* gpre, const float* mod_u, int shift_slot, int scale_slot) {
    const int tid_ = fresh_tid(); const int lane_ = tid_ & 63, wave_ = __builtin_amdgcn_readfirstlane(tid_ >> 6);
    constexpr int R = 8;
    const bf16* Yb = gY(F); bf16* U = gU(F); const float* PE = (const float*)(F.ws + WS_PE);
    LAS float* PS = (LAS float*)F.lds;
    const int col = 256 * wave_ + 4 * lane_;
    const int nblk = (row_hi - row_lo) / R;
    int cur_bb = -1;
    f32x4 gp = (f32x4){0.f, 0.f, 0.f, 0.f}, gt = gp, gn = gp, sh = gp, sc = gp;
    if (HAS_Y) gp = *(const f32x4*)(gpost + col);
    if (HAS_U) gn = *(const f32x4*)(gpre + col);
    __syncthreads();
    f32x4 hn[R]; u32x2 yn[R];
#define NRM_LOAD(blk_) do { const int r0_ = row_lo + (blk_) * R; \
        _Pragma("unroll") for (int i = 0; i < R; ++i) { const int r = r0_ + i; \
            if (INIT) hn[i] = r < MC ? *(const f32x4*)(F.A.in[I_CTX] + (size_t)(r + F.grp * MC) * D + col) : *(const f32x4*)(F.A.in[I_X] + (size_t)((r - MC) + F.grp * MLAT) * D + col); \
            else hn[i] = *(const f32x4*)(hrow(F, r) + col); \
            if (HAS_Y) { if (r0_ >= MC) yn[i] = *(const u32x2*)(Yb + (size_t)r * D + col); } } } while (0)
    int blk = F.wg;
    if (blk < nblk) NRM_LOAD(blk);
    for (; blk < nblk; blk += F.G) {
        const int r0 = row_lo + blk * R;
        const int bb = r0 < MC ? 8 : F.grp * NBG + ((r0 - MC) >> 12);
        if (bb != cur_bb) { cur_bb = bb;
            if (HAS_Y) gt = *(const f32x4*)(mod_g + ((size_t)bb * 9 + gate_slot) * D + col);
            if (HAS_U) { sh = *(const f32x4*)(mod_u + ((size_t)bb * 9 + shift_slot) * D + col); sc = *(const f32x4*)(mod_u + ((size_t)bb * 9 + scale_slot) * D + col) + 1.0f; } }
        f32x4 hv[R]; u32x2 yr[R];
#pragma unroll
        for (int i = 0; i < R; ++i) { hv[i] = hn[i]; yr[i] = yn[i]; }
        if (blk + F.G < nblk) NRM_LOAD(blk + F.G);
        if (INIT) { if (r0 >= MC) {
#pragma unroll
            for (int i = 0; i < R; ++i) { const int t = (r0 + i - MC) & (SEQ - 1), prow = t >> 6, pcol = t & 63;
                hv[i] = hv[i] + (col < 1024 ? *(const f32x4*)(PE + prow * 1024 + col) : *(const f32x4*)(PE + pcol * 1024 + col - 1024)); } } }
        if (HAS_Y) {
            f32x4 yv[R];
#pragma unroll
            for (int i = 0; i < R; ++i) {
                if (r0 < MC) { const float* yc = gYC(F) + (size_t)(r0 + i) * D + col;
                    f32x4 s = *(const f32x4*)yc;
#pragma unroll
                    for (int k = 1; k < KSPLIT; ++k) s = s + *(const f32x4*)(yc + (size_t)k * MC * D);
                    yv[i] = s; }
                else yv[i] = (f32x4){bflo(yr[i].x), bfhi(yr[i].x), bflo(yr[i].y), bfhi(yr[i].y)}; }
#pragma unroll
            for (int i = 0; i < R; ++i) { const float ss = wave_sum((yv[i].x * yv[i].x + yv[i].y * yv[i].y) + (yv[i].z * yv[i].z + yv[i].w * yv[i].w)); if (lane_ == 0) PS[i * 8 + wave_] = ss; }
            asm volatile("s_waitcnt lgkmcnt(0)" ::: "memory"); __builtin_amdgcn_s_barrier(); asm volatile("" ::: "memory");
#pragma unroll
            for (int i = 0; i < R; ++i) { const f32x4 p0 = *(const LAS f32x4*)(PS + i * 8), p1 = *(const LAS f32x4*)(PS + i * 8 + 4);
                const float tot = ((p0.x + p0.y) + (p0.z + p0.w)) + ((p1.x + p1.y) + (p1.z + p1.w));
                const float r1 = rsqrtf(tot * (1.0f / D) + EPS) * wgt;
                hv[i] = hv[i] + gt * (yv[i] * r1 * gp); }
        }
        if (INIT || HAS_Y) {
#pragma unroll
            for (int i = 0; i < R; ++i) *(f32x4*)(hrow(F, r0 + i) + col) = hv[i];
        }
        if (HAS_U) {
#pragma unroll
            for (int i = 0; i < R; ++i) { const float ss = wave_sum((hv[i].x * hv[i].x + hv[i].y * hv[i].y) + (hv[i].z * hv[i].z + hv[i].w * hv[i].w)); if (lane_ == 0) PS[64 + i * 8 + wave_] = ss; }
            asm volatile("s_waitcnt lgkmcnt(0)" ::: "memory"); __builtin_amdgcn_s_barrier(); asm volatile("" ::: "memory");
#pragma unroll
            for (int i = 0; i < R; ++i) { const f32x4 p0 = *(const LAS f32x4*)(PS + 64 + i * 8), p1 = *(const LAS f32x4*)(PS + 64 + i * 8 + 4);
                const float tot = ((p0.x + p0.y) + (p0.z + p0.w)) + ((p1.x + p1.y) + (p1.z + p1.w));
                const float r2 = rsqrtf(tot * (1.0f / D) + EPS);
                const f32x4 u = (hv[i] * r2 * gn) * sc + sh;
                u32x2 w; w.x = pk2(u.x, u.y); w.y = pk2(u.z, u.w);
                *(u32x2*)(U + (size_t)(r0 + i) * D + col) = w; }
        }
        if (!HAS_Y || !HAS_U) { asm volatile("s_waitcnt lgkmcnt(0)" ::: "memory"); __builtin_amdgcn_s_barrier(); asm volatile("" ::: "memory"); }
    }
#undef NRM_LOAD
    __syncthreads();
}

__device__ __forceinline__ void unpack8(const u32x4 v, float (&f)[8]) { f[0] = bflo(v.x); f[1] = bfhi(v.x); f[2] = bflo(v.y); f[3] = bfhi(v.y); f[4] = bflo(v.z); f[5] = bfhi(v.z); f[6] = bflo(v.w); f[7] = bfhi(v.w); }
__device__ __forceinline__ u32x4 pack8(const float (&f)[8]) { u32x4 o; o.x = pk2(f[0], f[1]); o.y = pk2(f[2], f[3]); o.z = pk2(f[4], f[5]); o.w = pk2(f[6], f[7]); return o; }
__device__ __forceinline__ void comb0_rows(Frame& F, int row_lo, int row_hi) {
    const int tid_ = fresh_tid(); const int lane_ = tid_ & 63, wave_ = __builtin_amdgcn_readfirstlane(tid_ >> 6), gw_ = F.wg * NWAVES + wave_; (void)lane_; (void)gw_;
    const bf16* OFb = gY(F); const bf16* OBb = OFb + (size_t)M * 1024; const bf16* HFb = OBb + (size_t)M * 1024; const bf16* HBb = HFb + (size_t)M * 1024;
    const bf16* P = gBIG(F); bf16* U = gU(F); const float* gg = F.A.in[I_GLANG];
    const int e0 = 16 * lane_;
    for (int r = row_lo + gw_; r < row_hi; r += F.NGW) {
#pragma unroll
        for (int part = 0; part < 2; ++part) {
            const bf16* fa = (part ? HFb : OFb) + (size_t)r * 1024 + e0; const bf16* fb = (part ? HBb : OBb) + (size_t)r * 1024 + e0;
            const bf16* gp = P + (size_t)r * NP0 + (part ? 4096 : 2048) + e0;
            float a[2][8], b8[8], g[2][8];
            unpack8(*(const u32x4*)fa, a[0]); unpack8(*(const u32x4*)(fa + 8), a[1]);
            unpack8(*(const u32x4*)fb, b8);
#pragma unroll
            for (int e = 0; e < 8; ++e) a[0][e] += b8[e];
            unpack8(*(const u32x4*)(fb + 8), b8);
#pragma unroll
            for (int e = 0; e < 8; ++e) a[1][e] += b8[e];
            unpack8(*(const u32x4*)gp, g[0]); unpack8(*(const u32x4*)(gp + 8), g[1]);
            float o[2][8];
            if (part == 0) {
                float ss = 0.f;
#pragma unroll
                for (int c = 0; c < 2; ++c)
#pragma unroll
                    for (int e = 0; e < 8; ++e) ss += a[c][e] * a[c][e];
                ss += __shfl_xor(ss, 1); ss += __shfl_xor(ss, 2); ss += __shfl_xor(ss, 4); ss += __shfl_xor(ss, 8);
                const float rr = rsqrtf(ss * (1.0f / 256.0f) + EPS);
#pragma unroll
                for (int c = 0; c < 2; ++c)
#pragma unroll
                    for (int e = 0; e < 8; ++e) o[c][e] = a[c][e] * rr * gg[(e0 & 255) + 8 * c + e] * silu_f(g[c][e]);
            } else {
#pragma unroll
                for (int c = 0; c < 2; ++c)
#pragma unroll
                    for (int e = 0; e < 8; ++e) o[c][e] = a[c][e] * gelu_tanh_f(g[c][e]);
            }
            bf16* up = U + (size_t)r * D + part * 1024 + e0;
            *(u32x4*)up = pack8(o[0]); *(u32x4*)(up + 8) = pack8(o[1]);
        }
    }
}
__device__ __forceinline__ void comb1_rows(Frame& F, int row_lo, int row_hi) {
    const int tid_ = fresh_tid(); const int lane_ = tid_ & 63, wave_ = __builtin_amdgcn_readfirstlane(tid_ >> 6), gw_ = F.wg * NWAVES + wave_; (void)lane_; (void)gw_;
    const bf16* HFb = gY(F); const bf16* HBb = HFb + (size_t)M * D;
    const bf16* P = gBIG(F); bf16* U = gU(F); const float* gg = F.A.in[I_MLNG];
    const int e0 = 32 * lane_;
    for (int r = row_lo + gw_; r < row_hi; r += F.NGW) {
        float a[32]; float ss = 0.f;
#pragma unroll
        for (int c = 0; c < 4; ++c) { float x8[8], y8[8]; unpack8(*(const u32x4*)(HFb + (size_t)r * D + e0 + 8 * c), x8); unpack8(*(const u32x4*)(HBb + (size_t)r * D + e0 + 8 * c), y8);
#pragma unroll
            for (int e = 0; e < 8; ++e) { a[8 * c + e] = x8[e] + y8[e]; ss += a[8 * c + e] * a[8 * c + e]; } }
        ss += __shfl_xor(ss, 1); ss += __shfl_xor(ss, 2); ss += __shfl_xor(ss, 4);
        const float rr = rsqrtf(ss * (1.0f / 256.0f) + EPS);
#pragma unroll
        for (int c = 0; c < 4; ++c) { float g8[8], o8[8]; unpack8(*(const u32x4*)(P + (size_t)r * NP1 + 4096 + e0 + 8 * c), g8);
#pragma unroll
            for (int e = 0; e < 8; ++e) o8[e] = a[8 * c + e] * rr * gg[((e0 + 8 * c) & 255) + e] * sigmoid_f(g8[e]);
            *(u32x4*)(U + (size_t)r * D + e0 + 8 * c) = pack8(o8); }
    }
}

#define WG_BAR() do { asm volatile("s_waitcnt lgkmcnt(0)" ::: "memory"); __builtin_amdgcn_s_barrier(); asm volatile("" ::: "memory"); } while (0)
__device__ __forceinline__ int chunk_rlo(int b, int dir, int c) {
    return c < 4 ? b * CTXL + (dir ? (CTXL - 64 - 64 * c) : 64 * c) : MC + b * SEQ + (dir ? (SEQ - 64 - 64 * (c - 4)) : 64 * (c - 4));
}
__device__ __forceinline__ bf16x8 tr_frag(LAS unsigned char* tile, int pitch, int k0, int c0, int lane) {
    const int g = lane >> 4, q = (lane & 15) >> 2, p = lane & 3;
    LAS unsigned char* a0 = tile + (k0 + 8 * g + q) * pitch + (c0 + 4 * p) * 2;
    const bf16x4 lo = __builtin_amdgcn_ds_read_tr16_b64_v4i16((LAS bf16x4*)a0);
    const bf16x4 hi = __builtin_amdgcn_ds_read_tr16_b64_v4i16((LAS bf16x4*)(a0 + 4 * pitch));
    return __builtin_shufflevector(lo, hi, 0, 1, 2, 3, 4, 5, 6, 7);
}
__device__ __forceinline__ u32x4 scale8(const u32x4 v, float s) {
    u32x4 o; o.x = pk2(bflo(v.x) * s, bfhi(v.x) * s); o.y = pk2(bflo(v.y) * s, bfhi(v.y) * s); o.z = pk2(bflo(v.z) * s, bfhi(v.z) * s); o.w = pk2(bflo(v.w) * s, bfhi(v.w) * s); return o;
}
__device__ __forceinline__ float wave_incl_sum(float x, int lane) {
#pragma unroll
    for (int o = 1; o < 64; o <<= 1) { const float t = __shfl_up(x, o); if (lane >= o) x += t; }
    return x;
}
__device__ __forceinline__ float wave_incl_max(float x, int lane) {
#pragma unroll
    for (int o = 1; o < 64; o <<= 1) { const float t = __shfl_up(x, o); if (lane >= o) x = fmaxf(x, t); }
    return x;
}

template <int MODE>
__device__ __forceinline__ void chain_scan(LAS unsigned char* lds,
        const bf16* __restrict__ proj, const int NP, const int qcol, const int kcol, const int vcol,
        const float* __restrict__ gates, const int gcol, const int b, const int dir,
        bf16* __restrict__ outb, const int out_ld, const int ocol, const bool ctx_out,
        const float* __restrict__ w2, const float* __restrict__ ba, const float bias_i, const float bias_f) {
    const int tid = fresh_tid(); const int lane = tid & 63, wave = __builtin_amdgcn_readfirstlane(tid >> 6);
    constexpr int NVB = MODE ? 9 : 8;
    constexpr int PQ = 272, PV = 304, PP = 144;
    constexpr int O_QS = 0, O_KS = 17408, O_QH = 34816, O_KH = 52224, O_VS = 69632, O_PS = 89088, O_SB = 98304, O_SM = 137472;
    LAS float* LR = (LAS float*)(lds + O_SM);
    LAS float* TOT = (LAS float*)(lds + O_SM + 4096);
    LAS float* FIRST = (LAS float*)(lds + O_SM + 8192);
    LAS float* DEC = (LAS float*)(lds + O_SM + 8704);
    LAS float* A_ = (LAS float*)(lds + O_SM);
    LAS float* MI = A_ + 64; LAS float* WI = A_ + 128; LAS float* WK = A_ + 192; LAS float* MR = A_ + 256; LAS float* DEN = A_ + 320; LAS float* DECS = A_ + 384;
    const int fr = lane & 15, fq = lane >> 4;

    __syncthreads();
    for (int i = tid; i < (9216 + 39168) / 16; i += 512) *(LAS u32x4*)(lds + O_PS + 16 * i) = (u32x4){0u, 0u, 0u, 0u};
    if (MODE) { if (tid < 64) { *(LAS u32x4*)(lds + O_VS + tid * PV + 256) = (u32x4){0x3F80u, 0u, 0u, 0u}; *(LAS u32x4*)(lds + O_VS + tid * PV + 272) = (u32x4){0u, 0u, 0u, 0u}; } }
    f32x4 S[NVB];
#pragma unroll
    for (int v = 0; v < NVB; ++v) S[v] = (f32x4){0.f, 0.f, 0.f, 0.f};
    float mst = 0.f;
    const int dp = tid & 63, d0 = 2 * dp, jg = wave;
    f32x2 w2r[16]; f32x2 bar = (f32x2){0.f, 0.f};
    if (MODE == 0) {
#pragma unroll
        for (int r = 0; r < 16; ++r) w2r[r] = *(const f32x2*)(w2 + r * 512 + d0);
        bar = *(const f32x2*)(ba + d0);
    }
    const int sj0 = tid >> 4, sj1 = (tid + 512) >> 4, sch = tid & 15;
    u32x4 pq[2], pk[2], pv[2]; f32x2 plr = (f32x2){0.f, 0.f}; float pgi = 0.f, pgf = 0.f;
#define CH_PREFETCH(cc) do { const int rl_ = chunk_rlo(b, dir, (cc)); \
        { const int row_ = dir ? rl_ + 63 - sj0 : rl_ + sj0; const bf16* rp_ = proj + (size_t)row_ * NP + 8 * sch; pq[0] = *(const u32x4*)(rp_ + qcol); pk[0] = *(const u32x4*)(rp_ + kcol); pv[0] = *(const u32x4*)(rp_ + vcol); } \
        { const int row_ = dir ? rl_ + 63 - sj1 : rl_ + sj1; const bf16* rp_ = proj + (size_t)row_ * NP + 8 * sch; pq[1] = *(const u32x4*)(rp_ + qcol); pk[1] = *(const u32x4*)(rp_ + kcol); pv[1] = *(const u32x4*)(rp_ + vcol); } \
        if (MODE == 0) { const int j_ = 8 * wave + (lane >> 3); const int row_ = dir ? rl_ + 63 - j_ : rl_ + j_; plr = *(const f32x2*)(gates + (size_t)row_ * 32 + gcol + 2 * (lane & 7)); } \
        else { if (wave == 0) { const int row_ = dir ? rl_ + 63 - lane : rl_ + lane; pgi = gates[(size_t)row_ * 32 + gcol]; pgf = gates[(size_t)row_ * 32 + gcol + 8]; } } } while (0)
    CH_PREFETCH(0);
    for (int c = 0; c < NCH; ++c) {
        const int rl = chunk_rlo(b, dir, c);
        *(LAS u32x4*)(lds + O_QS + sj0 * PQ + 16 * sch) = pq[0]; *(LAS u32x4*)(lds + O_QS + sj1 * PQ + 16 * sch) = pq[1];
        *(LAS u32x4*)(lds + O_KS + sj0 * PQ + 16 * sch) = pk[0]; *(LAS u32x4*)(lds + O_KS + sj1 * PQ + 16 * sch) = pk[1];
        *(LAS u32x4*)(lds + O_VS + sj0 * PV + 16 * sch) = pv[0]; *(LAS u32x4*)(lds + O_VS + sj1 * PV + 16 * sch) = pv[1];
        const f32x2 lrc = plr; const float gi = pgi, gf = pgf;
        if (c + 1 < NCH) CH_PREFETCH(c + 1);
        WG_BAR();
        if (MODE == 0) {
            f32x2 cs[8]; f32x2 run = (f32x2){0.f, 0.f};
#pragma unroll
            for (int jj = 0; jj < 8; ++jj) {
                f32x2 z = bar;
#pragma unroll
                for (int r2 = 0; r2 < 8; ++r2) { const float l0 = __int_as_float(__builtin_amdgcn_readlane(__float_as_int(lrc.x), 8 * jj + r2)), l1 = __int_as_float(__builtin_amdgcn_readlane(__float_as_int(lrc.y), 8 * jj + r2));
                    z += w2r[2 * r2] * l0; z += w2r[2 * r2 + 1] * l1; }
                f32x2 la; la.x = fmaxf(logsig_f(z.x) * (1.0f / 16.0f), -1.0f); la.y = fmaxf(logsig_f(z.y) * (1.0f / 16.0f), -1.0f);
                run += la; cs[jj] = run;
            }
            *(LAS f32x2*)(TOT + jg * 128 + d0) = run;
            if (jg == 4) *(LAS f32x2*)(FIRST + d0) = cs[0];
            WG_BAR();
            f32x2 pre = (f32x2){0.f, 0.f}, bref = (f32x2){0.f, 0.f}, blast = (f32x2){0.f, 0.f};
#pragma unroll
            for (int g = 0; g < 8; ++g) { const f32x2 t = *(const LAS f32x2*)(TOT + g * 128 + d0); if (g < jg) pre += t; if (g < 4) bref += t; blast += t; }
            bref += *(const LAS f32x2*)(FIRST + d0);
            f32x2 e1, e2; e1.x = __expf(bref.x); e1.y = __expf(bref.y); e2.x = __expf(blast.x - bref.x); e2.y = __expf(blast.y - bref.y);
            unsigned qw[8], kw[8];
#pragma unroll
            for (int jj = 0; jj < 8; ++jj) { const int j = 8 * jg + jj; qw[jj] = *(const LAS unsigned*)(lds + O_QS + j * PQ + 4 * dp); kw[jj] = *(const LAS unsigned*)(lds + O_KS + j * PQ + 4 * dp); }
#pragma unroll
            for (int jj = 0; jj < 8; ++jj) {
                const int j = 8 * jg + jj; const f32x2 bb = pre + cs[jj];
                f32x2 ef, er; ef.x = __expf(bb.x - bref.x); ef.y = __expf(bb.y - bref.y); er.x = __builtin_amdgcn_rcpf(ef.x); er.y = __builtin_amdgcn_rcpf(ef.y);
                f32x2 qv, kv; qv.x = bflo(qw[jj]) * QSCALE; qv.y = bfhi(qw[jj]) * QSCALE; kv.x = bflo(kw[jj]); kv.y = bfhi(kw[jj]);
                const f32x2 qt = qv * ef, kt = kv * er, qh = qt * e1, kh = kt * e2;
                *(LAS unsigned*)(lds + O_QS + j * PQ + 4 * dp) = pk2(qt.x, qt.y);
                *(LAS unsigned*)(lds + O_QH + j * PQ + 4 * dp) = pk2(qh.x, qh.y);
                *(LAS unsigned*)(lds + O_KS + j * PQ + 4 * dp) = pk2(kt.x, kt.y);
                *(LAS unsigned*)(lds + O_KH + j * PQ + 4 * dp) = pk2(kh.x, kh.y);
            }
            if (jg == 0) { f32x2 dv; dv.x = __expf(blast.x); dv.y = __expf(blast.y); *(LAS f32x2*)(DEC + d0) = dv; }
        } else {
            if (wave == 0) {
                const float ipre = gi + bias_i, lf = logsig_f(gf + bias_f);
                const float bsum = wave_incl_sum(lf, lane);
                const float a = ipre - bsum;
                const float cm = wave_incl_max(a, lane);
                const float Mi = fmaxf(mst, cm);
                const float blast = __shfl(bsum, 63), M63 = __shfl(Mi, 63);
                A_[lane] = a; MI[lane] = Mi; WI[lane] = __expf(mst - Mi) * QSCALE; WK[lane] = __expf(a - M63); MR[lane] = __expf(-(bsum + Mi));
                if (lane == 0) DECS[0] = __expf(mst - M63);
                mst = blast + M63;
            }
            WG_BAR();
            { const float wi0 = WI[sj0], wi1 = WI[sj1], wk0 = WK[sj0], wk1 = WK[sj1];
              *(LAS u32x4*)(lds + O_QH + sj0 * PQ + 16 * sch) = scale8(*(const LAS u32x4*)(lds + O_QS + sj0 * PQ + 16 * sch), wi0);
              *(LAS u32x4*)(lds + O_QH + sj1 * PQ + 16 * sch) = scale8(*(const LAS u32x4*)(lds + O_QS + sj1 * PQ + 16 * sch), wi1);
              *(LAS u32x4*)(lds + O_KH + sj0 * PQ + 16 * sch) = scale8(*(const LAS u32x4*)(lds + O_KS + sj0 * PQ + 16 * sch), wk0);
              *(LAS u32x4*)(lds + O_KH + sj1 * PQ + 16 * sch) = scale8(*(const LAS u32x4*)(lds + O_KS + sj1 * PQ + 16 * sch), wk1); }
        }
        WG_BAR();
        for (int tix = wave; tix < 10; tix += 8) {
            const int ib = tix >= 6 ? 3 : (tix >= 3 ? 2 : (tix >= 1 ? 1 : 0)); const int jb = tix - ib * (ib + 1) / 2;
            f32x4 acc = (f32x4){0.f, 0.f, 0.f, 0.f};
            bf16x8 Ak[4], Bq[4];
#pragma unroll
            for (int ks = 0; ks < 4; ++ks) { Ak[ks] = *(const LAS bf16x8*)(lds + O_KS + (16 * jb + fr) * PQ + (32 * ks + 8 * fq) * 2); Bq[ks] = *(const LAS bf16x8*)(lds + O_QS + (16 * ib + fr) * PQ + (32 * ks + 8 * fq) * 2); }
#pragma unroll
            for (int ks = 0; ks < 4; ++ks) acc = __builtin_amdgcn_mfma_f32_16x16x32_bf16(Ak[ks], Bq[ks], acc, 0, 0, 0);
            const int i = 16 * ib + fr, j0 = 16 * jb + 4 * fq;
            float w[4];
            if (MODE) { const float Mi = MI[i];
#pragma unroll
                for (int r = 0; r < 4; ++r) w[r] = (j0 + r <= i) ? acc[r] * QSCALE * __expf(A_[j0 + r] - Mi) : 0.f;
            } else {
#pragma unroll
                for (int r = 0; r < 4; ++r) w[r] = (j0 + r <= i) ? acc[r] : 0.f;
            }
            u32x2 pw; pw.x = pk2(w[0], w[1]); pw.y = pk2(w[2], w[3]);
            *(LAS u32x2*)(lds + O_PS + i * PP + j0 * 2) = pw;
        }
        WG_BAR();
        const int ib = wave & 3, vb0 = (wave >> 2) * 4, irow = 16 * ib + fr;
        f32x4 ao[5];
#pragma unroll
        for (int v = 0; v < 5; ++v) ao[v] = (f32x4){0.f, 0.f, 0.f, 0.f};
        {
            bf16x8 Bp[2], Av[2][5];
#pragma unroll
            for (int ks = 0; ks < 2; ++ks) { Bp[ks] = *(const LAS bf16x8*)(lds + O_PS + irow * PP + (32 * ks + 8 * fq) * 2);
#pragma unroll
                for (int v = 0; v < 4; ++v) Av[ks][v] = tr_frag(lds + O_VS, PV, 32 * ks, 16 * (vb0 + v), lane);
                if (MODE) Av[ks][4] = tr_frag(lds + O_VS, PV, 32 * ks, 128, lane); }
#pragma unroll
            for (int ks = 0; ks < 2; ++ks) {
#pragma unroll
                for (int v = 0; v < 4; ++v) ao[v] = __builtin_amdgcn_mfma_f32_16x16x32_bf16(Av[ks][v], Bp[ks], ao[v], 0, 0, 0);
                if (MODE) { if (wave < 4) ao[4] = __builtin_amdgcn_mfma_f32_16x16x32_bf16(Av[ks][4], Bp[ks], ao[4], 0, 0, 0); } }
        }
#pragma unroll
        for (int kh = 0; kh < 2; ++kh) {
            bf16x8 Bq[2], As[2][5];
#pragma unroll
            for (int k2 = 0; k2 < 2; ++k2) { const int ks = 2 * kh + k2; Bq[k2] = *(const LAS bf16x8*)(lds + O_QH + irow * PQ + (32 * ks + 8 * fq) * 2);
#pragma unroll
                for (int v = 0; v < 4; ++v) As[k2][v] = *(const LAS bf16x8*)(lds + O_SB + (16 * (vb0 + v) + fr) * PQ + (32 * ks + 8 * fq) * 2);
                if (MODE) As[k2][4] = *(const LAS bf16x8*)(lds + O_SB + (128 + fr) * PQ + (32 * ks + 8 * fq) * 2); }
#pragma unroll
            for (int k2 = 0; k2 < 2; ++k2) {
#pragma unroll
                for (int v = 0; v < 4; ++v) ao[v] = __builtin_amdgcn_mfma_f32_16x16x32_bf16(As[k2][v], Bq[k2], ao[v], 0, 0, 0);
                if (MODE) { if (wave < 4) ao[4] = __builtin_amdgcn_mfma_f32_16x16x32_bf16(As[k2][4], Bq[k2], ao[4], 0, 0, 0); } }
        }
        const int db = wave;
        if (MODE == 0) { const f32x4 dec = *(const LAS f32x4*)(DEC + 16 * db + 4 * fq);
#pragma unroll
            for (int v = 0; v < NVB; ++v) S[v] = S[v] * dec;
        } else { const float dsc = DECS[0];
#pragma unroll
            for (int v = 0; v < NVB; ++v) S[v] = S[v] * dsc;
        }
#pragma unroll
        for (int ks = 0; ks < 2; ++ks) {
            const bf16x8 A = tr_frag(lds + O_KH, PQ, 32 * ks, 16 * db, lane);
#pragma unroll
            for (int v = 0; v < NVB; ++v) { const bf16x8 B = tr_frag(lds + O_VS, PV, 32 * ks, 16 * v, lane); S[v] = __builtin_amdgcn_mfma_f32_16x16x32_bf16(A, B, S[v], 0, 0, 0); }
        }
        if (MODE) { if (wave < 4 && lane < 16) DEN[16 * ib + lane] = ao[4][0]; }
        WG_BAR();
        if (ctx_out || c >= 4) {
            const int row = dir ? rl + 63 - irow : rl + irow;
            float sc = 1.0f;
            if (MODE) sc = 1.0f / fmaxf(fabsf(DEN[irow]), MR[irow]);
            bf16* op = outb + (size_t)row * out_ld + ocol + 16 * vb0 + 4 * fq;
#pragma unroll
            for (int v = 0; v < 4; ++v) { u32x2 w; w.x = pk2(ao[v][0] * sc, ao[v][1] * sc); w.y = pk2(ao[v][2] * sc, ao[v][3] * sc); *(u32x2*)(op + 16 * v) = w; }
        }
#pragma unroll
        for (int v = 0; v < NVB; ++v) { u32x2 w; w.x = pk2(S[v][0], S[v][1]); w.y = pk2(S[v][2], S[v][3]); *(LAS u32x2*)(lds + O_SB + (16 * v + fr) * PQ + (16 * db + 4 * fq) * 2) = w; }
    }
#undef CH_PREFETCH
    __syncthreads();
}

__device__ __forceinline__ void rg_chain(LAS unsigned char* lds,
        const bf16* __restrict__ proj, const int b, const int n, const int dir, const bf16* __restrict__ wrg,
        const float* __restrict__ lam, const float* __restrict__ b_a, const float* __restrict__ b_i, const float* __restrict__ conv_w, const float* __restrict__ conv_b,
        bf16* __restrict__ hout) {
    const int tid = fresh_tid(); const int lane = tid & 63, wave = __builtin_amdgcn_readfirstlane(tid >> 6);
    constexpr int O_XR = 0, O_XBF = 17408, O_XBH = 51200, O_AA = 68608, O_BX = 102400, O_CW = 136192;
    constexpr int PXF = 528, PXH = 272;
    const int fr = lane & 15, fq = lane >> 4;
    LAS float* CW = (LAS float*)(lds + O_CW);
    __syncthreads();
    for (int i = tid; i < 5 * 128; i += 512) CW[i] = i < 512 ? conv_w[(i >> 7) * 1024 + 128 * n + (i & 127)] : conv_b[128 * n + (i - 512)];
    bf16x8 Afr[2][4];
#pragma unroll
    for (int mat = 0; mat < 2; ++mat)
#pragma unroll
        for (int ks = 0; ks < 4; ++ks) Afr[mat][ks] = *(const bf16x8*)(wrg + ((size_t)((dir * 2 + mat) * 8 + n) * 128 + 16 * wave + fr) * 128 + 32 * ks + 8 * fq);
    f32x4 c8, bav, biv;
#pragma unroll
    for (int r = 0; r < 4; ++r) { const int ch = 128 * n + 16 * wave + 4 * fq + r; const float l = lam[dir * 1024 + ch];
        c8[r] = -8.0f * (fmaxf(-l, 0.f) + log1pf(expf(-fabsf(l)))); bav[r] = b_a[dir * 1024 + ch]; biv[r] = b_i[dir * 1024 + ch]; }
    float hst = 0.f;
    const int ch2 = tid & 63, tg = tid >> 6;
    u32x4 px[3];
#define RG_PREFETCH(cc) do { const int c_ = (cc); const int L_ = c_ < 4 ? CTXL : SEQ, cs_ = c_ < 4 ? c_ : c_ - 4, base_ = c_ < 4 ? b * CTXL : MC + b * SEQ; \
        const int t0_ = dir ? L_ - 64 * (cs_ + 1) : 64 * cs_; \
        _Pragma("unroll") for (int e_ = 0; e_ < 3; ++e_) { const int id_ = tid + 512 * e_, rr_ = id_ >> 4, tt_ = t0_ - 2 + rr_; \
            px[e_] = (rr_ < 67 && tt_ >= 0 && tt_ < L_) ? *(const u32x4*)(proj + (size_t)(base_ + tt_) * NP0 + 3072 + 128 * n + 8 * (id_ & 15)) : (u32x4){0u, 0u, 0u, 0u}; } } while (0)
    RG_PREFETCH(0);
    for (int c = 0; c < NCH; ++c) {
        const int L = c < 4 ? CTXL : SEQ, cs = c < 4 ? c : c - 4, base = c < 4 ? b * CTXL : MC + b * SEQ;
        const int t0 = dir ? L - 64 * (cs + 1) : 64 * cs;
#pragma unroll
        for (int e = 0; e < 3; ++e) { const int id = tid + 512 * e, rr = id >> 4; if (rr < 68) *(LAS u32x4*)(lds + O_XR + rr * 256 + 16 * (id & 15)) = px[e]; }
        if (c + 1 < NCH) RG_PREFETCH(c + 1);
        WG_BAR();
        {
            const f32x2 w0 = *(const LAS f32x2*)(CW + 0 * 128 + 2 * ch2), w1 = *(const LAS f32x2*)(CW + 1 * 128 + 2 * ch2), w2_ = *(const LAS f32x2*)(CW + 2 * 128 + 2 * ch2), w3 = *(const LAS f32x2*)(CW + 3 * 128 + 2 * ch2), cb = *(const LAS f32x2*)(CW + 512 + 2 * ch2);
            f32x2 xw[11];
#pragma unroll
            for (int rr = 0; rr < 11; ++rr) { const unsigned u = *(const LAS unsigned*)(lds + O_XR + (8 * tg + rr) * 256 + 4 * ch2); xw[rr].x = bflo(u); xw[rr].y = bfhi(u); }
#pragma unroll
            for (int jj = 0; jj < 8; ++jj) {
                f32x2 y = cb; y += xw[jj] * w0; y += xw[jj + 1] * w1; y += xw[jj + 2] * w2_; y += xw[jj + 3] * w3;
                *(LAS f32x2*)(lds + O_XBF + (8 * tg + jj) * PXF + 8 * ch2) = y;
                *(LAS unsigned*)(lds + O_XBH + (8 * tg + jj) * PXH + 4 * ch2) = pk2(y.x, y.y);
            }
        }
        WG_BAR();
#pragma unroll
        for (int tb = 0; tb < 4; ++tb) {
            f32x4 ga = (f32x4){0.f, 0.f, 0.f, 0.f}, gi = (f32x4){0.f, 0.f, 0.f, 0.f};
            bf16x8 Bx[4];
#pragma unroll
            for (int ks = 0; ks < 4; ++ks) Bx[ks] = *(const LAS bf16x8*)(lds + O_XBH + (16 * tb + fr) * PXH + (32 * ks + 8 * fq) * 2);
#pragma unroll
            for (int ks = 0; ks < 4; ++ks) { ga = __builtin_amdgcn_mfma_f32_16x16x32_bf16(Afr[0][ks], Bx[ks], ga, 0, 0, 0); gi = __builtin_amdgcn_mfma_f32_16x16x32_bf16(Afr[1][ks], Bx[ks], gi, 0, 0, 0); }
            const int t = 16 * tb + fr;
            const f32x4 xb = *(const LAS f32x4*)(lds + O_XBF + t * PXF + (16 * wave + 4 * fq) * 4);
            f32x4 av, bx;
#pragma unroll
            for (int r = 0; r < 4; ++r) { const float rg = sigmoid_f(ga[r] + bav[r]), ig = sigmoid_f(gi[r] + biv[r]); const float la = c8[r] * rg;
                av[r] = __expf(la); bx[r] = sqrtf(-expm1f(2.0f * la)) * (ig * xb[r]); }
            *(LAS f32x4*)(lds + O_AA + t * PXF + (16 * wave + 4 * fq) * 4) = av;
            *(LAS f32x4*)(lds + O_BX + t * PXF + (16 * wave + 4 * fq) * 4) = bx;
        }
        WG_BAR();
        if (tid < 128) {
            bf16* hp = hout + (size_t)(base + t0) * 1024 + 128 * n + tid;
            for (int s8 = 0; s8 < 64; s8 += 8) {
                float av8[8], bx8[8];
#pragma unroll
                for (int e = 0; e < 8; ++e) { const int jj = dir ? 63 - (s8 + e) : s8 + e; av8[e] = *(const LAS float*)(lds + O_AA + jj * PXF + 4 * tid); bx8[e] = *(const LAS float*)(lds + O_BX + jj * PXF + 4 * tid); }
#pragma unroll
                for (int e = 0; e < 8; ++e) { const int jj = dir ? 63 - (s8 + e) : s8 + e; hst = av8[e] * hst + bx8[e]; hp[(size_t)jj * 1024] = (bf16)f2bf(hst); }
            }
        }
    }
#undef RG_PREFETCH
    __syncthreads();
}

#ifndef MK_LAST_PHASE
#define MK_LAST_PHASE 24
#endif
constexpr int NPH = 24;
__global__ void __launch_bounds__(NWAVES * 64, 2) mk_fwd(Args args) {
    extern __shared__ __attribute__((aligned(16))) unsigned char lds_raw[];
    const int GA = (int)gridDim.x, bx = (int)blockIdx.x;
    const int grp = (bx >> 2) & 1, gi = ((bx >> 3) << 2) | (bx & 3), GG = GA >> 1;
    Frame FA{(LAS unsigned char*)lds_raw, GA, bx, GA * NWAVES, 0, args.out, args.ws, args};
    Frame F{(LAS unsigned char*)lds_raw, GG, gi, GG * NWAVES, grp, args.out, args.ws, args};
    volatile LAS unsigned* MISC = (volatile LAS unsigned*)(F.lds + LDSCTL_OFF);
    for (int u = threadIdx.x; u < (LDS_BYTES - LDSCTL_OFF) / 4; u += NWAVES * 64) ((LAS unsigned*)(F.lds + LDSCTL_OFF))[u] = 0u;
    __syncthreads();
    const int lo = args.ph_lo, hi = args.ph_hi;
    unsigned* ctl = (unsigned*)(F.ws + WS_CTL);
    XcdBarrier barA = xcd_barrier_post(ctl + CW_BAR, MISC + 8, (unsigned)GA);
    XcdBarrier barG = xcd_barrier_post(ctl + CW_BAR + (1 + grp) * XCD_BAR_WORDS, MISC + 12, (unsigned)GG);
#ifndef MK_REP_GEMM
#define MK_REP_GEMM 1
#endif
#ifndef MK_REP_SCAN
#define MK_REP_SCAN 1
#endif
#ifndef MK_REP_COMB
#define MK_REP_COMB 1
#endif
#ifndef MK_REP_CVT
#define MK_REP_CVT 1
#endif
#ifndef MK_CVT_SPLIT
#define MK_CVT_SPLIT 30
#endif
#ifndef MK_OFFMASK
#define MK_OFFMASK 0x7FF
#endif
#ifndef MK_PREMASK
#define MK_PREMASK 3
#endif
#define IN(k) (lo <= (k) && (k) < hi)
#define INL(o) (((MK_OFFMASK >> (o)) & 1) && IN(pb + (o)))
#define SEAM(k) do { if (IN(k) && IN((k) + 1)) xcd_barrier(barG); } while (0)
    float* MOD = (float*)(F.ws + WS_MOD);
    bf16* U = gU(F); bf16* Yb = gY(F); bf16* BIG = gBIG(F); float* GATES = gGATES(F); float* YC = gYC(F);

    if ((MK_PREMASK & 1) && IN(0)) { pre_mod(FA); pre_pe(FA); for (int rep_ = 0; rep_ < MK_REP_CVT; ++rep_) cvt_layer<0>(FA); }
    if (IN(0) && IN(1)) xcd_barrier(barA);
    if ((MK_PREMASK & 2) && IN(1)) {
        for (int rep_ = 0; rep_ < MK_REP_CVT; ++rep_) { if (grp == 0) cvt_layer<1>(F, 0, MK_CVT_SPLIT); else cvt_layer<1>(F, MK_CVT_SPLIT, 100); }
        nrm_rows<true, false, true>(F, 0, M, 0.f, nullptr, nullptr, 0, F.A.in[I_NORMG], MOD, 0, 1);
    }
    SEAM(1);
    if (IN(1) && IN(2) && gi == 0 && threadIdx.x == 0) __hip_atomic_store(ctl + CW_W1READY + 64 * grp, 1u, __ATOMIC_RELAXED, __HIP_MEMORY_SCOPE_AGENT);
    for (int layer = 0; layer < 2; ++layer) {
        const int pb = 2 + 11 * layer; const bool last = layer == 1;
        const float* ng = F.A.in[I_NORMG] + (size_t)layer * 6 * D; const float* modl = MOD + (size_t)layer * 9 * 18432;
        const int NP = layer == 0 ? NP0 : NP1;
        const int rlo2 = last ? MC : 0;
        const unsigned char* W = F.ws + WS_W + (size_t)layer * W_LAYER;
        if (layer == 1 && IN(pb)) {
            if (threadIdx.x == 0) { unsigned sp = 0; while (__hip_atomic_load(ctl + CW_W1READY, __ATOMIC_RELAXED, __HIP_MEMORY_SCOPE_AGENT) == 0u || __hip_atomic_load(ctl + CW_W1READY + 64, __ATOMIC_RELAXED, __HIP_MEMORY_SCOPE_AGENT) == 0u) { __builtin_amdgcn_s_sleep(4); if (++sp > (1u << 22)) { atomicAdd(ctl + CW_BAR + XB_TMO, 1u); break; } }
                __builtin_amdgcn_fence(__ATOMIC_ACQUIRE, "agent"); asm volatile("s_waitcnt vmcnt(0)" ::: "memory"); }
            __syncthreads();
        }
        if (INL(0)) { pg8::Gemm g{U, (const bf16*)(W + W_F1I), M, 2 * DFF, D}; pg8::StaticOrder S; S.init(M, 2 * DFF, F.G, F.wg, D, 0, 4); pg8::EpiSwiglu E{BIG, DFF};
            for (int rep_ = 0; rep_ < MK_REP_GEMM; ++rep_) pg8::gemm_phase<pg8::EpiSwiglu, pg8::StaticOrder, PG8_ALIGN, PG8_SP2>(F.lds, g, S, E); }
        SEAM(pb + 0);
        if (INL(1)) {
            pg8::Gemm g{BIG, (const bf16*)(W + W_F1O), M, D, DFF}; pg8::MixedOrder S; S.init(MLAT, D, F.G, F.wg, DFF, MC / 256, MC, KSPLIT, 4);
            pg8::EpiY E{Yb, D, YC, (size_t)MC * D, DFF / 64};
            for (int rep_ = 0; rep_ < MK_REP_GEMM; ++rep_) pg8::gemm_phase<pg8::EpiY, pg8::MixedOrder, PG8_ALIGN, PG8_SP2>(F.lds, g, S, E);
        }
        SEAM(pb + 1);
        if (INL(2)) nrm_rows<false, true, true>(F, 0, M, 0.5f, ng + 1 * D, modl, 2, ng + 2 * D, modl, 3, 4);
        SEAM(pb + 2);
        if (INL(3)) { pg8::Gemm g{U, (const bf16*)(W + W_MI), M, NP, D}; pg8::StaticOrder S; S.init(M, NP, F.G, F.wg, D, 0, 4); pg8::EpiProj E{BIG, NP, GATES, NP / 256 - 1};
            for (int rep_ = 0; rep_ < MK_REP_GEMM; ++rep_) pg8::gemm_phase<pg8::EpiProj, pg8::StaticOrder, PG8_ALIGN, PG8_SP2>(F.lds, g, S, E); }
        SEAM(pb + 3);
        if (INL(4)) {
            if (layer == 0) {
                bf16* OFb = Yb; bf16* OBb = OFb + (size_t)M * 1024; bf16* HFb = OBb + (size_t)M * 1024; bf16* HBb = HFb + (size_t)M * 1024;
                for (int item = F.wg; item < 128 * MK_REP_SCAN; item += F.G) { const int it = item & 127;
                    if (it < 64) { const int ci = it >> 1, vh = it & 1, b = ci >> 3, h = (ci >> 1) & 3, dir = ci & 1;
                        chain_scan<0>(F.lds, BIG, NP0, h * 128, 512 + h * 128, 1024 + h * 256 + vh * 128, GATES, dir * 16, b, dir,
                                      dir ? OBb : OFb, 1024, h * 256 + vh * 128, true, F.A.in[I_WALPHA2] + (size_t)dir * 16 * 512 + h * 128, F.A.in[I_BALPHA] + dir * 512 + h * 128, 0.f, 0.f);
                    } else { const int ri = it - 64, b = ri >> 4, n = (ri >> 1) & 7, dir = ri & 1;
                        rg_chain(F.lds, BIG, b, n, dir, (const bf16*)(F.ws + WS_WRG), F.A.in[I_LAM], F.A.in[I_RGBA], F.A.in[I_RGBI], F.A.in[I_CONVW], F.A.in[I_CONVB], dir ? HBb : HFb);
                    }
                }
            } else {
                bf16* HFb = Yb; bf16* HBb = HFb + (size_t)M * D;
                for (int item = F.wg; item < 128 * MK_REP_SCAN; item += F.G) { const int it = item & 127; const int ci = it >> 1, vh = it & 1, b = ci >> 4, h = (ci >> 1) & 7, dir = ci & 1;
                    chain_scan<1>(F.lds, BIG, NP1, h * 128, 1024 + h * 128, 2048 + h * 256 + vh * 128, GATES, dir * 16 + h, b, dir,
                                  dir ? HBb : HFb, D, h * 256 + vh * 128, false, nullptr, nullptr, F.A.in[I_MLBG][dir * 16 + h], F.A.in[I_MLBG][dir * 16 + 8 + h]);
                }
            }
        }
        SEAM(pb + 4);
        if (INL(5)) { for (int rep_ = 0; rep_ < MK_REP_COMB; ++rep_) { if (layer == 0) comb0_rows(F, 0, M); else comb1_rows(F, MC, M); } }
        SEAM(pb + 5);
        if (INL(6)) {
            pg8::Gemm g{U, (const bf16*)(W + W_MO), M, D, D}; pg8::MixedOrder S; S.init(MLAT, D, F.G, F.wg, D, MC / 256, last ? 0 : MC, KSPLIT, 4);
            pg8::EpiY E{Yb, D, YC, (size_t)MC * D, D / 64};
            for (int rep_ = 0; rep_ < MK_REP_GEMM; ++rep_) pg8::gemm_phase<pg8::EpiY, pg8::MixedOrder, PG8_ALIGN, PG8_SP2>(F.lds, g, S, E);
        }
        SEAM(pb + 6);
        if (INL(7)) nrm_rows<false, true, true>(F, rlo2, M, 1.0f, ng + 3 * D, modl, 5, ng + 4 * D, modl, 6, 7);
        SEAM(pb + 7);
        if (INL(8)) { pg8::Gemm g{U + (size_t)rlo2 * D, (const bf16*)(W + W_F2I), M - rlo2, 2 * DFF, D}; pg8::StaticOrder S; S.init(M - rlo2, 2 * DFF, F.G, F.wg, D, 0, 4); pg8::EpiSwiglu E{BIG + (size_t)rlo2 * DFF, DFF};
            for (int rep_ = 0; rep_ < MK_REP_GEMM; ++rep_) pg8::gemm_phase<pg8::EpiSwiglu, pg8::StaticOrder, PG8_ALIGN, PG8_SP2>(F.lds, g, S, E); }
        SEAM(pb + 8);
        if (INL(9)) {
            pg8::Gemm g{BIG, (const bf16*)(W + W_F2O), M, D, DFF}; pg8::MixedOrder S; S.init(MLAT, D, F.G, F.wg, DFF, MC / 256, last ? 0 : MC, KSPLIT, 4);
            pg8::EpiY E{Yb, D, YC, (size_t)MC * D, DFF / 64};
            for (int rep_ = 0; rep_ < MK_REP_GEMM; ++rep_) pg8::gemm_phase<pg8::EpiY, pg8::MixedOrder, PG8_ALIGN, PG8_SP2>(F.lds, g, S, E);
        }
        SEAM(pb + 9);
        if (INL(10)) {
            if (!last) nrm_rows<false, true, true>(F, 0, M, 0.5f, ng + 5 * D, modl, 8, F.A.in[I_NORMG] + 6 * D, MOD + (size_t)9 * 18432, 0, 1);
            else nrm_rows<false, true, false>(F, MC, M, 0.5f, ng + 5 * D, modl, 8, nullptr, nullptr, 0, 0);
        }
        SEAM(pb + 10);
    }
#undef IN
#undef SEAM
}

extern "C" void kernel_launch(void* const* d_in, const int* in_sizes, int n_in, void* d_out, int out_size, void* d_ws, size_t ws_size, hipStream_t stream) {
    static int grid = 0;
    if (grid == 0) {
        if (n_in != 27 || out_size != NB * SEQ * D || ws_size < WS_END) { fprintf(stderr, "kernel_launch: unexpected problem (n_in %d, out %d, ws %zu; need ws >= %zu); nothing launched\n", n_in, out_size, ws_size, (size_t)WS_END); grid = -1; return; }
        int dev = 0, cus = 0, per_cu = 0;
        if (hipGetDevice(&dev) != hipSuccess || hipDeviceGetAttribute(&cus, hipDeviceAttributeMultiprocessorCount, dev) != hipSuccess) { fprintf(stderr, "kernel_launch: device query failed\n"); grid = -1; return; }
        if (hipFuncSetAttribute((const void*)mk_fwd, hipFuncAttributeMaxDynamicSharedMemorySize, LDS_BYTES) != hipSuccess) { fprintf(stderr, "kernel_launch: hipFuncSetAttribute failed\n"); grid = -1; return; }
        if (hipOccupancyMaxActiveBlocksPerMultiprocessor(&per_cu, (const void*)mk_fwd, NWAVES * 64, LDS_BYTES) != hipSuccess || per_cu < 1)
            fprintf(stderr, "kernel_launch: note: occupancy query reports %d workgroups per CU\n", per_cu);
        (void)hipGetLastError();
        grid = cus;
        if (grid % 8 != 0) { fprintf(stderr, "kernel_launch: %d CUs; this kernel splits the grid into two groups of whole XCD octets and needs a multiple of 16; nothing launched\n", cus); grid = -1; return; }
    }
    if (grid < 0) return;
    if (hipMemsetAsync((char*)d_ws + WS_CTL, 0, CTL_ZERO_BYTES, stream) != hipSuccess) { fprintf(stderr, "kernel_launch: memset failed\n"); return; }
    Args a{};
    for (int i = 0; i < 27; ++i) a.in[i] = (const float*)d_in[i];
    a.out = (float*)d_out; a.ws = (unsigned char*)d_ws;
    a.ph_lo = 0; a.ph_hi = MK_LAST_PHASE;
    hipLaunchKernelGGL(mk_fwd, dim3(grid), dim3(NWAVES * 64), LDS_BYTES, stream, a);
    const hipError_t le = hipPeekAtLastError();
    if (le != hipSuccess) fprintf(stderr, "kernel_launch: launch failed: %s\n", hipGetErrorName(le));
}
```

```cpp
#include <hip/hip_runtime.h>
#include <cstdio>
#include <cstdint>
__device__ __forceinline__ int fresh_tid() { int t = threadIdx.x; asm volatile("" : "+v"(t)); return t; }
namespace pg8 {
#define PG8_LAS __attribute__((address_space(3)))
typedef unsigned short bf16_t;
typedef short bf16x8 __attribute__((ext_vector_type(8)));
typedef float f32x4 __attribute__((ext_vector_type(4)));
typedef unsigned u32x4 __attribute__((ext_vector_type(4)));
constexpr int BM = 256, BK = 64, HALF = 128, HTB = HALF * BK * 2  , STAGE_BYTES = 8 * HTB, NXCD = 8, WGM = 8;

__host__ __device__ __forceinline__ int lds_byte(int r, int c) { const int st = (r >> 4) * 2 + (c >> 5), rr = r & 15, cc = c & 31, ob = rr * 64 + cc * 2; return st * 1024 + (ob ^ (((ob >> 9) & 1) << 5)); }
__host__ __device__ __forceinline__ void stage_rc(int b, int& R, int& C) { const int st = b / 1024, sb = b % 1024, swz = sb ^ (((sb >> 9) & 1) << 5); R = (st >> 1) * 16 + swz / 64; C = (st & 1) * 32 + (swz % 64) / 2; }
__host__ __device__ __forceinline__ int perm32(int rho) { const int n = rho >> 4, i = rho & 15; return 8 * (i >> 2) + 4 * n + (i & 3); }

struct Unit { int pm, pn, pk, koff, nt; };
struct Gemm { const bf16_t* A; const bf16_t* Bt; int M, N, K; };

struct StaticOrder {
    int nM, nN, nwg, G, c, nt, pm0, nx;
    __host__ __device__ void init(int M, int N, int G_, int c_, int K_ = 0, int pm0_ = 0, int nx_ = NXCD) { nM = M / BM; nN = N / BM; nwg = nM * nN; G = G_; c = c_; nt = K_ / BK; pm0 = pm0_; nx = nx_; }
    __host__ __device__ bool next(int i, Unit& u) const {
        const long L = (long)i * G + c; if (L >= nwg) return false;
        int wgid = (int)L; { const int q = nwg / nx, r = nwg % nx, xcd = wgid % nx, off = wgid / nx; wgid = (xcd < r ? xcd * (q + 1) : r * (q + 1) + (xcd - r) * q) + off; }
        const int nig = WGM * nN, gid = wgid / nig, fm = gid * WGM, gsz = (nM - fm) < WGM ? (nM - fm) : WGM;
        u.pm = pm0 + fm + ((wgid % nig) % gsz); u.pn = (wgid % nig) / gsz; u.pk = 0; u.koff = 0; u.nt = nt; return true;
    }
    __device__ __forceinline__ void a_ready(const Unit&) const {}
    __device__ __forceinline__ void done(const Unit&) const {}
};
struct MixedOrder : StaticOrder {
    int nMs, nS, nwgS, nts;
    __host__ __device__ void init(int M, int N, int G_, int c_, int K_, int pm0_, int Ms, int nS_, int nx_ = NXCD) { StaticOrder::init(M, N, G_, c_, K_, pm0_, nx_); nMs = Ms / BM; nS = nS_; nwgS = nMs * nN * nS; nts = K_ / BK / nS_; }
    __host__ __device__ bool next(int i, Unit& u) const {
        const long L = (long)i * G + c; if (L < nwg) return StaticOrder::next(i, u);
        const int l = (int)(L - nwg); if (l >= nwgS) return false;
        u.pk = l % nS; const int t = l / nS; u.pm = t % nMs; u.pn = t / nMs; u.koff = u.pk * nts * BK; u.nt = nts; return true;
    }
};

__device__ __forceinline__ unsigned cvt_pk_bf16(float lo, float hi) { unsigned r; asm volatile("v_cvt_pk_bf16_f32 %0, %1, %2" : "=v"(r) : "v"(lo), "v"(hi)); return r; }
__device__ __forceinline__ float silu_f(float x) { return x * __builtin_amdgcn_rcpf(1.0f + __expf(-x)); }

struct EpiF32 {
    static constexpr bool PERM = false, AFTER_DRAIN = false;
    float* C; int ldc;
    __device__ __forceinline__ void operator()(const f32x4 (&acc)[2][2][4][2], const Unit& u, int wr, int wc, int fr, int fq) const {
        const int row0 = u.pm * BM + wr * 64 + fr, col0 = u.pn * BM + wc * 32 + 4 * fq;
#pragma unroll
        for (int ai = 0; ai < 2; ++ai)
#pragma unroll
            for (int m = 0; m < 4; ++m) { float* rowp = C + (size_t)(row0 + ai * HALF + m * 16) * ldc + col0;
#pragma unroll
                for (int bj = 0; bj < 2; ++bj)
#pragma unroll
                    for (int n = 0; n < 2; ++n) *(f32x4*)(rowp + bj * HALF + n * 16) = acc[ai][bj][m][n]; }
    }
};
struct EpiY {
    static constexpr bool PERM = true, AFTER_DRAIN = false;
    bf16_t* O; int ldc; float* P; size_t split_stride; int nt_full;
    __device__ __forceinline__ void operator()(const f32x4 (&acc)[2][2][4][2], const Unit& u, int wr, int wc, int fr, int fq) const {
        const int row0 = u.pm * BM + wr * 64 + fr, col0 = u.pn * BM + wc * 32 + 8 * fq;
        if (u.nt == nt_full) {
#pragma unroll
            for (int ai = 0; ai < 2; ++ai)
#pragma unroll
                for (int m = 0; m < 4; ++m) { bf16_t* rowp = O + (size_t)(row0 + ai * HALF + m * 16) * ldc + col0;
#pragma unroll
                    for (int bj = 0; bj < 2; ++bj) { const f32x4 v0 = acc[ai][bj][m][0], v1 = acc[ai][bj][m][1];
                        u32x4 w; w.x = cvt_pk_bf16(v0[0], v0[1]); w.y = cvt_pk_bf16(v0[2], v0[3]); w.z = cvt_pk_bf16(v1[0], v1[1]); w.w = cvt_pk_bf16(v1[2], v1[3]);
                        *(u32x4*)(rowp + bj * HALF) = w; } }
        } else {
            float* Pb = P + (size_t)u.pk * split_stride;
#pragma unroll
            for (int ai = 0; ai < 2; ++ai)
#pragma unroll
                for (int m = 0; m < 4; ++m) { float* rowp = Pb + (size_t)(row0 + ai * HALF + m * 16) * ldc + col0;
#pragma unroll
                    for (int bj = 0; bj < 2; ++bj) { *(f32x4*)(rowp + bj * HALF) = acc[ai][bj][m][0]; *(f32x4*)(rowp + bj * HALF + 4) = acc[ai][bj][m][1]; } }
        }
    }
};
struct EpiSwiglu {
    static constexpr bool PERM = true, AFTER_DRAIN = false;
    bf16_t* O; int ldc;
    __device__ __forceinline__ void operator()(const f32x4 (&acc)[2][2][4][2], const Unit& u, int wr, int wc, int fr, int fq) const {
        const int row0 = u.pm * BM + wr * 64 + fr, col0 = u.pn * HALF + wc * 32 + 8 * fq;
#pragma unroll
        for (int ai = 0; ai < 2; ++ai)
#pragma unroll
            for (int m = 0; m < 4; ++m) { bf16_t* rowp = O + (size_t)(row0 + ai * HALF + m * 16) * ldc + col0;
                const f32x4 a0 = acc[ai][0][m][0], a1 = acc[ai][0][m][1], b0 = acc[ai][1][m][0], b1 = acc[ai][1][m][1];
                f32x4 v0, v1;
#pragma unroll
                for (int j = 0; j < 4; ++j) { v0[j] = silu_f(a0[j]) * b0[j]; v1[j] = silu_f(a1[j]) * b1[j]; }
                u32x4 w; w.x = cvt_pk_bf16(v0[0], v0[1]); w.y = cvt_pk_bf16(v0[2], v0[3]); w.z = cvt_pk_bf16(v1[0], v1[1]); w.w = cvt_pk_bf16(v1[2], v1[3]);
                *(u32x4*)rowp = w; }
    }
};
struct EpiProj {
    static constexpr bool PERM = true, AFTER_DRAIN = false;
    bf16_t* O; int ldc; float* gates; int gate_pn;
    __device__ __forceinline__ void operator()(const f32x4 (&acc)[2][2][4][2], const Unit& u, int wr, int wc, int fr, int fq) const {
        const int row0 = u.pm * BM + wr * 64 + fr, col0 = u.pn * BM + wc * 32 + 8 * fq;
#pragma unroll
        for (int ai = 0; ai < 2; ++ai)
#pragma unroll
            for (int m = 0; m < 4; ++m) { bf16_t* rowp = O + (size_t)(row0 + ai * HALF + m * 16) * ldc + col0;
#pragma unroll
                for (int bj = 0; bj < 2; ++bj) { const f32x4 v0 = acc[ai][bj][m][0], v1 = acc[ai][bj][m][1];
                    u32x4 w; w.x = cvt_pk_bf16(v0[0], v0[1]); w.y = cvt_pk_bf16(v0[2], v0[3]); w.z = cvt_pk_bf16(v1[0], v1[1]); w.w = cvt_pk_bf16(v1[2], v1[3]);
                    *(u32x4*)(rowp + bj * HALF) = w; } }
        if (u.pn == gate_pn && wc == 0) {
#pragma unroll
            for (int ai = 0; ai < 2; ++ai)
#pragma unroll
                for (int m = 0; m < 4; ++m) { float* gp = gates + (size_t)(row0 + ai * HALF + m * 16) * 32 + 8 * fq;
                    *(f32x4*)gp = acc[ai][0][m][0]; *(f32x4*)(gp + 4) = acc[ai][0][m][1]; }
        }
    }
};

template <class Epi, class Sched, bool ALIGN_EPI = false, bool SP2 = false>
__device__ __forceinline__ void gemm_phase(PG8_LAS unsigned char* lds, const Gemm g, const Sched& S, const Epi& E) {
    const int tid = fresh_tid(), wid = __builtin_amdgcn_readfirstlane(tid >> 6), lane = tid & 63, wr = wid >> 2, wc = wid & 3, fr = lane & 15, fq = lane >> 4;
    const int ld = g.K;
    unsigned voffA[2], voffB[2];
#pragma unroll
    for (int i = 0; i < 2; ++i) { int R, C; stage_rc(tid * 16 + i * 8192, R, C); const int Rb = Epi::PERM ? ((R & ~31) + perm32(R & 31)) : R;
        voffA[i] = (unsigned)(R * ld + C) * 2u; voffB[i] = (unsigned)(Rb * ld + C) * 2u; }
    const size_t kstep = (size_t)(BK * 2);
    const size_t hstep = (size_t)HALF * ld * 2;
    const size_t tstep = 2 * hstep;
    const unsigned ldsw = (unsigned)wid * 1024u;
    const int aoff = lds_byte(wr * 64 + fr, fq * 8), boff = lds_byte(wc * 32 + fr, fq * 8);
#define PG8_SA(b, h) (((b) * 2 + (h)) * HTB)
#define PG8_SB(b, h) ((4 + (b) * 2 + (h)) * HTB)
#define PG8_STAGE(bufoff, gbase, voff) do { _Pragma("unroll") for (int _i = 0; _i < 2; ++_i) \
        __builtin_amdgcn_global_load_lds((const unsigned*)((const char*)(gbase) + (voff)[_i]), (PG8_LAS unsigned*)(lds + (bufoff) + ldsw + _i * 8192), 16, 0, 0); } while (0)
#define PG8_LDA(dst, b, h) do { _Pragma("unroll") for (int m = 0; m < 4; ++m) _Pragma("unroll") for (int k = 0; k < 2; ++k) dst[m][k] = *(const PG8_LAS bf16x8*)(lds + PG8_SA(b, h) + aoff + m * 2048 + k * 1024); } while (0)
#define PG8_LDB(dst, b, h) do { _Pragma("unroll") for (int n = 0; n < 2; ++n) _Pragma("unroll") for (int k = 0; k < 2; ++k) dst[n][k] = *(const PG8_LAS bf16x8*)(lds + PG8_SB(b, h) + boff + n * 2048 + k * 1024); } while (0)
#define PG8_MMA(ai, bj, At, Bt) do { __builtin_amdgcn_s_setprio(1); _Pragma("unroll") for (int m = 0; m < 4; ++m) _Pragma("unroll") for (int n = 0; n < 2; ++n) _Pragma("unroll") for (int k = 0; k < 2; ++k) \
        acc[ai][bj][m][n] = __builtin_amdgcn_mfma_f32_16x16x32_bf16(Bt[n][k], At[m][k], acc[ai][bj][m][n], 0, 0, 0); __builtin_amdgcn_s_setprio(0); } while (0)
#define PG8_WAIT_V(n) asm volatile("s_waitcnt vmcnt(" #n ")" ::: "memory")
#define PG8_WAIT_L(n) asm volatile("s_waitcnt lgkmcnt(" #n ")" ::: "memory")
#define PG8_BAR __builtin_amdgcn_s_barrier()
#define PG8_SCHED __builtin_amdgcn_sched_barrier(0)
    Unit cur, nxt; int ui = 0;
    if (!S.next(0, cur)) return;
    int nt = cur.nt;
    f32x4 acc[2][2][4][2];
#pragma unroll
    for (int a = 0; a < 2; ++a)
#pragma unroll
        for (int b = 0; b < 2; ++b)
#pragma unroll
            for (int m = 0; m < 4; ++m)
#pragma unroll
                for (int n = 0; n < 2; ++n) acc[a][b][m][n] = (f32x4){0.f, 0.f, 0.f, 0.f};
    bf16x8 At[4][2], B0[2][2], B1[2][2];
    const char* cA = (const char*)g.A + (size_t)cur.pm * tstep + (size_t)cur.koff * 2; const char* cB = (const char*)g.Bt + (size_t)cur.pn * tstep + (size_t)cur.koff * 2;
    S.a_ready(cur);
    if constexpr (SP2) {
        PG8_STAGE(PG8_SB(0, 0), cB, voffB); PG8_STAGE(PG8_SB(0, 1), cB + hstep, voffB); PG8_STAGE(PG8_SA(0, 0), cA, voffA); PG8_STAGE(PG8_SA(0, 1), cA + hstep, voffA);
        if (wr == 1) PG8_BAR;
        PG8_WAIT_V(2); PG8_BAR;
        PG8_STAGE(PG8_SB(1, 0), cB + kstep, voffB); PG8_STAGE(PG8_SA(1, 0), cA + kstep, voffA); PG8_STAGE(PG8_SB(1, 1), cB + hstep + kstep, voffB);
        PG8_WAIT_V(6); PG8_BAR;
    } else {
        PG8_STAGE(PG8_SB(0, 0), cB, voffB); PG8_STAGE(PG8_SA(0, 0), cA, voffA); PG8_STAGE(PG8_SB(0, 1), cB + hstep, voffB); PG8_STAGE(PG8_SA(0, 1), cA + hstep, voffA);
        if (wr == 1) PG8_BAR;
        PG8_WAIT_V(4); PG8_BAR;
        PG8_STAGE(PG8_SB(1, 0), cB + kstep, voffB); PG8_STAGE(PG8_SA(1, 0), cA + kstep, voffA); PG8_STAGE(PG8_SB(1, 1), cB + hstep + kstep, voffB);
        PG8_WAIT_V(6); PG8_BAR;
    }
    for (;;) {
        const bool has_next = S.next(ui + 1, nxt);
        const char* nA = has_next ? (const char*)g.A + (size_t)nxt.pm * tstep + (size_t)nxt.koff * 2 : cA; const char* nB = has_next ? (const char*)g.Bt + (size_t)nxt.pn * tstep + (size_t)nxt.koff * 2 : cB;
        for (int t = 0; t < nt; t += 2) {
            const bool last = (t == nt - 2);
            const char* a1 = cA + (size_t)(t + 1) * kstep;
            const char* a2 = last ? nA : cA + (size_t)(t + 2) * kstep; const char* b2 = last ? nB : cB + (size_t)(t + 2) * kstep;
            const char* a3 = a2 + kstep; const char* b3 = b2 + kstep;
            if (last && has_next) S.a_ready(nxt);
            if constexpr (SP2) {
            PG8_LDB(B0, 0, 0); PG8_LDB(B1, 0, 1); PG8_SCHED; PG8_LDA(At, 0, 0); PG8_STAGE(PG8_SA(1, 1), a1 + hstep, voffA);
            PG8_WAIT_V(8); PG8_WAIT_L(0); PG8_BAR; PG8_MMA(0, 0, At, B0); PG8_MMA(0, 1, At, B1); PG8_BAR; PG8_SCHED;
            PG8_LDA(At, 0, 1); PG8_STAGE(PG8_SB(0, 0), b2, voffB); PG8_STAGE(PG8_SB(0, 1), b2 + hstep, voffB); PG8_STAGE(PG8_SA(0, 0), a2, voffA);
            PG8_WAIT_V(8); PG8_WAIT_L(0); PG8_BAR; PG8_MMA(1, 0, At, B0); PG8_MMA(1, 1, At, B1); PG8_BAR; PG8_SCHED;
            PG8_LDB(B0, 1, 0); PG8_LDB(B1, 1, 1); PG8_SCHED; PG8_LDA(At, 1, 0); PG8_STAGE(PG8_SA(0, 1), a2 + hstep, voffA);
            PG8_WAIT_V(8); PG8_WAIT_L(0); PG8_BAR; PG8_MMA(0, 0, At, B0); PG8_MMA(0, 1, At, B1); PG8_BAR; PG8_SCHED;
            PG8_LDA(At, 1, 1); PG8_STAGE(PG8_SB(1, 0), b3, voffB); PG8_STAGE(PG8_SB(1, 1), b3 + hstep, voffB); PG8_STAGE(PG8_SA(1, 0), a3, voffA);
            PG8_WAIT_V(8); PG8_WAIT_L(0); PG8_BAR; PG8_MMA(1, 0, At, B0); PG8_MMA(1, 1, At, B1); PG8_BAR; PG8_SCHED;
            } else {
            PG8_LDB(B0, 0, 0); PG8_SCHED; PG8_LDA(At, 0, 0); PG8_STAGE(PG8_SA(1, 1), a1 + hstep, voffA);
            PG8_WAIT_L(8); PG8_BAR; PG8_WAIT_L(0); PG8_MMA(0, 0, At, B0); PG8_BAR; PG8_SCHED;
            PG8_LDB(B1, 0, 1); PG8_STAGE(PG8_SB(0, 0), b2, voffB);
            PG8_BAR; PG8_WAIT_L(0); PG8_MMA(0, 1, At, B1); PG8_BAR;
            PG8_LDA(At, 0, 1); PG8_STAGE(PG8_SA(0, 0), a2, voffA);
            PG8_BAR; PG8_WAIT_L(0); PG8_MMA(1, 0, At, B0); PG8_BAR; PG8_SCHED;
            PG8_STAGE(PG8_SB(0, 1), b2 + hstep, voffB);
            PG8_WAIT_V(6); PG8_BAR; PG8_MMA(1, 1, At, B1); PG8_BAR;
            PG8_LDB(B0, 1, 0); PG8_SCHED; PG8_LDA(At, 1, 0); PG8_STAGE(PG8_SA(0, 1), a2 + hstep, voffA);
            PG8_WAIT_L(8); PG8_BAR; PG8_WAIT_L(0); PG8_MMA(0, 0, At, B0); PG8_BAR; PG8_SCHED;
            PG8_LDB(B1, 1, 1); PG8_STAGE(PG8_SB(1, 0), b3, voffB);
            PG8_BAR; PG8_WAIT_L(0); PG8_MMA(0, 1, At, B1); PG8_BAR;
            PG8_LDA(At, 1, 1); PG8_STAGE(PG8_SA(1, 0), a3, voffA);
            PG8_BAR; PG8_WAIT_L(0); PG8_MMA(1, 0, At, B0); PG8_BAR; PG8_SCHED;
            PG8_STAGE(PG8_SB(1, 1), b3 + hstep, voffB);
            PG8_WAIT_V(6); PG8_BAR; PG8_MMA(1, 1, At, B1); PG8_BAR;
            }
        }
        if constexpr (ALIGN_EPI) { if (wr == 0) PG8_BAR; }
        if constexpr (!Epi::AFTER_DRAIN) { E(acc, cur, wr, wc, fr, fq); S.done(cur); }
        if (!has_next) break;
#pragma unroll
        for (int a = 0; a < 2; ++a)
#pragma unroll
            for (int b = 0; b < 2; ++b)
#pragma unroll
                for (int m = 0; m < 4; ++m)
#pragma unroll
                    for (int n = 0; n < 2; ++n) acc[a][b][m][n] = (f32x4){0.f, 0.f, 0.f, 0.f};
        cur = nxt; cA = nA; cB = nB; ++ui; nt = cur.nt;
        if constexpr (ALIGN_EPI) { if (wr == 1) PG8_BAR; }
    }
    PG8_WAIT_V(0);
    if constexpr (!ALIGN_EPI) { if (wr == 0) PG8_BAR; }
    PG8_BAR;
    if constexpr (Epi::AFTER_DRAIN) { E.fused(acc, cur, wr, wc, fr, fq, lds, wid, lane); S.done(cur); }
#undef PG8_SA
#undef PG8_SB
#undef PG8_STAGE
#undef PG8_LDA
#undef PG8_LDB
#undef PG8_MMA
#undef PG8_WAIT_V
#undef PG8_WAIT_L
#undef PG8_BAR
#undef PG8_SCHED
}
}

#ifndef PG8_SP2
#define PG8_SP2 true
#endif
#ifndef PG8_ALIGN
#define PG8_ALIGN true
#endif

constexpr int NWAVES = 8;
constexpr int D = 2048, NB = 8, SEQ = 4096, CTXL = 256, DFF = 5632, NMOD = 9;
constexpr int NGRP = 2, NBG = NB / NGRP;
constexpr int MC = NBG * CTXL;
constexpr int MLAT = NBG * SEQ;
constexpr int M = MC + MLAT;
constexpr int NP0 = 5376, NP1 = 6400;
constexpr int NCH = (CTXL + SEQ) / 64;
constexpr int KSPLIT = 4;
constexpr float EPS = 1e-6f;
constexpr float QSCALE = 0.08838834764831845f;

constexpr size_t MiB = 1u << 20;
constexpr size_t WS_CTL = 0, CTL_ZERO_BYTES = 1 * MiB;
constexpr size_t WS_MOD = 1 * MiB;
constexpr size_t WS_GATES = 3 * MiB, GATES_G = (size_t)M * 32 * 4;
constexpr size_t WS_WRG = 8 * MiB;
constexpr size_t WS_PE = 9 * MiB;
constexpr size_t WS_HCTX = 10 * MiB;
constexpr size_t WS_W = 26 * MiB, W_LAYER = 165 * MiB;
constexpr size_t W_F1I = 0, W_F1O = W_F1I + 44 * MiB, W_F2I = W_F1O + 22 * MiB, W_F2O = W_F2I + 44 * MiB, W_MI = W_F2O + 22 * MiB, W_MO = W_MI + 25 * MiB;
constexpr size_t WS_U = 356 * MiB, U_G = (size_t)M * D * 2;
constexpr size_t WS_Y = 492 * MiB, Y_G = (size_t)M * D * 4;
constexpr size_t WS_BIG = 764 * MiB, BIG_G = (size_t)M * NP1 * 2;
constexpr size_t YC_OFF = (size_t)M * D * 2;
constexpr size_t WS_END = 1189 * MiB;
static_assert(W_MO + 8 * MiB <= W_LAYER && WS_W + 2 * W_LAYER <= WS_U && WS_U + NGRP * U_G <= WS_Y && WS_Y + NGRP * Y_G <= WS_BIG && WS_BIG + NGRP * BIG_G <= WS_END, "ws map");
static_assert(YC_OFF + (size_t)KSPLIT * MC * D * 4 <= Y_G && WS_GATES + NGRP * GATES_G <= WS_WRG, "ws map (group blocks)");
constexpr int CW_BAR = 4096;
constexpr int CW_W1READY = 64;

constexpr int SCR_BYTES = 151552;
constexpr int LDSCTL_OFF = SCR_BYTES;
constexpr int LDS_BYTES = 155648;

#define GAS __attribute__((address_space(1)))
#define LAS __attribute__((address_space(3)))
typedef unsigned short bf16;
typedef float f32x4 __attribute__((ext_vector_type(4)));
typedef float f32x2 __attribute__((ext_vector_type(2)));
typedef short bf16x8 __attribute__((ext_vector_type(8)));
typedef short bf16x4 __attribute__((ext_vector_type(4)));
typedef unsigned u32x4 __attribute__((ext_vector_type(4)));
typedef unsigned u32x2 __attribute__((ext_vector_type(2)));
#define LDS_WAIT() asm volatile("s_waitcnt lgkmcnt(0)" ::: "memory")
__device__ __forceinline__ unsigned f2bf(float f) { unsigned u = __builtin_bit_cast(unsigned, f); return (u + 0x7fffu + ((u >> 16) & 1u)) >> 16; }
__device__ __forceinline__ unsigned pk2(float lo, float hi) { return pg8::cvt_pk_bf16(lo, hi); }
__device__ __forceinline__ float bflo(unsigned w) { return __uint_as_float(w << 16); }
__device__ __forceinline__ float bfhi(unsigned w) { return __uint_as_float(w & 0xffff0000u); }
__device__ __forceinline__ float wave_sum(float v) {
#pragma unroll
    for (int o = 1; o < 64; o <<= 1) v += __shfl_xor(v, o);
    return v;
}
__device__ __forceinline__ float sigmoid_f(float x) { return __builtin_amdgcn_rcpf(1.0f + __expf(-x)); }
__device__ __forceinline__ float silu_f(float x) { return x * sigmoid_f(x); }
__device__ __forceinline__ float logsig_f(float z) { return fminf(z, 0.f) - __logf(1.0f + __expf(-fabsf(z))); }
__device__ __forceinline__ float gelu_tanh_f(float x) { const float u = 0.7978845608028654f * (x + 0.044715f * x * x * x); const float t = 1.0f - 2.0f * __builtin_amdgcn_rcpf(1.0f + __expf(2.0f * u)); return 0.5f * x * (1.0f + t); }

#define XB_TMO      128
#define XB_XCNT(j)  (256  + 64 * (j))
#define XB_XSUB(j)  (1280 + 64 * (j))
#define XB_XGEN(j)  (2304 + 64 * (j))
#define XB_TOP      3328
#define XB_TOPGEN   3392
#define XCD_BAR_WORDS 3456
#define XB_SPIN_CAP (1u << 18)

__device__ __forceinline__ unsigned xb_ld(unsigned* p)              { return __hip_atomic_load(p, __ATOMIC_RELAXED, __HIP_MEMORY_SCOPE_AGENT); }
__device__ __forceinline__ unsigned xb_add(unsigned* p, unsigned v) { return __hip_atomic_fetch_add(p, v, __ATOMIC_RELAXED, __HIP_MEMORY_SCOPE_AGENT); }
__device__ __forceinline__ unsigned xb_xcc_id() { return (unsigned)__builtin_amdgcn_s_getreg((3 << 11) | 20) & 0xFu; }
#define XB_SPIN(cond, bar) do { unsigned _sp = 0; while (cond) { __builtin_amdgcn_s_sleep(1); \
    if ((++_sp & 255u) == 0u) { if (xb_ld(&(bar)[XB_TMO])) break; if (_sp > XB_SPIN_CAP) { atomicAdd(&(bar)[XB_TMO], 1u); break; } } } } while (0)

struct XcdBarrier {
    unsigned* bar; unsigned x; unsigned ntot;
    volatile LAS unsigned* st;
};

__device__ __forceinline__ XcdBarrier xcd_barrier_post(unsigned* bar, volatile LAS unsigned* st, unsigned ntot) {
    XcdBarrier b; b.bar = bar; b.x = xb_xcc_id(); b.st = st; b.ntot = ntot;
    if (threadIdx.x == 0) (void)xb_add(&bar[XB_XCNT(b.x)], 1u);
    return b;
}
__device__ __forceinline__ void xcd_barrier_complete(unsigned* bar, unsigned x, unsigned G, unsigned& nloc, unsigned& nx) {
    unsigned sum, cnt, mine, sp = 0u;
    for (;;) {
        sum = 0u; cnt = 0u; mine = 0u;
#pragma unroll
        for (unsigned j = 0; j < 16; ++j) { const unsigned c = xb_ld(&bar[XB_XCNT(j)]); sum += c; cnt += (c > 0u) ? 1u : 0u; mine = (j == x) ? c : mine; }
        if (sum == G) break;
        __builtin_amdgcn_s_sleep(1);
        if ((++sp & 255u) == 0u) { if (xb_ld(&bar[XB_TMO])) break; if (sp > XB_SPIN_CAP) { atomicAdd(&bar[XB_TMO], 1u); break; } }
    }
    nloc = mine > 0u ? mine : 1u; nx = cnt > 0u ? cnt : 1u;
}

__device__ __forceinline__ void xcd_barrier(const XcdBarrier& b) {
    asm volatile("s_waitcnt vmcnt(0)" ::: "memory");
    __syncthreads();
    if (threadIdx.x == 0) {
        unsigned* bar = b.bar;
        __builtin_amdgcn_s_waitcnt(0);
        unsigned nloc = b.st[0], nx = b.st[1];
        if (nloc == 0u) { xcd_barrier_complete(bar, b.x, b.ntot, nloc, nx); b.st[0] = nloc; b.st[1] = nx; }
        const unsigned old = xb_add(&bar[XB_XSUB(b.x)], 1u);
        const unsigned gen = old / nloc;
        if (old + 1u == (gen + 1u) * nloc) {
            __builtin_amdgcn_fence(__ATOMIC_RELEASE, "agent");
            asm volatile("s_waitcnt vmcnt(0)" ::: "memory");
            const unsigned og = xb_add(&bar[XB_TOP], 1u);
            const unsigned tg = og / nx;
            if (og + 1u == (tg + 1u) * nx) xb_add(&bar[XB_TOPGEN], 1u);
            else XB_SPIN(xb_ld(&bar[XB_TOPGEN]) == tg, bar);
            __builtin_amdgcn_fence(__ATOMIC_ACQUIRE, "agent");
            xb_add(&bar[XB_XGEN(b.x)], 1u);
            asm volatile("s_waitcnt vmcnt(0)" ::: "memory");
        } else {
            XB_SPIN(xb_ld(&bar[XB_XGEN(b.x)]) == gen, bar);
            __builtin_amdgcn_fence(__ATOMIC_ACQUIRE, "agent");
            asm volatile("s_waitcnt vmcnt(0)" ::: "memory");
        }
    }
    __syncthreads();
}

struct Args { const float* in[27]; float* out; unsigned char* ws; int ph_lo, ph_hi; };
struct Frame {
    LAS unsigned char* lds;
    int G, wg, NGW;
    int grp;
    float* out; unsigned char* ws;
    const Args& A;
};
__device__ __forceinline__ bf16* gU(const Frame& F) { return (bf16*)(F.ws + WS_U + (size_t)F.grp * U_G); }
__device__ __forceinline__ bf16* gY(const Frame& F) { return (bf16*)(F.ws + WS_Y + (size_t)F.grp * Y_G); }
__device__ __forceinline__ bf16* gBIG(const Frame& F) { return (bf16*)(F.ws + WS_BIG + (size_t)F.grp * BIG_G); }
__device__ __forceinline__ float* gYC(const Frame& F) { return (float*)(F.ws + WS_Y + (size_t)F.grp * Y_G + YC_OFF); }
__device__ __forceinline__ float* gGATES(const Frame& F) { return (float*)(F.ws + WS_GATES + (size_t)F.grp * GATES_G); }
enum { I_X = 0, I_C, I_CTX, I_CCTX, I_WMOD, I_BMOD, I_NORMG, I_F1WI, I_F1WO, I_F2WI, I_F2WO, I_ABWI, I_WALPHA2, I_BALPHA, I_GLANG, I_CONVW, I_CONVB, I_RGWA, I_RGBA, I_RGWI, I_RGBI, I_LAM, I_ABWO, I_MLWI, I_MLBG, I_MLNG, I_MLWO };

__device__ __forceinline__ void pre_mod(Frame& F) {
    const int tid_ = fresh_tid(); const int lane_ = tid_ & 63, wave_ = __builtin_amdgcn_readfirstlane(tid_ >> 6), gw_ = F.wg * NWAVES + wave_; (void)lane_; (void)gw_;
    LAS float* sc = (LAS float*)F.lds;
    LAS float* red = (LAS float*)(F.lds + 9 * 2048 * 4);
    for (int i = tid_; i < 9 * 2048; i += 512) { const int bb = i >> 11, k = i & 2047; const float v = bb < 8 ? F.A.in[I_C][bb * 2048 + k] : F.A.in[I_CCTX][k]; sc[i] = v * (1.0f / (1.0f + expf(-v))); }
    __syncthreads();
    float* MOD = (float*)(F.ws + WS_MOD);
    const int q = tid_ & 15, kg = tid_ >> 4;
    for (int item = F.wg; item < 2 * 288; item += F.G) {
        const int layer = item / 288, col0 = (item % 288) * 64;
        const float* wp = F.A.in[I_WMOD] + ((size_t)layer * 2048 + (size_t)kg * 64) * 18432 + col0 + 4 * q;
        f32x4 acc[9];
#pragma unroll
        for (int bb = 0; bb < 9; ++bb) acc[bb] = (f32x4){0.f, 0.f, 0.f, 0.f};
#pragma unroll 4
        for (int kk = 0; kk < 64; ++kk) {
            const f32x4 w = *(const f32x4*)(wp + (size_t)kk * 18432);
#pragma unroll
            for (int bb = 0; bb < 9; ++bb) acc[bb] += w * sc[bb * 2048 + kg * 64 + kk];
        }
#pragma unroll
        for (int bb = 0; bb < 9; ++bb)
#pragma unroll
            for (int e = 0; e < 4; ++e) { float v = acc[bb][e]; v += __shfl_xor(v, 16); v += __shfl_xor(v, 32); acc[bb][e] = v; }
        __syncthreads();
        if (lane_ < 16) {
#pragma unroll
            for (int bb = 0; bb < 9; ++bb) *(LAS f32x4*)(red + (wave_ * 9 + bb) * 64 + 4 * q) = acc[bb];
        }
        __syncthreads();
        for (int t = tid_; t < 9 * 64; t += 512) { const int bb = t >> 6, ci = t & 63; float s = F.A.in[I_BMOD][layer * 18432 + col0 + ci];
#pragma unroll
            for (int w = 0; w < 8; ++w) s += red[(w * 9 + bb) * 64 + ci];
            MOD[((size_t)layer * 9 + bb) * 18432 + col0 + ci] = s; }
    }
    __syncthreads();
}
__device__ __forceinline__ void pre_pe(Frame& F) {
    const int tid_ = fresh_tid(); const int lane_ = tid_ & 63, wave_ = __builtin_amdgcn_readfirstlane(tid_ >> 6), gw_ = F.wg * NWAVES + wave_; (void)lane_; (void)gw_;
    float* PE = (float*)(F.ws + WS_PE);
    for (int i = F.wg * 512 + tid_; i < 64 * 512; i += F.G * 512) {
        const int p = i >> 9, f = i & 511;
        const float om = (float)exp2(-(double)f * (13.287712379549449 / 512.0));
        const float angf = (float)p * om; const double x = (double)angf;
        const double kf = rint(x * 0.6366197723675814);
        double r = fma(-kf, 1.5707963267948966, x); r = fma(-kf, 6.123233995736766e-17, r);
        const int k = ((int)kf) & 3; const double r2 = r * r;
        const double sp = r * (1.0 + r2 * (-1.0 / 6.0 + r2 * (1.0 / 120.0 + r2 * (-1.0 / 5040.0 + r2 * (1.0 / 362880.0 + r2 * (-1.0 / 39916800.0 + r2 * (1.0 / 6227020800.0)))))));
        const double cp = 1.0 + r2 * (-0.5 + r2 * (1.0 / 24.0 + r2 * (-1.0 / 720.0 + r2 * (1.0 / 40320.0 + r2 * (-1.0 / 3628800.0 + r2 * (1.0 / 479001600.0))))));
        const double s = (k == 0) ? sp : (k == 1) ? cp : (k == 2) ? -sp : -cp;
        const double c = (k == 0) ? cp : (k == 1) ? -sp : (k == 2) ? -cp : sp;
        PE[p * 1024 + f] = (float)s; PE[p * 1024 + 512 + f] = (float)c;
    }
}
template <int MAP> __device__ __forceinline__ int cvt_row(int n) {
    if (MAP == 1) return n < DFF ? ((n >> 7) << 8) + (n & 127) : (((n - DFF) >> 7) << 8) + 128 + ((n - DFF) & 127);
    if (MAP == 2) return n < 3072 ? n : (n < 3104 ? n + 2048 : n - 32);
    return n;
}
template <int MAP> __device__ __forceinline__ void cvt_item(const float* W, int K, int N, bf16* WT, LAS float* scr, int item, int lane) {
    const int nblk = N / 32, kb = item / nblk, nb = item % nblk, k0 = 64 * kb, n0 = 32 * nb;
#pragma unroll 8
    for (int i = 0; i < 32; ++i) { const int kk = 2 * i + (lane >> 5); scr[kk * 33 + (lane & 31)] = W[(size_t)(k0 + kk) * N + n0 + (lane & 31)]; }
    LDS_WAIT(); asm volatile("" ::: "memory");
    const int c = lane & 7;
#pragma unroll
    for (int j = 0; j < 4; ++j) { const int n = (lane >> 3) + 8 * j; const LAS float* s = scr + (8 * c) * 33 + n;
        u32x4 o; o.x = pk2(s[0 * 33], s[1 * 33]); o.y = pk2(s[2 * 33], s[3 * 33]); o.z = pk2(s[4 * 33], s[5 * 33]); o.w = pk2(s[6 * 33], s[7 * 33]);
        *(u32x4*)(WT + (size_t)cvt_row<MAP>(n0 + n) * K + k0 + 8 * c) = o; }
    LDS_WAIT(); asm volatile("" ::: "memory");
}
template <int LAYER> __device__ __forceinline__ void cvt_layer(Frame& F, int pct_lo = 0, int pct_hi = 100) {
    const int tid_ = fresh_tid(); const int lane_ = tid_ & 63, wave_ = __builtin_amdgcn_readfirstlane(tid_ >> 6), gw_ = F.wg * NWAVES + wave_; (void)lane_; (void)gw_;
    LAS float* scr = (LAS float*)(F.lds + wave_ * 16384);
    constexpr int I0 = 32 * 352, I1 = 88 * 64, I4 = LAYER == 0 ? 32 * 161 : 32 * 193, I5 = 32 * 64, I6 = LAYER == 0 ? 256 : 0;
    constexpr int NITEMS = 2 * I0 + 2 * I1 + I4 + I5 + I6;
    const float* f1i = F.A.in[I_F1WI] + (size_t)LAYER * D * 2 * DFF; const float* f1o = F.A.in[I_F1WO] + (size_t)LAYER * DFF * D;
    const float* f2i = F.A.in[I_F2WI] + (size_t)LAYER * D * 2 * DFF; const float* f2o = F.A.in[I_F2WO] + (size_t)LAYER * DFF * D;
    const int it_lo = (int)((long)NITEMS * pct_lo / 100), it_hi = (int)((long)NITEMS * pct_hi / 100);
    for (int it = it_lo + gw_; it < it_hi; it += F.NGW) {
        int r = it;
        if (r < I0) { cvt_item<1>(f1i, D, 2 * DFF, (bf16*)(F.ws + WS_W + LAYER * W_LAYER + W_F1I), scr, r, lane_); continue; } r -= I0;
        if (r < I1) { cvt_item<0>(f1o, DFF, D, (bf16*)(F.ws + WS_W + LAYER * W_LAYER + W_F1O), scr, r, lane_); continue; } r -= I1;
        if (r < I0) { cvt_item<1>(f2i, D, 2 * DFF, (bf16*)(F.ws + WS_W + LAYER * W_LAYER + W_F2I), scr, r, lane_); continue; } r -= I0;
        if (r < I1) { cvt_item<0>(f2o, DFF, D, (bf16*)(F.ws + WS_W + LAYER * W_LAYER + W_F2O), scr, r, lane_); continue; } r -= I1;
        if (r < I4) { if (LAYER == 0) cvt_item<2>(F.A.in[I_ABWI], D, 5152, (bf16*)(F.ws + WS_W + LAYER * W_LAYER + W_MI), scr, r, lane_); else cvt_item<0>(F.A.in[I_MLWI], D, 6176, (bf16*)(F.ws + WS_W + LAYER * W_LAYER + W_MI), scr, r, lane_); continue; } r -= I4;
        if (r < I5) { cvt_item<0>(LAYER == 0 ? F.A.in[I_ABWO] : F.A.in[I_MLWO], D, D, (bf16*)(F.ws + WS_W + LAYER * W_LAYER + W_MO), scr, r, lane_); continue; } r -= I5;
        if (LAYER == 0) { const int mi = r >> 3, sub = r & 7, dir = mi >> 4, mat = (mi >> 3) & 1, n = mi & 7;
            const float* src = (mat ? F.A.in[I_RGWI] : F.A.in[I_RGWA]) + (size_t)(dir * 8 + n) * 128 * 128;
            cvt_item<0>(src, 128, 128, (bf16*)(F.ws + WS_WRG) + (size_t)mi * 128 * 128, scr, sub, lane_); }
    }
    constexpr int PR0 = LAYER == 0 ? 5152 : 6176, PR1 = LAYER == 0 ? NP0 : NP1;
    u32x4* z = (u32x4*)((bf16*)(F.ws + WS_W + LAYER * W_LAYER + W_MI) + (size_t)PR0 * D);
    if (pct_hi == 100) for (int i = F.wg * 512 + tid_; i < (PR1 - PR0) * D / 8; i += F.G * 512) z[i] = (u32x4){0u, 0u, 0u, 0u};
}

__device__ __forceinline__ float* hrow(Frame& F, int r) { return r < MC ? (float*)(F.ws + WS_HCTX) + (size_t)(r + F.grp * MC) * D : F.out + (size_t)((r - MC) + F.grp * MLAT) * D; }
template <bool INIT, bool HAS_Y, bool HAS_U>
__device__ __forceinline__ void nrm_rows(Frame& F, int row_lo, int row_hi, float wgt, const float* gpost, const float* mod_g, int gate_slot,
                                         const float* gpre, const float* mod_u, int shift_slot, int scale_slot) {
    const int tid_ = fresh_tid(); const int lane_ = tid_ & 63, wave_ = __builtin_amdgcn_readfirstlane(tid_ >> 6);
    constexpr int R = 8;
    const bf16* Yb = gY(F); bf16* U = gU(F); const float* PE = (const float*)(F.ws + WS_PE);
    LAS float* PS = (LAS float*)F.lds;
    const int col = 256 * wave_ + 4 * lane_;
    const int nblk = (row_hi - row_lo) / R;
    int cur_bb = -1;
    f32x4 gp = (f32x4){0.f, 0.f, 0.f, 0.f}, gt = gp, gn = gp, sh = gp, sc = gp;
    if (HAS_Y) gp = *(const f32x4*)(gpost + col);
    if (HAS_U) gn = *(const f32x4*)(gpre + col);
    __syncthreads();
    f32x4 hn[R]; u32x2 yn[R];
#define NRM_LOAD(blk_) do { const int r0_ = row_lo + (blk_) * R; \
        _Pragma("unroll") for (int i = 0; i < R; ++i) { const int r = r0_ + i; \
            if (INIT) hn[i] = r < MC ? *(const f32x4*)(F.A.in[I_CTX] + (size_t)(r + F.grp * MC) * D + col) : *(const f32x4*)(F.A.in[I_X] + (size_t)((r - MC) + F.grp * MLAT) * D + col); \
            else hn[i] = *(const f32x4*)(hrow(F, r) + col); \
            if (HAS_Y) { if (r0_ >= MC) yn[i] = *(const u32x2*)(Yb + (size_t)r * D + col); } } } while (0)
    int blk = F.wg;
    if (blk < nblk) NRM_LOAD(blk);
    for (; blk < nblk; blk += F.G) {
        const int r0 = row_lo + blk * R;
        const int bb = r0 < MC ? 8 : F.grp * NBG + ((r0 - MC) >> 12);
        if (bb != cur_bb) { cur_bb = bb;
            if (HAS_Y) gt = *(const f32x4*)(mod_g + ((size_t)bb * 9 + gate_slot) * D + col);
            if (HAS_U) { sh = *(const f32x4*)(mod_u + ((size_t)bb * 9 + shift_slot) * D + col); sc = *(const f32x4*)(mod_u + ((size_t)bb * 9 + scale_slot) * D + col) + 1.0f; } }
        f32x4 hv[R]; u32x2 yr[R];
#pragma unroll
        for (int i = 0; i < R; ++i) { hv[i] = hn[i]; yr[i] = yn[i]; }
        if (blk + F.G < nblk) NRM_LOAD(blk + F.G);
        if (INIT) { if (r0 >= MC) {
#pragma unroll
            for (int i = 0; i < R; ++i) { const int t = (r0 + i - MC) & (SEQ - 1), prow = t >> 6, pcol = t & 63;
                hv[i] = hv[i] + (col < 1024 ? *(const f32x4*)(PE + prow * 1024 + col) : *(const f32x4*)(PE + pcol * 1024 + col - 1024)); } } }
        if (HAS_Y) {
            f32x4 yv[R];
#pragma unroll
            for (int i = 0; i < R; ++i) {
                if (r0 < MC) { const float* yc = gYC(F) + (size_t)(r0 + i) * D + col;
                    f32x4 s = *(const f32x4*)yc;
#pragma unroll
                    for (int k = 1; k < KSPLIT; ++k) s = s + *(const f32x4*)(yc + (size_t)k * MC * D);
                    yv[i] = s; }
                else yv[i] = (f32x4){bflo(yr[i].x), bfhi(yr[i].x), bflo(yr[i].y), bfhi(yr[i].y)}; }
#pragma unroll
            for (int i = 0; i < R; ++i) { const float ss = wave_sum((yv[i].x * yv[i].x + yv[i].y * yv[i].y) + (yv[i].z * yv[i].z + yv[i].w * yv[i].w)); if (lane_ == 0) PS[i * 8 + wave_] = ss; }
            asm volatile("s_waitcnt lgkmcnt(0)" ::: "memory"); __builtin_amdgcn_s_barrier(); asm volatile("" ::: "memory");
#pragma unroll
            for (int i = 0; i < R; ++i) { const f32x4 p0 = *(const LAS f32x4*)(PS + i * 8), p1 = *(const LAS f32x4*)(PS + i * 8 + 4);
                const float tot = ((p0.x + p0.y) + (p0.z + p0.w)) + ((p1.x + p1.y) + (p1.z + p1.w));
                const float r1 = rsqrtf(tot * (1.0f / D) + EPS) * wgt;
                hv[i] = hv[i] + gt * (yv[i] * r1 * gp); }
        }
        if (INIT || HAS_Y) {
#pragma unroll
            for (int i = 0; i < R; ++i) *(f32x4*)(hrow(F, r0 + i) + col) = hv[i];
        }
        if (HAS_U) {
#pragma unroll
            for (int i = 0; i < R; ++i) { const float ss = wave_sum((hv[i].x * hv[i].x + hv[i].y * hv[i].y) + (hv[i].z * hv[i].z + hv[i].w * hv[i].w)); if (lane_ == 0) PS[64 + i * 8 + wave_] = ss; }
            asm volatile("s_waitcnt lgkmcnt(0)" ::: "memory"); __builtin_amdgcn_s_barrier(); asm volatile("" ::: "memory");
#pragma unroll
            for (int i = 0; i < R; ++i) { const f32x4 p0 = *(const LAS f32x4*)(PS + 64 + i * 8), p1 = *(const LAS f32x4*)(PS + 64 + i * 8 + 4);
                const float tot = ((p0.x + p0.y) + (p0.z + p0.w)) + ((p1.x + p1.y) + (p1.z + p1.w));
                const float r2 = rsqrtf(tot * (1.0f / D) + EPS);
                const f32x4 u = (hv[i] * r2 * gn) * sc + sh;
                u32x2 w; w.x = pk2(u.x, u.y); w.y = pk2(u.z, u.w);
                *(u32x2*)(U + (size_t)(r0 + i) * D + col) = w; }
        }
        if (!HAS_Y || !HAS_U) { asm volatile("s_waitcnt lgkmcnt(0)" ::: "memory"); __builtin_amdgcn_s_barrier(); asm volatile("" ::: "memory"); }
    }
#undef NRM_LOAD
    __syncthreads();
}

__device__ __forceinline__ void unpack8(const u32x4 v, float (&f)[8]) { f[0] = bflo(v.x); f[1] = bfhi(v.x); f[2] = bflo(v.y); f[3] = bfhi(v.y); f[4] = bflo(v.z); f[5] = bfhi(v.z); f[6] = bflo(v.w); f[7] = bfhi(v.w); }
__device__ __forceinline__ u32x4 pack8(const float (&f)[8]) { u32x4 o; o.x = pk2(f[0], f[1]); o.y = pk2(f[2], f[3]); o.z = pk2(f[4], f[5]); o.w = pk2(f[6], f[7]); return o; }
__device__ __forceinline__ void comb0_rows(Frame& F, int row_lo, int row_hi) {
    const int tid_ = fresh_tid(); const int lane_ = tid_ & 63, wave_ = __builtin_amdgcn_readfirstlane(tid_ >> 6), gw_ = F.wg * NWAVES + wave_;
    const bf16* OFb = gY(F); const bf16* OBb = OFb + (size_t)M * 1024; const bf16* HFb = OBb + (size_t)M * 1024; const bf16* HBb = HFb + (size_t)M * 1024;
    const bf16* P = gBIG(F); bf16* U = gU(F); const float* gg = F.A.in[I_GLANG];
    const int e0 = 16 * lane_;
    f32x4 gn[4];
#pragma unroll
    for (int c = 0; c < 4; ++c) gn[c] = *(const f32x4*)(gg + (e0 & 255) + 4 * c);
    u32x4 nx[12];
#define C0_LOAD(r_) do { const size_t o_ = (size_t)(r_) * 1024 + e0; const bf16* g_ = P + (size_t)(r_) * NP0 + e0; \
        nx[0] = *(const u32x4*)(OFb + o_); nx[1] = *(const u32x4*)(OFb + o_ + 8); nx[2] = *(const u32x4*)(OBb + o_); nx[3] = *(const u32x4*)(OBb + o_ + 8); nx[4] = *(const u32x4*)(g_ + 2048); nx[5] = *(const u32x4*)(g_ + 2056); \
        nx[6] = *(const u32x4*)(HFb + o_); nx[7] = *(const u32x4*)(HFb + o_ + 8); nx[8] = *(const u32x4*)(HBb + o_); nx[9] = *(const u32x4*)(HBb + o_ + 8); nx[10] = *(const u32x4*)(g_ + 4096); nx[11] = *(const u32x4*)(g_ + 4104); } while (0)
    int r = row_lo + gw_;
    if (r < row_hi) C0_LOAD(r);
    for (; r < row_hi; r += F.NGW) {
        u32x4 cu[12];
#pragma unroll
        for (int i = 0; i < 12; ++i) cu[i] = nx[i];
        if (r + F.NGW < row_hi) C0_LOAD(r + F.NGW);
#pragma unroll
        for (int part = 0; part < 2; ++part) {
            float a[2][8], b8[8], g[2][8], o[2][8];
            unpack8(cu[6 * part + 0], a[0]); unpack8(cu[6 * part + 1], a[1]);
            unpack8(cu[6 * part + 2], b8);
#pragma unroll
            for (int e = 0; e < 8; ++e) a[0][e] += b8[e];
            unpack8(cu[6 * part + 3], b8);
#pragma unroll
            for (int e = 0; e < 8; ++e) a[1][e] += b8[e];
            unpack8(cu[6 * part + 4], g[0]); unpack8(cu[6 * part + 5], g[1]);
            if (part == 0) {
                float ss = 0.f;
#pragma unroll
                for (int c = 0; c < 2; ++c)
#pragma unroll
                    for (int e = 0; e < 8; ++e) ss += a[c][e] * a[c][e];
                ss += __shfl_xor(ss, 1); ss += __shfl_xor(ss, 2); ss += __shfl_xor(ss, 4); ss += __shfl_xor(ss, 8);
                const float rr = rsqrtf(ss * (1.0f / 256.0f) + EPS);
#pragma unroll
                for (int c = 0; c < 2; ++c)
#pragma unroll
                    for (int e = 0; e < 8; ++e) o[c][e] = a[c][e] * rr * gn[2 * c + (e >> 2)][e & 3] * silu_f(g[c][e]);
            } else {
#pragma unroll
                for (int c = 0; c < 2; ++c)
#pragma unroll
                    for (int e = 0; e < 8; ++e) o[c][e] = a[c][e] * gelu_tanh_f(g[c][e]);
            }
            bf16* up = U + (size_t)r * D + part * 1024 + e0;
            *(u32x4*)up = pack8(o[0]); *(u32x4*)(up + 8) = pack8(o[1]);
        }
    }
#undef C0_LOAD
}
__device__ __forceinline__ void comb1_rows(Frame& F, int row_lo, int row_hi) {
    const int tid_ = fresh_tid(); const int lane_ = tid_ & 63, wave_ = __builtin_amdgcn_readfirstlane(tid_ >> 6), gw_ = F.wg * NWAVES + wave_;
    const bf16* HFb = gY(F); const bf16* HBb = HFb + (size_t)M * D;
    const bf16* P = gBIG(F); bf16* U = gU(F); const float* gg = F.A.in[I_MLNG];
    const int e0 = 32 * lane_;
    f32x4 gn[8];
#pragma unroll
    for (int c = 0; c < 8; ++c) gn[c] = *(const f32x4*)(gg + (e0 & 255) + 4 * c);
    u32x4 nx[12];
#define C1_LOAD(r_) do { const size_t o_ = (size_t)(r_) * D + e0; const bf16* g_ = P + (size_t)(r_) * NP1 + 4096 + e0; \
        _Pragma("unroll") for (int c = 0; c < 4; ++c) { nx[c] = *(const u32x4*)(HFb + o_ + 8 * c); nx[4 + c] = *(const u32x4*)(HBb + o_ + 8 * c); nx[8 + c] = *(const u32x4*)(g_ + 8 * c); } } while (0)
    int r = row_lo + gw_;
    if (r < row_hi) C1_LOAD(r);
    for (; r < row_hi; r += F.NGW) {
        u32x4 cu[12];
#pragma unroll
        for (int i = 0; i < 12; ++i) cu[i] = nx[i];
        if (r + F.NGW < row_hi) C1_LOAD(r + F.NGW);
        float a[4][8]; float ss = 0.f;
#pragma unroll
        for (int c = 0; c < 4; ++c) { float y8[8]; unpack8(cu[c], a[c]); unpack8(cu[4 + c], y8);
#pragma unroll
            for (int e = 0; e < 8; ++e) { a[c][e] += y8[e]; ss += a[c][e] * a[c][e]; } }
        ss += __shfl_xor(ss, 1); ss += __shfl_xor(ss, 2); ss += __shfl_xor(ss, 4);
        const float rr = rsqrtf(ss * (1.0f / 256.0f) + EPS);
#pragma unroll
        for (int c = 0; c < 4; ++c) { float g8[8], o8[8]; unpack8(cu[8 + c], g8);
#pragma unroll
            for (int e = 0; e < 8; ++e) o8[e] = a[c][e] * rr * gn[2 * c + (e >> 2)][e & 3] * sigmoid_f(g8[e]);
            *(u32x4*)(U + (size_t)r * D + e0 + 8 * c) = pack8(o8); }
    }
#undef C1_LOAD
}

#define WG_BAR() do { asm volatile("s_waitcnt lgkmcnt(0)" ::: "memory"); __builtin_amdgcn_s_barrier(); asm volatile("" ::: "memory"); } while (0)
__device__ __forceinline__ int chunk_rlo(int b, int dir, int c) {
    return c < 4 ? b * CTXL + (dir ? (CTXL - 64 - 64 * c) : 64 * c) : MC + b * SEQ + (dir ? (SEQ - 64 - 64 * (c - 4)) : 64 * (c - 4));
}
__device__ __forceinline__ bf16x8 tr_frag(LAS unsigned char* tile, int pitch, int k0, int c0, int lane) {
    const int g = lane >> 4, q = (lane & 15) >> 2, p = lane & 3;
    LAS unsigned char* a0 = tile + (k0 + 8 * g + q) * pitch + (c0 + 4 * p) * 2;
    const bf16x4 lo = __builtin_amdgcn_ds_read_tr16_b64_v4i16((LAS bf16x4*)a0);
    const bf16x4 hi = __builtin_amdgcn_ds_read_tr16_b64_v4i16((LAS bf16x4*)(a0 + 4 * pitch));
    return __builtin_shufflevector(lo, hi, 0, 1, 2, 3, 4, 5, 6, 7);
}
__device__ __forceinline__ u32x4 scale8(const u32x4 v, float s) {
    u32x4 o; o.x = pk2(bflo(v.x) * s, bfhi(v.x) * s); o.y = pk2(bflo(v.y) * s, bfhi(v.y) * s); o.z = pk2(bflo(v.z) * s, bfhi(v.z) * s); o.w = pk2(bflo(v.w) * s, bfhi(v.w) * s); return o;
}
__device__ __forceinline__ float wave_incl_sum(float x, int lane) {
#pragma unroll
    for (int o = 1; o < 64; o <<= 1) { const float t = __shfl_up(x, o); if (lane >= o) x += t; }
    return x;
}
__device__ __forceinline__ float wave_incl_max(float x, int lane) {
#pragma unroll
    for (int o = 1; o < 64; o <<= 1) { const float t = __shfl_up(x, o); if (lane >= o) x = fmaxf(x, t); }
    return x;
}

template <int MODE>
__device__ __forceinline__ void chain_scan(LAS unsigned char* lds,
        const bf16* __restrict__ proj, const int NP, const int qcol, const int kcol, const int vcol,
        const float* __restrict__ gates, const int gcol, const int b, const int dir,
        bf16* __restrict__ outb, const int out_ld, const int ocol, const bool ctx_out,
        const float* __restrict__ w2, const float* __restrict__ ba, const float bias_i, const float bias_f) {
    const int tid = fresh_tid(); const int lane = tid & 63, wave = __builtin_amdgcn_readfirstlane(tid >> 6);
    constexpr int NVB = MODE ? 9 : 8;
    constexpr int PQ = 272, PV = 304, PP = 144;
    constexpr int O_QS = 0, O_KS = 17408, O_QH = 34816, O_KH = 52224, O_VS = 69632, O_PS = 89088, O_SB = 98304, O_SM = 137472;
    LAS float* LR = (LAS float*)(lds + O_SM);
    LAS float* TOT = (LAS float*)(lds + O_SM + 4096);
    LAS float* FIRST = (LAS float*)(lds + O_SM + 8192);
    LAS float* DEC = (LAS float*)(lds + O_SM + 8704);
    LAS float* A_ = (LAS float*)(lds + O_SM);
    LAS float* MI = A_ + 64; LAS float* WI = A_ + 128; LAS float* WK = A_ + 192; LAS float* MR = A_ + 256; LAS float* DEN = A_ + 320; LAS float* DECS = A_ + 384;
    const int fr = lane & 15, fq = lane >> 4;

    __syncthreads();
    for (int i = tid; i < (9216 + 39168) / 16; i += 512) *(LAS u32x4*)(lds + O_PS + 16 * i) = (u32x4){0u, 0u, 0u, 0u};
    if (MODE) { if (tid < 64) { *(LAS u32x4*)(lds + O_VS + tid * PV + 256) = (u32x4){0x3F80u, 0u, 0u, 0u}; *(LAS u32x4*)(lds + O_VS + tid * PV + 272) = (u32x4){0u, 0u, 0u, 0u}; } }
    f32x4 S[NVB];
#pragma unroll
    for (int v = 0; v < NVB; ++v) S[v] = (f32x4){0.f, 0.f, 0.f, 0.f};
    float mst = 0.f;
    const int dp = tid & 63, d0 = 2 * dp, jg = wave;
    f32x2 w2r[16]; f32x2 bar = (f32x2){0.f, 0.f};
    if (MODE == 0) {
#pragma unroll
        for (int r = 0; r < 16; ++r) w2r[r] = *(const f32x2*)(w2 + r * 512 + d0);
        bar = *(const f32x2*)(ba + d0);
    }
    const int sj0 = tid >> 4, sj1 = (tid + 512) >> 4, sch = tid & 15;
    u32x4 pq[2], pk[2], pv[2]; f32x2 plr = (f32x2){0.f, 0.f}; float pgi = 0.f, pgf = 0.f;
#define CH_PREFETCH(cc) do { const int rl_ = chunk_rlo(b, dir, (cc)); \
        { const int row_ = dir ? rl_ + 63 - sj0 : rl_ + sj0; const bf16* rp_ = proj + (size_t)row_ * NP + 8 * sch; pq[0] = *(const u32x4*)(rp_ + qcol); pk[0] = *(const u32x4*)(rp_ + kcol); pv[0] = *(const u32x4*)(rp_ + vcol); } \
        { const int row_ = dir ? rl_ + 63 - sj1 : rl_ + sj1; const bf16* rp_ = proj + (size_t)row_ * NP + 8 * sch; pq[1] = *(const u32x4*)(rp_ + qcol); pk[1] = *(const u32x4*)(rp_ + kcol); pv[1] = *(const u32x4*)(rp_ + vcol); } \
        if (MODE == 0) { const int j_ = 8 * wave + (lane >> 3); const int row_ = dir ? rl_ + 63 - j_ : rl_ + j_; plr = *(const f32x2*)(gates + (size_t)row_ * 32 + gcol + 2 * (lane & 7)); } \
        else { if (wave == 0) { const int row_ = dir ? rl_ + 63 - lane : rl_ + lane; pgi = gates[(size_t)row_ * 32 + gcol]; pgf = gates[(size_t)row_ * 32 + gcol + 8]; } } } while (0)
    CH_PREFETCH(0);
    for (int c = 0; c < NCH; ++c) {
        const int rl = chunk_rlo(b, dir, c);
        *(LAS u32x4*)(lds + O_QS + sj0 * PQ + 16 * sch) = pq[0]; *(LAS u32x4*)(lds + O_QS + sj1 * PQ + 16 * sch) = pq[1];
        *(LAS u32x4*)(lds + O_KS + sj0 * PQ + 16 * sch) = pk[0]; *(LAS u32x4*)(lds + O_KS + sj1 * PQ + 16 * sch) = pk[1];
        *(LAS u32x4*)(lds + O_VS + sj0 * PV + 16 * sch) = pv[0]; *(LAS u32x4*)(lds + O_VS + sj1 * PV + 16 * sch) = pv[1];
        const f32x2 lrc = plr; const float gi = pgi, gf = pgf;
        if (c + 1 < NCH) CH_PREFETCH(c + 1);
        WG_BAR();
        if (MODE == 0) {
            f32x2 cs[8]; f32x2 run = (f32x2){0.f, 0.f};
#pragma unroll
            for (int jj = 0; jj < 8; ++jj) {
                f32x2 z = bar;
#pragma unroll
                for (int r2 = 0; r2 < 8; ++r2) { const float l0 = __int_as_float(__builtin_amdgcn_readlane(__float_as_int(lrc.x), 8 * jj + r2)), l1 = __int_as_float(__builtin_amdgcn_readlane(__float_as_int(lrc.y), 8 * jj + r2));
                    z += w2r[2 * r2] * l0; z += w2r[2 * r2 + 1] * l1; }
                f32x2 la; la.x = fmaxf(logsig_f(z.x) * (1.0f / 16.0f), -1.0f); la.y = fmaxf(logsig_f(z.y) * (1.0f / 16.0f), -1.0f);
                run += la; cs[jj] = run;
            }
            *(LAS f32x2*)(TOT + jg * 128 + d0) = run;
            if (jg == 4) *(LAS f32x2*)(FIRST + d0) = cs[0];
            WG_BAR();
            f32x2 pre = (f32x2){0.f, 0.f}, bref = (f32x2){0.f, 0.f}, blast = (f32x2){0.f, 0.f};
#pragma unroll
            for (int g = 0; g < 8; ++g) { const f32x2 t = *(const LAS f32x2*)(TOT + g * 128 + d0); if (g < jg) pre += t; if (g < 4) bref += t; blast += t; }
            bref += *(const LAS f32x2*)(FIRST + d0);
            f32x2 e1, e2; e1.x = __expf(bref.x); e1.y = __expf(bref.y); e2.x = __expf(blast.x - bref.x); e2.y = __expf(blast.y - bref.y);
            unsigned qw[8], kw[8];
#pragma unroll
            for (int jj = 0; jj < 8; ++jj) { const int j = 8 * jg + jj; qw[jj] = *(const LAS unsigned*)(lds + O_QS + j * PQ + 4 * dp); kw[jj] = *(const LAS unsigned*)(lds + O_KS + j * PQ + 4 * dp); }
#pragma unroll
            for (int jj = 0; jj < 8; ++jj) {
                const int j = 8 * jg + jj; const f32x2 bb = pre + cs[jj];
                f32x2 ef, er; ef.x = __expf(bb.x - bref.x); ef.y = __expf(bb.y - bref.y); er.x = __builtin_amdgcn_rcpf(ef.x); er.y = __builtin_amdgcn_rcpf(ef.y);
                f32x2 qv, kv; qv.x = bflo(qw[jj]) * QSCALE; qv.y = bfhi(qw[jj]) * QSCALE; kv.x = bflo(kw[jj]); kv.y = bfhi(kw[jj]);
                const f32x2 qt = qv * ef, kt = kv * er, qh = qt * e1, kh = kt * e2;
                *(LAS unsigned*)(lds + O_QS + j * PQ + 4 * dp) = pk2(qt.x, qt.y);
                *(LAS unsigned*)(lds + O_QH + j * PQ + 4 * dp) = pk2(qh.x, qh.y);
                *(LAS unsigned*)(lds + O_KS + j * PQ + 4 * dp) = pk2(kt.x, kt.y);
                *(LAS unsigned*)(lds + O_KH + j * PQ + 4 * dp) = pk2(kh.x, kh.y);
            }
            if (jg == 0) { f32x2 dv; dv.x = __expf(blast.x); dv.y = __expf(blast.y); *(LAS f32x2*)(DEC + d0) = dv; }
        } else {
            if (wave == 0) {
                const float ipre = gi + bias_i, lf = logsig_f(gf + bias_f);
                const float bsum = wave_incl_sum(lf, lane);
                const float a = ipre - bsum;
                const float cm = wave_incl_max(a, lane);
                const float Mi = fmaxf(mst, cm);
                const float blast = __shfl(bsum, 63), M63 = __shfl(Mi, 63);
                A_[lane] = a; MI[lane] = Mi; WI[lane] = __expf(mst - Mi) * QSCALE; WK[lane] = __expf(a - M63); MR[lane] = __expf(-(bsum + Mi));
                if (lane == 0) DECS[0] = __expf(mst - M63);
                mst = blast + M63;
            }
            WG_BAR();
            { const float wi0 = WI[sj0], wi1 = WI[sj1], wk0 = WK[sj0], wk1 = WK[sj1];
              *(LAS u32x4*)(lds + O_QH + sj0 * PQ + 16 * sch) = scale8(*(const LAS u32x4*)(lds + O_QS + sj0 * PQ + 16 * sch), wi0);
              *(LAS u32x4*)(lds + O_QH + sj1 * PQ + 16 * sch) = scale8(*(const LAS u32x4*)(lds + O_QS + sj1 * PQ + 16 * sch), wi1);
              *(LAS u32x4*)(lds + O_KH + sj0 * PQ + 16 * sch) = scale8(*(const LAS u32x4*)(lds + O_KS + sj0 * PQ + 16 * sch), wk0);
              *(LAS u32x4*)(lds + O_KH + sj1 * PQ + 16 * sch) = scale8(*(const LAS u32x4*)(lds + O_KS + sj1 * PQ + 16 * sch), wk1); }
        }
        WG_BAR();
        for (int tix = wave; tix < 10; tix += 8) {
            const int ib = tix >= 6 ? 3 : (tix >= 3 ? 2 : (tix >= 1 ? 1 : 0)); const int jb = tix - ib * (ib + 1) / 2;
            f32x4 acc = (f32x4){0.f, 0.f, 0.f, 0.f};
            bf16x8 Ak[4], Bq[4];
#pragma unroll
            for (int ks = 0; ks < 4; ++ks) { Ak[ks] = *(const LAS bf16x8*)(lds + O_KS + (16 * jb + fr) * PQ + (32 * ks + 8 * fq) * 2); Bq[ks] = *(const LAS bf16x8*)(lds + O_QS + (16 * ib + fr) * PQ + (32 * ks + 8 * fq) * 2); }
#pragma unroll
            for (int ks = 0; ks < 4; ++ks) acc = __builtin_amdgcn_mfma_f32_16x16x32_bf16(Ak[ks], Bq[ks], acc, 0, 0, 0);
            const int i = 16 * ib + fr, j0 = 16 * jb + 4 * fq;
            float w[4];
            if (MODE) { const float Mi = MI[i];
#pragma unroll
                for (int r = 0; r < 4; ++r) w[r] = (j0 + r <= i) ? acc[r] * QSCALE * __expf(A_[j0 + r] - Mi) : 0.f;
            } else {
#pragma unroll
                for (int r = 0; r < 4; ++r) w[r] = (j0 + r <= i) ? acc[r] : 0.f;
            }
            u32x2 pw; pw.x = pk2(w[0], w[1]); pw.y = pk2(w[2], w[3]);
            *(LAS u32x2*)(lds + O_PS + i * PP + j0 * 2) = pw;
        }
        WG_BAR();
        const int ib = wave & 3, vb0 = (wave >> 2) * 4, irow = 16 * ib + fr;
        f32x4 ao[5];
#pragma unroll
        for (int v = 0; v < 5; ++v) ao[v] = (f32x4){0.f, 0.f, 0.f, 0.f};
        {
            bf16x8 Bp[2], Av[2][5];
#pragma unroll
            for (int ks = 0; ks < 2; ++ks) { Bp[ks] = *(const LAS bf16x8*)(lds + O_PS + irow * PP + (32 * ks + 8 * fq) * 2);
#pragma unroll
                for (int v = 0; v < 4; ++v) Av[ks][v] = tr_frag(lds + O_VS, PV, 32 * ks, 16 * (vb0 + v), lane);
                if (MODE) Av[ks][4] = tr_frag(lds + O_VS, PV, 32 * ks, 128, lane); }
#pragma unroll
            for (int ks = 0; ks < 2; ++ks) {
#pragma unroll
                for (int v = 0; v < 4; ++v) ao[v] = __builtin_amdgcn_mfma_f32_16x16x32_bf16(Av[ks][v], Bp[ks], ao[v], 0, 0, 0);
                if (MODE) { if (wave < 4) ao[4] = __builtin_amdgcn_mfma_f32_16x16x32_bf16(Av[ks][4], Bp[ks], ao[4], 0, 0, 0); } }
        }
#pragma unroll
        for (int kh = 0; kh < 2; ++kh) {
            bf16x8 Bq[2], As[2][5];
#pragma unroll
            for (int k2 = 0; k2 < 2; ++k2) { const int ks = 2 * kh + k2; Bq[k2] = *(const LAS bf16x8*)(lds + O_QH + irow * PQ + (32 * ks + 8 * fq) * 2);
#pragma unroll
                for (int v = 0; v < 4; ++v) As[k2][v] = *(const LAS bf16x8*)(lds + O_SB + (16 * (vb0 + v) + fr) * PQ + (32 * ks + 8 * fq) * 2);
                if (MODE) As[k2][4] = *(const LAS bf16x8*)(lds + O_SB + (128 + fr) * PQ + (32 * ks + 8 * fq) * 2); }
#pragma unroll
            for (int k2 = 0; k2 < 2; ++k2) {
#pragma unroll
                for (int v = 0; v < 4; ++v) ao[v] = __builtin_amdgcn_mfma_f32_16x16x32_bf16(As[k2][v], Bq[k2], ao[v], 0, 0, 0);
                if (MODE) { if (wave < 4) ao[4] = __builtin_amdgcn_mfma_f32_16x16x32_bf16(As[k2][4], Bq[k2], ao[4], 0, 0, 0); } }
        }
        const int db = wave;
        if (MODE == 0) { const f32x4 dec = *(const LAS f32x4*)(DEC + 16 * db + 4 * fq);
#pragma unroll
            for (int v = 0; v < NVB; ++v) S[v] = S[v] * dec;
        } else { const float dsc = DECS[0];
#pragma unroll
            for (int v = 0; v < NVB; ++v) S[v] = S[v] * dsc;
        }
#pragma unroll
        for (int ks = 0; ks < 2; ++ks) {
            const bf16x8 A = tr_frag(lds + O_KH, PQ, 32 * ks, 16 * db, lane);
#pragma unroll
            for (int v = 0; v < NVB; ++v) { const bf16x8 B = tr_frag(lds + O_VS, PV, 32 * ks, 16 * v, lane); S[v] = __builtin_amdgcn_mfma_f32_16x16x32_bf16(A, B, S[v], 0, 0, 0); }
        }
        if (MODE) { if (wave < 4 && lane < 16) DEN[16 * ib + lane] = ao[4][0]; }
        WG_BAR();
        if (ctx_out || c >= 4) {
            const int row = dir ? rl + 63 - irow : rl + irow;
            float sc = 1.0f;
            if (MODE) sc = 1.0f / fmaxf(fabsf(DEN[irow]), MR[irow]);
            bf16* op = outb + (size_t)row * out_ld + ocol + 16 * vb0 + 4 * fq;
#pragma unroll
            for (int v = 0; v < 4; ++v) { u32x2 w; w.x = pk2(ao[v][0] * sc, ao[v][1] * sc); w.y = pk2(ao[v][2] * sc, ao[v][3] * sc); *(u32x2*)(op + 16 * v) = w; }
        }
#pragma unroll
        for (int v = 0; v < NVB; ++v) { u32x2 w; w.x = pk2(S[v][0], S[v][1]); w.y = pk2(S[v][2], S[v][3]); *(LAS u32x2*)(lds + O_SB + (16 * v + fr) * PQ + (16 * db + 4 * fq) * 2) = w; }
    }
#undef CH_PREFETCH
    __syncthreads();
}

__device__ __forceinline__ void rg_chain(LAS unsigned char* lds,
        const bf16* __restrict__ proj, const int b, const int n, const int dir, const bf16* __restrict__ wrg,
        const float* __restrict__ lam, const float* __restrict__ b_a, const float* __restrict__ b_i, const float* __restrict__ conv_w, const float* __restrict__ conv_b,
        bf16* __restrict__ hout) {
    const int tid = fresh_tid(); const int lane = tid & 63, wave = __builtin_amdgcn_readfirstlane(tid >> 6);
    constexpr int O_XR = 0, O_XBF = 17408, O_XBH = 51200, O_AA = 68608, O_BX = 102400, O_CW = 136192;
    constexpr int PXF = 528, PXH = 272;
    const int fr = lane & 15, fq = lane >> 4;
    LAS float* CW = (LAS float*)(lds + O_CW);
    __syncthreads();
    for (int i = tid; i < 5 * 128; i += 512) CW[i] = i < 512 ? conv_w[(i >> 7) * 1024 + 128 * n + (i & 127)] : conv_b[128 * n + (i - 512)];
    bf16x8 Afr[2][4];
#pragma unroll
    for (int mat = 0; mat < 2; ++mat)
#pragma unroll
        for (int ks = 0; ks < 4; ++ks) Afr[mat][ks] = *(const bf16x8*)(wrg + ((size_t)((dir * 2 + mat) * 8 + n) * 128 + 16 * wave + fr) * 128 + 32 * ks + 8 * fq);
    f32x4 c8, bav, biv;
#pragma unroll
    for (int r = 0; r < 4; ++r) { const int ch = 128 * n + 16 * wave + 4 * fq + r; const float l = lam[dir * 1024 + ch];
        c8[r] = -8.0f * (fmaxf(-l, 0.f) + log1pf(expf(-fabsf(l)))); bav[r] = b_a[dir * 1024 + ch]; biv[r] = b_i[dir * 1024 + ch]; }
    float hst = 0.f;
    const int ch2 = tid & 63, tg = tid >> 6;
    u32x4 px[3];
#define RG_PREFETCH(cc) do { const int c_ = (cc); const int L_ = c_ < 4 ? CTXL : SEQ, cs_ = c_ < 4 ? c_ : c_ - 4, base_ = c_ < 4 ? b * CTXL : MC + b * SEQ; \
        const int t0_ = dir ? L_ - 64 * (cs_ + 1) : 64 * cs_; \
        _Pragma("unroll") for (int e_ = 0; e_ < 3; ++e_) { const int id_ = tid + 512 * e_, rr_ = id_ >> 4, tt_ = t0_ - 2 + rr_; \
            px[e_] = (rr_ < 67 && tt_ >= 0 && tt_ < L_) ? *(const u32x4*)(proj + (size_t)(base_ + tt_) * NP0 + 3072 + 128 * n + 8 * (id_ & 15)) : (u32x4){0u, 0u, 0u, 0u}; } } while (0)
    RG_PREFETCH(0);
    for (int c = 0; c < NCH; ++c) {
        const int L = c < 4 ? CTXL : SEQ, cs = c < 4 ? c : c - 4, base = c < 4 ? b * CTXL : MC + b * SEQ;
        const int t0 = dir ? L - 64 * (cs + 1) : 64 * cs;
#pragma unroll
        for (int e = 0; e < 3; ++e) { const int id = tid + 512 * e, rr = id >> 4; if (rr < 68) *(LAS u32x4*)(lds + O_XR + rr * 256 + 16 * (id & 15)) = px[e]; }
        if (c + 1 < NCH) RG_PREFETCH(c + 1);
        WG_BAR();
        {
            const f32x2 w0 = *(const LAS f32x2*)(CW + 0 * 128 + 2 * ch2), w1 = *(const LAS f32x2*)(CW + 1 * 128 + 2 * ch2), w2_ = *(const LAS f32x2*)(CW + 2 * 128 + 2 * ch2), w3 = *(const LAS f32x2*)(CW + 3 * 128 + 2 * ch2), cb = *(const LAS f32x2*)(CW + 512 + 2 * ch2);
            f32x2 xw[11];
#pragma unroll
            for (int rr = 0; rr < 11; ++rr) { const unsigned u = *(const LAS unsigned*)(lds + O_XR + (8 * tg + rr) * 256 + 4 * ch2); xw[rr].x = bflo(u); xw[rr].y = bfhi(u); }
#pragma unroll
            for (int jj = 0; jj < 8; ++jj) {
                f32x2 y = cb; y += xw[jj] * w0; y += xw[jj + 1] * w1; y += xw[jj + 2] * w2_; y += xw[jj + 3] * w3;
                *(LAS f32x2*)(lds + O_XBF + (8 * tg + jj) * PXF + 8 * ch2) = y;
                *(LAS unsigned*)(lds + O_XBH + (8 * tg + jj) * PXH + 4 * ch2) = pk2(y.x, y.y);
            }
        }
        WG_BAR();
#pragma unroll
        for (int tb = 0; tb < 4; ++tb) {
            f32x4 ga = (f32x4){0.f, 0.f, 0.f, 0.f}, gi = (f32x4){0.f, 0.f, 0.f, 0.f};
            bf16x8 Bx[4];
#pragma unroll
            for (int ks = 0; ks < 4; ++ks) Bx[ks] = *(const LAS bf16x8*)(lds + O_XBH + (16 * tb + fr) * PXH + (32 * ks + 8 * fq) * 2);
#pragma unroll
            for (int ks = 0; ks < 4; ++ks) { ga = __builtin_amdgcn_mfma_f32_16x16x32_bf16(Afr[0][ks], Bx[ks], ga, 0, 0, 0); gi = __builtin_amdgcn_mfma_f32_16x16x32_bf16(Afr[1][ks], Bx[ks], gi, 0, 0, 0); }
            const int t = 16 * tb + fr;
            const f32x4 xb = *(const LAS f32x4*)(lds + O_XBF + t * PXF + (16 * wave + 4 * fq) * 4);
            f32x4 av, bx;
#pragma unroll
            for (int r = 0; r < 4; ++r) { const float rg = sigmoid_f(ga[r] + bav[r]), ig = sigmoid_f(gi[r] + biv[r]); const float la = c8[r] * rg;
                av[r] = __expf(la); bx[r] = sqrtf(-expm1f(2.0f * la)) * (ig * xb[r]); }
            *(LAS f32x4*)(lds + O_AA + t * PXF + (16 * wave + 4 * fq) * 4) = av;
            *(LAS f32x4*)(lds + O_BX + t * PXF + (16 * wave + 4 * fq) * 4) = bx;
        }
        WG_BAR();
        if (tid < 128) {
            bf16* hp = hout + (size_t)(base + t0) * 1024 + 128 * n + tid;
            for (int s8 = 0; s8 < 64; s8 += 8) {
                float av8[8], bx8[8];
#pragma unroll
                for (int e = 0; e < 8; ++e) { const int jj = dir ? 63 - (s8 + e) : s8 + e; av8[e] = *(const LAS float*)(lds + O_AA + jj * PXF + 4 * tid); bx8[e] = *(const LAS float*)(lds + O_BX + jj * PXF + 4 * tid); }
#pragma unroll
                for (int e = 0; e < 8; ++e) { const int jj = dir ? 63 - (s8 + e) : s8 + e; hst = av8[e] * hst + bx8[e]; hp[(size_t)jj * 1024] = (bf16)f2bf(hst); }
            }
        }
    }
#undef RG_PREFETCH
    __syncthreads();
}

#ifndef MK_LAST_PHASE
#define MK_LAST_PHASE 24
#endif
constexpr int NPH = 24;
__global__ void __launch_bounds__(NWAVES * 64, 2) mk_fwd(Args args) {
    extern __shared__ __attribute__((aligned(16))) unsigned char lds_raw[];
    const int GA = (int)gridDim.x, bx = (int)blockIdx.x;
    const int grp = (bx >> 2) & 1, gi = ((bx >> 3) << 2) | (bx & 3), GG = GA >> 1;
    Frame FA{(LAS unsigned char*)lds_raw, GA, bx, GA * NWAVES, 0, args.out, args.ws, args};
    Frame F{(LAS unsigned char*)lds_raw, GG, gi, GG * NWAVES, grp, args.out, args.ws, args};
    volatile LAS unsigned* MISC = (volatile LAS unsigned*)(F.lds + LDSCTL_OFF);
    for (int u = threadIdx.x; u < (LDS_BYTES - LDSCTL_OFF) / 4; u += NWAVES * 64) ((LAS unsigned*)(F.lds + LDSCTL_OFF))[u] = 0u;
    __syncthreads();
    const int lo = args.ph_lo, hi = args.ph_hi;
    unsigned* ctl = (unsigned*)(F.ws + WS_CTL);
    XcdBarrier barA = xcd_barrier_post(ctl + CW_BAR, MISC + 8, (unsigned)GA);
    XcdBarrier barG = xcd_barrier_post(ctl + CW_BAR + (1 + grp) * XCD_BAR_WORDS, MISC + 12, (unsigned)GG);
#ifndef MK_REP_GEMM
#define MK_REP_GEMM 1
#endif
#ifndef MK_REP_SCAN
#define MK_REP_SCAN 1
#endif
#ifndef MK_REP_COMB
#define MK_REP_COMB 1
#endif
#ifndef MK_REP_CVT
#define MK_REP_CVT 1
#endif
#ifndef MK_CVT_SPLIT
#define MK_CVT_SPLIT 30
#endif
#ifndef MK_OFFMASK
#define MK_OFFMASK 0x7FF
#endif
#ifndef MK_PREMASK
#define MK_PREMASK 3
#endif
#define IN(k) (lo <= (k) && (k) < hi)
#define INL(o) (((MK_OFFMASK >> (o)) & 1) && IN(pb + (o)))
#define SEAM(k) do { if (IN(k) && IN((k) + 1)) xcd_barrier(barG); } while (0)
    float* MOD = (float*)(F.ws + WS_MOD);
    bf16* U = gU(F); bf16* Yb = gY(F); bf16* BIG = gBIG(F); float* GATES = gGATES(F); float* YC = gYC(F);

    if ((MK_PREMASK & 1) && IN(0)) { pre_mod(FA); pre_pe(FA); for (int rep_ = 0; rep_ < MK_REP_CVT; ++rep_) cvt_layer<0>(FA); }
    if (IN(0) && IN(1)) xcd_barrier(barA);
    if ((MK_PREMASK & 2) && IN(1)) {
        for (int rep_ = 0; rep_ < MK_REP_CVT; ++rep_) { if (grp == 0) cvt_layer<1>(F, 0, MK_CVT_SPLIT); else cvt_layer<1>(F, MK_CVT_SPLIT, 100); }
        nrm_rows<true, false, true>(F, 0, M, 0.f, nullptr, nullptr, 0, F.A.in[I_NORMG], MOD, 0, 1);
    }
    SEAM(1);
    if (IN(1) && IN(2) && gi == 0 && threadIdx.x == 0) __hip_atomic_store(ctl + CW_W1READY + 64 * grp, 1u, __ATOMIC_RELAXED, __HIP_MEMORY_SCOPE_AGENT);
    for (int layer = 0; layer < 2; ++layer) {
        const int pb = 2 + 11 * layer; const bool last = layer == 1;
        const float* ng = F.A.in[I_NORMG] + (size_t)layer * 6 * D; const float* modl = MOD + (size_t)layer * 9 * 18432;
        const int NP = layer == 0 ? NP0 : NP1;
        const int rlo2 = last ? MC : 0;
        const unsigned char* W = F.ws + WS_W + (size_t)layer * W_LAYER;
        if (layer == 1 && IN(pb)) {
            if (threadIdx.x == 0) { unsigned sp = 0; while (__hip_atomic_load(ctl + CW_W1READY, __ATOMIC_RELAXED, __HIP_MEMORY_SCOPE_AGENT) == 0u || __hip_atomic_load(ctl + CW_W1READY + 64, __ATOMIC_RELAXED, __HIP_MEMORY_SCOPE_AGENT) == 0u) { __builtin_amdgcn_s_sleep(4); if (++sp > (1u << 22)) { atomicAdd(ctl + CW_BAR + XB_TMO, 1u); break; } }
                __builtin_amdgcn_fence(__ATOMIC_ACQUIRE, "agent"); asm volatile("s_waitcnt vmcnt(0)" ::: "memory"); }
            __syncthreads();
        }
        if (INL(0)) { pg8::Gemm g{U, (const bf16*)(W + W_F1I), M, 2 * DFF, D}; pg8::StaticOrder S; S.init(M, 2 * DFF, F.G, F.wg, D, 0, 4); pg8::EpiSwiglu E{BIG, DFF};
            for (int rep_ = 0; rep_ < MK_REP_GEMM; ++rep_) pg8::gemm_phase<pg8::EpiSwiglu, pg8::StaticOrder, PG8_ALIGN, PG8_SP2>(F.lds, g, S, E); }
        SEAM(pb + 0);
        if (INL(1)) {
            pg8::Gemm g{BIG, (const bf16*)(W + W_F1O), M, D, DFF}; pg8::MixedOrder S; S.init(MLAT, D, F.G, F.wg, DFF, MC / 256, MC, KSPLIT, 4);
            pg8::EpiY E{Yb, D, YC, (size_t)MC * D, DFF / 64};
            for (int rep_ = 0; rep_ < MK_REP_GEMM; ++rep_) pg8::gemm_phase<pg8::EpiY, pg8::MixedOrder, PG8_ALIGN, PG8_SP2>(F.lds, g, S, E);
        }
        SEAM(pb + 1);
        if (INL(2)) nrm_rows<false, true, true>(F, 0, M, 0.5f, ng + 1 * D, modl, 2, ng + 2 * D, modl, 3, 4);
        SEAM(pb + 2);
        if (INL(3)) { pg8::Gemm g{U, (const bf16*)(W + W_MI), M, NP, D}; pg8::StaticOrder S; S.init(M, NP, F.G, F.wg, D, 0, 4); pg8::EpiProj E{BIG, NP, GATES, NP / 256 - 1};
            for (int rep_ = 0; rep_ < MK_REP_GEMM; ++rep_) pg8::gemm_phase<pg8::EpiProj, pg8::StaticOrder, PG8_ALIGN, PG8_SP2>(F.lds, g, S, E); }
        SEAM(pb + 3);
        if (INL(4)) {
            if (layer == 0) {
                bf16* OFb = Yb; bf16* OBb = OFb + (size_t)M * 1024; bf16* HFb = OBb + (size_t)M * 1024; bf16* HBb = HFb + (size_t)M * 1024;
                for (int item = F.wg; item < 128 * MK_REP_SCAN; item += F.G) { const int it = item & 127;
                    if (it < 64) { const int ci = it >> 1, vh = it & 1, b = ci >> 3, h = (ci >> 1) & 3, dir = ci & 1;
                        chain_scan<0>(F.lds, BIG, NP0, h * 128, 512 + h * 128, 1024 + h * 256 + vh * 128, GATES, dir * 16, b, dir,
                                      dir ? OBb : OFb, 1024, h * 256 + vh * 128, true, F.A.in[I_WALPHA2] + (size_t)dir * 16 * 512 + h * 128, F.A.in[I_BALPHA] + dir * 512 + h * 128, 0.f, 0.f);
                    } else { const int ri = it - 64, b = ri >> 4, n = (ri >> 1) & 7, dir = ri & 1;
                        rg_chain(F.lds, BIG, b, n, dir, (const bf16*)(F.ws + WS_WRG), F.A.in[I_LAM], F.A.in[I_RGBA], F.A.in[I_RGBI], F.A.in[I_CONVW], F.A.in[I_CONVB], dir ? HBb : HFb);
                    }
                }
            } else {
                bf16* HFb = Yb; bf16* HBb = HFb + (size_t)M * D;
                for (int item = F.wg; item < 128 * MK_REP_SCAN; item += F.G) { const int it = item & 127; const int ci = it >> 1, vh = it & 1, b = ci >> 4, h = (ci >> 1) & 7, dir = ci & 1;
                    chain_scan<1>(F.lds, BIG, NP1, h * 128, 1024 + h * 128, 2048 + h * 256 + vh * 128, GATES, dir * 16 + h, b, dir,
                                  dir ? HBb : HFb, D, h * 256 + vh * 128, false, nullptr, nullptr, F.A.in[I_MLBG][dir * 16 + h], F.A.in[I_MLBG][dir * 16 + 8 + h]);
                }
            }
        }
        SEAM(pb + 4);
        if (INL(5)) { for (int rep_ = 0; rep_ < MK_REP_COMB; ++rep_) { if (layer == 0) comb0_rows(F, 0, M); else comb1_rows(F, MC, M); } }
        SEAM(pb + 5);
        if (INL(6)) {
            pg8::Gemm g{U, (const bf16*)(W + W_MO), M, D, D}; pg8::MixedOrder S; S.init(MLAT, D, F.G, F.wg, D, MC / 256, last ? 0 : MC, KSPLIT, 4);
            pg8::EpiY E{Yb, D, YC, (size_t)MC * D, D / 64};
            for (int rep_ = 0; rep_ < MK_REP_GEMM; ++rep_) pg8::gemm_phase<pg8::EpiY, pg8::MixedOrder, PG8_ALIGN, PG8_SP2>(F.lds, g, S, E);
        }
        SEAM(pb + 6);
        if (INL(7)) nrm_rows<false, true, true>(F, rlo2, M, 1.0f, ng + 3 * D, modl, 5, ng + 4 * D, modl, 6, 7);
        SEAM(pb + 7);
        if (INL(8)) { pg8::Gemm g{U + (size_t)rlo2 * D, (const bf16*)(W + W_F2I), M - rlo2, 2 * DFF, D}; pg8::StaticOrder S; S.init(M - rlo2, 2 * DFF, F.G, F.wg, D, 0, 4); pg8::EpiSwiglu E{BIG + (size_t)rlo2 * DFF, DFF};
            for (int rep_ = 0; rep_ < MK_REP_GEMM; ++rep_) pg8::gemm_phase<pg8::EpiSwiglu, pg8::StaticOrder, PG8_ALIGN, PG8_SP2>(F.lds, g, S, E); }
        SEAM(pb + 8);
        if (INL(9)) {
            pg8::Gemm g{BIG, (const bf16*)(W + W_F2O), M, D, DFF}; pg8::MixedOrder S; S.init(MLAT, D, F.G, F.wg, DFF, MC / 256, last ? 0 : MC, KSPLIT, 4);
            pg8::EpiY E{Yb, D, YC, (size_t)MC * D, DFF / 64};
            for (int rep_ = 0; rep_ < MK_REP_GEMM; ++rep_) pg8::gemm_phase<pg8::EpiY, pg8::MixedOrder, PG8_ALIGN, PG8_SP2>(F.lds, g, S, E);
        }
        SEAM(pb + 9);
        if (INL(10)) {
            if (!last) nrm_rows<false, true, true>(F, 0, M, 0.5f, ng + 5 * D, modl, 8, F.A.in[I_NORMG] + 6 * D, MOD + (size_t)9 * 18432, 0, 1);
            else nrm_rows<false, true, false>(F, MC, M, 0.5f, ng + 5 * D, modl, 8, nullptr, nullptr, 0, 0);
        }
        SEAM(pb + 10);
    }
#undef IN
#undef SEAM
}

extern "C" void kernel_launch(void* const* d_in, const int* in_sizes, int n_in, void* d_out, int out_size, void* d_ws, size_t ws_size, hipStream_t stream) {
    static int grid = 0;
    if (grid == 0) {
        if (n_in != 27 || out_size != NB * SEQ * D || ws_size < WS_END) { fprintf(stderr, "kernel_launch: unexpected problem (n_in %d, out %d, ws %zu; need ws >= %zu); nothing launched\n", n_in, out_size, ws_size, (size_t)WS_END); grid = -1; return; }
        int dev = 0, cus = 0, per_cu = 0;
        if (hipGetDevice(&dev) != hipSuccess || hipDeviceGetAttribute(&cus, hipDeviceAttributeMultiprocessorCount, dev) != hipSuccess) { fprintf(stderr, "kernel_launch: device query failed\n"); grid = -1; return; }
        if (hipFuncSetAttribute((const void*)mk_fwd, hipFuncAttributeMaxDynamicSharedMemorySize, LDS_BYTES) != hipSuccess) { fprintf(stderr, "kernel_launch: hipFuncSetAttribute failed\n"); grid = -1; return; }
        if (hipOccupancyMaxActiveBlocksPerMultiprocessor(&per_cu, (const void*)mk_fwd, NWAVES * 64, LDS_BYTES) != hipSuccess || per_cu < 1)
            fprintf(stderr, "kernel_launch: note: occupancy query reports %d workgroups per CU\n", per_cu);
        (void)hipGetLastError();
        grid = cus;
        if (grid % 8 != 0) { fprintf(stderr, "kernel_launch: %d CUs; this kernel splits the grid into two groups of whole XCD octets and needs a multiple of 16; nothing launched\n", cus); grid = -1; return; }
    }
    if (grid < 0) return;
    if (hipMemsetAsync((char*)d_ws + WS_CTL, 0, CTL_ZERO_BYTES, stream) != hipSuccess) { fprintf(stderr, "kernel_launch: memset failed\n"); return; }
    Args a{};
    for (int i = 0; i < 27; ++i) a.in[i] = (const float*)d_in[i];
    a.out = (float*)d_out; a.ws = (unsigned char*)d_ws;
    a.ph_lo = 0; a.ph_hi = MK_LAST_PHASE;
    hipLaunchKernelGGL(mk_fwd, dim3(grid), dim3(NWAVES * 64), LDS_BYTES, stream, a);
    const hipError_t le = hipPeekAtLastError();
    if (le != hipSuccess) fprintf(stderr, "kernel_launch: launch failed: %s\n", hipGetErrorName(le));
}
```

```cpp
#include <hip/hip_runtime.h>
#include <cstdio>
#include <cstdint>
__device__ __forceinline__ int fresh_tid() { int t = threadIdx.x; asm volatile("" : "+v"(t)); return t; }
__device__ __forceinline__ float fexp(float x) { return __builtin_amdgcn_exp2f(x * 1.4426950408889634f); }
__device__ __forceinline__ float flog(float x) { return __builtin_amdgcn_logf(x) * 0.6931471805599453f; }
namespace pg8 {
#define PG8_LAS __attribute__((address_space(3)))
typedef unsigned short bf16_t;
typedef short bf16x8 __attribute__((ext_vector_type(8)));
typedef float f32x4 __attribute__((ext_vector_type(4)));
typedef unsigned u32x4 __attribute__((ext_vector_type(4)));
constexpr int BM = 256, BK = 64, HALF = 128, HTB = HALF * BK * 2  , STAGE_BYTES = 8 * HTB, NXCD = 8, WGM = 8;

__host__ __device__ __forceinline__ int lds_byte(int r, int c) { const int st = (r >> 4) * 2 + (c >> 5), rr = r & 15, cc = c & 31, ob = rr * 64 + cc * 2; return st * 1024 + (ob ^ (((ob >> 9) & 1) << 5)); }
__host__ __device__ __forceinline__ void stage_rc(int b, int& R, int& C) { const int st = b / 1024, sb = b % 1024, swz = sb ^ (((sb >> 9) & 1) << 5); R = (st >> 1) * 16 + swz / 64; C = (st & 1) * 32 + (swz % 64) / 2; }
__host__ __device__ __forceinline__ int perm32(int rho) { const int n = rho >> 4, i = rho & 15; return 8 * (i >> 2) + 4 * n + (i & 3); }

typedef int i32x4 __attribute__((ext_vector_type(4)));
template <bool I8> __device__ __forceinline__ f32x4 mma_op(const bf16x8 a, const bf16x8 b, const f32x4 c) {
    if constexpr (I8) return __builtin_bit_cast(f32x4, __builtin_amdgcn_mfma_i32_16x16x64_i8(__builtin_bit_cast(i32x4, a), __builtin_bit_cast(i32x4, b), __builtin_bit_cast(i32x4, c), 0, 0, 0));
    else return __builtin_amdgcn_mfma_f32_16x16x32_bf16(a, b, c, 0, 0, 0);
}
struct Unit { int pm, pn, pk, koff, nt; };
struct Gemm { const bf16_t* A; const bf16_t* Bt; int M, N, K; };

struct StaticOrder {
    int nM, nN, nwg, G, c, nt, pm0, nx, cmA = 1 << 20, cmB = 0;
    __host__ __device__ void init(int M, int N, int G_, int c_, int K_ = 0, int pm0_ = 0, int nx_ = NXCD) { nM = M / BM; nN = N / BM; nwg = nM * nN; G = G_; c = c_; nt = K_ / BK; pm0 = pm0_; nx = nx_; }
    __host__ __device__ bool next(int i, Unit& u) const {
        const long L = (long)i * G + c; if (L >= nwg) return false;
        int wgid = (int)L; { const int q = nwg / nx, r = nwg % nx, xcd = wgid % nx, off = wgid / nx; wgid = (xcd < r ? xcd * (q + 1) : r * (q + 1) + (xcd - r) * q) + off; }
        const int nig = WGM * nN, gid = wgid / nig, fm = gid * WGM, gsz = (nM - fm) < WGM ? (nM - fm) : WGM;
        u.pm = pm0 + fm + ((wgid % nig) % gsz); const int pj = (wgid % nig) / gsz; u.pn = pj < cmA ? pj : cmB + (pj - cmA); u.pk = 0; u.koff = 0; u.nt = nt; return true;
    }
    __device__ __forceinline__ void a_ready(const Unit&) const {}
    __device__ __forceinline__ void done(const Unit&) const {}
};
struct MixedOrder : StaticOrder {
    int nMs, nS, nwgS, nts, nA, a0, b0;
    __host__ __device__ void init(int M, int N, int G_, int c_, int K_, int pm0_, int Ms, int nS_, int nx_ = NXCD, int nNs_ = -1, int nA_ = 1 << 20, int a0_ = 0, int b0_ = 0) {
        StaticOrder::init(M, N, G_, c_, K_, pm0_, nx_); nMs = Ms / BM; nS = nS_; nwgS = nMs * (nNs_ < 0 ? nN : nNs_) * nS; nts = K_ / BK / nS_; nA = nA_; a0 = a0_; b0 = b0_; }
    __host__ __device__ bool next(int i, Unit& u) const {
        const long L = (long)i * G + c; if (L < nwg) return StaticOrder::next(i, u);
        const int l = (int)(L - nwg); if (l >= nwgS) return false;
        u.pk = l % nS; const int t = l / nS, q = t / nMs; u.pm = t % nMs; u.pn = q < nA ? a0 + q : b0 + (q - nA); u.koff = u.pk * nts * BK; u.nt = nts; return true;
    }
};

typedef float f32x2_t __attribute__((ext_vector_type(2)));
typedef __bf16 bf16x2_t __attribute__((ext_vector_type(2)));
__device__ __forceinline__ unsigned cvt_pk_bf16(float lo, float hi) { const f32x2_t v = {lo, hi}; return __builtin_bit_cast(unsigned, __builtin_convertvector(v, bf16x2_t)); }
__device__ __forceinline__ float silu_f(float x) { return x * __builtin_amdgcn_rcpf(1.0f + fexp(-x)); }

struct EpiF32 {
    static constexpr bool PERM = false, AFTER_DRAIN = false;
    float* C; int ldc;
    __device__ __forceinline__ void operator()(const f32x4 (&acc)[2][2][4][2], const Unit& u, int wr, int wc, int fr, int fq) const {
        const int row0 = u.pm * BM + wr * 64 + fr, col0 = u.pn * BM + wc * 32 + 4 * fq;
#pragma unroll
        for (int ai = 0; ai < 2; ++ai)
#pragma unroll
            for (int m = 0; m < 4; ++m) { float* rowp = C + (size_t)(row0 + ai * HALF + m * 16) * ldc + col0;
#pragma unroll
                for (int bj = 0; bj < 2; ++bj)
#pragma unroll
                    for (int n = 0; n < 2; ++n) *(f32x4*)(rowp + bj * HALF + n * 16) = acc[ai][bj][m][n]; }
    }
};
struct EpiY {
    static constexpr bool PERM = true, AFTER_DRAIN = false;
    bf16_t* O; int ldc; float* P; size_t split_stride; int nt_full;
    __device__ __forceinline__ void operator()(const f32x4 (&acc)[2][2][4][2], const Unit& u, int wr, int wc, int fr, int fq) const {
        const int row0 = u.pm * BM + wr * 64 + fr, col0 = u.pn * BM + wc * 32 + 8 * fq;
        if (u.nt == nt_full) {
#pragma unroll
            for (int ai = 0; ai < 2; ++ai)
#pragma unroll
                for (int m = 0; m < 4; ++m) { bf16_t* rowp = O + (size_t)(row0 + ai * HALF + m * 16) * ldc + col0;
#pragma unroll
                    for (int bj = 0; bj < 2; ++bj) { const f32x4 v0 = acc[ai][bj][m][0], v1 = acc[ai][bj][m][1];
                        u32x4 w; w.x = cvt_pk_bf16(v0[0], v0[1]); w.y = cvt_pk_bf16(v0[2], v0[3]); w.z = cvt_pk_bf16(v1[0], v1[1]); w.w = cvt_pk_bf16(v1[2], v1[3]);
                        *(u32x4*)(rowp + bj * HALF) = w; } }
        } else {
            float* Pb = P + (size_t)u.pk * split_stride;
#pragma unroll
            for (int ai = 0; ai < 2; ++ai)
#pragma unroll
                for (int m = 0; m < 4; ++m) { float* rowp = Pb + (size_t)(row0 + ai * HALF + m * 16) * ldc + col0;
#pragma unroll
                    for (int bj = 0; bj < 2; ++bj) { *(f32x4*)(rowp + bj * HALF) = acc[ai][bj][m][0]; *(f32x4*)(rowp + bj * HALF + 4) = acc[ai][bj][m][1]; } }
        }
    }
};
struct EpiSwiglu {
    static constexpr bool PERM = true, AFTER_DRAIN = false;
    bf16_t* O; int ldc;
    __device__ __forceinline__ void operator()(const f32x4 (&acc)[2][2][4][2], const Unit& u, int wr, int wc, int fr, int fq) const {
        const int row0 = u.pm * BM + wr * 64 + fr, col0 = u.pn * HALF + wc * 32 + 8 * fq;
#pragma unroll
        for (int ai = 0; ai < 2; ++ai)
#pragma unroll
            for (int m = 0; m < 4; ++m) { bf16_t* rowp = O + (size_t)(row0 + ai * HALF + m * 16) * ldc + col0;
                const f32x4 a0 = acc[ai][0][m][0], a1 = acc[ai][0][m][1], b0 = acc[ai][1][m][0], b1 = acc[ai][1][m][1];
                f32x4 v0, v1;
#pragma unroll
                for (int j = 0; j < 4; ++j) { v0[j] = silu_f(a0[j]) * b0[j]; v1[j] = silu_f(a1[j]) * b1[j]; }
                u32x4 w; w.x = cvt_pk_bf16(v0[0], v0[1]); w.y = cvt_pk_bf16(v0[2], v0[3]); w.z = cvt_pk_bf16(v1[0], v1[1]); w.w = cvt_pk_bf16(v1[2], v1[3]);
                *(u32x4*)rowp = w; }
    }
};
struct EpiSwigluI8 {
    static constexpr bool PERM = true, AFTER_DRAIN = false;
    bf16_t* O; int ldc; const float* rs; const float* cs;
    __device__ __forceinline__ void operator()(const f32x4 (&acc)[2][2][4][2], const Unit& u, int wr, int wc, int fr, int fq) const {
        const int row0 = u.pm * BM + wr * 64 + fr, col0 = u.pn * HALF + wc * 32 + 8 * fq;
        const float* csp = cs + u.pn * BM + wc * 32 + 8 * fq;
        const f32x4 ca0 = *(const f32x4*)csp, ca1 = *(const f32x4*)(csp + 4), cb0 = *(const f32x4*)(csp + HALF), cb1 = *(const f32x4*)(csp + HALF + 4);
        float rsv[2][4];
#pragma unroll
        for (int ai = 0; ai < 2; ++ai)
#pragma unroll
            for (int m = 0; m < 4; ++m) rsv[ai][m] = rs[row0 + ai * HALF + m * 16];
#pragma unroll
        for (int ai = 0; ai < 2; ++ai)
#pragma unroll
            for (int m = 0; m < 4; ++m) { bf16_t* rowp = O + (size_t)(row0 + ai * HALF + m * 16) * ldc + col0;
                const f32x4 a0 = acc[ai][0][m][0], a1 = acc[ai][0][m][1], b0 = acc[ai][1][m][0], b1 = acc[ai][1][m][1];
                const float rv = rsv[ai][m];
                f32x4 v0, v1;
#pragma unroll
                for (int j = 0; j < 4; ++j) {
                    const float fa0 = a0[j], fa1 = a1[j], fb0 = b0[j], fb1 = b1[j];
                    const float x0 = (float)__float_as_int(fa0) * (rv * ca0[j]), x1 = (float)__float_as_int(fa1) * (rv * ca1[j]);
                    const float y0 = (float)__float_as_int(fb0) * (rv * cb0[j]), y1 = (float)__float_as_int(fb1) * (rv * cb1[j]);
                    v0[j] = silu_f(x0) * y0; v1[j] = silu_f(x1) * y1; }
#pragma unroll
                for (int j = 0; j < 4; j += 2) { const float a = v0[j], c = v0[j + 1], d = v1[j], e = v1[j + 1]; v0[j] = a + c; v0[j + 1] = a - c; v1[j] = d + e; v1[j + 1] = d - e; }
#pragma unroll
                for (int j = 0; j < 2; ++j) { const float a = v0[j], c = v0[j + 2], d = v1[j], e = v1[j + 2]; v0[j] = a + c; v0[j + 2] = a - c; v1[j] = d + e; v1[j + 2] = d - e; }
#pragma unroll
                for (int j = 0; j < 4; ++j) { const float a = v0[j], c = v1[j]; v0[j] = (a + c) * 0.35355339059327379f; v1[j] = (a - c) * 0.35355339059327379f; }
                u32x4 w; w.x = cvt_pk_bf16(v0[0], v0[1]); w.y = cvt_pk_bf16(v0[2], v0[3]); w.z = cvt_pk_bf16(v1[0], v1[1]); w.w = cvt_pk_bf16(v1[2], v1[3]);
                *(u32x4*)rowp = w; }
    }
};
struct EpiYI8 {
    static constexpr bool PERM = true, AFTER_DRAIN = false;
    bf16_t* O; int ldc; float* P; size_t split_stride; int nt_full; const float* rs; const float* cs;
    __device__ __forceinline__ void operator()(const f32x4 (&acc)[2][2][4][2], const Unit& u, int wr, int wc, int fr, int fq) const {
        const int row0 = u.pm * BM + wr * 64 + fr, col0 = u.pn * BM + wc * 32 + 8 * fq;
        const float* csp = cs + col0;
        const f32x4 c00 = *(const f32x4*)csp, c01 = *(const f32x4*)(csp + 4), c10 = *(const f32x4*)(csp + HALF), c11 = *(const f32x4*)(csp + HALF + 4);
        float rsv[2][4];
#pragma unroll
        for (int ai = 0; ai < 2; ++ai)
#pragma unroll
            for (int m = 0; m < 4; ++m) rsv[ai][m] = rs[row0 + ai * HALF + m * 16];
        const bool whole = u.nt == nt_full;
        float* Pb = P + (size_t)u.pk * split_stride;
#pragma unroll
        for (int ai = 0; ai < 2; ++ai)
#pragma unroll
            for (int m = 0; m < 4; ++m) { const size_t ro = (size_t)(row0 + ai * HALF + m * 16) * ldc + col0; const float rv = rsv[ai][m];
#pragma unroll
                for (int bj = 0; bj < 2; ++bj) { const f32x4 v0 = acc[ai][bj][m][0], v1 = acc[ai][bj][m][1]; const f32x4 s0 = (bj ? c10 : c00) * rv, s1 = (bj ? c11 : c01) * rv;
                    f32x4 o0, o1;
#pragma unroll
                    for (int j = 0; j < 4; ++j) { const float f0 = v0[j], f1 = v1[j]; o0[j] = (float)__float_as_int(f0) * s0[j]; o1[j] = (float)__float_as_int(f1) * s1[j]; }
                    if (whole) { u32x4 w; w.x = cvt_pk_bf16(o0[0], o0[1]); w.y = cvt_pk_bf16(o0[2], o0[3]); w.z = cvt_pk_bf16(o1[0], o1[1]); w.w = cvt_pk_bf16(o1[2], o1[3]);
                        *(u32x4*)(O + ro + bj * HALF) = w; }
                    else { *(f32x4*)(Pb + ro + bj * HALF) = o0; *(f32x4*)(Pb + ro + bj * HALF + 4) = o1; } } }
    }
};
struct EpiProjI8 {
    static constexpr bool PERM = true, AFTER_DRAIN = false;
    bf16_t* O; int ldc; const float* rs; const float* cs;
    __device__ __forceinline__ void operator()(const f32x4 (&acc)[2][2][4][2], const Unit& u, int wr, int wc, int fr, int fq) const {
        const int row0 = u.pm * BM + wr * 64 + fr, col0 = u.pn * BM + wc * 32 + 8 * fq;
        const float* csp = cs + col0;
        const f32x4 c00 = *(const f32x4*)csp, c01 = *(const f32x4*)(csp + 4), c10 = *(const f32x4*)(csp + HALF), c11 = *(const f32x4*)(csp + HALF + 4);
        float rsv[2][4];
#pragma unroll
        for (int ai = 0; ai < 2; ++ai)
#pragma unroll
            for (int m = 0; m < 4; ++m) rsv[ai][m] = rs[row0 + ai * HALF + m * 16];
#pragma unroll
        for (int ai = 0; ai < 2; ++ai)
#pragma unroll
            for (int m = 0; m < 4; ++m) { bf16_t* rowp = O + (size_t)(row0 + ai * HALF + m * 16) * ldc + col0; const float rv = rsv[ai][m];
#pragma unroll
                for (int bj = 0; bj < 2; ++bj) { const f32x4 v0 = acc[ai][bj][m][0], v1 = acc[ai][bj][m][1]; const f32x4 s0 = (bj ? c10 : c00) * rv, s1 = (bj ? c11 : c01) * rv;
                    float o0[4], o1[4];
#pragma unroll
                    for (int j = 0; j < 4; ++j) { const float f0 = v0[j], f1 = v1[j]; o0[j] = (float)__float_as_int(f0) * s0[j]; o1[j] = (float)__float_as_int(f1) * s1[j]; }
                    u32x4 w; w.x = cvt_pk_bf16(o0[0], o0[1]); w.y = cvt_pk_bf16(o0[2], o0[3]); w.z = cvt_pk_bf16(o1[0], o1[1]); w.w = cvt_pk_bf16(o1[2], o1[3]);
                    *(u32x4*)(rowp + bj * HALF) = w; } }
    }
};
struct EpiProj {
    static constexpr bool PERM = true, AFTER_DRAIN = false;
    bf16_t* O; int ldc; float* gates; int gate_pn;
    __device__ __forceinline__ void operator()(const f32x4 (&acc)[2][2][4][2], const Unit& u, int wr, int wc, int fr, int fq) const {
        const int row0 = u.pm * BM + wr * 64 + fr, col0 = u.pn * BM + wc * 32 + 8 * fq;
#pragma unroll
        for (int ai = 0; ai < 2; ++ai)
#pragma unroll
            for (int m = 0; m < 4; ++m) { bf16_t* rowp = O + (size_t)(row0 + ai * HALF + m * 16) * ldc + col0;
#pragma unroll
                for (int bj = 0; bj < 2; ++bj) { const f32x4 v0 = acc[ai][bj][m][0], v1 = acc[ai][bj][m][1];
                    u32x4 w; w.x = cvt_pk_bf16(v0[0], v0[1]); w.y = cvt_pk_bf16(v0[2], v0[3]); w.z = cvt_pk_bf16(v1[0], v1[1]); w.w = cvt_pk_bf16(v1[2], v1[3]);
                    *(u32x4*)(rowp + bj * HALF) = w; } }
        if (u.pn == gate_pn && wc == 0) {
#pragma unroll
            for (int ai = 0; ai < 2; ++ai)
#pragma unroll
                for (int m = 0; m < 4; ++m) { float* gp = gates + (size_t)(row0 + ai * HALF + m * 16) * 32 + 8 * fq;
                    *(f32x4*)gp = acc[ai][0][m][0]; *(f32x4*)(gp + 4) = acc[ai][0][m][1]; }
        }
    }
};

template <class Epi, class Sched, bool ALIGN_EPI = false, bool SP2 = false, bool I8 = false>
__device__ __forceinline__ void gemm_phase(PG8_LAS unsigned char* lds, const Gemm g, const Sched& S, const Epi& E) {
    const int tid = fresh_tid(), wid = __builtin_amdgcn_readfirstlane(tid >> 6), lane = tid & 63, wr = wid >> 2, wc = wid & 3, fr = lane & 15, fq = lane >> 4;
    const int ld = g.K;
    unsigned voffA[2], voffB[2];
#pragma unroll
    for (int i = 0; i < 2; ++i) { int R, C; stage_rc(tid * 16 + i * 8192, R, C); const int Rb = Epi::PERM ? ((R & ~31) + perm32(R & 31)) : R;
        voffA[i] = (unsigned)(R * ld + C) * 2u; voffB[i] = (unsigned)(Rb * ld + C) * 2u; }
    const size_t kstep = (size_t)(BK * 2);
    const size_t hstep = (size_t)HALF * ld * 2;
    const size_t tstep = 2 * hstep;
    const unsigned ldsw = (unsigned)wid * 1024u;
    const int aoff = lds_byte(wr * 64 + fr, fq * 8), boff = lds_byte(wc * 32 + fr, fq * 8);
#define PG8_SA(b, h) (((b) * 2 + (h)) * HTB)
#define PG8_SB(b, h) ((4 + (b) * 2 + (h)) * HTB)
#define PG8_STAGE(bufoff, gbase, voff) do { _Pragma("unroll") for (int _i = 0; _i < 2; ++_i) \
        __builtin_amdgcn_global_load_lds((const unsigned*)((const char*)(gbase) + (voff)[_i]), (PG8_LAS unsigned*)(lds + (bufoff) + ldsw + _i * 8192), 16, 0, 0); } while (0)
#define PG8_LDA(dst, b, h) do { _Pragma("unroll") for (int m = 0; m < 4; ++m) _Pragma("unroll") for (int k = 0; k < 2; ++k) dst[m][k] = *(const PG8_LAS bf16x8*)(lds + PG8_SA(b, h) + aoff + m * 2048 + k * 1024); } while (0)
#define PG8_LDB(dst, b, h) do { _Pragma("unroll") for (int n = 0; n < 2; ++n) _Pragma("unroll") for (int k = 0; k < 2; ++k) dst[n][k] = *(const PG8_LAS bf16x8*)(lds + PG8_SB(b, h) + boff + n * 2048 + k * 1024); } while (0)
#define PG8_MMA(ai, bj, At, Bt) do { __builtin_amdgcn_s_setprio(1); _Pragma("unroll") for (int m = 0; m < 4; ++m) _Pragma("unroll") for (int n = 0; n < 2; ++n) _Pragma("unroll") for (int k = 0; k < 2; ++k) \
        acc[ai][bj][m][n] = mma_op<I8>(Bt[n][k], At[m][k], acc[ai][bj][m][n]); __builtin_amdgcn_s_setprio(0); } while (0)
#define PG8_WAIT_V(n) asm volatile("s_waitcnt vmcnt(" #n ")" ::: "memory")
#define PG8_WAIT_L(n) asm volatile("s_waitcnt lgkmcnt(" #n ")" ::: "memory")
#define PG8_BAR __builtin_amdgcn_s_barrier()
#define PG8_SCHED __builtin_amdgcn_sched_barrier(0)
    Unit cur, nxt; int ui = 0;
    if (!S.next(0, cur)) return;
    int nt = cur.nt;
    f32x4 acc[2][2][4][2];
#pragma unroll
    for (int a = 0; a < 2; ++a)
#pragma unroll
        for (int b = 0; b < 2; ++b)
#pragma unroll
            for (int m = 0; m < 4; ++m)
#pragma unroll
                for (int n = 0; n < 2; ++n) acc[a][b][m][n] = (f32x4){0.f, 0.f, 0.f, 0.f};
    bf16x8 At[4][2], B0[2][2], B1[2][2];
    const char* cA = (const char*)g.A + (size_t)cur.pm * tstep + (size_t)cur.koff * 2; const char* cB = (const char*)g.Bt + (size_t)cur.pn * tstep + (size_t)cur.koff * 2;
    S.a_ready(cur);
    if constexpr (SP2) {
        PG8_STAGE(PG8_SB(0, 0), cB, voffB); PG8_STAGE(PG8_SB(0, 1), cB + hstep, voffB); PG8_STAGE(PG8_SA(0, 0), cA, voffA); PG8_STAGE(PG8_SA(0, 1), cA + hstep, voffA);
        if (wr == 1) PG8_BAR;
        PG8_WAIT_V(2); PG8_BAR;
        PG8_STAGE(PG8_SB(1, 0), cB + kstep, voffB); PG8_STAGE(PG8_SA(1, 0), cA + kstep, voffA); PG8_STAGE(PG8_SB(1, 1), cB + hstep + kstep, voffB);
        PG8_WAIT_V(6); PG8_BAR;
    } else {
        PG8_STAGE(PG8_SB(0, 0), cB, voffB); PG8_STAGE(PG8_SA(0, 0), cA, voffA); PG8_STAGE(PG8_SB(0, 1), cB + hstep, voffB); PG8_STAGE(PG8_SA(0, 1), cA + hstep, voffA);
        if (wr == 1) PG8_BAR;
        PG8_WAIT_V(4); PG8_BAR;
        PG8_STAGE(PG8_SB(1, 0), cB + kstep, voffB); PG8_STAGE(PG8_SA(1, 0), cA + kstep, voffA); PG8_STAGE(PG8_SB(1, 1), cB + hstep + kstep, voffB);
        PG8_WAIT_V(6); PG8_BAR;
    }
    for (;;) {
        const bool has_next = S.next(ui + 1, nxt);
        const char* nA = has_next ? (const char*)g.A + (size_t)nxt.pm * tstep + (size_t)nxt.koff * 2 : cA; const char* nB = has_next ? (const char*)g.Bt + (size_t)nxt.pn * tstep + (size_t)nxt.koff * 2 : cB;
        for (int t = 0; t < nt; t += 2) {
            const bool last = (t == nt - 2);
            const char* a1 = cA + (size_t)(t + 1) * kstep;
            const char* a2 = last ? nA : cA + (size_t)(t + 2) * kstep; const char* b2 = last ? nB : cB + (size_t)(t + 2) * kstep;
            const char* a3 = a2 + kstep; const char* b3 = b2 + kstep;
            if (last && has_next) S.a_ready(nxt);
            if constexpr (SP2) {
            PG8_LDB(B0, 0, 0); PG8_LDB(B1, 0, 1); PG8_SCHED; PG8_LDA(At, 0, 0); PG8_STAGE(PG8_SA(1, 1), a1 + hstep, voffA);
            PG8_WAIT_V(8); PG8_WAIT_L(0); PG8_BAR; PG8_MMA(0, 0, At, B0); PG8_MMA(0, 1, At, B1); PG8_BAR; PG8_SCHED;
            PG8_LDA(At, 0, 1); PG8_STAGE(PG8_SB(0, 0), b2, voffB); PG8_STAGE(PG8_SB(0, 1), b2 + hstep, voffB); PG8_STAGE(PG8_SA(0, 0), a2, voffA);
            PG8_WAIT_V(8); PG8_WAIT_L(0); PG8_BAR; PG8_MMA(1, 0, At, B0); PG8_MMA(1, 1, At, B1); PG8_BAR; PG8_SCHED;
            PG8_LDB(B0, 1, 0); PG8_LDB(B1, 1, 1); PG8_SCHED; PG8_LDA(At, 1, 0); PG8_STAGE(PG8_SA(0, 1), a2 + hstep, voffA);
            PG8_WAIT_V(8); PG8_WAIT_L(0); PG8_BAR; PG8_MMA(0, 0, At, B0); PG8_MMA(0, 1, At, B1); PG8_BAR; PG8_SCHED;
            PG8_LDA(At, 1, 1); PG8_STAGE(PG8_SB(1, 0), b3, voffB); PG8_STAGE(PG8_SB(1, 1), b3 + hstep, voffB); PG8_STAGE(PG8_SA(1, 0), a3, voffA);
            PG8_WAIT_V(8); PG8_WAIT_L(0); PG8_BAR; PG8_MMA(1, 0, At, B0); PG8_MMA(1, 1, At, B1); PG8_BAR; PG8_SCHED;
            } else {
            PG8_LDB(B0, 0, 0); PG8_SCHED; PG8_LDA(At, 0, 0); PG8_STAGE(PG8_SA(1, 1), a1 + hstep, voffA);
            PG8_WAIT_L(8); PG8_BAR; PG8_WAIT_L(0); PG8_MMA(0, 0, At, B0); PG8_BAR; PG8_SCHED;
            PG8_LDB(B1, 0, 1); PG8_STAGE(PG8_SB(0, 0), b2, voffB);
            PG8_BAR; PG8_WAIT_L(0); PG8_MMA(0, 1, At, B1); PG8_BAR;
            PG8_LDA(At, 0, 1); PG8_STAGE(PG8_SA(0, 0), a2, voffA);
            PG8_BAR; PG8_WAIT_L(0); PG8_MMA(1, 0, At, B0); PG8_BAR; PG8_SCHED;
            PG8_STAGE(PG8_SB(0, 1), b2 + hstep, voffB);
            PG8_WAIT_V(6); PG8_BAR; PG8_MMA(1, 1, At, B1); PG8_BAR;
            PG8_LDB(B0, 1, 0); PG8_SCHED; PG8_LDA(At, 1, 0); PG8_STAGE(PG8_SA(0, 1), a2 + hstep, voffA);
            PG8_WAIT_L(8); PG8_BAR; PG8_WAIT_L(0); PG8_MMA(0, 0, At, B0); PG8_BAR; PG8_SCHED;
            PG8_LDB(B1, 1, 1); PG8_STAGE(PG8_SB(1, 0), b3, voffB);
            PG8_BAR; PG8_WAIT_L(0); PG8_MMA(0, 1, At, B1); PG8_BAR;
            PG8_LDA(At, 1, 1); PG8_STAGE(PG8_SA(1, 0), a3, voffA);
            PG8_BAR; PG8_WAIT_L(0); PG8_MMA(1, 0, At, B0); PG8_BAR; PG8_SCHED;
            PG8_STAGE(PG8_SB(1, 1), b3 + hstep, voffB);
            PG8_WAIT_V(6); PG8_BAR; PG8_MMA(1, 1, At, B1); PG8_BAR;
            }
        }
        if constexpr (ALIGN_EPI) { if (wr == 0) PG8_BAR; }
        if constexpr (!Epi::AFTER_DRAIN) { E(acc, cur, wr, wc, fr, fq); S.done(cur); }
        if (!has_next) break;
#pragma unroll
        for (int a = 0; a < 2; ++a)
#pragma unroll
            for (int b = 0; b < 2; ++b)
#pragma unroll
                for (int m = 0; m < 4; ++m)
#pragma unroll
                    for (int n = 0; n < 2; ++n) acc[a][b][m][n] = (f32x4){0.f, 0.f, 0.f, 0.f};
        cur = nxt; cA = nA; cB = nB; ++ui; nt = cur.nt;
        if constexpr (ALIGN_EPI) { if (wr == 1) PG8_BAR; }
    }
    PG8_WAIT_V(0);
    if constexpr (!ALIGN_EPI) { if (wr == 0) PG8_BAR; }
    PG8_BAR;
    if constexpr (Epi::AFTER_DRAIN) { E.fused(acc, cur, wr, wc, fr, fq, lds, wid, lane); S.done(cur); }
#undef PG8_SA
#undef PG8_SB
#undef PG8_STAGE
#undef PG8_LDA
#undef PG8_LDB
#undef PG8_MMA
#undef PG8_WAIT_V
#undef PG8_WAIT_L
#undef PG8_BAR
#undef PG8_SCHED
}
}

#ifndef PG8_SP2
#define PG8_SP2 true
#endif
#ifndef PG8_ALIGN
#define PG8_ALIGN true
#endif
#ifndef PG8_ALIGN_SWI
#define PG8_ALIGN_SWI true
#endif

constexpr int NWAVES = 8;
constexpr int D = 2048, NB = 8, SEQ = 4096, CTXL = 256, DFF = 5632, NMOD = 9;
#ifndef MK_NGRP
#define MK_NGRP 8
#endif
constexpr int NGRP = MK_NGRP, NBG = NB / NGRP, XPG = 8 / NGRP;
constexpr int MC = NBG * CTXL;
constexpr int MLAT = NBG * SEQ;
constexpr int M = MC + MLAT;
constexpr int NP0 = 5376, NP1 = 6400;
constexpr int NCH = (CTXL + SEQ) / 64;
constexpr int KSPLIT = 4;
constexpr float EPS = 1e-6f;
constexpr float QSCALE = 0.08838834764831845f;

constexpr size_t MiB = 1u << 20;
constexpr size_t WS_CTL = 0, CTL_ZERO_BYTES = 256 * 1024;
constexpr size_t WS_MOD = 1 * MiB;
constexpr size_t WS_GATES = 3 * MiB, GATES_G = (size_t)M * 32 * 4;
constexpr size_t WS_WRG = 8 * MiB;
constexpr size_t WS_PE = 9 * MiB;
constexpr size_t WS_RS = 9 * MiB + 512 * 1024;
constexpr size_t WS_CS = 9 * MiB + 768 * 1024;
constexpr size_t WS_CS2 = WS_CS + (size_t)4 * 2 * DFF * 4;
constexpr size_t WS_CS3 = WS_CS2 + (size_t)2 * 4096 * 4;
constexpr size_t WS_HCTX = 10 * MiB;
constexpr size_t WS_W = 26 * MiB, W_LAYER = 165 * MiB;
constexpr size_t W_F1I = 0, W_F1O = W_F1I + 44 * MiB, W_F2I = W_F1O + 22 * MiB, W_F2O = W_F2I + 44 * MiB, W_MI = W_F2O + 22 * MiB, W_MO = W_MI + 25 * MiB;
constexpr size_t WS_U = 356 * MiB, U_G = (size_t)M * D * 2;
constexpr size_t WS_Y = 492 * MiB, Y_G = (size_t)M * D * 4;
constexpr size_t WS_BIG = 764 * MiB, BIG_G = (size_t)M * NP1 * 2;
constexpr size_t YC_OFF = (size_t)M * D * 2;
constexpr size_t WS_END = 1189 * MiB;
static_assert(W_MO + 8 * MiB <= W_LAYER && WS_W + 2 * W_LAYER <= WS_U && WS_U + NGRP * U_G <= WS_Y && WS_Y + NGRP * Y_G <= WS_BIG && WS_BIG + NGRP * BIG_G <= WS_END, "ws map");
static_assert(YC_OFF + (size_t)KSPLIT * MC * D * 4 <= Y_G && WS_GATES + NGRP * GATES_G <= WS_WRG, "ws map (group blocks)");
constexpr size_t W_MI8 = W_F1I + 22 * MiB;
constexpr size_t U8B_OFF = YC_OFF + (size_t)KSPLIT * MC * D * 4;
static_assert(WS_CS3 + (size_t)4 * 2048 * 4 <= WS_HCTX, "ws map (FFN-out scales)");
static_assert(W_MI8 + (size_t)4096 * D <= W_F1O && U8B_OFF + (size_t)M * D <= Y_G && WS_CS2 + 2 * 4096 * 4 <= WS_HCTX, "ws map (int8 in-projection)");
static_assert(WS_PE + 64 * 1024 * 4 <= WS_RS && WS_RS + (size_t)NGRP * M * 4 <= WS_CS && WS_CS + (size_t)4 * 2 * DFF * 4 <= WS_HCTX, "ws map (scales)");
constexpr int CW_BAR = 4096;
static_assert((CW_BAR + (1 + NGRP) * 3456) * 4 <= (int)CTL_ZERO_BYTES, "control words inside the per-launch memset");
constexpr int CW_W1READY = 64;

constexpr int SCR_BYTES = 151552;
constexpr int LDSCTL_OFF = SCR_BYTES;
constexpr int LDS_BYTES = 155648;

#define GAS __attribute__((address_space(1)))
#define LAS __attribute__((address_space(3)))
typedef unsigned short bf16;
typedef float f32x4 __attribute__((ext_vector_type(4)));
typedef float f32x2 __attribute__((ext_vector_type(2)));
typedef short bf16x8 __attribute__((ext_vector_type(8)));
typedef short bf16x4 __attribute__((ext_vector_type(4)));
typedef unsigned u32x4 __attribute__((ext_vector_type(4)));
typedef unsigned u32x2 __attribute__((ext_vector_type(2)));
#define LDS_WAIT() asm volatile("s_waitcnt lgkmcnt(0)" ::: "memory")
__device__ __forceinline__ unsigned f2bf(float f) { unsigned u = __builtin_bit_cast(unsigned, f); return (u + 0x7fffu + ((u >> 16) & 1u)) >> 16; }
__device__ __forceinline__ unsigned pk2(float lo, float hi) { return pg8::cvt_pk_bf16(lo, hi); }
__device__ __forceinline__ float bflo(unsigned w) { return __uint_as_float(w << 16); }
__device__ __forceinline__ float bfhi(unsigned w) { return __uint_as_float(w & 0xffff0000u); }
__device__ __forceinline__ float wave_sum(float v) {
#pragma unroll
    for (int o = 1; o < 64; o <<= 1) v += __shfl_xor(v, o);
    return v;
}
__device__ __forceinline__ float sigmoid_f(float x) { return __builtin_amdgcn_rcpf(1.0f + fexp(-x)); }
__device__ __forceinline__ float silu_f(float x) { return x * sigmoid_f(x); }
__device__ __forceinline__ float logsig_f(float z) { return fminf(z, 0.f) - flog(1.0f + fexp(-fabsf(z))); }
__device__ __forceinline__ float gelu_tanh_f(float x) { const float u = 0.7978845608028654f * (x + 0.044715f * x * x * x); const float t = 1.0f - 2.0f * __builtin_amdgcn_rcpf(1.0f + fexp(2.0f * u)); return 0.5f * x * (1.0f + t); }

template <int N> __device__ __forceinline__ float dpp_row_shr(float x) { return __int_as_float(__builtin_amdgcn_update_dpp(0, __float_as_int(x), 0x110 + N, 0xF, 0xF, false)); }
typedef _Float16 f16x2_t __attribute__((ext_vector_type(2)));
__device__ __forceinline__ unsigned pkh2(float lo, float hi) { const f32x2 v = {lo, hi}; return __builtin_bit_cast(unsigned, __builtin_convertvector(v, f16x2_t)); }
__device__ __forceinline__ f32x2 uph2(unsigned w) { return __builtin_convertvector(__builtin_bit_cast(f16x2_t, w), f32x2); }
__device__ __forceinline__ unsigned q8x4(const f32x4 v, float inv) {
    const int q0 = (int)__builtin_rintf(v.x * inv), q1 = (int)__builtin_rintf(v.y * inv), q2 = (int)__builtin_rintf(v.z * inv), q3 = (int)__builtin_rintf(v.w * inv);
    return (unsigned)(q0 & 255) | ((unsigned)(q1 & 255) << 8) | ((unsigned)(q2 & 255) << 16) | ((unsigned)q3 << 24);
}
__device__ __forceinline__ void wht8(float (&x)[8]) {
#pragma unroll
    for (int h = 1; h < 8; h <<= 1)
#pragma unroll
        for (int i = 0; i < 8; ++i) if ((i & h) == 0) { const float a = x[i], c = x[i + h]; x[i] = a + c; x[i + h] = a - c; }
#pragma unroll
    for (int i = 0; i < 8; ++i) x[i] *= 0.35355339059327379f;
}
#define XB_TMO      128
#define XB_XCNT(j)  (256  + 64 * (j))
#define XB_XSUB(j)  (1280 + 64 * (j))
#define XB_XGEN(j)  (2304 + 64 * (j))
#define XB_TOP      3328
#define XB_TOPGEN   3392
#define XCD_BAR_WORDS 3456
#define XB_SPIN_CAP (1u << 18)

__device__ __forceinline__ unsigned xb_ld(unsigned* p)              { return __hip_atomic_load(p, __ATOMIC_RELAXED, __HIP_MEMORY_SCOPE_AGENT); }
__device__ __forceinline__ unsigned xb_add(unsigned* p, unsigned v) { return __hip_atomic_fetch_add(p, v, __ATOMIC_RELAXED, __HIP_MEMORY_SCOPE_AGENT); }
__device__ __forceinline__ unsigned xb_xcc_id() { return (unsigned)__builtin_amdgcn_s_getreg((3 << 11) | 20) & 0xFu; }
#define XB_SPIN(cond, bar) do { unsigned _sp = 0; while (cond) { __builtin_amdgcn_s_sleep(1); \
    if ((++_sp & 255u) == 0u) { if (xb_ld(&(bar)[XB_TMO])) break; if (_sp > XB_SPIN_CAP) { atomicAdd(&(bar)[XB_TMO], 1u); break; } } } } while (0)

struct XcdBarrier {
    unsigned* bar; unsigned x; unsigned ntot;
    volatile LAS unsigned* st;
};

__device__ __forceinline__ XcdBarrier xcd_barrier_post(unsigned* bar, volatile LAS unsigned* st, unsigned ntot) {
    XcdBarrier b; b.bar = bar; b.x = xb_xcc_id(); b.st = st; b.ntot = ntot;
    if (threadIdx.x == 0) (void)xb_add(&bar[XB_XCNT(b.x)], 1u);
    return b;
}
__device__ __forceinline__ void xcd_barrier_complete(unsigned* bar, unsigned x, unsigned G, unsigned& nloc, unsigned& nx) {
    unsigned sum, cnt, mine, sp = 0u;
    for (;;) {
        sum = 0u; cnt = 0u; mine = 0u;
#pragma unroll
        for (unsigned j = 0; j < 16; ++j) { const unsigned c = xb_ld(&bar[XB_XCNT(j)]); sum += c; cnt += (c > 0u) ? 1u : 0u; mine = (j == x) ? c : mine; }
        if (sum == G) break;
        __builtin_amdgcn_s_sleep(1);
        if ((++sp & 255u) == 0u) { if (xb_ld(&bar[XB_TMO])) break; if (sp > XB_SPIN_CAP) { atomicAdd(&bar[XB_TMO], 1u); break; } }
    }
    nloc = mine > 0u ? mine : 1u; nx = cnt > 0u ? cnt : 1u;
}

__device__ __forceinline__ void xcd_barrier(const XcdBarrier& b) {
    asm volatile("s_waitcnt vmcnt(0)" ::: "memory");
    __syncthreads();
    if (threadIdx.x == 0) {
        unsigned* bar = b.bar;
        __builtin_amdgcn_s_waitcnt(0);
        unsigned nloc = b.st[0], nx = b.st[1];
        if (nloc == 0u) { xcd_barrier_complete(bar, b.x, b.ntot, nloc, nx); b.st[0] = nloc; b.st[1] = nx; }
        const unsigned old = xb_add(&bar[XB_XSUB(b.x)], 1u);
        const unsigned gen = old / nloc;
        if (old + 1u == (gen + 1u) * nloc) {
            __builtin_amdgcn_fence(__ATOMIC_RELEASE, "agent");
            asm volatile("s_waitcnt vmcnt(0)" ::: "memory");
            const unsigned og = xb_add(&bar[XB_TOP], 1u);
            const unsigned tg = og / nx;
            if (og + 1u == (tg + 1u) * nx) xb_add(&bar[XB_TOPGEN], 1u);
            else XB_SPIN(xb_ld(&bar[XB_TOPGEN]) == tg, bar);
            __builtin_amdgcn_fence(__ATOMIC_ACQUIRE, "agent");
            xb_add(&bar[XB_XGEN(b.x)], 1u);
            asm volatile("s_waitcnt vmcnt(0)" ::: "memory");
        } else {
            XB_SPIN(xb_ld(&bar[XB_XGEN(b.x)]) == gen, bar);
            __builtin_amdgcn_fence(__ATOMIC_ACQUIRE, "agent");
            asm volatile("s_waitcnt vmcnt(0)" ::: "memory");
        }
    }
    __syncthreads();
}

struct Args { const float* in[27]; float* out; unsigned char* ws; int ph_lo, ph_hi; };
struct Frame {
    LAS unsigned char* lds;
    int G, wg, NGW;
    int grp;
    float* out; unsigned char* ws;
    const Args& A;
};
__device__ __forceinline__ bf16* gU(const Frame& F) { return (bf16*)(F.ws + WS_U + (size_t)F.grp * U_G); }
__device__ __forceinline__ bf16* gY(const Frame& F) { return (bf16*)(F.ws + WS_Y + (size_t)F.grp * Y_G); }
__device__ __forceinline__ bf16* gBIG(const Frame& F) { return (bf16*)(F.ws + WS_BIG + (size_t)F.grp * BIG_G); }
__device__ __forceinline__ float* gYC(const Frame& F) { return (float*)(F.ws + WS_Y + (size_t)F.grp * Y_G + YC_OFF); }
__device__ __forceinline__ float* gGATES(const Frame& F) { return (float*)(F.ws + WS_GATES + (size_t)F.grp * GATES_G); }
enum { I_X = 0, I_C, I_CTX, I_CCTX, I_WMOD, I_BMOD, I_NORMG, I_F1WI, I_F1WO, I_F2WI, I_F2WO, I_ABWI, I_WALPHA2, I_BALPHA, I_GLANG, I_CONVW, I_CONVB, I_RGWA, I_RGBA, I_RGWI, I_RGBI, I_LAM, I_ABWO, I_MLWI, I_MLBG, I_MLNG, I_MLWO };

__device__ __forceinline__ void pre_mod(Frame& F) {
    const int tid_ = fresh_tid(); const int lane_ = tid_ & 63, wave_ = __builtin_amdgcn_readfirstlane(tid_ >> 6), gw_ = F.wg * NWAVES + wave_; (void)lane_; (void)gw_;
    LAS float* sc = (LAS float*)F.lds;
    LAS float* red = (LAS float*)(F.lds + 9 * 2048 * 4);
    for (int i = tid_; i < 9 * 2048; i += 512) { const int bb = i >> 11, k = i & 2047; const float v = bb < 8 ? F.A.in[I_C][bb * 2048 + k] : F.A.in[I_CCTX][k]; sc[i] = v * (1.0f / (1.0f + expf(-v))); }
    __syncthreads();
    float* MOD = (float*)(F.ws + WS_MOD);
    const int q = tid_ & 15, kg = tid_ >> 4;
    for (int item = F.wg; item < 2 * 288; item += F.G) {
        const int layer = item / 288, col0 = (item % 288) * 64;
        const float* wp = F.A.in[I_WMOD] + ((size_t)layer * 2048 + (size_t)kg * 64) * 18432 + col0 + 4 * q;
        f32x4 acc[9];
#pragma unroll
        for (int bb = 0; bb < 9; ++bb) acc[bb] = (f32x4){0.f, 0.f, 0.f, 0.f};
#pragma unroll 4
        for (int kk = 0; kk < 64; ++kk) {
            const f32x4 w = *(const f32x4*)(wp + (size_t)kk * 18432);
#pragma unroll
            for (int bb = 0; bb < 9; ++bb) acc[bb] += w * sc[bb * 2048 + kg * 64 + kk];
        }
#pragma unroll
        for (int bb = 0; bb < 9; ++bb)
#pragma unroll
            for (int e = 0; e < 4; ++e) { float v = acc[bb][e]; v += __shfl_xor(v, 16); v += __shfl_xor(v, 32); acc[bb][e] = v; }
        __syncthreads();
        if (lane_ < 16) {
#pragma unroll
            for (int bb = 0; bb < 9; ++bb) *(LAS f32x4*)(red + (wave_ * 9 + bb) * 64 + 4 * q) = acc[bb];
        }
        __syncthreads();
        for (int t = tid_; t < 9 * 64; t += 512) { const int bb = t >> 6, ci = t & 63; float s = F.A.in[I_BMOD][layer * 18432 + col0 + ci];
#pragma unroll
            for (int w = 0; w < 8; ++w) s += red[(w * 9 + bb) * 64 + ci];
            MOD[((size_t)layer * 9 + bb) * 18432 + col0 + ci] = s; }
    }
    __syncthreads();
}
__device__ __forceinline__ void pre_pe(Frame& F) {
    const int tid_ = fresh_tid(); const int lane_ = tid_ & 63, wave_ = __builtin_amdgcn_readfirstlane(tid_ >> 6), gw_ = F.wg * NWAVES + wave_; (void)lane_; (void)gw_;
    float* PE = (float*)(F.ws + WS_PE);
    for (int i = F.wg * 512 + tid_; i < 64 * 512; i += F.G * 512) {
        const int p = i >> 9, f = i & 511;
        const float om = (float)exp2(-(double)f * (13.287712379549449 / 512.0));
        const float angf = (float)p * om; const double x = (double)angf;
        const double kf = rint(x * 0.6366197723675814);
        double r = fma(-kf, 1.5707963267948966, x); r = fma(-kf, 6.123233995736766e-17, r);
        const int k = ((int)kf) & 3; const double r2 = r * r;
        const double sp = r * (1.0 + r2 * (-1.0 / 6.0 + r2 * (1.0 / 120.0 + r2 * (-1.0 / 5040.0 + r2 * (1.0 / 362880.0 + r2 * (-1.0 / 39916800.0 + r2 * (1.0 / 6227020800.0)))))));
        const double cp = 1.0 + r2 * (-0.5 + r2 * (1.0 / 24.0 + r2 * (-1.0 / 720.0 + r2 * (1.0 / 40320.0 + r2 * (-1.0 / 3628800.0 + r2 * (1.0 / 479001600.0))))));
        const double s = (k == 0) ? sp : (k == 1) ? cp : (k == 2) ? -sp : -cp;
        const double c = (k == 0) ? cp : (k == 1) ? -sp : (k == 2) ? -cp : sp;
        PE[p * 1024 + f] = (float)s; PE[p * 1024 + 512 + f] = (float)c;
    }
}
template <int MAP> __device__ __forceinline__ int cvt_row(int n) {
    if (MAP == 1) return n < DFF ? ((n >> 7) << 8) + (n & 127) : (((n - DFF) >> 7) << 8) + 128 + ((n - DFF) & 127);
    if (MAP == 2) return n < 3072 ? n : (n < 3104 ? n + 2048 : n - 32);
    return n;
}
template <int MAP> __device__ __forceinline__ void cvt_item_kn(const float* W, int K, int N, bf16* WT, LAS float* scr, int kb, int nb, int lane) {
    const int k0 = 64 * kb, n0 = 32 * nb;
#pragma unroll 8
    for (int i = 0; i < 32; ++i) { const int kk = 2 * i + (lane >> 5); scr[kk * 33 + (lane & 31)] = W[(size_t)(k0 + kk) * N + n0 + (lane & 31)]; }
    LDS_WAIT(); asm volatile("" ::: "memory");
    const int c = lane & 7;
#pragma unroll
    for (int j = 0; j < 4; ++j) { const int n = (lane >> 3) + 8 * j; const LAS float* s = scr + (8 * c) * 33 + n;
        u32x4 o; o.x = pk2(s[0 * 33], s[1 * 33]); o.y = pk2(s[2 * 33], s[3 * 33]); o.z = pk2(s[4 * 33], s[5 * 33]); o.w = pk2(s[6 * 33], s[7 * 33]);
        *(u32x4*)(WT + (size_t)cvt_row<MAP>(n0 + n) * K + k0 + 8 * c) = o; }
    LDS_WAIT(); asm volatile("" ::: "memory");
}
template <int MAP> __device__ __forceinline__ void cvt_item(const float* W, int K, int N, bf16* WT, LAS float* scr, int item, int lane) { const int nblk = N / 32; cvt_item_kn<MAP>(W, K, N, WT, scr, item / nblk, item % nblk, lane); }
__device__ __forceinline__ void cvt8_item(const float* W, int N, unsigned char* WT8, float* cs, int n0, int nr0, LAS unsigned char* lds, int tid) {
    constexpr int PITCH = 2048 + 16;
    const int c = tid & 31, kg = tid >> 5;
    float v[128]; float am = 0.f;
    const float* wp = W + (size_t)(4 * kg) * N + n0 + c; const size_t istep = (size_t)64 * N;
#pragma unroll
    for (int i = 0; i < 32; ++i) {
#pragma unroll
        for (int e = 0; e < 4; ++e) { const float x = wp[(size_t)e * N]; v[4 * i + e] = x; am = fmaxf(am, fabsf(x)); }
        wp += istep;
        if ((i & 7) == 7) __builtin_amdgcn_sched_barrier(0);
    }
    LAS float* red = (LAS float*)(lds + 32 * PITCH);
    red[kg * 32 + c] = am;
    __syncthreads();
    float m = 0.f;
#pragma unroll
    for (int g = 0; g < 16; ++g) m = fmaxf(m, red[g * 32 + c]);
    m = fmaxf(m, 1e-30f);
    const float inv = 127.0f / m;
#pragma unroll
    for (int i = 0; i < 32; ++i) *(LAS unsigned*)(lds + c * PITCH + 4 * (kg + 16 * i)) = q8x4((f32x4){v[4 * i], v[4 * i + 1], v[4 * i + 2], v[4 * i + 3]}, inv);
    if (kg == 0) cs[nr0 + c] = m * (1.0f / 127.0f);
    __syncthreads();
#pragma unroll
    for (int j = 0; j < 8; ++j) { const int id = tid + 512 * j, col = id >> 7, ch = id & 127;
        *(u32x4*)(WT8 + (size_t)(nr0 + col) * 2048 + 16 * ch) = *(const LAS u32x4*)(lds + col * PITCH + 16 * ch); }
    __syncthreads();
}
__device__ __forceinline__ void cvt8o_item(const float* W, unsigned char* WT8, float* cs, int n0, LAS unsigned char* lds, int tid) {
    constexpr int KH = DFF / 2, PITCH = KH + 16;
    const int c = tid & 31, kg = tid >> 5;
    const float* wp = W + n0 + c;
    float am = 0.f;
#pragma unroll 4
    for (int i = 0; i < 44; ++i) { const int g = kg + 16 * i; float x[8];
#pragma unroll
        for (int e = 0; e < 8; ++e) x[e] = wp[(size_t)(8 * g + e) * D];
        wht8(x);
#pragma unroll
        for (int e = 0; e < 8; ++e) am = fmaxf(am, fabsf(x[e])); }
    LAS float* red = (LAS float*)(lds + 32 * PITCH);
    red[kg * 32 + c] = am;
    __syncthreads();
    float m = 0.f;
#pragma unroll
    for (int g = 0; g < 16; ++g) m = fmaxf(m, red[g * 32 + c]);
    m = fmaxf(m, 1e-30f);
    const float inv = 127.0f / m;
    if (kg == 0) cs[n0 + c] = m * (1.0f / 127.0f);
    for (int half = 0; half < 2; ++half) {
#pragma unroll 2
        for (int i = 22 * half; i < 22 * half + 22; ++i) { const int g = kg + 16 * i; float x[8];
#pragma unroll
            for (int e = 0; e < 8; ++e) x[e] = wp[(size_t)(8 * g + e) * D];
            wht8(x);
            u32x2 w; w.x = q8x4((f32x4){x[0], x[1], x[2], x[3]}, inv); w.y = q8x4((f32x4){x[4], x[5], x[6], x[7]}, inv);
            *(LAS u32x2*)(lds + c * PITCH + 8 * (g - 352 * half)) = w; }
        __syncthreads();
        for (int id = tid; id < 32 * (KH / 16); id += 512) { const int col = id / (KH / 16), ch = id % (KH / 16);
            *(u32x4*)(WT8 + (size_t)(n0 + col) * (2 * DFF) + half * KH + 16 * ch) = *(const LAS u32x4*)(lds + col * PITCH + 16 * ch); }
        __syncthreads();
    }
}
template <int LAYER> __device__ __forceinline__ void cvt_layer(Frame& F, int pct_lo = 0, int pct_hi = 1024) {
    const int tid_ = fresh_tid(); const int lane_ = tid_ & 63, wave_ = __builtin_amdgcn_readfirstlane(tid_ >> 6), gw_ = F.wg * NWAVES + wave_; (void)lane_; (void)gw_;
    LAS float* scr = (LAS float*)(F.lds + wave_ * 16384);
    constexpr int I0 = 32 * 352, I1 = 88 * 64, NKEEP = LAYER == 0 ? 33 : 65, I4 = 32 * NKEEP, I5 = 32 * 64, I6 = LAYER == 0 ? 256 : 0;
    constexpr int NITEMS = I4 + I5 + I6; (void)I0; (void)I1;
    const float* f1i = F.A.in[I_F1WI] + (size_t)LAYER * D * 2 * DFF; const float* f1o = F.A.in[I_F1WO] + (size_t)LAYER * DFF * D;
    const float* f2i = F.A.in[I_F2WI] + (size_t)LAYER * D * 2 * DFF; const float* f2o = F.A.in[I_F2WO] + (size_t)LAYER * DFF * D;
    {
        constexpr int NB8 = 2 * DFF / 32;
        const int lo8 = 2 * NB8 * pct_lo / 1024, hi8 = 2 * NB8 * pct_hi / 1024;
        float* cs = (float*)(F.ws + WS_CS) + (size_t)LAYER * 2 * (2 * DFF);
        __syncthreads();
        for (int it = lo8 + F.wg; it < hi8; it += F.G) { const int f = it >= NB8, n0 = 32 * (it - f * NB8);
            cvt8_item(f ? f2i : f1i, 2 * DFF, F.ws + WS_W + LAYER * W_LAYER + (f ? W_F2I : W_F1I), cs + f * (2 * DFF), n0, cvt_row<1>(n0), F.lds, tid_); }
        const int loA = 128 * pct_lo / 1024, hiA = 128 * pct_hi / 1024;
        for (int it = loA + F.wg; it < hiA; it += F.G) { const int f = it >= 64;
            cvt8o_item(f ? f2o : f1o, F.ws + WS_W + LAYER * W_LAYER + (f ? W_F2O : W_F1O), (float*)(F.ws + WS_CS3) + (LAYER * 2 + f) * 2048, 32 * (it - 64 * f), F.lds, tid_); }
        const int lo9 = 128 * pct_lo / 1024, hi9 = 128 * pct_hi / 1024;
        for (int it = lo9 + F.wg; it < hi9; it += F.G) { const int j0 = 32 * it;
            const int n0 = LAYER == 0 ? j0 + 1024 + (j0 >= 2048 ? 32 : 0) : j0 + 2048;
            cvt8_item(LAYER == 0 ? F.A.in[I_ABWI] : F.A.in[I_MLWI], LAYER == 0 ? 5152 : 6176, F.ws + WS_W + LAYER * W_LAYER + W_MI8, (float*)(F.ws + WS_CS2) + LAYER * 4096, n0, j0, F.lds, tid_); }
    }
    const int it_lo = (int)((long)NITEMS * pct_lo / 1024), it_hi = (int)((long)NITEMS * pct_hi / 1024);
    for (int it = it_lo + gw_; it < it_hi; it += F.NGW) {
        int r = it;
        if (r < I4) {
            const int kb = r / NKEEP, j = r % NKEEP, nb = j < NKEEP - 1 ? j : (LAYER == 0 ? 96 : 192);
            if (LAYER == 0) cvt_item_kn<2>(F.A.in[I_ABWI], D, 5152, (bf16*)(F.ws + WS_W + LAYER * W_LAYER + W_MI), scr, kb, nb, lane_); else cvt_item_kn<0>(F.A.in[I_MLWI], D, 6176, (bf16*)(F.ws + WS_W + LAYER * W_LAYER + W_MI), scr, kb, nb, lane_); continue; } r -= I4;
        if (r < I5) { cvt_item<0>(LAYER == 0 ? F.A.in[I_ABWO] : F.A.in[I_MLWO], D, D, (bf16*)(F.ws + WS_W + LAYER * W_LAYER + W_MO), scr, r, lane_); continue; } r -= I5;
        if (LAYER == 0) { const int mi = r >> 3, sub = r & 7, dir = mi >> 4, mat = (mi >> 3) & 1, n = mi & 7;
            const float* src = (mat ? F.A.in[I_RGWI] : F.A.in[I_RGWA]) + (size_t)(dir * 8 + n) * 128 * 128;
            cvt_item<0>(src, 128, 128, (bf16*)(F.ws + WS_WRG) + (size_t)mi * 128 * 128, scr, sub, lane_); }
    }
    constexpr int PR0 = LAYER == 0 ? 5152 : 6176, PR1 = LAYER == 0 ? NP0 : NP1;
    u32x4* z = (u32x4*)((bf16*)(F.ws + WS_W + LAYER * W_LAYER + W_MI) + (size_t)PR0 * D);
    if (pct_hi == 1024) for (int i = F.wg * 512 + tid_; i < (PR1 - PR0) * D / 8; i += F.G * 512) z[i] = (u32x4){0u, 0u, 0u, 0u};
}

__device__ __forceinline__ float wave_sum8(const float (&v)[8], int lane) {
    const bool h1 = (lane & 1) != 0, h2 = (lane & 2) != 0, h4 = (lane & 4) != 0;
    float w4[4], w2[2];
#pragma unroll
    for (int i = 0; i < 4; ++i) { const float send = h1 ? v[i] : v[4 + i], keep = h1 ? v[4 + i] : v[i]; w4[i] = keep + __shfl_xor(send, 1); }
#pragma unroll
    for (int i = 0; i < 2; ++i) { const float send = h2 ? w4[i] : w4[2 + i], keep = h2 ? w4[2 + i] : w4[i]; w2[i] = keep + __shfl_xor(send, 2); }
    const float send = h4 ? w2[0] : w2[1], keep = h4 ? w2[1] : w2[0];
    float w = keep + __shfl_xor(send, 4);
    w += __shfl_xor(w, 8); w += __shfl_xor(w, 16); w += __shfl_xor(w, 32);
    return w;
}
__device__ __forceinline__ unsigned char* gU8B(const Frame& F) { return (unsigned char*)gY(F) + U8B_OFF; }
__device__ __forceinline__ float* gRS(const Frame& F) { return (float*)(F.ws + WS_RS) + (size_t)F.grp * M; }
__device__ __forceinline__ float* hrow(Frame& F, int r) { return r < MC ? (float*)(F.ws + WS_HCTX) + (size_t)(r + F.grp * MC) * D : F.out + (size_t)((r - MC) + F.grp * MLAT) * D; }
__device__ __forceinline__ float wave_total(float x) {
    x += dpp_row_shr<1>(x); x += dpp_row_shr<2>(x); x += dpp_row_shr<4>(x); x += dpp_row_shr<8>(x);
    const int xi = __float_as_int(x);
    return (__int_as_float(__builtin_amdgcn_readlane(xi, 15)) + __int_as_float(__builtin_amdgcn_readlane(xi, 31))) + (__int_as_float(__builtin_amdgcn_readlane(xi, 47)) + __int_as_float(__builtin_amdgcn_readlane(xi, 63)));
}
__device__ __forceinline__ float wave_max_nonneg(float x) {
    x = fmaxf(x, dpp_row_shr<1>(x)); x = fmaxf(x, dpp_row_shr<2>(x)); x = fmaxf(x, dpp_row_shr<4>(x)); x = fmaxf(x, dpp_row_shr<8>(x));
    const int xi = __float_as_int(x);
    return fmaxf(fmaxf(__int_as_float(__builtin_amdgcn_readlane(xi, 15)), __int_as_float(__builtin_amdgcn_readlane(xi, 31))), fmaxf(__int_as_float(__builtin_amdgcn_readlane(xi, 47)), __int_as_float(__builtin_amdgcn_readlane(xi, 63))));
}
template <bool INIT, bool HAS_Y>
__device__ __forceinline__ void nrm_load(Frame& F, int rr_, int lane_, const bf16* Yb, f32x4 (&hn)[8], u32x2 (&hbn)[8], u32x2 (&yn)[8]) {
#pragma unroll
    for (int j = 0; j < 8; ++j) { const int d0 = 256 * j + 4 * lane_;
        if (INIT) hn[j] = rr_ < MC ? *(const f32x4*)(F.A.in[I_CTX] + (size_t)(rr_ + F.grp * MC) * D + d0) : *(const f32x4*)(F.A.in[I_X] + (size_t)((rr_ - MC) + F.grp * MLAT) * D + d0);
        else hbn[j] = *(const u32x2*)((const bf16*)hrow(F, rr_) + D + d0);
        if (HAS_Y) { if (rr_ >= MC) yn[j] = *(const u32x2*)(Yb + (size_t)rr_ * D + d0); } }
}
template <bool INIT, bool HAS_Y, bool HAS_U, bool FINAL, int U8>
__device__ __forceinline__ void nrm_row(Frame& F, int r, int nxt, int row_hi, int lane_, LAS float* PRM, const bf16* Yb, bf16* U, const float* PE, float wgt, int nsplit,
                                        f32x4 (&hn)[8], u32x2 (&hbn)[8], u32x2 (&yn)[8]) {
    const int s = r < MC ? NBG : (r - MC) >> 12;
    const LAS float* Pg = PRM + (2 + 3 * s) * D;
    f32x4 hv[8]; u32x2 yr[8];
#pragma unroll
    for (int j = 0; j < 8; ++j) { if (INIT) hv[j] = hn[j]; else { const f32x2 a_ = uph2(hbn[j].x), b_ = uph2(hbn[j].y); hv[j] = (f32x4){a_.x, a_.y, b_.x, b_.y}; } if (HAS_Y) yr[j] = yn[j]; }
    if (nxt < row_hi) nrm_load<INIT, HAS_Y>(F, nxt, lane_, Yb, hn, hbn, yn);
    float* hp = hrow(F, r);
    if (INIT) { if (r >= MC) { const int t = (r - MC) & (SEQ - 1), prow = t >> 6, pcol = t & 63;
#pragma unroll
        for (int j = 0; j < 8; ++j) { const int d0 = 256 * j + 4 * lane_; hv[j] = hv[j] + (j < 4 ? *(const f32x4*)(PE + prow * 1024 + d0) : *(const f32x4*)(PE + pcol * 1024 + d0 - 1024)); } } }
    if (HAS_Y) {
        f32x4 yv[8]; float ss = 0.f;
#pragma unroll
        for (int j = 0; j < 8; ++j) { const int d0 = 256 * j + 4 * lane_;
            if (r < MC) { const float* yc = gYC(F) + (size_t)r * D + d0;
                f32x4 a = *(const f32x4*)yc;
#pragma unroll
                for (int k = 1; k < KSPLIT; ++k) if (k < nsplit) a = a + *(const f32x4*)(yc + (size_t)k * MC * D);
                yv[j] = a; }
            else yv[j] = (f32x4){bflo(yr[j].x), bfhi(yr[j].x), bflo(yr[j].y), bfhi(yr[j].y)};
            ss += (yv[j].x * yv[j].x + yv[j].y * yv[j].y) + (yv[j].z * yv[j].z + yv[j].w * yv[j].w); }
        const float r1 = rsqrtf(wave_total(ss) * (1.0f / D) + EPS) * wgt;
#pragma unroll
        for (int j = 0; j < 8; ++j) { const int d0 = 256 * j + 4 * lane_;
            const f32x4 gp = *(const LAS f32x4*)(PRM + d0), gt = *(const LAS f32x4*)(Pg + d0);
            hv[j] = hv[j] + gt * (yv[j] * r1 * gp); }
    }
    if (INIT || HAS_Y) {
#pragma unroll
        for (int j = 0; j < 8; ++j) { if (FINAL) *(f32x4*)(hp + 256 * j + 4 * lane_) = hv[j]; else { u32x2 w; w.x = pkh2(hv[j].x, hv[j].y); w.y = pkh2(hv[j].z, hv[j].w); *(u32x2*)((bf16*)hp + D + 256 * j + 4 * lane_) = w; } }
    }
    if (HAS_U) {
        float ss = 0.f;
#pragma unroll
        for (int j = 0; j < 8; ++j) ss += (hv[j].x * hv[j].x + hv[j].y * hv[j].y) + (hv[j].z * hv[j].z + hv[j].w * hv[j].w);
        const float r2 = rsqrtf(wave_total(ss) * (1.0f / D) + EPS);
#pragma unroll
        for (int j = 0; j < 8; ++j) { const int d0 = 256 * j + 4 * lane_;
            const f32x4 gn = *(const LAS f32x4*)(PRM + D + d0), sh = *(const LAS f32x4*)(Pg + D + d0), sc = *(const LAS f32x4*)(Pg + 2 * D + d0);
            const f32x4 u = (hv[j] * r2 * gn) * sc + sh;
            if (U8 != 0) hv[j] = u;
            if (U8 != 1) { u32x2 w; w.x = pk2(u.x, u.y); w.y = pk2(u.z, u.w);
                *(u32x2*)(U + (size_t)r * D + d0) = w; } }
        if (U8 != 0) {
            float am = 0.f;
#pragma unroll
            for (int j = 0; j < 8; ++j) am = fmaxf(am, fmaxf(fmaxf(fabsf(hv[j].x), fabsf(hv[j].y)), fmaxf(fabsf(hv[j].z), fabsf(hv[j].w))));
            am = fmaxf(wave_max_nonneg(am), 1e-20f);
            const float inv = 127.0f / am;
            unsigned char* u8p = (U8 == 1 ? (unsigned char*)U : gU8B(F)) + (size_t)r * D + 4 * lane_;
#pragma unroll
            for (int j = 0; j < 8; ++j) *(unsigned*)(u8p + 256 * j) = q8x4(hv[j], inv);
            if (lane_ == 0) gRS(F)[r] = am * (1.0f / 127.0f);
        }
    }
}
template <bool INIT, bool HAS_Y, bool HAS_U, bool FINAL = false, int U8 = 0>
__device__ __forceinline__ void nrm_rows(Frame& F, int row_lo, int row_hi, float wgt, const float* gpost, const float* mod_g, int gate_slot,
                                         const float* gpre, const float* mod_u, int shift_slot, int scale_slot, int nsplit = KSPLIT) {
    const int tid_ = fresh_tid(); const int lane_ = tid_ & 63, wave_ = __builtin_amdgcn_readfirstlane(tid_ >> 6), gw_ = F.wg * NWAVES + wave_;
    const bf16* Yb = gY(F); bf16* U = gU(F); const float* PE = (const float*)(F.ws + WS_PE);
    LAS float* PRM = (LAS float*)F.lds;
    __syncthreads();
    for (int i = tid_; i < (2 + 3 * (NBG + 1)) * (D / 4); i += NWAVES * 64) { const int v = i / (D / 4), c4 = (i % (D / 4)) * 4;
        f32x4 val = (f32x4){0.f, 0.f, 0.f, 0.f};
        if (v == 0) { if (HAS_Y) val = *(const f32x4*)(gpost + c4); }
        else if (v == 1) { if (HAS_U) val = *(const f32x4*)(gpre + c4); }
        else { const int s = (v - 2) / 3, k = (v - 2) % 3; const int bb = s < NBG ? F.grp * NBG + s : 8;
            if (k == 0) { if (HAS_Y) val = *(const f32x4*)(mod_g + ((size_t)bb * 9 + gate_slot) * D + c4); }
            else if (HAS_U) { val = *(const f32x4*)(mod_u + ((size_t)bb * 9 + (k == 1 ? shift_slot : scale_slot)) * D + c4); if (k == 2) val = val + 1.0f; } }
        *(LAS f32x4*)(PRM + v * D + c4) = val; }
    f32x4 hnA[8]; u32x2 hbA[8], ynA[8];
    const int st = F.NGW; int r = row_lo + gw_;
    if (r < row_hi) nrm_load<INIT, HAS_Y>(F, r, lane_, Yb, hnA, hbA, ynA);
    __syncthreads();
    for (; r < row_hi; r += st) nrm_row<INIT, HAS_Y, HAS_U, FINAL, U8>(F, r, r + st, row_hi, lane_, PRM, Yb, U, PE, wgt, nsplit, hnA, hbA, ynA);
    __syncthreads();
}

__device__ __forceinline__ void requant_rows(Frame& F, int row_lo, int row_hi) {
    const int tid_ = fresh_tid(); const int lane_ = tid_ & 63, wave_ = __builtin_amdgcn_readfirstlane(tid_ >> 6), gw_ = F.wg * NWAVES + wave_;
    bf16* H = gBIG(F); float* RS = gRS(F);
    u32x4 nx[11];
    int r = row_lo + gw_;
    if (r < row_hi) {
#pragma unroll
        for (int j = 0; j < 11; ++j) nx[j] = *(const u32x4*)(H + (size_t)r * DFF + (j * 64 + lane_) * 8); }
    for (; r < row_hi; r += F.NGW) {
        u32x4 cv[11];
#pragma unroll
        for (int j = 0; j < 11; ++j) cv[j] = nx[j];
        if (r + F.NGW < row_hi) {
#pragma unroll
            for (int j = 0; j < 11; ++j) nx[j] = *(const u32x4*)(H + (size_t)(r + F.NGW) * DFF + (j * 64 + lane_) * 8); }
        float am = 0.f;
#pragma unroll
        for (int j = 0; j < 11; ++j) { const u32x4 v = cv[j];
            am = fmaxf(am, fmaxf(fmaxf(fmaxf(fabsf(bflo(v.x)), fabsf(bfhi(v.x))), fmaxf(fabsf(bflo(v.y)), fabsf(bfhi(v.y)))), fmaxf(fmaxf(fabsf(bflo(v.z)), fabsf(bfhi(v.z))), fmaxf(fabsf(bflo(v.w)), fabsf(bfhi(v.w)))))); }
        am = fmaxf(wave_max_nonneg(am), 1e-20f);
        const float inv = 127.0f / am;
        unsigned char* o8 = (unsigned char*)(H + (size_t)r * DFF);
#pragma unroll
        for (int j = 0; j < 11; ++j) { const u32x4 v = cv[j];
            u32x2 w; w.x = q8x4((f32x4){bflo(v.x), bfhi(v.x), bflo(v.y), bfhi(v.y)}, inv); w.y = q8x4((f32x4){bflo(v.z), bfhi(v.z), bflo(v.w), bfhi(v.w)}, inv);
            *(u32x2*)(o8 + (j * 64 + lane_) * 8) = w; }
        if (lane_ == 0) RS[r] = am * (1.0f / 127.0f);
    }
}
__device__ __forceinline__ void unpack8(const u32x4 v, float (&f)[8]) { f[0] = bflo(v.x); f[1] = bfhi(v.x); f[2] = bflo(v.y); f[3] = bfhi(v.y); f[4] = bflo(v.z); f[5] = bfhi(v.z); f[6] = bflo(v.w); f[7] = bfhi(v.w); }
__device__ __forceinline__ u32x4 pack8(const float (&f)[8]) { u32x4 o; o.x = pk2(f[0], f[1]); o.y = pk2(f[2], f[3]); o.z = pk2(f[4], f[5]); o.w = pk2(f[6], f[7]); return o; }
__device__ __forceinline__ void comb0_rows(Frame& F, int row_lo, int row_hi) {
    const int tid_ = fresh_tid(); const int lane_ = tid_ & 63, wave_ = __builtin_amdgcn_readfirstlane(tid_ >> 6), gw_ = F.wg * NWAVES + wave_;
    const bf16* OFb = gY(F); const bf16* OBb = OFb + (size_t)M * 1024; const bf16* HFb = OBb + (size_t)M * 1024; const bf16* HBb = HFb + (size_t)M * 1024;
    const bf16* P = gBIG(F); bf16* U = gU(F); const float* gg = F.A.in[I_GLANG];
    const int e0 = 16 * lane_;
    f32x4 gn[4];
#pragma unroll
    for (int c = 0; c < 4; ++c) gn[c] = *(const f32x4*)(gg + (e0 & 255) + 4 * c);
    u32x4 nx[12];
#define C0_LOAD(r_) do { const size_t o_ = (size_t)(r_) * 1024 + e0; const bf16* g_ = P + (size_t)(r_) * NP0 + e0; \
        nx[0] = *(const u32x4*)(OFb + o_); nx[1] = *(const u32x4*)(OFb + o_ + 8); nx[2] = *(const u32x4*)(OBb + o_); nx[3] = *(const u32x4*)(OBb + o_ + 8); nx[4] = *(const u32x4*)(g_ + 2048); nx[5] = *(const u32x4*)(g_ + 2056); \
        nx[6] = *(const u32x4*)(HFb + o_); nx[7] = *(const u32x4*)(HFb + o_ + 8); nx[8] = *(const u32x4*)(HBb + o_); nx[9] = *(const u32x4*)(HBb + o_ + 8); nx[10] = *(const u32x4*)(g_ + 4096); nx[11] = *(const u32x4*)(g_ + 4104); } while (0)
    int r = row_lo + gw_;
    if (r < row_hi) C0_LOAD(r);
    for (; r < row_hi; r += F.NGW) {
        u32x4 cu[12];
#pragma unroll
        for (int i = 0; i < 12; ++i) cu[i] = nx[i];
        if (r + F.NGW < row_hi) C0_LOAD(r + F.NGW);
#pragma unroll
        for (int part = 0; part < 2; ++part) {
            float a[2][8], b8[8], g[2][8], o[2][8];
            unpack8(cu[6 * part + 0], a[0]); unpack8(cu[6 * part + 1], a[1]);
            unpack8(cu[6 * part + 2], b8);
#pragma unroll
            for (int e = 0; e < 8; ++e) a[0][e] += b8[e];
            unpack8(cu[6 * part + 3], b8);
#pragma unroll
            for (int e = 0; e < 8; ++e) a[1][e] += b8[e];
            unpack8(cu[6 * part + 4], g[0]); unpack8(cu[6 * part + 5], g[1]);
            if (part == 0) {
                float ss = 0.f;
#pragma unroll
                for (int c = 0; c < 2; ++c)
#pragma unroll
                    for (int e = 0; e < 8; ++e) ss += a[c][e] * a[c][e];
                ss += __shfl_xor(ss, 1); ss += __shfl_xor(ss, 2); ss += __shfl_xor(ss, 4); ss += __shfl_xor(ss, 8);
                const float rr = rsqrtf(ss * (1.0f / 256.0f) + EPS);
#pragma unroll
                for (int c = 0; c < 2; ++c)
#pragma unroll
                    for (int e = 0; e < 8; ++e) o[c][e] = a[c][e] * rr * gn[2 * c + (e >> 2)][e & 3] * silu_f(g[c][e]);
            } else {
#pragma unroll
                for (int c = 0; c < 2; ++c)
#pragma unroll
                    for (int e = 0; e < 8; ++e) o[c][e] = a[c][e] * gelu_tanh_f(g[c][e]);
            }
            bf16* up = U + (size_t)r * D + part * 1024 + e0;
            *(u32x4*)up = pack8(o[0]); *(u32x4*)(up + 8) = pack8(o[1]);
        }
    }
#undef C0_LOAD
}
__device__ __forceinline__ void comb1_rows(Frame& F, int row_lo, int row_hi) {
    const int tid_ = fresh_tid(); const int lane_ = tid_ & 63, wave_ = __builtin_amdgcn_readfirstlane(tid_ >> 6), gw_ = F.wg * NWAVES + wave_;
    const bf16* HFb = gY(F); const bf16* HBb = HFb + (size_t)M * D;
    const bf16* P = gBIG(F); bf16* U = gU(F); const float* gg = F.A.in[I_MLNG];
    const int e0 = 32 * lane_;
    f32x4 gn[8];
#pragma unroll
    for (int c = 0; c < 8; ++c) gn[c] = *(const f32x4*)(gg + (e0 & 255) + 4 * c);
    u32x4 nx[12];
#define C1_LOAD(r_) do { const size_t o_ = (size_t)(r_) * D + e0; const bf16* g_ = P + (size_t)(r_) * NP1 + 4096 + e0; \
        _Pragma("unroll") for (int c = 0; c < 4; ++c) { nx[c] = *(const u32x4*)(HFb + o_ + 8 * c); nx[4 + c] = *(const u32x4*)(HBb + o_ + 8 * c); nx[8 + c] = *(const u32x4*)(g_ + 8 * c); } } while (0)
    int r = row_lo + gw_;
    if (r < row_hi) C1_LOAD(r);
    for (; r < row_hi; r += F.NGW) {
        u32x4 cu[12];
#pragma unroll
        for (int i = 0; i < 12; ++i) cu[i] = nx[i];
        if (r + F.NGW < row_hi) C1_LOAD(r + F.NGW);
        float a[4][8]; float ss = 0.f;
#pragma unroll
        for (int c = 0; c < 4; ++c) { float y8[8]; unpack8(cu[c], a[c]); unpack8(cu[4 + c], y8);
#pragma unroll
            for (int e = 0; e < 8; ++e) { a[c][e] += y8[e]; ss += a[c][e] * a[c][e]; } }
        ss += __shfl_xor(ss, 1); ss += __shfl_xor(ss, 2); ss += __shfl_xor(ss, 4);
        const float rr = rsqrtf(ss * (1.0f / 256.0f) + EPS);
#pragma unroll
        for (int c = 0; c < 4; ++c) { float g8[8], o8[8]; unpack8(cu[8 + c], g8);
#pragma unroll
            for (int e = 0; e < 8; ++e) o8[e] = a[c][e] * rr * gn[2 * c + (e >> 2)][e & 3] * sigmoid_f(g8[e]);
            *(u32x4*)(U + (size_t)r * D + e0 + 8 * c) = pack8(o8); }
    }
#undef C1_LOAD
}

#define WG_BAR() do { asm volatile("s_waitcnt lgkmcnt(0)" ::: "memory"); __builtin_amdgcn_s_barrier(); asm volatile("" ::: "memory"); } while (0)
__device__ __forceinline__ int chunk_rlo(int b, int dir, int c) {
    return c < 4 ? b * CTXL + (dir ? (CTXL - 64 - 64 * c) : 64 * c) : MC + b * SEQ + (dir ? (SEQ - 64 - 64 * (c - 4)) : 64 * (c - 4));
}
__device__ __forceinline__ bf16x8 tr_frag(LAS unsigned char* tile, int pitch, int k0, int c0, int lane) {
    const int g = lane >> 4, q = (lane & 15) >> 2, p = lane & 3;
    LAS unsigned char* a0 = tile + (k0 + 8 * g + q) * pitch + (c0 + 4 * p) * 2;
    const bf16x4 lo = __builtin_amdgcn_ds_read_tr16_b64_v4i16((LAS bf16x4*)a0);
    const bf16x4 hi = __builtin_amdgcn_ds_read_tr16_b64_v4i16((LAS bf16x4*)(a0 + 4 * pitch));
    return __builtin_shufflevector(lo, hi, 0, 1, 2, 3, 4, 5, 6, 7);
}
__device__ __forceinline__ u32x4 scale8(const u32x4 v, float s) {
    u32x4 o; o.x = pk2(bflo(v.x) * s, bfhi(v.x) * s); o.y = pk2(bflo(v.y) * s, bfhi(v.y) * s); o.z = pk2(bflo(v.z) * s, bfhi(v.z) * s); o.w = pk2(bflo(v.w) * s, bfhi(v.w) * s); return o;
}
template <int N> __device__ __forceinline__ float dpp_row_shr_ninf(float x) { return __int_as_float(__builtin_amdgcn_update_dpp((int)0xff800000u, __float_as_int(x), 0x110 + N, 0xF, 0xF, false)); }
__device__ __forceinline__ float wave_incl_sum(float x, int lane) {
    x += dpp_row_shr<1>(x); x += dpp_row_shr<2>(x); x += dpp_row_shr<4>(x); x += dpp_row_shr<8>(x);
    const int xi = __float_as_int(x);
    const float t0 = __int_as_float(__builtin_amdgcn_readlane(xi, 15)), t1 = __int_as_float(__builtin_amdgcn_readlane(xi, 31)), t2 = __int_as_float(__builtin_amdgcn_readlane(xi, 47));
    return x + (lane >= 16 ? t0 : 0.f) + (lane >= 32 ? t1 : 0.f) + (lane >= 48 ? t2 : 0.f);
}
__device__ __forceinline__ float wave_incl_max(float x, int lane) {
    x = fmaxf(x, dpp_row_shr_ninf<1>(x)); x = fmaxf(x, dpp_row_shr_ninf<2>(x)); x = fmaxf(x, dpp_row_shr_ninf<4>(x)); x = fmaxf(x, dpp_row_shr_ninf<8>(x));
    const int xi = __float_as_int(x);
    const float t0 = __int_as_float(__builtin_amdgcn_readlane(xi, 15)), t1 = __int_as_float(__builtin_amdgcn_readlane(xi, 31)), t2 = __int_as_float(__builtin_amdgcn_readlane(xi, 47));
    const float ninf = __int_as_float((int)0xff800000u);
    return fmaxf(fmaxf(x, lane >= 16 ? t0 : ninf), fmaxf(lane >= 32 ? t1 : ninf, lane >= 48 ? t2 : ninf));
}

template <int MODE>
__device__ __forceinline__ void chain_scan(LAS unsigned char* lds,
        const bf16* __restrict__ proj, const int NP, const int qcol, const int kcol, const int vcol,
        const float* __restrict__ gates, const int gcol, const int b, const int dir,
        bf16* __restrict__ outb, const int out_ld, const int ocol, const bool ctx_out,
        const float* __restrict__ w2, const float* __restrict__ ba, const float bias_i, const float bias_f) {
    const int tid = fresh_tid(); const int lane = tid & 63, wave = __builtin_amdgcn_readfirstlane(tid >> 6);
    constexpr int NVB = MODE ? 9 : 8;
    constexpr int PQ = 272, PV = 304, PP = 144;
    constexpr int O_QS = 0, O_KS = 17408, O_QH = 34816, O_KH = 52224, O_VS = 69632, O_PS = 89088, O_SB = 98304, O_SM = 137472;
    LAS float* LR = (LAS float*)(lds + O_SM);
    LAS float* TOT = (LAS float*)(lds + O_SM + 4096);
    LAS float* FIRST = (LAS float*)(lds + O_SM + 8192);
    LAS float* DEC = (LAS float*)(lds + O_SM + 8704);
    LAS float* A_ = (LAS float*)(lds + O_SM);
    LAS float* MI = A_ + 64; LAS float* WI = A_ + 128; LAS float* WK = A_ + 192; LAS float* MR = A_ + 256; LAS float* DEN = A_ + 320; LAS float* DECS = A_ + 384;
    const int fr = lane & 15, fq = lane >> 4;

    __syncthreads();
    for (int i = tid; i < (9216 + 39168) / 16; i += 512) *(LAS u32x4*)(lds + O_PS + 16 * i) = (u32x4){0u, 0u, 0u, 0u};
    if (MODE) { if (tid < 64) { *(LAS u32x4*)(lds + O_VS + tid * PV + 256) = (u32x4){0x3F80u, 0u, 0u, 0u}; *(LAS u32x4*)(lds + O_VS + tid * PV + 272) = (u32x4){0u, 0u, 0u, 0u}; } }
    constexpr int NVW = MODE ? 5 : 4;
    const int dq = wave & 3, vh2 = wave >> 2;
    f32x4 S[2][NVW];
#pragma unroll
    for (int dl = 0; dl < 2; ++dl)
#pragma unroll
        for (int v = 0; v < NVW; ++v) S[dl][v] = (f32x4){0.f, 0.f, 0.f, 0.f};
    float mst = 0.f;
    bf16x8 W2A = (bf16x8){0, 0, 0, 0, 0, 0, 0, 0}; f32x4 bias4 = (f32x4){0.f, 0.f, 0.f, 0.f};
    if (MODE == 0) {
        if (fq < 2) { float wv[8];
#pragma unroll
            for (int e = 0; e < 8; ++e) wv[e] = w2[(8 * fq + e) * 512 + 16 * wave + fr];
            const u32x4 pk = pack8(wv); W2A = __builtin_bit_cast(bf16x8, pk); }
        bias4 = *(const f32x4*)(ba + 16 * wave + 4 * fq);
    }
    const int sj0 = tid >> 4, sj1 = (tid + 512) >> 4, sch = tid & 15;
    u32x4 pq[2], pk[2], pv[2]; f32x4 plr = (f32x4){0.f, 0.f, 0.f, 0.f}; float pgi = 0.f, pgf = 0.f;
#define CH_PREFETCH(cc) do { const int rl_ = chunk_rlo(b, dir, (cc)); \
        { const int row_ = dir ? rl_ + 63 - sj0 : rl_ + sj0; const bf16* rp_ = proj + (size_t)row_ * NP + 8 * sch; pq[0] = *(const u32x4*)(rp_ + qcol); pk[0] = *(const u32x4*)(rp_ + kcol); pv[0] = *(const u32x4*)(rp_ + vcol); } \
        { const int row_ = dir ? rl_ + 63 - sj1 : rl_ + sj1; const bf16* rp_ = proj + (size_t)row_ * NP + 8 * sch; pq[1] = *(const u32x4*)(rp_ + qcol); pk[1] = *(const u32x4*)(rp_ + kcol); pv[1] = *(const u32x4*)(rp_ + vcol); } \
        if (MODE == 0) { if (tid < 256) { const int j_ = tid >> 2; const int row_ = dir ? rl_ + 63 - j_ : rl_ + j_; plr = *(const f32x4*)(gates + (size_t)row_ * 32 + gcol + 4 * (tid & 3)); } } \
        else { const int row_ = dir ? rl_ + 63 - lane : rl_ + lane; pgi = gates[(size_t)row_ * 32 + gcol]; pgf = gates[(size_t)row_ * 32 + gcol + 8]; } } while (0)
#if defined(MK_CHAIN_PROBE)
    unsigned long long cp_acc = 0ull, cp_t = 0ull;
#define CP_MARK(seg) do { if (MODE == MK_CHAIN_PROBE_MODE) { const unsigned long long n_ = __builtin_amdgcn_s_memrealtime(); if ((seg) == MK_CHAIN_PROBE + 1 || (MK_CHAIN_PROBE == 9 && (seg) != 0)) cp_acc += n_ - cp_t; cp_t = n_; } } while (0)
#else
#define CP_MARK(seg) do {} while (0)
#endif
    CH_PREFETCH(0);
    for (int c = 0; c < NCH; ++c) {
        const int rl = chunk_rlo(b, dir, c);
        CP_MARK(0);
        *(LAS u32x4*)(lds + O_QS + sj0 * PQ + 16 * sch) = pq[0]; *(LAS u32x4*)(lds + O_QS + sj1 * PQ + 16 * sch) = pq[1];
        *(LAS u32x4*)(lds + O_KS + sj0 * PQ + 16 * sch) = pk[0]; *(LAS u32x4*)(lds + O_KS + sj1 * PQ + 16 * sch) = pk[1];
        *(LAS u32x4*)(lds + O_VS + sj0 * PV + 16 * sch) = pv[0]; *(LAS u32x4*)(lds + O_VS + sj1 * PV + 16 * sch) = pv[1];
        if (MODE == 0) { if (tid < 256) *(LAS f32x4*)(LR + (tid >> 2) * 16 + 4 * (tid & 3)) = plr; }
        if (MODE == 1) {
            const float ipre = pgi + bias_i, lf = logsig_f(pgf + bias_f);
            const float bsum = wave_incl_sum(lf, lane);
            const float a = ipre - bsum;
            const float cm = wave_incl_max(a, lane);
            const float Mi = fmaxf(mst, cm);
            const float blast = __int_as_float(__builtin_amdgcn_readlane(__float_as_int(bsum), 63)), M63 = __int_as_float(__builtin_amdgcn_readlane(__float_as_int(Mi), 63));
            const float wi = fexp(mst - Mi) * QSCALE, wk = fexp(a - M63);
            if (wave == 0) { A_[lane] = a; MI[lane] = Mi; ((c & 1) ? WI : MR)[lane] = fexp(-(bsum + Mi)); if (lane == 0) DECS[0] = fexp(mst - M63); }
            mst = blast + M63;
            const float wi0 = __shfl(wi, sj0), wi1 = __shfl(wi, sj1), wk0 = __shfl(wk, sj0), wk1 = __shfl(wk, sj1);
            *(LAS u32x4*)(lds + O_QH + sj0 * PQ + 16 * sch) = scale8(pq[0], wi0); *(LAS u32x4*)(lds + O_QH + sj1 * PQ + 16 * sch) = scale8(pq[1], wi1);
            *(LAS u32x4*)(lds + O_KH + sj0 * PQ + 16 * sch) = scale8(pk[0], wk0); *(LAS u32x4*)(lds + O_KH + sj1 * PQ + 16 * sch) = scale8(pk[1], wk1);
        }
        if (c + 1 < NCH) CH_PREFETCH(c + 1);
        if (MODE == 0) WG_BAR();
        if (MODE == 0) {
            f32x4 zz[4];
#pragma unroll
            for (int tb = 0; tb < 4; ++tb) {
                bf16x8 Bf = (bf16x8){0, 0, 0, 0, 0, 0, 0, 0};
                if (fq < 2) { const f32x4 l0 = *(const LAS f32x4*)(LR + (16 * tb + fr) * 16 + 8 * fq), l1 = *(const LAS f32x4*)(LR + (16 * tb + fr) * 16 + 8 * fq + 4);
                    u32x4 pk; pk.x = pk2(l0.x, l0.y); pk.y = pk2(l0.z, l0.w); pk.z = pk2(l1.x, l1.y); pk.w = pk2(l1.z, l1.w); Bf = __builtin_bit_cast(bf16x8, pk); }
                zz[tb] = __builtin_amdgcn_mfma_f32_16x16x32_bf16(W2A, Bf, bias4, 0, 0, 0);
            }
            f32x4 bb[4]; f32x4 carry = (f32x4){0.f, 0.f, 0.f, 0.f};
#pragma unroll
            for (int tb = 0; tb < 4; ++tb) {
#pragma unroll
                for (int r = 0; r < 4; ++r) { float x = fmaxf(logsig_f(zz[tb][r]) * (1.0f / 16.0f), -1.0f);
                    x += dpp_row_shr<1>(x); x += dpp_row_shr<2>(x); x += dpp_row_shr<4>(x); x += dpp_row_shr<8>(x);
                    const float tot = __shfl(x, (lane & 48) | 15);
                    bb[tb][r] = x + carry[r]; carry[r] += tot; }
            }
            f32x4 bref, e1, e2;
#pragma unroll
            for (int r = 0; r < 4; ++r) { bref[r] = __shfl(bb[2][r], lane & 48); e1[r] = fexp(bref[r]); e2[r] = fexp(carry[r] - bref[r]); }
#pragma unroll
            for (int tb = 0; tb < 4; ++tb) {
                const int off = (16 * tb + fr) * PQ + (16 * wave + 4 * fq) * 2;
                const u32x2 qw = *(const LAS u32x2*)(lds + O_QS + off), kw = *(const LAS u32x2*)(lds + O_KS + off);
                const f32x4 qv = (f32x4){bflo(qw.x), bfhi(qw.x), bflo(qw.y), bfhi(qw.y)} * QSCALE, kv = (f32x4){bflo(kw.x), bfhi(kw.x), bflo(kw.y), bfhi(kw.y)};
                f32x4 ef, er;
#pragma unroll
                for (int r = 0; r < 4; ++r) { ef[r] = fexp(bb[tb][r] - bref[r]); er[r] = __builtin_amdgcn_rcpf(ef[r]); }
                const f32x4 qt = qv * ef, kt = kv * er, qh = qt * e1, kh = kt * e2;
                u32x2 w; w.x = pk2(qt[0], qt[1]); w.y = pk2(qt[2], qt[3]); *(LAS u32x2*)(lds + O_QS + off) = w;
                w.x = pk2(qh[0], qh[1]); w.y = pk2(qh[2], qh[3]); *(LAS u32x2*)(lds + O_QH + off) = w;
                w.x = pk2(kt[0], kt[1]); w.y = pk2(kt[2], kt[3]); *(LAS u32x2*)(lds + O_KS + off) = w;
                w.x = pk2(kh[0], kh[1]); w.y = pk2(kh[2], kh[3]); *(LAS u32x2*)(lds + O_KH + off) = w;
            }
            if (fr == 0) { f32x4 dv;
#pragma unroll
                for (int r = 0; r < 4; ++r) dv[r] = fexp(carry[r]);
                *(LAS f32x4*)(DEC + 16 * wave + 4 * fq) = dv; }
        }
        WG_BAR();
        CP_MARK(1);
        for (int tix = wave; tix < 10; tix += 8) {
            const int ib = tix >= 6 ? 3 : (tix >= 3 ? 2 : (tix >= 1 ? 1 : 0)); const int jb = tix - ib * (ib + 1) / 2;
            f32x4 acc = (f32x4){0.f, 0.f, 0.f, 0.f};
            bf16x8 Ak[4], Bq[4];
#pragma unroll
            for (int ks = 0; ks < 4; ++ks) { Ak[ks] = *(const LAS bf16x8*)(lds + O_KS + (16 * jb + fr) * PQ + (32 * ks + 8 * fq) * 2); Bq[ks] = *(const LAS bf16x8*)(lds + O_QS + (16 * ib + fr) * PQ + (32 * ks + 8 * fq) * 2); }
#pragma unroll
            for (int ks = 0; ks < 4; ++ks) acc = __builtin_amdgcn_mfma_f32_16x16x32_bf16(Ak[ks], Bq[ks], acc, 0, 0, 0);
            const int i = 16 * ib + fr, j0 = 16 * jb + 4 * fq;
            float w[4];
            if (MODE) { const float Mi = MI[i];
#pragma unroll
                for (int r = 0; r < 4; ++r) w[r] = (j0 + r <= i) ? acc[r] * QSCALE * fexp(A_[j0 + r] - Mi) : 0.f;
            } else {
#pragma unroll
                for (int r = 0; r < 4; ++r) w[r] = (j0 + r <= i) ? acc[r] : 0.f;
            }
            u32x2 pw; pw.x = pk2(w[0], w[1]); pw.y = pk2(w[2], w[3]);
            *(LAS u32x2*)(lds + O_PS + i * PP + j0 * 2) = pw;
        }
        WG_BAR();
        CP_MARK(2);
        const int ibp = wave & 1, vq = wave >> 1;
        const bool has8 = MODE && vq == 0;
        f32x4 ao[2][3];
#pragma unroll
        for (int il = 0; il < 2; ++il)
#pragma unroll
            for (int vl = 0; vl < 3; ++vl) ao[il][vl] = (f32x4){0.f, 0.f, 0.f, 0.f};
#pragma unroll
        for (int ks = 0; ks < 2; ++ks) {
            bf16x8 Bp[2], Av[3];
#pragma unroll
            for (int il = 0; il < 2; ++il) Bp[il] = *(const LAS bf16x8*)(lds + O_PS + (16 * (2 * ibp + il) + fr) * PP + (32 * ks + 8 * fq) * 2);
#pragma unroll
            for (int vl = 0; vl < 2; ++vl) Av[vl] = tr_frag(lds + O_VS, PV, 32 * ks, 16 * (2 * vq + vl), lane);
            if (MODE) Av[2] = tr_frag(lds + O_VS, PV, 32 * ks, 128, lane);
#pragma unroll
            for (int il = 0; il < 2; ++il) {
#pragma unroll
                for (int vl = 0; vl < 2; ++vl) ao[il][vl] = __builtin_amdgcn_mfma_f32_16x16x32_bf16(Av[vl], Bp[il], ao[il][vl], 0, 0, 0);
                if (MODE) { if (has8) ao[il][2] = __builtin_amdgcn_mfma_f32_16x16x32_bf16(Av[2], Bp[il], ao[il][2], 0, 0, 0); } }
        }
#pragma unroll
        for (int ks = 0; ks < 4; ++ks) {
            bf16x8 Bq[2], As[3];
#pragma unroll
            for (int il = 0; il < 2; ++il) Bq[il] = *(const LAS bf16x8*)(lds + O_QH + (16 * (2 * ibp + il) + fr) * PQ + (32 * ks + 8 * fq) * 2);
#pragma unroll
            for (int vl = 0; vl < 2; ++vl) As[vl] = *(const LAS bf16x8*)(lds + O_SB + (16 * (2 * vq + vl) + fr) * PQ + (32 * ks + 8 * fq) * 2);
            if (MODE) As[2] = *(const LAS bf16x8*)(lds + O_SB + (128 + fr) * PQ + (32 * ks + 8 * fq) * 2);
#pragma unroll
            for (int il = 0; il < 2; ++il) {
#pragma unroll
                for (int vl = 0; vl < 2; ++vl) ao[il][vl] = __builtin_amdgcn_mfma_f32_16x16x32_bf16(As[vl], Bq[il], ao[il][vl], 0, 0, 0);
                if (MODE) { if (has8) ao[il][2] = __builtin_amdgcn_mfma_f32_16x16x32_bf16(As[2], Bq[il], ao[il][2], 0, 0, 0); } }
        }
        if (MODE == 0) {
#pragma unroll
            for (int dl = 0; dl < 2; ++dl) { const f32x4 dec = *(const LAS f32x4*)(DEC + 16 * (2 * dq + dl) + 4 * fq);
#pragma unroll
                for (int v = 0; v < NVW; ++v) S[dl][v] = S[dl][v] * dec; }
        } else { const float dsc = DECS[0];
#pragma unroll
            for (int dl = 0; dl < 2; ++dl)
#pragma unroll
                for (int v = 0; v < NVW; ++v) S[dl][v] = S[dl][v] * dsc;
        }
#pragma unroll
        for (int ks = 0; ks < 2; ++ks) {
            bf16x8 Ak[2], Bv[NVW];
#pragma unroll
            for (int dl = 0; dl < 2; ++dl) Ak[dl] = tr_frag(lds + O_KH, PQ, 32 * ks, 16 * (2 * dq + dl), lane);
#pragma unroll
            for (int v = 0; v < 4; ++v) Bv[v] = tr_frag(lds + O_VS, PV, 32 * ks, 16 * (4 * vh2 + v), lane);
            if (MODE) Bv[NVW - 1] = tr_frag(lds + O_VS, PV, 32 * ks, 128, lane);
#pragma unroll
            for (int dl = 0; dl < 2; ++dl) {
#pragma unroll
                for (int v = 0; v < 4; ++v) S[dl][v] = __builtin_amdgcn_mfma_f32_16x16x32_bf16(Ak[dl], Bv[v], S[dl][v], 0, 0, 0);
                if (MODE) { if (vh2 == 1) S[dl][NVW - 1] = __builtin_amdgcn_mfma_f32_16x16x32_bf16(Ak[dl], Bv[NVW - 1], S[dl][NVW - 1], 0, 0, 0); } }
        }
        if (MODE) { if (has8 && lane < 16) { DEN[16 * (2 * ibp) + lane] = ao[0][2][0]; DEN[16 * (2 * ibp + 1) + lane] = ao[1][2][0]; } }
        WG_BAR();
        CP_MARK(3);
        if (ctx_out || c >= 4) {
#pragma unroll
            for (int il = 0; il < 2; ++il) {
                const int irow = 16 * (2 * ibp + il) + fr; const int row = dir ? rl + 63 - irow : rl + irow;
                float sc = 1.0f;
                if (MODE) sc = 1.0f / fmaxf(fabsf(DEN[irow]), ((c & 1) ? WI : MR)[irow]);
                bf16* op = outb + (size_t)row * out_ld + ocol + 16 * (2 * vq) + 4 * fq;
#pragma unroll
                for (int vl = 0; vl < 2; ++vl) { u32x2 w; w.x = pk2(ao[il][vl][0] * sc, ao[il][vl][1] * sc); w.y = pk2(ao[il][vl][2] * sc, ao[il][vl][3] * sc); *(u32x2*)(op + 16 * vl) = w; }
            }
        }
#pragma unroll
        for (int dl = 0; dl < 2; ++dl) {
#pragma unroll
            for (int v = 0; v < 4; ++v) { u32x2 w; w.x = pk2(S[dl][v][0], S[dl][v][1]); w.y = pk2(S[dl][v][2], S[dl][v][3]); *(LAS u32x2*)(lds + O_SB + (16 * (4 * vh2 + v) + fr) * PQ + (16 * (2 * dq + dl) + 4 * fq) * 2) = w; }
            if (MODE) { if (vh2 == 1) { u32x2 w; w.x = pk2(S[dl][NVW - 1][0], S[dl][NVW - 1][1]); w.y = pk2(S[dl][NVW - 1][2], S[dl][NVW - 1][3]); *(LAS u32x2*)(lds + O_SB + (128 + fr) * PQ + (16 * (2 * dq + dl) + 4 * fq) * 2) = w; } }
        }
        CP_MARK(4);
    }
#undef CH_PREFETCH
#if defined(MK_CHAIN_PROBE)
    if (MODE == MK_CHAIN_PROBE_MODE && tid == 0) *(LAS unsigned long long*)(lds + LDSCTL_OFF + 128) += cp_acc;
#endif
#undef CP_MARK
    __syncthreads();
}

__device__ __forceinline__ void rg_chain(LAS unsigned char* lds,
        const bf16* __restrict__ proj, const int b, const int n, const int dir, const bf16* __restrict__ wrg,
        const float* __restrict__ lam, const float* __restrict__ b_a, const float* __restrict__ b_i, const float* __restrict__ conv_w, const float* __restrict__ conv_b,
        bf16* __restrict__ hout) {
    const int tid = fresh_tid(); const int lane = tid & 63, wave = __builtin_amdgcn_readfirstlane(tid >> 6);
    constexpr int O_XR = 0, O_XBF = 17408, O_XBH = 51200, O_AA = 68608, O_BX = 102400, O_CW = 136192;
    constexpr int PXF = 528, PXH = 272;
    const int fr = lane & 15, fq = lane >> 4;
    LAS float* CW = (LAS float*)(lds + O_CW);
    LAS float* SEG = (LAS float*)(lds + 139264);
    LAS float* HST = (LAS float*)(lds + 143360);
    __syncthreads();
    for (int i = tid; i < 5 * 128; i += 512) CW[i] = i < 512 ? conv_w[(i >> 7) * 1024 + 128 * n + (i & 127)] : conv_b[128 * n + (i - 512)];
    if (tid < 128) HST[tid] = 0.f;
    bf16x8 Afr[2][4];
#pragma unroll
    for (int mat = 0; mat < 2; ++mat)
#pragma unroll
        for (int ks = 0; ks < 4; ++ks) Afr[mat][ks] = *(const bf16x8*)(wrg + ((size_t)((dir * 2 + mat) * 8 + n) * 128 + 16 * wave + fr) * 128 + 32 * ks + 8 * fq);
    f32x4 c8, bav, biv;
#pragma unroll
    for (int r = 0; r < 4; ++r) { const int ch = 128 * n + 16 * wave + 4 * fq + r; const float l = lam[dir * 1024 + ch];
        c8[r] = -8.0f * (fmaxf(-l, 0.f) + log1pf(expf(-fabsf(l)))); bav[r] = b_a[dir * 1024 + ch]; biv[r] = b_i[dir * 1024 + ch]; }
    const int ch2 = tid & 63, tg = tid >> 6;
    u32x4 px[3];
#define RG_PREFETCH(cc) do { const int c_ = (cc); const int L_ = c_ < 4 ? CTXL : SEQ, cs_ = c_ < 4 ? c_ : c_ - 4, base_ = c_ < 4 ? b * CTXL : MC + b * SEQ; \
        const int t0_ = dir ? L_ - 64 * (cs_ + 1) : 64 * cs_; \
        _Pragma("unroll") for (int e_ = 0; e_ < 3; ++e_) { const int id_ = tid + 512 * e_, rr_ = id_ >> 4, tt_ = t0_ - 2 + rr_; \
            px[e_] = (rr_ < 67 && tt_ >= 0 && tt_ < L_) ? *(const u32x4*)(proj + (size_t)(base_ + tt_) * NP0 + 3072 + 128 * n + 8 * (id_ & 15)) : (u32x4){0u, 0u, 0u, 0u}; } } while (0)
#if defined(MK_CHAIN_PROBE)
    const unsigned long long rg_t0 = __builtin_amdgcn_s_memrealtime();
#endif
    RG_PREFETCH(0);
    for (int c = 0; c < NCH; ++c) {
        const int L = c < 4 ? CTXL : SEQ, cs = c < 4 ? c : c - 4, base = c < 4 ? b * CTXL : MC + b * SEQ;
        const int t0 = dir ? L - 64 * (cs + 1) : 64 * cs;
#pragma unroll
        for (int e = 0; e < 3; ++e) { const int id = tid + 512 * e, rr = id >> 4; if (rr < 68) *(LAS u32x4*)(lds + O_XR + rr * 256 + 16 * (id & 15)) = px[e]; }
        if (c + 1 < NCH) RG_PREFETCH(c + 1);
        WG_BAR();
        {
            const f32x2 w0 = *(const LAS f32x2*)(CW + 0 * 128 + 2 * ch2), w1 = *(const LAS f32x2*)(CW + 1 * 128 + 2 * ch2), w2_ = *(const LAS f32x2*)(CW + 2 * 128 + 2 * ch2), w3 = *(const LAS f32x2*)(CW + 3 * 128 + 2 * ch2), cb = *(const LAS f32x2*)(CW + 512 + 2 * ch2);
            f32x2 xw[11];
#pragma unroll
            for (int rr = 0; rr < 11; ++rr) { const unsigned u = *(const LAS unsigned*)(lds + O_XR + (8 * tg + rr) * 256 + 4 * ch2); xw[rr].x = bflo(u); xw[rr].y = bfhi(u); }
#pragma unroll
            for (int jj = 0; jj < 8; ++jj) {
                f32x2 y = cb; y += xw[jj] * w0; y += xw[jj + 1] * w1; y += xw[jj + 2] * w2_; y += xw[jj + 3] * w3;
                *(LAS f32x2*)(lds + O_XBF + (8 * tg + jj) * PXF + 8 * ch2) = y;
                *(LAS unsigned*)(lds + O_XBH + (8 * tg + jj) * PXH + 4 * ch2) = pk2(y.x, y.y);
            }
        }
        WG_BAR();
#pragma unroll
        for (int tb = 0; tb < 4; ++tb) {
            f32x4 ga = (f32x4){0.f, 0.f, 0.f, 0.f}, gi = (f32x4){0.f, 0.f, 0.f, 0.f};
            bf16x8 Bx[4];
#pragma unroll
            for (int ks = 0; ks < 4; ++ks) Bx[ks] = *(const LAS bf16x8*)(lds + O_XBH + (16 * tb + fr) * PXH + (32 * ks + 8 * fq) * 2);
#pragma unroll
            for (int ks = 0; ks < 4; ++ks) { ga = __builtin_amdgcn_mfma_f32_16x16x32_bf16(Afr[0][ks], Bx[ks], ga, 0, 0, 0); gi = __builtin_amdgcn_mfma_f32_16x16x32_bf16(Afr[1][ks], Bx[ks], gi, 0, 0, 0); }
            const int t = 16 * tb + fr;
            const f32x4 xb = *(const LAS f32x4*)(lds + O_XBF + t * PXF + (16 * wave + 4 * fq) * 4);
            f32x4 av, bx;
#pragma unroll
            for (int r = 0; r < 4; ++r) { const float rg = sigmoid_f(ga[r] + bav[r]), ig = sigmoid_f(gi[r] + biv[r]); const float la = c8[r] * rg;
                const float a_ = fexp(la); av[r] = a_; bx[r] = __builtin_amdgcn_sqrtf(fmaxf(1.0f - a_ * a_, 0.f)) * (ig * xb[r]); }
            *(LAS f32x4*)(lds + O_AA + t * PXF + (16 * wave + 4 * fq) * 4) = av;
            *(LAS f32x4*)(lds + O_BX + t * PXF + (16 * wave + 4 * fq) * 4) = bx;
        }
        WG_BAR();
        {
            const int ch = tid & 127, seg = tid >> 7;
            float av[16], bv[16];
#pragma unroll
            for (int e = 0; e < 16; ++e) { const int s_ = 16 * seg + e, jj = dir ? 63 - s_ : s_; av[e] = *(const LAS float*)(lds + O_AA + jj * PXF + 4 * ch); bv[e] = *(const LAS float*)(lds + O_BX + jj * PXF + 4 * ch); }
            float h = HST[ch];
            float A = 1.0f, B = 0.0f;
#pragma unroll
            for (int e = 0; e < 16; ++e) { B = av[e] * B + bv[e]; A *= av[e]; }
            *(LAS f32x2*)(SEG + (seg * 128 + ch) * 2) = (f32x2){A, B};
            WG_BAR();
            for (int s2 = 0; s2 < seg; ++s2) { const f32x2 ab = *(const LAS f32x2*)(SEG + (s2 * 128 + ch) * 2); h = ab.x * h + ab.y; }
            bf16* hp = hout + (size_t)(base + t0) * 1024 + 128 * n + ch;
#pragma unroll
            for (int e = 0; e < 16; ++e) { const int s_ = 16 * seg + e, jj = dir ? 63 - s_ : s_; h = av[e] * h + bv[e]; hp[(size_t)jj * 1024] = (bf16)f2bf(h); }
            if (seg == 3) HST[ch] = h;
        }
    }
#undef RG_PREFETCH
#if defined(MK_CHAIN_PROBE)
    if (MK_CHAIN_PROBE_MODE == 2 && tid == 0) *(LAS unsigned long long*)(lds + LDSCTL_OFF + 128) += __builtin_amdgcn_s_memrealtime() - rg_t0;
#endif
    __syncthreads();
}

#ifndef MK_LAST_PHASE
#define MK_LAST_PHASE 24
#endif
constexpr int NPH = 24;
__global__ void __launch_bounds__(NWAVES * 64, 2) mk_fwd(Args args) {
    extern __shared__ __attribute__((aligned(16))) unsigned char lds_raw[];
    const int GA = (int)gridDim.x, bx = (int)blockIdx.x;
    const int grp = (bx & 7) / XPG, gi = (bx >> 3) * XPG + (bx & 7) % XPG, GG = GA / NGRP;
    Frame FA{(LAS unsigned char*)lds_raw, GA, bx, GA * NWAVES, 0, args.out, args.ws, args};
    Frame F{(LAS unsigned char*)lds_raw, GG, gi, GG * NWAVES, grp, args.out, args.ws, args};
    volatile LAS unsigned* MISC = (volatile LAS unsigned*)(F.lds + LDSCTL_OFF);
    for (int u = threadIdx.x; u < (LDS_BYTES - LDSCTL_OFF) / 4; u += NWAVES * 64) ((LAS unsigned*)(F.lds + LDSCTL_OFF))[u] = 0u;
    __syncthreads();
    const int lo = args.ph_lo, hi = args.ph_hi;
    unsigned* ctl = (unsigned*)(F.ws + WS_CTL);
    XcdBarrier barA = xcd_barrier_post(ctl + CW_BAR, MISC + 8, (unsigned)GA);
    XcdBarrier barG = xcd_barrier_post(ctl + CW_BAR + (1 + grp) * XCD_BAR_WORDS, MISC + 12, (unsigned)GG);
#ifndef MK_REP_GEMM
#define MK_REP_GEMM 1
#endif
#ifndef MK_REP_SCAN
#define MK_REP_SCAN 1
#endif
#ifndef MK_REP_COMB
#define MK_REP_COMB 1
#endif
#ifndef MK_REP_CVT
#define MK_REP_CVT 1
#endif
#ifndef MK_G1_DELAY_US
#define MK_G1_DELAY_US 0
#endif
#ifndef MK_STAG_C
#define MK_STAG_C 30
#endif
#ifndef MK_OFFMASK
#define MK_OFFMASK 0x7FF
#endif
#ifndef MK_PREMASK
#define MK_PREMASK 3
#endif
#define IN(k) (lo <= (k) && (k) < hi)
#define INL(o) (((MK_OFFMASK >> (o)) & 1) && IN(pb + (o)))
#ifdef MK_PROBE_MASK
    unsigned long long prb_acc = 0ull, prb_t0 = 0ull;
#ifdef MK_PROBE_CYCLES
#define PRB_NOW() ((unsigned long long)clock64())
#else
#define PRB_NOW() ((unsigned long long)__builtin_amdgcn_s_memrealtime())
#endif
#define PRB_BEGIN(bit) do { if ((MK_PROBE_MASK >> (bit)) & 1) prb_t0 = PRB_NOW(); } while (0)
#define PRB_END(bit) do { if ((MK_PROBE_MASK >> (bit)) & 1) prb_acc += PRB_NOW() - prb_t0; } while (0)
#else
#define PRB_BEGIN(bit) do {} while (0)
#define PRB_END(bit) do {} while (0)
#endif
#if defined(MK_PROBE_MASK) && ((MK_PROBE_MASK >> 13) & 1)
#define SEAM(k) do { if (IN(k) && IN((k) + 1)) { const unsigned long long ts_ = PRB_NOW(); xcd_barrier(barG); prb_acc += PRB_NOW() - ts_; } } while (0)
#else
#define SEAM(k) do { if (IN(k) && IN((k) + 1)) xcd_barrier(barG); } while (0)
#endif
    float* MOD = (float*)(F.ws + WS_MOD); const float* CS = (const float*)(F.ws + WS_CS);
    bf16* U = gU(F); bf16* Yb = gY(F); bf16* BIG = gBIG(F); float* GATES = gGATES(F); float* YC = gYC(F);

    PRB_BEGIN(11);
    if ((MK_PREMASK & 1) && IN(0)) { pre_mod(FA); pre_pe(FA); for (int rep_ = 0; rep_ < MK_REP_CVT; ++rep_) cvt_layer<0>(FA); }
    if (IN(0) && IN(1)) xcd_barrier(barA);
    PRB_END(11); PRB_BEGIN(12);
    if ((MK_PREMASK & 2) && IN(1)) {
#if MK_G1_DELAY_US > 0
        if (grp > 0) { const unsigned long long t0 = __builtin_amdgcn_s_memrealtime(); while (__builtin_amdgcn_s_memrealtime() - t0 < (unsigned long long)MK_G1_DELAY_US * grp * 100ull) __builtin_amdgcn_s_sleep(16); }
#endif
        nrm_rows<true, false, true, false, 1>(F, 0, M, 0.f, nullptr, nullptr, 0, F.A.in[I_NORMG], MOD, 0, 1);
    }
    SEAM(1);
    PRB_END(12);
    for (int layer = 0; layer < 2; ++layer) {
        const int pb = 2 + 11 * layer; const bool last = layer == 1;
        const float* ng = F.A.in[I_NORMG] + (size_t)layer * 6 * D; const float* modl = MOD + (size_t)layer * 9 * 18432;
        const int NP = layer == 0 ? NP0 : NP1;
        const int rlo2 = last ? MC : 0;
        const unsigned char* W = F.ws + WS_W + (size_t)layer * W_LAYER;
        if (layer == 1 && IN(pb)) {
            if (threadIdx.x == 0) { unsigned sp = 0;
                for (int g = 0; g < NGRP; ++g) while (__hip_atomic_load(ctl + CW_W1READY + 64 * g, __ATOMIC_RELAXED, __HIP_MEMORY_SCOPE_AGENT) == 0u) { __builtin_amdgcn_s_sleep(4); if (++sp > (1u << 22)) { atomicAdd(ctl + CW_BAR + XB_TMO, 1u); break; } }
                __builtin_amdgcn_fence(__ATOMIC_ACQUIRE, "agent"); asm volatile("s_waitcnt vmcnt(0)" ::: "memory"); }
            __syncthreads();
        }
        PRB_BEGIN(0);
        if (INL(0)) {
            pg8::Gemm g{U, (const bf16*)(W + W_F1I), M, 2 * DFF, D / 2}; pg8::StaticOrder S; S.init(M, 2 * DFF, F.G, F.wg, D / 2, 0, XPG); pg8::EpiSwigluI8 E{BIG, DFF, gRS(F), CS + (size_t)layer * 2 * (2 * DFF)};
            for (int rep_ = 0; rep_ < MK_REP_GEMM; ++rep_) pg8::gemm_phase<pg8::EpiSwigluI8, pg8::StaticOrder, PG8_ALIGN_SWI, PG8_SP2, true>(F.lds, g, S, E); }
        SEAM(pb + 0); PRB_END(0);
        PRB_BEGIN(1);
        if (INL(1)) {
            requant_rows(F, 0, M); xcd_barrier(barG);
            pg8::Gemm g{BIG, (const bf16*)(W + W_F1O), M, D, DFF}; pg8::MixedOrder S; S.init(MLAT, D, F.G, F.wg, DFF / 2, MC / 256, MC, 2, XPG);
            pg8::EpiYI8 E{Yb, D, YC, (size_t)MC * D, DFF / 2 / 64, gRS(F), (const float*)(F.ws + WS_CS3) + (layer * 2 + 0) * 2048};
            for (int rep_ = 0; rep_ < MK_REP_GEMM; ++rep_) pg8::gemm_phase<pg8::EpiYI8, pg8::MixedOrder, PG8_ALIGN, PG8_SP2, true>(F.lds, g, S, E);
        }
        SEAM(pb + 1); PRB_END(1);
        PRB_BEGIN(2);
        if (INL(2)) nrm_rows<false, true, true, false, 2>(F, 0, M, 0.5f, ng + 1 * D, modl, 2, ng + 2 * D, modl, 3, 4, 2);
        SEAM(pb + 2); PRB_END(2);
        PRB_BEGIN(3);
        if (INL(3)) {
            const int r0 = layer == 0 ? 1024 : 2048;
            { pg8::Gemm g{(const bf16*)gU8B(F), (const bf16*)(W + W_MI8), M, 4096, D / 2}; pg8::StaticOrder S; S.init(M, 4096, F.G, F.wg, D / 2, 0, XPG);
              pg8::EpiProjI8 E{BIG + r0, NP, gRS(F), (const float*)(F.ws + WS_CS2) + layer * 4096};
              for (int rep_ = 0; rep_ < MK_REP_GEMM; ++rep_) pg8::gemm_phase<pg8::EpiProjI8, pg8::StaticOrder, PG8_ALIGN, PG8_SP2, true>(F.lds, g, S, E); }
            { const int nl = layer == 0 ? 5 : 9;
              pg8::Gemm g{U, (const bf16*)(W + W_MI), M, nl * 256, D}; pg8::MixedOrder S;
              S.init(MLAT, nl * 256, F.G, F.wg, D, MC / 256, MC, 1, XPG, 5, 4, last ? 4 : 0, NP / 256 - 1); S.cmA = nl - 1; S.cmB = NP / 256 - 1;
              pg8::EpiProj E{BIG, NP, GATES, NP / 256 - 1};
              for (int rep_ = 0; rep_ < MK_REP_GEMM; ++rep_) pg8::gemm_phase<pg8::EpiProj, pg8::MixedOrder, PG8_ALIGN, PG8_SP2>(F.lds, g, S, E); }
        }
        SEAM(pb + 3); PRB_END(3);
        PRB_BEGIN(4);
        if (INL(4)) {
            if (layer == 0) {
                bf16* OFb = Yb; bf16* OBb = OFb + (size_t)M * 1024; bf16* HFb = OBb + (size_t)M * 1024; bf16* HBb = HFb + (size_t)M * 1024;
                for (int item = F.wg; item < 32 * NBG * MK_REP_SCAN; item += F.G) { const int it = item % (32 * NBG);
                    if (it < 16 * NBG) { const int ci = it >> 1, vh = it & 1, b = ci >> 3, h = (ci >> 1) & 3, dir = ci & 1;
                        chain_scan<0>(F.lds, BIG, NP0, h * 128, 512 + h * 128, 1024 + h * 256 + vh * 128, GATES, dir * 16, b, dir,
                                      dir ? OBb : OFb, 1024, h * 256 + vh * 128, true, F.A.in[I_WALPHA2] + (size_t)dir * 16 * 512 + h * 128, F.A.in[I_BALPHA] + dir * 512 + h * 128, 0.f, 0.f);
                    } else { const int ri = it - 16 * NBG, b = ri >> 4, n = (ri >> 1) & 7, dir = ri & 1;
                        rg_chain(F.lds, BIG, b, n, dir, (const bf16*)(F.ws + WS_WRG), F.A.in[I_LAM], F.A.in[I_RGBA], F.A.in[I_RGBI], F.A.in[I_CONVW], F.A.in[I_CONVB], dir ? HBb : HFb);
                        { Frame FR{F.lds, 16 * NBG, ri, 16 * NBG * NWAVES, grp, args.out, args.ws, args};
                          for (int rep_ = 0; rep_ < MK_REP_CVT; ++rep_) cvt_layer<1>(FR, grp * 1024 / NGRP, (grp + 1) * 1024 / NGRP); }
                    }
                }
            } else {
                bf16* HFb = Yb; bf16* HBb = HFb + (size_t)M * D;
                for (int item = F.wg; item < 32 * NBG * MK_REP_SCAN; item += F.G) { const int it = item % (32 * NBG); const int ci = it >> 1, vh = it & 1, b = ci >> 4, h = (ci >> 1) & 7, dir = ci & 1;
                    chain_scan<1>(F.lds, BIG, NP1, h * 128, 1024 + h * 128, 2048 + h * 256 + vh * 128, GATES, dir * 16 + h, b, dir,
                                  dir ? HBb : HFb, D, h * 256 + vh * 128, false, nullptr, nullptr, F.A.in[I_MLBG][dir * 16 + h], F.A.in[I_MLBG][dir * 16 + 8 + h]);
                }
            }
        }
        SEAM(pb + 4);
        if (layer == 0 && IN(pb + 4) && IN(pb + 5) && gi == 0 && threadIdx.x == 0) __hip_atomic_store(ctl + CW_W1READY + 64 * grp, 1u, __ATOMIC_RELAXED, __HIP_MEMORY_SCOPE_AGENT);
        PRB_END(4);
        PRB_BEGIN(5);
        if (INL(5)) { for (int rep_ = 0; rep_ < MK_REP_COMB; ++rep_) { if (layer == 0) comb0_rows(F, 0, M); else comb1_rows(F, MC, M); } }
        SEAM(pb + 5); PRB_END(5);
        PRB_BEGIN(6);
        if (INL(6)) {
            pg8::Gemm g{U, (const bf16*)(W + W_MO), M, D, D}; pg8::MixedOrder S; S.init(MLAT, D, F.G, F.wg, D, MC / 256, last ? 0 : MC, KSPLIT, XPG);
            pg8::EpiY E{Yb, D, YC, (size_t)MC * D, D / 64};
            for (int rep_ = 0; rep_ < MK_REP_GEMM; ++rep_) pg8::gemm_phase<pg8::EpiY, pg8::MixedOrder, PG8_ALIGN, PG8_SP2>(F.lds, g, S, E);
        }
        SEAM(pb + 6); PRB_END(6);
        PRB_BEGIN(7);
        if (INL(7)) nrm_rows<false, true, true, false, 1>(F, rlo2, M, 1.0f, ng + 3 * D, modl, 5, ng + 4 * D, modl, 6, 7);
        SEAM(pb + 7); PRB_END(7);
        PRB_BEGIN(8);
        if (INL(8)) { pg8::Gemm g{U + (size_t)rlo2 * (D / 2), (const bf16*)(W + W_F2I), M - rlo2, 2 * DFF, D / 2}; pg8::StaticOrder S; S.init(M - rlo2, 2 * DFF, F.G, F.wg, D / 2, 0, XPG);
            pg8::EpiSwigluI8 E{BIG + (size_t)rlo2 * DFF, DFF, gRS(F) + rlo2, CS + (size_t)(layer * 2 + 1) * (2 * DFF)};
            for (int rep_ = 0; rep_ < MK_REP_GEMM; ++rep_) pg8::gemm_phase<pg8::EpiSwigluI8, pg8::StaticOrder, PG8_ALIGN_SWI, PG8_SP2, true>(F.lds, g, S, E); }
        SEAM(pb + 8); PRB_END(8);
        PRB_BEGIN(9);
        if (INL(9)) {
            requant_rows(F, rlo2, M); xcd_barrier(barG);
            pg8::Gemm g{BIG, (const bf16*)(W + W_F2O), M, D, DFF}; pg8::MixedOrder S; S.init(MLAT, D, F.G, F.wg, DFF / 2, MC / 256, last ? 0 : MC, 2, XPG);
            pg8::EpiYI8 E{Yb, D, YC, (size_t)MC * D, DFF / 2 / 64, gRS(F), (const float*)(F.ws + WS_CS3) + (layer * 2 + 1) * 2048};
            for (int rep_ = 0; rep_ < MK_REP_GEMM; ++rep_) pg8::gemm_phase<pg8::EpiYI8, pg8::MixedOrder, PG8_ALIGN, PG8_SP2, true>(F.lds, g, S, E);
        }
        SEAM(pb + 9); PRB_END(9);
        PRB_BEGIN(10);
        if (INL(10)) {
            if (!last) nrm_rows<false, true, true, false, 1>(F, 0, M, 0.5f, ng + 5 * D, modl, 8, F.A.in[I_NORMG] + 6 * D, MOD + (size_t)9 * 18432, 0, 1, 2);
            else nrm_rows<false, true, false, true>(F, MC, M, 0.5f, ng + 5 * D, modl, 8, nullptr, nullptr, 0, 0, 2);
        }
        SEAM(pb + 10); PRB_END(10);
    }
#ifdef MK_PROBE_MASK
#ifndef MK_PROBE_BX
#define MK_PROBE_BX 0
#endif
    if (bx == MK_PROBE_BX) {
#if defined(MK_CHAIN_PROBE)
        const unsigned long long want = *(LAS unsigned long long*)(F.lds + LDSCTL_OFF + 128) * MK_PROBE_K;
#elif defined(MK_PROBE_CYCLES)
        const unsigned long long want = prb_acc >> 6;
#else
        const unsigned long long want = prb_acc * MK_PROBE_K;
#endif
        const unsigned long long t0 = __builtin_amdgcn_s_memrealtime(); while (__builtin_amdgcn_s_memrealtime() - t0 < want) __builtin_amdgcn_s_sleep(8); }
#endif
#undef IN
#undef SEAM
}

extern "C" void kernel_launch(void* const* d_in, const int* in_sizes, int n_in, void* d_out, int out_size, void* d_ws, size_t ws_size, hipStream_t stream) {
    static int grid = 0;
    if (grid == 0) {
        if (n_in != 27 || out_size != NB * SEQ * D || ws_size < WS_END) { fprintf(stderr, "kernel_launch: unexpected problem (n_in %d, out %d, ws %zu; need ws >= %zu); nothing launched\n", n_in, out_size, ws_size, (size_t)WS_END); grid = -1; return; }
        int dev = 0, cus = 0, per_cu = 0;
        if (hipGetDevice(&dev) != hipSuccess || hipDeviceGetAttribute(&cus, hipDeviceAttributeMultiprocessorCount, dev) != hipSuccess) { fprintf(stderr, "kernel_launch: device query failed\n"); grid = -1; return; }
        if (hipFuncSetAttribute((const void*)mk_fwd, hipFuncAttributeMaxDynamicSharedMemorySize, LDS_BYTES) != hipSuccess) { fprintf(stderr, "kernel_launch: hipFuncSetAttribute failed\n"); grid = -1; return; }
        if (hipOccupancyMaxActiveBlocksPerMultiprocessor(&per_cu, (const void*)mk_fwd, NWAVES * 64, LDS_BYTES) != hipSuccess || per_cu < 1)
            fprintf(stderr, "kernel_launch: note: occupancy query reports %d workgroups per CU\n", per_cu);
        (void)hipGetLastError();
        grid = cus;
        if (grid % 8 != 0) { fprintf(stderr, "kernel_launch: %d CUs; this kernel splits the grid into two groups of whole XCD octets and needs a multiple of 16; nothing launched\n", cus); grid = -1; return; }
    }
    if (grid < 0) return;
    if (hipMemsetAsync((char*)d_ws + WS_CTL, 0, CTL_ZERO_BYTES, stream) != hipSuccess) { fprintf(stderr, "kernel_launch: memset failed\n"); return; }
    Args a{};
    for (int i = 0; i < 27; ++i) a.in[i] = (const float*)d_in[i];
    a.out = (float*)d_out; a.ws = (unsigned char*)d_ws;
    a.ph_lo = 0; a.ph_hi = MK_LAST_PHASE;
    hipLaunchKernelGGL(mk_fwd, dim3(grid), dim3(NWAVES * 64), LDS_BYTES, stream, a);
    const hipError_t le = hipPeekAtLastError();
    if (le != hipSuccess) fprintf(stderr, "kernel_launch: launch failed: %s\n", hipGetErrorName(le));
}
```

```cpp
#include <hip/hip_runtime.h>
#include <cstdio>
#include <cstdint>
__device__ __forceinline__ int fresh_tid() { int t = threadIdx.x; asm volatile("" : "+v"(t)); return t; }
__device__ __forceinline__ float fexp(float x) { return __builtin_amdgcn_exp2f(x * 1.4426950408889634f); }
__device__ __forceinline__ float flog(float x) { return __builtin_amdgcn_logf(x) * 0.6931471805599453f; }
namespace pg8 {
#define PG8_LAS __attribute__((address_space(3)))
typedef unsigned short bf16_t;
typedef short bf16x8 __attribute__((ext_vector_type(8)));
typedef float f32x4 __attribute__((ext_vector_type(4)));
typedef unsigned u32x4 __attribute__((ext_vector_type(4)));
constexpr int BM = 256, BK = 64, HALF = 128, HTB = HALF * BK * 2  , STAGE_BYTES = 8 * HTB, NXCD = 8, WGM = 8;

__host__ __device__ __forceinline__ int lds_byte(int r, int c) { const int st = (r >> 4) * 2 + (c >> 5), rr = r & 15, cc = c & 31, ob = rr * 64 + cc * 2; return st * 1024 + (ob ^ (((ob >> 9) & 1) << 5)); }
__host__ __device__ __forceinline__ void stage_rc(int b, int& R, int& C) { const int st = b / 1024, sb = b % 1024, swz = sb ^ (((sb >> 9) & 1) << 5); R = (st >> 1) * 16 + swz / 64; C = (st & 1) * 32 + (swz % 64) / 2; }
__host__ __device__ __forceinline__ int perm32(int rho) { const int n = rho >> 4, i = rho & 15; return 8 * (i >> 2) + 4 * n + (i & 3); }

typedef int i32x4 __attribute__((ext_vector_type(4)));
template <bool I8> __device__ __forceinline__ f32x4 mma_op(const bf16x8 a, const bf16x8 b, const f32x4 c) {
    if constexpr (I8) return __builtin_bit_cast(f32x4, __builtin_amdgcn_mfma_i32_16x16x64_i8(__builtin_bit_cast(i32x4, a), __builtin_bit_cast(i32x4, b), __builtin_bit_cast(i32x4, c), 0, 0, 0));
    else return __builtin_amdgcn_mfma_f32_16x16x32_bf16(a, b, c, 0, 0, 0);
}
typedef float f32x2v __attribute__((ext_vector_type(2)));
__device__ __forceinline__ f32x4 zero4() {
    f32x2v lo, hi;
    asm volatile("v_pk_mov_b32 %0, 0, 0" : "=v"(lo));
    asm volatile("v_pk_mov_b32 %0, 0, 0" : "=v"(hi));
    return __builtin_shufflevector(lo, hi, 0, 1, 2, 3);
}
struct Unit { int pm, pn, pk, koff, nt; };
struct Gemm { const bf16_t* A; const bf16_t* Bt; int M, N, K; };

struct StaticOrder {
    int nM, nN, nwg, G, c, nt, pm0, nx, nig, cmA = 1 << 20, cmB = 0;
    float inv_nig;
    __host__ __device__ void init(int M, int N, int G_, int c_, int K_ = 0, int pm0_ = 0, int nx_ = NXCD) { nM = M / BM; nN = N / BM; nwg = nM * nN; G = G_; c = c_; nt = K_ / BK; pm0 = pm0_; nx = nx_; nig = WGM * nN; inv_nig = 1.0f / (float)nig; }
    __host__ __device__ bool next(int i, Unit& u) const {
        const int L = i * G + c; if (L >= nwg) return false;
        int wgid = L;
        if (nx != 1) { const int q = nwg / nx, r = nwg % nx, xcd = wgid % nx, off = wgid / nx; wgid = (xcd < r ? xcd * (q + 1) : r * (q + 1) + (xcd - r) * q) + off; }
        const int gid = (int)(((float)wgid + 0.5f) * inv_nig), rem = wgid - gid * nig, fm = gid * WGM, left = nM - fm;
        int po, pj;
        if (left >= WGM) { po = rem & (WGM - 1); pj = rem / WGM; }
        else { pj = rem / left; po = rem - pj * left; }
        u.pm = pm0 + fm + po; u.pn = pj < cmA ? pj : cmB + (pj - cmA); u.pk = 0; u.koff = 0; u.nt = nt; return true;
    }
    __device__ __forceinline__ void a_ready(const Unit&) const {}
    __device__ __forceinline__ void done(const Unit&) const {}
};
struct MixedOrder : StaticOrder {
    int nMs, nS, nSsh, nwgS, nts, nA, a0, b0;
    __host__ __device__ void init(int M, int N, int G_, int c_, int K_, int pm0_, int Ms, int nS_, int nx_ = NXCD, int nNs_ = -1, int nA_ = 1 << 20, int a0_ = 0, int b0_ = 0) {
        StaticOrder::init(M, N, G_, c_, K_, pm0_, nx_); nMs = Ms / BM; nS = nS_; nSsh = nS_ >= 8 ? 3 : nS_ >= 4 ? 2 : nS_ >= 2 ? 1 : 0; nwgS = nMs * (nNs_ < 0 ? nN : nNs_) * nS; nts = K_ / BK / nS_; nA = nA_; a0 = a0_; b0 = b0_; }
    __host__ __device__ bool next(int i, Unit& u) const {
        const int L = i * G + c; if (L < nwg) return StaticOrder::next(i, u);
        const int l = L - nwg; if (l >= nwgS) return false;
        u.pk = l & (nS - 1); const int t = l >> nSsh; int q, pm;
        if (nMs == 1) { q = t; pm = 0; } else { q = t / nMs; pm = t - q * nMs; }
        u.pm = pm; u.pn = q < nA ? a0 + q : b0 + (q - nA); u.koff = u.pk * nts * BK; u.nt = nts; return true;
    }
};

typedef float f32x2_t __attribute__((ext_vector_type(2)));
typedef __bf16 bf16x2_t __attribute__((ext_vector_type(2)));
__device__ __forceinline__ unsigned cvt_pk_bf16(float lo, float hi) { const f32x2_t v = {lo, hi}; return __builtin_bit_cast(unsigned, __builtin_convertvector(v, bf16x2_t)); }
__device__ __forceinline__ float silu_f(float x) { return x * __builtin_amdgcn_rcpf(1.0f + fexp(-x)); }

struct EpiF32 {
    static constexpr bool PERM = false, AFTER_DRAIN = false;
    float* C; int ldc;
    __device__ __forceinline__ void operator()(const f32x4 (&acc)[2][2][4][2], const Unit& u, int wr, int wc, int fr, int fq) const {
        const int row0 = u.pm * BM + wr * 64 + fr, col0 = u.pn * BM + wc * 32 + 4 * fq;
#pragma unroll
        for (int ai = 0; ai < 2; ++ai)
#pragma unroll
            for (int m = 0; m < 4; ++m) { float* rowp = C + (size_t)(row0 + ai * HALF + m * 16) * ldc + col0;
#pragma unroll
                for (int bj = 0; bj < 2; ++bj)
#pragma unroll
                    for (int n = 0; n < 2; ++n) *(f32x4*)(rowp + bj * HALF + n * 16) = acc[ai][bj][m][n]; }
    }
};
struct EpiY {
    static constexpr bool PERM = true, AFTER_DRAIN = false;
    bf16_t* O; int ldc; float* P; size_t split_stride; int nt_full;
    __device__ __forceinline__ void operator()(const f32x4 (&acc)[2][2][4][2], const Unit& u, int wr, int wc, int fr, int fq) const {
        const int row0 = u.pm * BM + wr * 64 + fr, col0 = u.pn * BM + wc * 32 + 8 * fq;
        if (u.nt == nt_full) {
#pragma unroll
            for (int ai = 0; ai < 2; ++ai)
#pragma unroll
                for (int m = 0; m < 4; ++m) { bf16_t* rowp = O + (size_t)(row0 + ai * HALF + m * 16) * ldc + col0;
#pragma unroll
                    for (int bj = 0; bj < 2; ++bj) { const f32x4 v0 = acc[ai][bj][m][0], v1 = acc[ai][bj][m][1];
                        u32x4 w; w.x = cvt_pk_bf16(v0[0], v0[1]); w.y = cvt_pk_bf16(v0[2], v0[3]); w.z = cvt_pk_bf16(v1[0], v1[1]); w.w = cvt_pk_bf16(v1[2], v1[3]);
                        *(u32x4*)(rowp + bj * HALF) = w; } }
        } else {
            float* Pb = P + (size_t)u.pk * split_stride;
#pragma unroll
            for (int ai = 0; ai < 2; ++ai)
#pragma unroll
                for (int m = 0; m < 4; ++m) { float* rowp = Pb + (size_t)(row0 + ai * HALF + m * 16) * ldc + col0;
#pragma unroll
                    for (int bj = 0; bj < 2; ++bj) { *(f32x4*)(rowp + bj * HALF) = acc[ai][bj][m][0]; *(f32x4*)(rowp + bj * HALF + 4) = acc[ai][bj][m][1]; } }
        }
    }
};
struct EpiSwiglu {
    static constexpr bool PERM = true, AFTER_DRAIN = false;
    bf16_t* O; int ldc;
    __device__ __forceinline__ void operator()(const f32x4 (&acc)[2][2][4][2], const Unit& u, int wr, int wc, int fr, int fq) const {
        const int row0 = u.pm * BM + wr * 64 + fr, col0 = u.pn * HALF + wc * 32 + 8 * fq;
#pragma unroll
        for (int ai = 0; ai < 2; ++ai)
#pragma unroll
            for (int m = 0; m < 4; ++m) { bf16_t* rowp = O + (size_t)(row0 + ai * HALF + m * 16) * ldc + col0;
                const f32x4 a0 = acc[ai][0][m][0], a1 = acc[ai][0][m][1], b0 = acc[ai][1][m][0], b1 = acc[ai][1][m][1];
                f32x4 v0, v1;
#pragma unroll
                for (int j = 0; j < 4; ++j) { v0[j] = silu_f(a0[j]) * b0[j]; v1[j] = silu_f(a1[j]) * b1[j]; }
                u32x4 w; w.x = cvt_pk_bf16(v0[0], v0[1]); w.y = cvt_pk_bf16(v0[2], v0[3]); w.z = cvt_pk_bf16(v1[0], v1[1]); w.w = cvt_pk_bf16(v1[2], v1[3]);
                *(u32x4*)rowp = w; }
    }
};
struct EpiSwigluI8 {
    static constexpr bool PERM = true, AFTER_DRAIN = false;
    bf16_t* O; int ldc; const float* rs; const float* cs;
    __device__ __forceinline__ void operator()(const f32x4 (&acc)[2][2][4][2], const Unit& u, int wr, int wc, int fr, int fq) const {
        const int row0 = u.pm * BM + wr * 64 + fr, col0 = u.pn * HALF + wc * 32 + 8 * fq;
        const float* csp = cs + u.pn * BM + wc * 32 + 8 * fq;
        const f32x4 ca0 = *(const f32x4*)csp, ca1 = *(const f32x4*)(csp + 4), cb0 = *(const f32x4*)(csp + HALF), cb1 = *(const f32x4*)(csp + HALF + 4);
        float rsv[2][4];
#pragma unroll
        for (int ai = 0; ai < 2; ++ai)
#pragma unroll
            for (int m = 0; m < 4; ++m) rsv[ai][m] = rs[row0 + ai * HALF + m * 16];
#pragma unroll
        for (int ai = 0; ai < 2; ++ai)
#pragma unroll
            for (int m = 0; m < 4; ++m) { bf16_t* rowp = O + (size_t)(row0 + ai * HALF + m * 16) * ldc + col0;
                const f32x4 a0 = acc[ai][0][m][0], a1 = acc[ai][0][m][1], b0 = acc[ai][1][m][0], b1 = acc[ai][1][m][1];
                const float rv = rsv[ai][m];
                f32x4 v0, v1;
#pragma unroll
                for (int j = 0; j < 4; ++j) {
                    const float fa0 = a0[j], fa1 = a1[j], fb0 = b0[j], fb1 = b1[j];
                    const float x0 = (float)__float_as_int(fa0) * (rv * ca0[j]), x1 = (float)__float_as_int(fa1) * (rv * ca1[j]);
                    const float y0 = (float)__float_as_int(fb0) * (rv * cb0[j]), y1 = (float)__float_as_int(fb1) * (rv * cb1[j]);
                    v0[j] = silu_f(x0) * y0; v1[j] = silu_f(x1) * y1; }
                u32x4 w; w.x = cvt_pk_bf16(v0[0], v0[1]); w.y = cvt_pk_bf16(v0[2], v0[3]); w.z = cvt_pk_bf16(v1[0], v1[1]); w.w = cvt_pk_bf16(v1[2], v1[3]);
                *(u32x4*)rowp = w; }
    }
};
struct EpiYI8 {
    static constexpr bool PERM = true, AFTER_DRAIN = false;
    bf16_t* O; int ldc; float* P; size_t split_stride; int nt_full; const float* rs; const float* cs;
    __device__ __forceinline__ void operator()(const f32x4 (&acc)[2][2][4][2], const Unit& u, int wr, int wc, int fr, int fq) const {
        const int row0 = u.pm * BM + wr * 64 + fr, col0 = u.pn * BM + wc * 32 + 8 * fq;
        const float* csp = cs + col0;
        const f32x4 c00 = *(const f32x4*)csp, c01 = *(const f32x4*)(csp + 4), c10 = *(const f32x4*)(csp + HALF), c11 = *(const f32x4*)(csp + HALF + 4);
        float rsv[2][4];
#pragma unroll
        for (int ai = 0; ai < 2; ++ai)
#pragma unroll
            for (int m = 0; m < 4; ++m) rsv[ai][m] = rs[row0 + ai * HALF + m * 16];
        const bool whole = u.nt == nt_full;
        float* Pb = P + (size_t)u.pk * split_stride;
#pragma unroll
        for (int ai = 0; ai < 2; ++ai)
#pragma unroll
            for (int m = 0; m < 4; ++m) { const size_t ro = (size_t)(row0 + ai * HALF + m * 16) * ldc + col0; const float rv = rsv[ai][m];
#pragma unroll
                for (int bj = 0; bj < 2; ++bj) { const f32x4 v0 = acc[ai][bj][m][0], v1 = acc[ai][bj][m][1]; const f32x4 s0 = (bj ? c10 : c00) * rv, s1 = (bj ? c11 : c01) * rv;
                    f32x4 o0, o1;
#pragma unroll
                    for (int j = 0; j < 4; ++j) { const float f0 = v0[j], f1 = v1[j]; o0[j] = (float)__float_as_int(f0) * s0[j]; o1[j] = (float)__float_as_int(f1) * s1[j]; }
                    if (whole) { u32x4 w; w.x = cvt_pk_bf16(o0[0], o0[1]); w.y = cvt_pk_bf16(o0[2], o0[3]); w.z = cvt_pk_bf16(o1[0], o1[1]); w.w = cvt_pk_bf16(o1[2], o1[3]);
                        *(u32x4*)(O + ro + bj * HALF) = w; }
                    else { *(f32x4*)(Pb + ro + bj * HALF) = o0; *(f32x4*)(Pb + ro + bj * HALF + 4) = o1; } } }
    }
};
struct EpiProjI8 {
    static constexpr bool PERM = true, AFTER_DRAIN = false;
    bf16_t* O; int ldc; const float* rs; const float* cs;
    __device__ __forceinline__ void operator()(const f32x4 (&acc)[2][2][4][2], const Unit& u, int wr, int wc, int fr, int fq) const {
        const int row0 = u.pm * BM + wr * 64 + fr, col0 = u.pn * BM + wc * 32 + 8 * fq;
        const float* csp = cs + col0;
        const f32x4 c00 = *(const f32x4*)csp, c01 = *(const f32x4*)(csp + 4), c10 = *(const f32x4*)(csp + HALF), c11 = *(const f32x4*)(csp + HALF + 4);
        float rsv[2][4];
#pragma unroll
        for (int ai = 0; ai < 2; ++ai)
#pragma unroll
            for (int m = 0; m < 4; ++m) rsv[ai][m] = rs[row0 + ai * HALF + m * 16];
#pragma unroll
        for (int ai = 0; ai < 2; ++ai)
#pragma unroll
            for (int m = 0; m < 4; ++m) { bf16_t* rowp = O + (size_t)(row0 + ai * HALF + m * 16) * ldc + col0; const float rv = rsv[ai][m];
#pragma unroll
                for (int bj = 0; bj < 2; ++bj) { const f32x4 v0 = acc[ai][bj][m][0], v1 = acc[ai][bj][m][1]; const f32x4 s0 = (bj ? c10 : c00) * rv, s1 = (bj ? c11 : c01) * rv;
                    float o0[4], o1[4];
#pragma unroll
                    for (int j = 0; j < 4; ++j) { const float f0 = v0[j], f1 = v1[j]; o0[j] = (float)__float_as_int(f0) * s0[j]; o1[j] = (float)__float_as_int(f1) * s1[j]; }
                    u32x4 w; w.x = cvt_pk_bf16(o0[0], o0[1]); w.y = cvt_pk_bf16(o0[2], o0[3]); w.z = cvt_pk_bf16(o1[0], o1[1]); w.w = cvt_pk_bf16(o1[2], o1[3]);
                    *(u32x4*)(rowp + bj * HALF) = w; } }
    }
};
struct EpiProj {
    static constexpr bool PERM = true, AFTER_DRAIN = false;
    bf16_t* O; int ldc; float* gates; int gate_pn;
    __device__ __forceinline__ void operator()(const f32x4 (&acc)[2][2][4][2], const Unit& u, int wr, int wc, int fr, int fq) const {
        const int row0 = u.pm * BM + wr * 64 + fr, col0 = u.pn * BM + wc * 32 + 8 * fq;
#pragma unroll
        for (int ai = 0; ai < 2; ++ai)
#pragma unroll
            for (int m = 0; m < 4; ++m) { bf16_t* rowp = O + (size_t)(row0 + ai * HALF + m * 16) * ldc + col0;
#pragma unroll
                for (int bj = 0; bj < 2; ++bj) { const f32x4 v0 = acc[ai][bj][m][0], v1 = acc[ai][bj][m][1];
                    u32x4 w; w.x = cvt_pk_bf16(v0[0], v0[1]); w.y = cvt_pk_bf16(v0[2], v0[3]); w.z = cvt_pk_bf16(v1[0], v1[1]); w.w = cvt_pk_bf16(v1[2], v1[3]);
                    *(u32x4*)(rowp + bj * HALF) = w; } }
        if (u.pn == gate_pn && wc == 0) {
#pragma unroll
            for (int ai = 0; ai < 2; ++ai)
#pragma unroll
                for (int m = 0; m < 4; ++m) { float* gp = gates + (size_t)(row0 + ai * HALF + m * 16) * 32 + 8 * fq;
                    *(f32x4*)gp = acc[ai][0][m][0]; *(f32x4*)(gp + 4) = acc[ai][0][m][1]; }
        }
    }
};

template <class Epi, class Sched, bool ALIGN_EPI = false, bool SP2 = false, bool I8 = false>
__device__ __forceinline__ void gemm_phase(PG8_LAS unsigned char* lds, const Gemm g, const Sched& S, const Epi& E) {
    const int tid = fresh_tid(), wid = __builtin_amdgcn_readfirstlane(tid >> 6), lane = tid & 63, wr = wid >> 2, wc = wid & 3, fr = lane & 15, fq = lane >> 4;
    const int ld = g.K;
    unsigned voffA[2], voffB[2];
#pragma unroll
    for (int i = 0; i < 2; ++i) { int R, C; stage_rc(tid * 16 + i * 8192, R, C); const int Rb = Epi::PERM ? ((R & ~31) + perm32(R & 31)) : R;
        voffA[i] = (unsigned)(R * ld + C) * 2u; voffB[i] = (unsigned)(Rb * ld + C) * 2u; }
    const size_t kstep = (size_t)(BK * 2);
    const size_t hstep = (size_t)HALF * ld * 2;
    const size_t tstep = 2 * hstep;
    const unsigned ldsw = (unsigned)wid * 1024u;
    const int aoff = lds_byte(wr * 64 + fr, fq * 8), boff = lds_byte(wc * 32 + fr, fq * 8);
#define PG8_SA(b, h) (((b) * 2 + (h)) * HTB)
#define PG8_SB(b, h) ((4 + (b) * 2 + (h)) * HTB)
#define PG8_STAGE(bufoff, gbase, voff) do { _Pragma("unroll") for (int _i = 0; _i < 2; ++_i) \
        __builtin_amdgcn_global_load_lds((const unsigned*)((const char*)(gbase) + (voff)[_i]), (PG8_LAS unsigned*)(lds + (bufoff) + ldsw + _i * 8192), 16, 0, 0); } while (0)
#define PG8_LDA(dst, b, h) do { _Pragma("unroll") for (int m = 0; m < 4; ++m) _Pragma("unroll") for (int k = 0; k < 2; ++k) dst[m][k] = *(const PG8_LAS bf16x8*)(lds + PG8_SA(b, h) + aoff + m * 2048 + k * 1024); } while (0)
#define PG8_LDB(dst, b, h) do { _Pragma("unroll") for (int n = 0; n < 2; ++n) _Pragma("unroll") for (int k = 0; k < 2; ++k) dst[n][k] = *(const PG8_LAS bf16x8*)(lds + PG8_SB(b, h) + boff + n * 2048 + k * 1024); } while (0)
#define PG8_MMA(ai, bj, At, Bt) do { __builtin_amdgcn_s_setprio(1); _Pragma("unroll") for (int m = 0; m < 4; ++m) _Pragma("unroll") for (int n = 0; n < 2; ++n) _Pragma("unroll") for (int k = 0; k < 2; ++k) \
        acc[ai][bj][m][n] = mma_op<I8>(Bt[n][k], At[m][k], acc[ai][bj][m][n]); __builtin_amdgcn_s_setprio(0); } while (0)
#define PG8_WAIT_V(n) asm volatile("s_waitcnt vmcnt(" #n ")" ::: "memory")
#define PG8_WAIT_L(n) asm volatile("s_waitcnt lgkmcnt(" #n ")" ::: "memory")
#define PG8_BAR __builtin_amdgcn_s_barrier()
#define PG8_SCHED __builtin_amdgcn_sched_barrier(0)
    Unit cur, nxt; int ui = 0;
    if (!S.next(0, cur)) return;
    int nt = cur.nt;
    f32x4 acc[2][2][4][2];
#pragma unroll
    for (int a = 0; a < 2; ++a)
#pragma unroll
        for (int b = 0; b < 2; ++b)
#pragma unroll
            for (int m = 0; m < 4; ++m)
#pragma unroll
                for (int n = 0; n < 2; ++n) acc[a][b][m][n] = zero4();
    bf16x8 At[4][2], B0[2][2], B1[2][2];
    const char* cA = (const char*)g.A + (size_t)cur.pm * tstep + (size_t)cur.koff * 2; const char* cB = (const char*)g.Bt + (size_t)cur.pn * tstep + (size_t)cur.koff * 2;
    S.a_ready(cur);
    if constexpr (SP2) {
        PG8_STAGE(PG8_SB(0, 0), cB, voffB); PG8_STAGE(PG8_SB(0, 1), cB + hstep, voffB); PG8_STAGE(PG8_SA(0, 0), cA, voffA); PG8_STAGE(PG8_SA(0, 1), cA + hstep, voffA);
        if (wr == 1) PG8_BAR;
        PG8_WAIT_V(2); PG8_BAR;
        PG8_STAGE(PG8_SB(1, 0), cB + kstep, voffB); PG8_STAGE(PG8_SA(1, 0), cA + kstep, voffA); PG8_STAGE(PG8_SB(1, 1), cB + hstep + kstep, voffB);
        PG8_WAIT_V(6); PG8_BAR;
    } else {
        PG8_STAGE(PG8_SB(0, 0), cB, voffB); PG8_STAGE(PG8_SA(0, 0), cA, voffA); PG8_STAGE(PG8_SB(0, 1), cB + hstep, voffB); PG8_STAGE(PG8_SA(0, 1), cA + hstep, voffA);
        if (wr == 1) PG8_BAR;
        PG8_WAIT_V(4); PG8_BAR;
        PG8_STAGE(PG8_SB(1, 0), cB + kstep, voffB); PG8_STAGE(PG8_SA(1, 0), cA + kstep, voffA); PG8_STAGE(PG8_SB(1, 1), cB + hstep + kstep, voffB);
        PG8_WAIT_V(6); PG8_BAR;
    }
    for (;;) {
        const bool has_next = S.next(ui + 1, nxt);
        const char* nA = has_next ? (const char*)g.A + (size_t)nxt.pm * tstep + (size_t)nxt.koff * 2 : cA; const char* nB = has_next ? (const char*)g.Bt + (size_t)nxt.pn * tstep + (size_t)nxt.koff * 2 : cB;
        for (int t = 0; t < nt; t += 2) {
            const bool last = (t == nt - 2);
            const char* a1 = cA + (size_t)(t + 1) * kstep;
            const char* a2 = last ? nA : cA + (size_t)(t + 2) * kstep; const char* b2 = last ? nB : cB + (size_t)(t + 2) * kstep;
            const char* a3 = a2 + kstep; const char* b3 = b2 + kstep;
            if (last && has_next) S.a_ready(nxt);
            if constexpr (SP2) {
            PG8_LDB(B0, 0, 0); PG8_LDB(B1, 0, 1); PG8_SCHED; PG8_LDA(At, 0, 0); PG8_STAGE(PG8_SA(1, 1), a1 + hstep, voffA);
            PG8_WAIT_V(8); PG8_WAIT_L(0); PG8_BAR; PG8_MMA(0, 0, At, B0); PG8_MMA(0, 1, At, B1); PG8_BAR; PG8_SCHED;
            PG8_LDA(At, 0, 1); PG8_STAGE(PG8_SB(0, 0), b2, voffB); PG8_STAGE(PG8_SB(0, 1), b2 + hstep, voffB); PG8_STAGE(PG8_SA(0, 0), a2, voffA);
            PG8_WAIT_V(8); PG8_WAIT_L(0); PG8_BAR; PG8_MMA(1, 0, At, B0); PG8_MMA(1, 1, At, B1); PG8_BAR; PG8_SCHED;
            PG8_LDB(B0, 1, 0); PG8_LDB(B1, 1, 1); PG8_SCHED; PG8_LDA(At, 1, 0); PG8_STAGE(PG8_SA(0, 1), a2 + hstep, voffA);
            PG8_WAIT_V(8); PG8_WAIT_L(0); PG8_BAR; PG8_MMA(0, 0, At, B0); PG8_MMA(0, 1, At, B1); PG8_BAR; PG8_SCHED;
            PG8_LDA(At, 1, 1); PG8_STAGE(PG8_SB(1, 0), b3, voffB); PG8_STAGE(PG8_SB(1, 1), b3 + hstep, voffB); PG8_STAGE(PG8_SA(1, 0), a3, voffA);
            PG8_WAIT_V(8); PG8_WAIT_L(0); PG8_BAR; PG8_MMA(1, 0, At, B0); PG8_MMA(1, 1, At, B1); PG8_BAR; PG8_SCHED;
            } else {
            PG8_LDB(B0, 0, 0); PG8_SCHED; PG8_LDA(At, 0, 0); PG8_STAGE(PG8_SA(1, 1), a1 + hstep, voffA);
            PG8_WAIT_L(8); PG8_BAR; PG8_WAIT_L(0); PG8_MMA(0, 0, At, B0); PG8_BAR; PG8_SCHED;
            PG8_LDB(B1, 0, 1); PG8_STAGE(PG8_SB(0, 0), b2, voffB);
            PG8_BAR; PG8_WAIT_L(0); PG8_MMA(0, 1, At, B1); PG8_BAR;
            PG8_LDA(At, 0, 1); PG8_STAGE(PG8_SA(0, 0), a2, voffA);
            PG8_BAR; PG8_WAIT_L(0); PG8_MMA(1, 0, At, B0); PG8_BAR; PG8_SCHED;
            PG8_STAGE(PG8_SB(0, 1), b2 + hstep, voffB);
            PG8_WAIT_V(6); PG8_BAR; PG8_MMA(1, 1, At, B1); PG8_BAR;
            PG8_LDB(B0, 1, 0); PG8_SCHED; PG8_LDA(At, 1, 0); PG8_STAGE(PG8_SA(0, 1), a2 + hstep, voffA);
            PG8_WAIT_L(8); PG8_BAR; PG8_WAIT_L(0); PG8_MMA(0, 0, At, B0); PG8_BAR; PG8_SCHED;
            PG8_LDB(B1, 1, 1); PG8_STAGE(PG8_SB(1, 0), b3, voffB);
            PG8_BAR; PG8_WAIT_L(0); PG8_MMA(0, 1, At, B1); PG8_BAR;
            PG8_LDA(At, 1, 1); PG8_STAGE(PG8_SA(1, 0), a3, voffA);
            PG8_BAR; PG8_WAIT_L(0); PG8_MMA(1, 0, At, B0); PG8_BAR; PG8_SCHED;
            PG8_STAGE(PG8_SB(1, 1), b3 + hstep, voffB);
            PG8_WAIT_V(6); PG8_BAR; PG8_MMA(1, 1, At, B1); PG8_BAR;
            }
        }
        if constexpr (ALIGN_EPI) { if (wr == 0) PG8_BAR; }
        if constexpr (!Epi::AFTER_DRAIN) { E(acc, cur, wr, wc, fr, fq); S.done(cur); }
        if (!has_next) break;
#pragma unroll
        for (int a = 0; a < 2; ++a)
#pragma unroll
            for (int b = 0; b < 2; ++b)
#pragma unroll
                for (int m = 0; m < 4; ++m)
#pragma unroll
                    for (int n = 0; n < 2; ++n) acc[a][b][m][n] = zero4();
        cur = nxt; cA = nA; cB = nB; ++ui; nt = cur.nt;
        if constexpr (ALIGN_EPI) { if (wr == 1) PG8_BAR; }
    }
    PG8_WAIT_V(0);
    if constexpr (!ALIGN_EPI) { if (wr == 0) PG8_BAR; }
    PG8_BAR;
    if constexpr (Epi::AFTER_DRAIN) { E.fused(acc, cur, wr, wc, fr, fq, lds, wid, lane); S.done(cur); }
#undef PG8_SA
#undef PG8_SB
#undef PG8_STAGE
#undef PG8_LDA
#undef PG8_LDB
#undef PG8_MMA
#undef PG8_WAIT_V
#undef PG8_WAIT_L
#undef PG8_BAR
#undef PG8_SCHED
}
}

#ifndef PG8_SP2
#define PG8_SP2 true
#endif
#ifndef PG8_ALIGN
#define PG8_ALIGN true
#endif
#ifndef PG8_ALIGN_SWI
#define PG8_ALIGN_SWI true
#endif

constexpr int NWAVES = 8;
constexpr int D = 2048, NB = 8, SEQ = 4096, CTXL = 256, DFF = 5632, NMOD = 9;
#ifndef MK_NGRP
#define MK_NGRP 8
#endif
constexpr int NGRP = MK_NGRP, NBG = NB / NGRP, XPG = 8 / NGRP;
constexpr int MC = NBG * CTXL;
constexpr int MLAT = NBG * SEQ;
constexpr int M = MC + MLAT;
constexpr int NP0 = 5376, NP1 = 6400;
constexpr int NCH = (CTXL + SEQ) / 64;
constexpr int KSPLIT = 4;
constexpr float EPS = 1e-6f;
constexpr float QSCALE = 0.08838834764831845f;

constexpr size_t MiB = 1u << 20;
constexpr size_t WS_CTL = 0, CTL_ZERO_BYTES = 256 * 1024;
constexpr size_t WS_MOD = 1 * MiB;
constexpr size_t WS_GATES = 3 * MiB, GATES_G = (size_t)M * 32 * 4;
constexpr size_t WS_WRG = 8 * MiB;
constexpr size_t WS_PE = 9 * MiB;
constexpr size_t WS_RS = 9 * MiB + 512 * 1024;
constexpr size_t WS_CS = 9 * MiB + 768 * 1024;
constexpr size_t WS_CS2 = WS_CS + (size_t)4 * 2 * DFF * 4;
constexpr size_t WS_CS3 = WS_CS2 + (size_t)2 * 4096 * 4;
constexpr size_t WS_HCTX = 10 * MiB;
constexpr size_t WS_W = 26 * MiB, W_LAYER = 165 * MiB;
constexpr size_t W_F1I = 0, W_F1O = W_F1I + 44 * MiB, W_F2I = W_F1O + 22 * MiB, W_F2O = W_F2I + 44 * MiB, W_MI = W_F2O + 22 * MiB, W_MO = W_MI + 25 * MiB;
constexpr size_t WS_U = 356 * MiB, U_G = (size_t)M * D * 2;
constexpr size_t WS_Y = 492 * MiB, Y_G = (size_t)M * D * 4;
constexpr size_t WS_BIG = 764 * MiB, BIG_G = (size_t)M * NP1 * 2;
constexpr size_t YC_OFF = (size_t)M * D * 2;
constexpr size_t WS_END = 1189 * MiB;
static_assert(W_MO + 8 * MiB <= W_LAYER && WS_W + 2 * W_LAYER <= WS_U && WS_U + NGRP * U_G <= WS_Y && WS_Y + NGRP * Y_G <= WS_BIG && WS_BIG + NGRP * BIG_G <= WS_END, "ws map");
static_assert(YC_OFF + (size_t)KSPLIT * MC * D * 4 <= Y_G && WS_GATES + NGRP * GATES_G <= WS_WRG, "ws map (group blocks)");
constexpr size_t W_MI8 = W_F1I + 22 * MiB;
constexpr size_t U8B_OFF = YC_OFF + (size_t)KSPLIT * MC * D * 4;
static_assert(WS_CS3 + (size_t)4 * 2048 * 4 <= WS_HCTX, "ws map (FFN-out scales)");
static_assert(W_MI8 + (size_t)4096 * D <= W_F1O && U8B_OFF + (size_t)M * D <= Y_G && WS_CS2 + 2 * 4096 * 4 <= WS_HCTX, "ws map (int8 in-projection)");
static_assert(WS_PE + 64 * 1024 * 4 <= WS_RS && WS_RS + (size_t)NGRP * M * 4 <= WS_CS && WS_CS + (size_t)4 * 2 * DFF * 4 <= WS_HCTX, "ws map (scales)");
constexpr int CW_BAR = 4096;
static_assert((CW_BAR + (1 + NGRP) * 3456) * 4 <= (int)CTL_ZERO_BYTES, "control words inside the per-launch memset");
constexpr int CW_W1READY = 64;

constexpr int SCR_BYTES = 151552;
constexpr int LDSCTL_OFF = SCR_BYTES;
constexpr int LDS_BYTES = 155648;

#define GAS __attribute__((address_space(1)))
#define LAS __attribute__((address_space(3)))
typedef unsigned short bf16;
typedef float f32x4 __attribute__((ext_vector_type(4)));
typedef float f32x2 __attribute__((ext_vector_type(2)));
typedef short bf16x8 __attribute__((ext_vector_type(8)));
typedef short bf16x4 __attribute__((ext_vector_type(4)));
typedef unsigned u32x4 __attribute__((ext_vector_type(4)));
typedef unsigned u32x2 __attribute__((ext_vector_type(2)));
#define LDS_WAIT() asm volatile("s_waitcnt lgkmcnt(0)" ::: "memory")
__device__ __forceinline__ unsigned f2bf(float f) { unsigned u = __builtin_bit_cast(unsigned, f); return (u + 0x7fffu + ((u >> 16) & 1u)) >> 16; }
__device__ __forceinline__ unsigned pk2(float lo, float hi) { return pg8::cvt_pk_bf16(lo, hi); }
__device__ __forceinline__ float bflo(unsigned w) { return __uint_as_float(w << 16); }
__device__ __forceinline__ float bfhi(unsigned w) { return __uint_as_float(w & 0xffff0000u); }
__device__ __forceinline__ float wave_sum(float v) {
#pragma unroll
    for (int o = 1; o < 64; o <<= 1) v += __shfl_xor(v, o);
    return v;
}
__device__ __forceinline__ float sigmoid_f(float x) { return __builtin_amdgcn_rcpf(1.0f + fexp(-x)); }
__device__ __forceinline__ float silu_f(float x) { return x * sigmoid_f(x); }
__device__ __forceinline__ float logsig_f(float z) { return fminf(z, 0.f) - flog(1.0f + fexp(-fabsf(z))); }
__device__ __forceinline__ float gelu_tanh_f(float x) { const float u = 0.7978845608028654f * (x + 0.044715f * x * x * x); const float t = 1.0f - 2.0f * __builtin_amdgcn_rcpf(1.0f + fexp(2.0f * u)); return 0.5f * x * (1.0f + t); }

template <int N> __device__ __forceinline__ float dpp_row_shr(float x) { return __int_as_float(__builtin_amdgcn_update_dpp(0, __float_as_int(x), 0x110 + N, 0xF, 0xF, false)); }
typedef _Float16 f16x2_t __attribute__((ext_vector_type(2)));
__device__ __forceinline__ unsigned pkh2(float lo, float hi) { const f32x2 v = {lo, hi}; return __builtin_bit_cast(unsigned, __builtin_convertvector(v, f16x2_t)); }
__device__ __forceinline__ f32x2 uph2(unsigned w) { return __builtin_convertvector(__builtin_bit_cast(f16x2_t, w), f32x2); }
__device__ __forceinline__ unsigned q8x4(const f32x4 v, float inv) {
    const float MG = 12582912.0f;
    const unsigned y0 = __float_as_uint(__builtin_fmaf(v.x, inv, MG)), y1 = __float_as_uint(__builtin_fmaf(v.y, inv, MG)), y2 = __float_as_uint(__builtin_fmaf(v.z, inv, MG)), y3 = __float_as_uint(__builtin_fmaf(v.w, inv, MG));
    return __builtin_amdgcn_perm(y1, y0, 0x0c0c0400u) | __builtin_amdgcn_perm(y3, y2, 0x04000c0cu);
}
__device__ __forceinline__ void wht8_raw(float (&x)[8]) {
#pragma unroll
    for (int h = 1; h < 8; h <<= 1)
#pragma unroll
        for (int i = 0; i < 8; ++i) if ((i & h) == 0) { const float a = x[i], c = x[i + h]; x[i] = a + c; x[i + h] = a - c; }
}
__device__ __forceinline__ void wht8(float (&x)[8]) {
#pragma unroll
    for (int h = 1; h < 8; h <<= 1)
#pragma unroll
        for (int i = 0; i < 8; ++i) if ((i & h) == 0) { const float a = x[i], c = x[i + h]; x[i] = a + c; x[i + h] = a - c; }
#pragma unroll
    for (int i = 0; i < 8; ++i) x[i] *= 0.35355339059327379f;
}
#define XB_TMO      128
#define XB_XCNT(j)  (256  + 64 * (j))
#define XB_XSUB(j)  (1280 + 64 * (j))
#define XB_XGEN(j)  (2304 + 64 * (j))
#define XB_TOP      3328
#define XB_TOPGEN   3392
#define XCD_BAR_WORDS 3456
#define XB_SPIN_CAP (1u << 18)

__device__ __forceinline__ unsigned xb_ld(unsigned* p)              { return __hip_atomic_load(p, __ATOMIC_RELAXED, __HIP_MEMORY_SCOPE_AGENT); }
__device__ __forceinline__ unsigned xb_add(unsigned* p, unsigned v) { return __hip_atomic_fetch_add(p, v, __ATOMIC_RELAXED, __HIP_MEMORY_SCOPE_AGENT); }
__device__ __forceinline__ unsigned xb_xcc_id() { return (unsigned)__builtin_amdgcn_s_getreg((3 << 11) | 20) & 0xFu; }
#define XB_SPIN(cond, bar) do { unsigned _sp = 0; while (cond) { __builtin_amdgcn_s_sleep(1); \
    if ((++_sp & 255u) == 0u) { if (xb_ld(&(bar)[XB_TMO])) break; if (_sp > XB_SPIN_CAP) { atomicAdd(&(bar)[XB_TMO], 1u); break; } } } } while (0)

struct XcdBarrier {
    unsigned* bar; unsigned x; unsigned ntot;
    volatile LAS unsigned* st;
};

__device__ __forceinline__ XcdBarrier xcd_barrier_post(unsigned* bar, volatile LAS unsigned* st, unsigned ntot) {
    XcdBarrier b; b.bar = bar; b.x = xb_xcc_id(); b.st = st; b.ntot = ntot;
    if (threadIdx.x == 0) (void)xb_add(&bar[XB_XCNT(b.x)], 1u);
    return b;
}
__device__ __forceinline__ void xcd_barrier_complete(unsigned* bar, unsigned x, unsigned G, unsigned& nloc, unsigned& nx) {
    unsigned sum, cnt, mine, sp = 0u;
    for (;;) {
        sum = 0u; cnt = 0u; mine = 0u;
#pragma unroll
        for (unsigned j = 0; j < 16; ++j) { const unsigned c = xb_ld(&bar[XB_XCNT(j)]); sum += c; cnt += (c > 0u) ? 1u : 0u; mine = (j == x) ? c : mine; }
        if (sum == G) break;
        __builtin_amdgcn_s_sleep(1);
        if ((++sp & 255u) == 0u) { if (xb_ld(&bar[XB_TMO])) break; if (sp > XB_SPIN_CAP) { atomicAdd(&bar[XB_TMO], 1u); break; } }
    }
    nloc = mine > 0u ? mine : 1u; nx = cnt > 0u ? cnt : 1u;
}

__device__ __forceinline__ void xcd_barrier(const XcdBarrier& b) {
    asm volatile("s_waitcnt vmcnt(0)" ::: "memory");
    __syncthreads();
    if (threadIdx.x == 0) {
        unsigned* bar = b.bar;
        __builtin_amdgcn_s_waitcnt(0);
        unsigned nloc = b.st[0], nx = b.st[1];
        if (nloc == 0u) { xcd_barrier_complete(bar, b.x, b.ntot, nloc, nx); b.st[0] = nloc; b.st[1] = nx; }
        const unsigned old = xb_add(&bar[XB_XSUB(b.x)], 1u);
        const unsigned gen = old / nloc;
        if (old + 1u == (gen + 1u) * nloc) {
            __builtin_amdgcn_fence(__ATOMIC_RELEASE, "agent");
            asm volatile("s_waitcnt vmcnt(0)" ::: "memory");
            const unsigned og = xb_add(&bar[XB_TOP], 1u);
            const unsigned tg = og / nx;
            if (og + 1u == (tg + 1u) * nx) xb_add(&bar[XB_TOPGEN], 1u);
            else XB_SPIN(xb_ld(&bar[XB_TOPGEN]) == tg, bar);
            __builtin_amdgcn_fence(__ATOMIC_ACQUIRE, "agent");
            xb_add(&bar[XB_XGEN(b.x)], 1u);
            asm volatile("s_waitcnt vmcnt(0)" ::: "memory");
        } else {
            XB_SPIN(xb_ld(&bar[XB_XGEN(b.x)]) == gen, bar);
            __builtin_amdgcn_fence(__ATOMIC_ACQUIRE, "agent");
            asm volatile("s_waitcnt vmcnt(0)" ::: "memory");
        }
    }
    __syncthreads();
}

struct Args { const float* in[27]; float* out; unsigned char* ws; int ph_lo, ph_hi; };
struct Frame {
    LAS unsigned char* lds;
    int G, wg, NGW;
    int grp;
    float* out; unsigned char* ws;
    const Args& A;
};
__device__ __forceinline__ bf16* gU(const Frame& F) { return (bf16*)(F.ws + WS_U + (size_t)F.grp * U_G); }
__device__ __forceinline__ bf16* gY(const Frame& F) { return (bf16*)(F.ws + WS_Y + (size_t)F.grp * Y_G); }
__device__ __forceinline__ bf16* gBIG(const Frame& F) { return (bf16*)(F.ws + WS_BIG + (size_t)F.grp * BIG_G); }
__device__ __forceinline__ float* gYC(const Frame& F) { return (float*)(F.ws + WS_Y + (size_t)F.grp * Y_G + YC_OFF); }
__device__ __forceinline__ float* gGATES(const Frame& F) { return (float*)(F.ws + WS_GATES + (size_t)F.grp * GATES_G); }
enum { I_X = 0, I_C, I_CTX, I_CCTX, I_WMOD, I_BMOD, I_NORMG, I_F1WI, I_F1WO, I_F2WI, I_F2WO, I_ABWI, I_WALPHA2, I_BALPHA, I_GLANG, I_CONVW, I_CONVB, I_RGWA, I_RGBA, I_RGWI, I_RGBI, I_LAM, I_ABWO, I_MLWI, I_MLBG, I_MLNG, I_MLWO };

__device__ __forceinline__ void pre_mod(Frame& F) {
    const int tid_ = fresh_tid(); const int lane_ = tid_ & 63, wave_ = __builtin_amdgcn_readfirstlane(tid_ >> 6), gw_ = F.wg * NWAVES + wave_; (void)lane_; (void)gw_;
    LAS float* sc = (LAS float*)F.lds;
    LAS float* red = (LAS float*)(F.lds + 9 * 2048 * 4);
    for (int i = tid_; i < 9 * 2048; i += 512) { const int bb = i >> 11, k = i & 2047; const float v = bb < 8 ? F.A.in[I_C][bb * 2048 + k] : F.A.in[I_CCTX][k]; sc[i] = v * (1.0f / (1.0f + expf(-v))); }
    __syncthreads();
    float* MOD = (float*)(F.ws + WS_MOD);
    const int q = tid_ & 15, kg = tid_ >> 4;
    for (int item = F.wg; item < 2 * 288; item += F.G) {
        const int layer = item / 288, col0 = (item % 288) * 64;
        const float* wp = F.A.in[I_WMOD] + ((size_t)layer * 2048 + (size_t)kg * 64) * 18432 + col0 + 4 * q;
        f32x4 acc[9];
#pragma unroll
        for (int bb = 0; bb < 9; ++bb) acc[bb] = (f32x4){0.f, 0.f, 0.f, 0.f};
#pragma unroll 4
        for (int kk = 0; kk < 64; ++kk) {
            const f32x4 w = *(const f32x4*)(wp + (size_t)kk * 18432);
#pragma unroll
            for (int bb = 0; bb < 9; ++bb) acc[bb] += w * sc[bb * 2048 + kg * 64 + kk];
        }
#pragma unroll
        for (int bb = 0; bb < 9; ++bb)
#pragma unroll
            for (int e = 0; e < 4; ++e) { float v = acc[bb][e]; v += __shfl_xor(v, 16); v += __shfl_xor(v, 32); acc[bb][e] = v; }
        __syncthreads();
        if (lane_ < 16) {
#pragma unroll
            for (int bb = 0; bb < 9; ++bb) *(LAS f32x4*)(red + (wave_ * 9 + bb) * 64 + 4 * q) = acc[bb];
        }
        __syncthreads();
        for (int t = tid_; t < 9 * 64; t += 512) { const int bb = t >> 6, ci = t & 63; float s = F.A.in[I_BMOD][layer * 18432 + col0 + ci];
#pragma unroll
            for (int w = 0; w < 8; ++w) s += red[(w * 9 + bb) * 64 + ci];
            MOD[((size_t)layer * 9 + bb) * 18432 + col0 + ci] = s; }
    }
    __syncthreads();
}
__device__ __forceinline__ void pre_pe(Frame& F) {
    const int tid_ = fresh_tid(); const int lane_ = tid_ & 63, wave_ = __builtin_amdgcn_readfirstlane(tid_ >> 6), gw_ = F.wg * NWAVES + wave_; (void)lane_; (void)gw_;
    float* PE = (float*)(F.ws + WS_PE);
    for (int i = F.wg * 512 + tid_; i < 64 * 512; i += F.G * 512) {
        const int p = i >> 9, f = i & 511;
        const float om = (float)exp2(-(double)f * (13.287712379549449 / 512.0));
        const float angf = (float)p * om; const double x = (double)angf;
        const double kf = rint(x * 0.6366197723675814);
        double r = fma(-kf, 1.5707963267948966, x); r = fma(-kf, 6.123233995736766e-17, r);
        const int k = ((int)kf) & 3; const double r2 = r * r;
        const double sp = r * (1.0 + r2 * (-1.0 / 6.0 + r2 * (1.0 / 120.0 + r2 * (-1.0 / 5040.0 + r2 * (1.0 / 362880.0 + r2 * (-1.0 / 39916800.0 + r2 * (1.0 / 6227020800.0)))))));
        const double cp = 1.0 + r2 * (-0.5 + r2 * (1.0 / 24.0 + r2 * (-1.0 / 720.0 + r2 * (1.0 / 40320.0 + r2 * (-1.0 / 3628800.0 + r2 * (1.0 / 479001600.0))))));
        const double s = (k == 0) ? sp : (k == 1) ? cp : (k == 2) ? -sp : -cp;
        const double c = (k == 0) ? cp : (k == 1) ? -sp : (k == 2) ? -cp : sp;
        PE[p * 1024 + f] = (float)s; PE[p * 1024 + 512 + f] = (float)c;
    }
}
template <int MAP> __device__ __forceinline__ int cvt_row(int n) {
    if (MAP == 1) return n < DFF ? ((n >> 7) << 8) + (n & 127) : (((n - DFF) >> 7) << 8) + 128 + ((n - DFF) & 127);
    if (MAP == 2) return n < 3072 ? n : (n < 3104 ? n + 2048 : n - 32);
    return n;
}
template <int MAP> __device__ __forceinline__ void cvt_item(const float* W, int K, int N, bf16* WT, LAS float* scr, int item, int lane) {
    const int nblk = N / 32, kb = item / nblk, nb = item % nblk, k0 = 64 * kb, n0 = 32 * nb;
#pragma unroll 8
    for (int i = 0; i < 32; ++i) { const int kk = 2 * i + (lane >> 5); scr[kk * 33 + (lane & 31)] = W[(size_t)(k0 + kk) * N + n0 + (lane & 31)]; }
    LDS_WAIT(); asm volatile("" ::: "memory");
    const int c = lane & 7;
#pragma unroll
    for (int j = 0; j < 4; ++j) { const int n = (lane >> 3) + 8 * j; const LAS float* s = scr + (8 * c) * 33 + n;
        u32x4 o; o.x = pk2(s[0 * 33], s[1 * 33]); o.y = pk2(s[2 * 33], s[3 * 33]); o.z = pk2(s[4 * 33], s[5 * 33]); o.w = pk2(s[6 * 33], s[7 * 33]);
        *(u32x4*)(WT + (size_t)cvt_row<MAP>(n0 + n) * K + k0 + 8 * c) = o; }
    LDS_WAIT(); asm volatile("" ::: "memory");
}
__device__ __forceinline__ void cvt8_item(const float* W, int N, unsigned char* WT8, float* cs, int n0, int nr0, LAS unsigned char* lds, int tid) {
    constexpr int PITCH = 2048 + 16;
    const int c = tid & 31, kg = tid >> 5;
    float v[128]; float am = 0.f;
    const float* wp = W + (size_t)(4 * kg) * N + n0 + c; const size_t istep = (size_t)64 * N;
#pragma unroll
    for (int i = 0; i < 32; ++i) {
#pragma unroll
        for (int e = 0; e < 4; ++e) { const float x = wp[(size_t)e * N]; v[4 * i + e] = x; am = fmaxf(am, fabsf(x)); }
        wp += istep;
        if ((i & 7) == 7) __builtin_amdgcn_sched_barrier(0);
    }
    LAS float* red = (LAS float*)(lds + 32 * PITCH);
    red[kg * 32 + c] = am;
    __syncthreads();
    float m = 0.f;
#pragma unroll
    for (int g = 0; g < 16; ++g) m = fmaxf(m, red[g * 32 + c]);
    m = fmaxf(m, 1e-30f);
    const float inv = 127.0f / m;
#pragma unroll
    for (int i = 0; i < 32; ++i) *(LAS unsigned*)(lds + c * PITCH + 4 * (kg + 16 * i)) = q8x4((f32x4){v[4 * i], v[4 * i + 1], v[4 * i + 2], v[4 * i + 3]}, inv);
    if (kg == 0) cs[nr0 + c] = m * (1.0f / 127.0f);
    __syncthreads();
#pragma unroll
    for (int j = 0; j < 8; ++j) { const int id = tid + 512 * j, col = id >> 7, ch = id & 127;
        *(u32x4*)(WT8 + (size_t)(nr0 + col) * 2048 + 16 * ch) = *(const LAS u32x4*)(lds + col * PITCH + 16 * ch); }
    __syncthreads();
}
__device__ __forceinline__ void cvt8o_item(const float* W, unsigned char* WT8, float* cs, int n0, LAS unsigned char* lds, int tid) {
    constexpr int KH = DFF / 2, PITCH = KH + 16;
    const int c = tid & 31, kg = tid >> 5;
    const float* wp = W + n0 + c;
    float am = 0.f;
#pragma unroll 2
    for (int i = 0; i < 44; ++i) { const int g = kg + 16 * i; float x[8];
#pragma unroll
        for (int e = 0; e < 8; ++e) x[e] = wp[(size_t)(8 * g + e) * D];
        wht8(x);
#pragma unroll
        for (int e = 0; e < 8; ++e) am = fmaxf(am, fabsf(x[e])); }
    LAS float* red = (LAS float*)(lds + 32 * PITCH);
    red[kg * 32 + c] = am;
    __syncthreads();
    float m = 0.f;
#pragma unroll
    for (int g = 0; g < 16; ++g) m = fmaxf(m, red[g * 32 + c]);
    m = fmaxf(m, 1e-30f);
    const float inv = 127.0f / m;
    if (kg == 0) cs[n0 + c] = m * (1.0f / 127.0f);
    for (int half = 0; half < 2; ++half) {
#pragma unroll 2
        for (int i = 22 * half; i < 22 * half + 22; ++i) { const int g = kg + 16 * i; float x[8];
#pragma unroll
            for (int e = 0; e < 8; ++e) x[e] = wp[(size_t)(8 * g + e) * D];
            wht8(x);
            u32x2 w; w.x = q8x4((f32x4){x[0], x[1], x[2], x[3]}, inv); w.y = q8x4((f32x4){x[4], x[5], x[6], x[7]}, inv);
            *(LAS u32x2*)(lds + c * PITCH + 8 * (g - 352 * half)) = w; }
        __syncthreads();
        for (int id = tid; id < 32 * (KH / 16); id += 512) { const int col = id / (KH / 16), ch = id % (KH / 16);
            *(u32x4*)(WT8 + (size_t)(n0 + col) * (2 * DFF) + half * KH + 16 * ch) = *(const LAS u32x4*)(lds + col * PITCH + 16 * ch); }
        __syncthreads();
    }
}
template <int LAYER> __device__ __forceinline__ void cvt_layer(Frame& F, int pct_lo = 0, int pct_hi = 1024) {
    const int tid_ = fresh_tid(); const int lane_ = tid_ & 63, wave_ = __builtin_amdgcn_readfirstlane(tid_ >> 6), gw_ = F.wg * NWAVES + wave_; (void)lane_; (void)gw_;
    LAS float* scr = (LAS float*)(F.lds + wave_ * 16384);
    constexpr int I0 = 32 * 352, I1 = 88 * 64, I4 = LAYER == 0 ? 32 * 161 : 32 * 193, I5 = 32 * 64, I6 = LAYER == 0 ? 256 : 0;
    constexpr int NITEMS = I4 + I5 + I6; (void)I0; (void)I1;
    const float* f1i = F.A.in[I_F1WI] + (size_t)LAYER * D * 2 * DFF; const float* f1o = F.A.in[I_F1WO] + (size_t)LAYER * DFF * D;
    const float* f2i = F.A.in[I_F2WI] + (size_t)LAYER * D * 2 * DFF; const float* f2o = F.A.in[I_F2WO] + (size_t)LAYER * DFF * D;
    {
        constexpr int NB8 = 2 * DFF / 32;
        const int lo8 = 2 * NB8 * pct_lo / 1024, hi8 = 2 * NB8 * pct_hi / 1024;
        float* cs = (float*)(F.ws + WS_CS) + (size_t)LAYER * 2 * (2 * DFF);
        __syncthreads();
        for (int it = lo8 + F.wg; it < hi8; it += F.G) { const int f = it >= NB8, n0 = 32 * (it - f * NB8);
            cvt8_item(f ? f2i : f1i, 2 * DFF, F.ws + WS_W + LAYER * W_LAYER + (f ? W_F2I : W_F1I), cs + f * (2 * DFF), n0, cvt_row<1>(n0), F.lds, tid_); }
        const int loA = 128 * pct_lo / 1024, hiA = 128 * pct_hi / 1024;
        for (int it = loA + F.wg; it < hiA; it += F.G) { const int f = it >= 64;
            cvt8o_item(f ? f2o : f1o, F.ws + WS_W + LAYER * W_LAYER + (f ? W_F2O : W_F1O), (float*)(F.ws + WS_CS3) + (LAYER * 2 + f) * 2048, 32 * (it - 64 * f), F.lds, tid_); }
        const int lo9 = 128 * pct_lo / 1024, hi9 = 128 * pct_hi / 1024;
        for (int it = lo9 + F.wg; it < hi9; it += F.G) { const int j0 = 32 * it;
            const int n0 = LAYER == 0 ? j0 + 1024 + (j0 >= 2048 ? 32 : 0) : j0 + 2048;
            cvt8_item(LAYER == 0 ? F.A.in[I_ABWI] : F.A.in[I_MLWI], LAYER == 0 ? 5152 : 6176, F.ws + WS_W + LAYER * W_LAYER + W_MI8, (float*)(F.ws + WS_CS2) + LAYER * 4096, n0, j0, F.lds, tid_); }
    }
    const int it_lo = (int)((long)NITEMS * pct_lo / 1024), it_hi = (int)((long)NITEMS * pct_hi / 1024);
    for (int it = it_lo + gw_; it < it_hi; it += F.NGW) {
        int r = it;
        if (r < I4) { if (LAYER == 0) cvt_item<2>(F.A.in[I_ABWI], D, 5152, (bf16*)(F.ws + WS_W + LAYER * W_LAYER + W_MI), scr, r, lane_); else cvt_item<0>(F.A.in[I_MLWI], D, 6176, (bf16*)(F.ws + WS_W + LAYER * W_LAYER + W_MI), scr, r, lane_); continue; } r -= I4;
        if (r < I5) { cvt_item<0>(LAYER == 0 ? F.A.in[I_ABWO] : F.A.in[I_MLWO], D, D, (bf16*)(F.ws + WS_W + LAYER * W_LAYER + W_MO), scr, r, lane_); continue; } r -= I5;
        if (LAYER == 0) { const int mi = r >> 3, sub = r & 7, dir = mi >> 4, mat = (mi >> 3) & 1, n = mi & 7;
            const float* src = (mat ? F.A.in[I_RGWI] : F.A.in[I_RGWA]) + (size_t)(dir * 8 + n) * 128 * 128;
            cvt_item<0>(src, 128, 128, (bf16*)(F.ws + WS_WRG) + (size_t)mi * 128 * 128, scr, sub, lane_); }
    }
    constexpr int PR0 = LAYER == 0 ? 5152 : 6176, PR1 = LAYER == 0 ? NP0 : NP1;
    u32x4* z = (u32x4*)((bf16*)(F.ws + WS_W + LAYER * W_LAYER + W_MI) + (size_t)PR0 * D);
    if (pct_hi == 1024) for (int i = F.wg * 512 + tid_; i < (PR1 - PR0) * D / 8; i += F.G * 512) z[i] = (u32x4){0u, 0u, 0u, 0u};
}

__device__ __forceinline__ float wave_sum8(const float (&v)[8], int lane) {
    const bool h1 = (lane & 1) != 0, h2 = (lane & 2) != 0, h4 = (lane & 4) != 0;
    float w4[4], w2[2];
#pragma unroll
    for (int i = 0; i < 4; ++i) { const float send = h1 ? v[i] : v[4 + i], keep = h1 ? v[4 + i] : v[i]; w4[i] = keep + __shfl_xor(send, 1); }
#pragma unroll
    for (int i = 0; i < 2; ++i) { const float send = h2 ? w4[i] : w4[2 + i], keep = h2 ? w4[2 + i] : w4[i]; w2[i] = keep + __shfl_xor(send, 2); }
    const float send = h4 ? w2[0] : w2[1], keep = h4 ? w2[1] : w2[0];
    float w = keep + __shfl_xor(send, 4);
    w += __shfl_xor(w, 8); w += __shfl_xor(w, 16); w += __shfl_xor(w, 32);
    return w;
}
__device__ __forceinline__ unsigned char* gU8B(const Frame& F) { return (unsigned char*)gY(F) + U8B_OFF; }
__device__ __forceinline__ float* gRS(const Frame& F) { return (float*)(F.ws + WS_RS) + (size_t)F.grp * M; }
__device__ __forceinline__ float* hrow(Frame& F, int r) { return r < MC ? (float*)(F.ws + WS_HCTX) + (size_t)(r + F.grp * MC) * D : F.out + (size_t)((r - MC) + F.grp * MLAT) * D; }
__device__ __forceinline__ float wave_total(float x) {
    x += dpp_row_shr<1>(x); x += dpp_row_shr<2>(x); x += dpp_row_shr<4>(x); x += dpp_row_shr<8>(x);
    const int xi = __float_as_int(x);
    return (__int_as_float(__builtin_amdgcn_readlane(xi, 15)) + __int_as_float(__builtin_amdgcn_readlane(xi, 31))) + (__int_as_float(__builtin_amdgcn_readlane(xi, 47)) + __int_as_float(__builtin_amdgcn_readlane(xi, 63)));
}
__device__ __forceinline__ float wave_max_nonneg(float x) {
    x = fmaxf(x, dpp_row_shr<1>(x)); x = fmaxf(x, dpp_row_shr<2>(x)); x = fmaxf(x, dpp_row_shr<4>(x)); x = fmaxf(x, dpp_row_shr<8>(x));
    const int xi = __float_as_int(x);
    return fmaxf(fmaxf(__int_as_float(__builtin_amdgcn_readlane(xi, 15)), __int_as_float(__builtin_amdgcn_readlane(xi, 31))), fmaxf(__int_as_float(__builtin_amdgcn_readlane(xi, 47)), __int_as_float(__builtin_amdgcn_readlane(xi, 63))));
}
template <bool INIT, bool HAS_Y>
__device__ __forceinline__ void nrm_load(Frame& F, int rr_, int lane_, const bf16* Yb, f32x4 (&hn)[8], u32x2 (&hbn)[8], u32x2 (&yn)[8]) {
#pragma unroll
    for (int j = 0; j < 8; ++j) { const int d0 = 256 * j + 4 * lane_;
        if (INIT) hn[j] = rr_ < MC ? *(const f32x4*)(F.A.in[I_CTX] + (size_t)(rr_ + F.grp * MC) * D + d0) : *(const f32x4*)(F.A.in[I_X] + (size_t)((rr_ - MC) + F.grp * MLAT) * D + d0);
        else hbn[j] = *(const u32x2*)((const bf16*)hrow(F, rr_) + D + d0);
        if (HAS_Y) { if (rr_ >= MC) yn[j] = *(const u32x2*)(Yb + (size_t)rr_ * D + d0); } }
}
template <bool INIT, bool HAS_Y, bool HAS_U, bool FINAL, int U8>
__device__ __forceinline__ void nrm_row(Frame& F, int r, int nxt, int row_hi, int lane_, LAS float* PRM, const bf16* Yb, bf16* U, const float* PE, float wgt, int nsplit,
                                        f32x4 (&hn)[8], u32x2 (&hbn)[8], u32x2 (&yn)[8]) {
    const int s = r < MC ? NBG : (r - MC) >> 12;
    const LAS float* Pg = PRM + (2 + 3 * s) * D;
    f32x4 hv[8]; u32x2 yr[8];
#pragma unroll
    for (int j = 0; j < 8; ++j) { if (INIT) hv[j] = hn[j]; else { const f32x2 a_ = uph2(hbn[j].x), b_ = uph2(hbn[j].y); hv[j] = (f32x4){a_.x, a_.y, b_.x, b_.y}; } if (HAS_Y) yr[j] = yn[j]; }
    if (nxt < row_hi) nrm_load<INIT, HAS_Y>(F, nxt, lane_, Yb, hn, hbn, yn);
    float* hp = hrow(F, r);
    if (INIT) { if (r >= MC) { const int t = (r - MC) & (SEQ - 1), prow = t >> 6, pcol = t & 63;
#pragma unroll
        for (int j = 0; j < 8; ++j) { const int d0 = 256 * j + 4 * lane_; hv[j] = hv[j] + (j < 4 ? *(const f32x4*)(PE + prow * 1024 + d0) : *(const f32x4*)(PE + pcol * 1024 + d0 - 1024)); } } }
    if (HAS_Y) {
        f32x4 yv[8]; float ss = 0.f;
#pragma unroll
        for (int j = 0; j < 8; ++j) { const int d0 = 256 * j + 4 * lane_;
            if (r < MC) { const float* yc = gYC(F) + (size_t)r * D + d0;
                f32x4 a = *(const f32x4*)yc;
#pragma unroll
                for (int k = 1; k < KSPLIT; ++k) if (k < nsplit) a = a + *(const f32x4*)(yc + (size_t)k * MC * D);
                yv[j] = a; }
            else yv[j] = (f32x4){bflo(yr[j].x), bfhi(yr[j].x), bflo(yr[j].y), bfhi(yr[j].y)};
            ss += (yv[j].x * yv[j].x + yv[j].y * yv[j].y) + (yv[j].z * yv[j].z + yv[j].w * yv[j].w); }
        const float r1 = rsqrtf(wave_total(ss) * (1.0f / D) + EPS) * wgt;
#pragma unroll
        for (int j = 0; j < 8; ++j) { const int d0 = 256 * j + 4 * lane_;
            const f32x4 gt = *(const LAS f32x4*)(Pg + d0);
            hv[j] = hv[j] + gt * (yv[j] * r1); }
    }
    if (INIT || HAS_Y) {
#pragma unroll
        for (int j = 0; j < 8; ++j) { if (FINAL) *(f32x4*)(hp + 256 * j + 4 * lane_) = hv[j]; else { u32x2 w; w.x = pkh2(hv[j].x, hv[j].y); w.y = pkh2(hv[j].z, hv[j].w); *(u32x2*)((bf16*)hp + D + 256 * j + 4 * lane_) = w; } }
    }
    if (HAS_U) {
        float ss = 0.f;
#pragma unroll
        for (int j = 0; j < 8; ++j) ss += (hv[j].x * hv[j].x + hv[j].y * hv[j].y) + (hv[j].z * hv[j].z + hv[j].w * hv[j].w);
        const float r2 = rsqrtf(wave_total(ss) * (1.0f / D) + EPS);
#pragma unroll
        for (int j = 0; j < 8; ++j) { const int d0 = 256 * j + 4 * lane_;
            const f32x4 sh = *(const LAS f32x4*)(Pg + D + d0), sc = *(const LAS f32x4*)(Pg + 2 * D + d0);
            const f32x4 u = (hv[j] * r2) * sc + sh;
            if (U8 != 0) hv[j] = u;
            if (U8 != 1) { u32x2 w; w.x = pk2(u.x, u.y); w.y = pk2(u.z, u.w);
                *(u32x2*)(U + (size_t)r * D + d0) = w; } }
        if (U8 != 0) {
            float am = 0.f;
#pragma unroll
            for (int j = 0; j < 8; ++j) am = fmaxf(am, fmaxf(fmaxf(fabsf(hv[j].x), fabsf(hv[j].y)), fmaxf(fabsf(hv[j].z), fabsf(hv[j].w))));
            am = fmaxf(wave_max_nonneg(am), 1e-20f);
            const float inv = 127.0f / am;
            unsigned char* u8p = (U8 == 1 ? (unsigned char*)U : gU8B(F)) + (size_t)r * D + 4 * lane_;
#pragma unroll
            for (int j = 0; j < 8; ++j) *(unsigned*)(u8p + 256 * j) = q8x4(hv[j], inv);
            if (lane_ == 0) gRS(F)[r] = am * (1.0f / 127.0f);
        }
    }
}
template <bool INIT, bool HAS_Y, bool HAS_U, bool FINAL = false, int U8 = 0>
__device__ __forceinline__ void nrm_rows(Frame& F, int row_lo, int row_hi, float wgt, const float* gpost, const float* mod_g, int gate_slot,
                                         const float* gpre, const float* mod_u, int shift_slot, int scale_slot, int nsplit = KSPLIT) {
    const int tid_ = fresh_tid(); const int lane_ = tid_ & 63, wave_ = __builtin_amdgcn_readfirstlane(tid_ >> 6), gw_ = F.wg * NWAVES + wave_;
    const bf16* Yb = gY(F); bf16* U = gU(F); const float* PE = (const float*)(F.ws + WS_PE);
    LAS float* PRM = (LAS float*)F.lds;
    __syncthreads();
    for (int i = tid_; i < (2 + 3 * (NBG + 1)) * (D / 4); i += NWAVES * 64) { const int v = i / (D / 4), c4 = (i % (D / 4)) * 4;
        f32x4 val = (f32x4){0.f, 0.f, 0.f, 0.f};
        if (v == 0) { if (HAS_Y) val = *(const f32x4*)(gpost + c4); }
        else if (v == 1) { if (HAS_U) val = *(const f32x4*)(gpre + c4); }
        else { const int s = (v - 2) / 3, k = (v - 2) % 3; const int bb = s < NBG ? F.grp * NBG + s : 8;
            if (k == 0) { if (HAS_Y) val = *(const f32x4*)(mod_g + ((size_t)bb * 9 + gate_slot) * D + c4) * *(const f32x4*)(gpost + c4); }
            else if (HAS_U) { val = *(const f32x4*)(mod_u + ((size_t)bb * 9 + (k == 1 ? shift_slot : scale_slot)) * D + c4); if (k == 2) val = (val + 1.0f) * *(const f32x4*)(gpre + c4); } }
        *(LAS f32x4*)(PRM + v * D + c4) = val; }
    f32x4 hnA[8]; u32x2 hbA[8], ynA[8];
    const int st = F.NGW; int r = row_lo + gw_;
    if (r < row_hi) nrm_load<INIT, HAS_Y>(F, r, lane_, Yb, hnA, hbA, ynA);
    __syncthreads();
    for (; r < row_hi; r += st) nrm_row<INIT, HAS_Y, HAS_U, FINAL, U8>(F, r, r + st, row_hi, lane_, PRM, Yb, U, PE, wgt, nsplit, hnA, hbA, ynA);
    __syncthreads();
}

__device__ __forceinline__ void requant_rows(Frame& F, int row_lo, int row_hi) {
    const int tid_ = fresh_tid(); const int lane_ = tid_ & 63, wave_ = __builtin_amdgcn_readfirstlane(tid_ >> 6), gw_ = F.wg * NWAVES + wave_;
    bf16* H = gBIG(F); float* RS = gRS(F);
    u32x4 nx[11];
    int r = row_lo + gw_;
    if (r < row_hi) {
#pragma unroll
        for (int j = 0; j < 11; ++j) nx[j] = *(const u32x4*)(H + (size_t)r * DFF + (j * 64 + lane_) * 8); }
    for (; r < row_hi; r += F.NGW) {
        u32x4 cv[11];
#pragma unroll
        for (int j = 0; j < 11; ++j) cv[j] = nx[j];
        if (r + F.NGW < row_hi) {
#pragma unroll
            for (int j = 0; j < 11; ++j) nx[j] = *(const u32x4*)(H + (size_t)(r + F.NGW) * DFF + (j * 64 + lane_) * 8); }
        float xr[11][8]; float am = 0.f;
#pragma unroll
        for (int j = 0; j < 11; ++j) { const u32x4 v = cv[j];
            xr[j][0] = bflo(v.x); xr[j][1] = bfhi(v.x); xr[j][2] = bflo(v.y); xr[j][3] = bfhi(v.y); xr[j][4] = bflo(v.z); xr[j][5] = bfhi(v.z); xr[j][6] = bflo(v.w); xr[j][7] = bfhi(v.w);
            wht8_raw(xr[j]);
#pragma unroll
            for (int e = 0; e < 8; ++e) am = fmaxf(am, fabsf(xr[j][e])); }
        am = fmaxf(wave_max_nonneg(am), 1e-20f);
        const float inv = 127.0f / am;
        unsigned char* o8 = (unsigned char*)(H + (size_t)r * DFF);
#pragma unroll
        for (int j = 0; j < 11; ++j) {
            u32x2 w; w.x = q8x4((f32x4){xr[j][0], xr[j][1], xr[j][2], xr[j][3]}, inv); w.y = q8x4((f32x4){xr[j][4], xr[j][5], xr[j][6], xr[j][7]}, inv);
            *(u32x2*)(o8 + (j * 64 + lane_) * 8) = w; }
        if (lane_ == 0) RS[r] = am * (0.35355339059327379f / 127.0f);
    }
}
__device__ __forceinline__ void unpack8(const u32x4 v, float (&f)[8]) { f[0] = bflo(v.x); f[1] = bfhi(v.x); f[2] = bflo(v.y); f[3] = bfhi(v.y); f[4] = bflo(v.z); f[5] = bfhi(v.z); f[6] = bflo(v.w); f[7] = bfhi(v.w); }
__device__ __forceinline__ u32x4 pack8(const float (&f)[8]) { u32x4 o; o.x = pk2(f[0], f[1]); o.y = pk2(f[2], f[3]); o.z = pk2(f[4], f[5]); o.w = pk2(f[6], f[7]); return o; }
__device__ __forceinline__ void comb0_rows(Frame& F, int row_lo, int row_hi) {
    const int tid_ = fresh_tid(); const int lane_ = tid_ & 63, wave_ = __builtin_amdgcn_readfirstlane(tid_ >> 6), gw_ = F.wg * NWAVES + wave_;
    const bf16* OFb = gY(F); const bf16* OBb = OFb + (size_t)M * 1024; const bf16* HFb = OBb + (size_t)M * 1024; const bf16* HBb = HFb + (size_t)M * 1024;
    const bf16* P = gBIG(F); bf16* U = gU(F); const float* gg = F.A.in[I_GLANG];
    const int e0 = 16 * lane_;
    f32x4 gn[4];
#pragma unroll
    for (int c = 0; c < 4; ++c) gn[c] = *(const f32x4*)(gg + (e0 & 255) + 4 * c);
    u32x4 nx[12];
#define C0_LOAD(r_) do { const size_t o_ = (size_t)(r_) * 1024 + e0; const bf16* g_ = P + (size_t)(r_) * NP0 + e0; \
        nx[0] = *(const u32x4*)(OFb + o_); nx[1] = *(const u32x4*)(OFb + o_ + 8); nx[2] = *(const u32x4*)(OBb + o_); nx[3] = *(const u32x4*)(OBb + o_ + 8); nx[4] = *(const u32x4*)(g_ + 2048); nx[5] = *(const u32x4*)(g_ + 2056); \
        nx[6] = *(const u32x4*)(HFb + o_); nx[7] = *(const u32x4*)(HFb + o_ + 8); nx[8] = *(const u32x4*)(HBb + o_); nx[9] = *(const u32x4*)(HBb + o_ + 8); nx[10] = *(const u32x4*)(g_ + 4096); nx[11] = *(const u32x4*)(g_ + 4104); } while (0)
    int r = row_lo + gw_;
    if (r < row_hi) C0_LOAD(r);
    for (; r < row_hi; r += F.NGW) {
        u32x4 cu[12];
#pragma unroll
        for (int i = 0; i < 12; ++i) cu[i] = nx[i];
        if (r + F.NGW < row_hi) C0_LOAD(r + F.NGW);
#pragma unroll
        for (int part = 0; part < 2; ++part) {
            float a[2][8], b8[8], g[2][8], o[2][8];
            unpack8(cu[6 * part + 0], a[0]); unpack8(cu[6 * part + 1], a[1]);
            unpack8(cu[6 * part + 2], b8);
#pragma unroll
            for (int e = 0; e < 8; ++e) a[0][e] += b8[e];
            unpack8(cu[6 * part + 3], b8);
#pragma unroll
            for (int e = 0; e < 8; ++e) a[1][e] += b8[e];
            unpack8(cu[6 * part + 4], g[0]); unpack8(cu[6 * part + 5], g[1]);
            if (part == 0) {
                float ss = 0.f;
#pragma unroll
                for (int c = 0; c < 2; ++c)
#pragma unroll
                    for (int e = 0; e < 8; ++e) ss += a[c][e] * a[c][e];
                ss += __shfl_xor(ss, 1); ss += __shfl_xor(ss, 2); ss += __shfl_xor(ss, 4); ss += __shfl_xor(ss, 8);
                const float rr = rsqrtf(ss * (1.0f / 256.0f) + EPS);
#pragma unroll
                for (int c = 0; c < 2; ++c)
#pragma unroll
                    for (int e = 0; e < 8; ++e) o[c][e] = a[c][e] * rr * gn[2 * c + (e >> 2)][e & 3] * silu_f(g[c][e]);
            } else {
#pragma unroll
                for (int c = 0; c < 2; ++c)
#pragma unroll
                    for (int e = 0; e < 8; ++e) o[c][e] = a[c][e] * gelu_tanh_f(g[c][e]);
            }
            bf16* up = U + (size_t)r * D + part * 1024 + e0;
            *(u32x4*)up = pack8(o[0]); *(u32x4*)(up + 8) = pack8(o[1]);
        }
    }
#undef C0_LOAD
}
__device__ __forceinline__ void comb1_rows(Frame& F, int row_lo, int row_hi) {
    const int tid_ = fresh_tid(); const int lane_ = tid_ & 63, wave_ = __builtin_amdgcn_readfirstlane(tid_ >> 6), gw_ = F.wg * NWAVES + wave_;
    const bf16* HFb = gY(F); const bf16* HBb = HFb + (size_t)M * D;
    const bf16* P = gBIG(F); bf16* U = gU(F); const float* gg = F.A.in[I_MLNG];
    const int e0 = 32 * lane_;
    f32x4 gn[8];
#pragma unroll
    for (int c = 0; c < 8; ++c) gn[c] = *(const f32x4*)(gg + (e0 & 255) + 4 * c);
    u32x4 nx[12];
#define C1_LOAD(r_) do { const size_t o_ = (size_t)(r_) * D + e0; const bf16* g_ = P + (size_t)(r_) * NP1 + 4096 + e0; \
        _Pragma("unroll") for (int c = 0; c < 4; ++c) { nx[c] = *(const u32x4*)(HFb + o_ + 8 * c); nx[4 + c] = *(const u32x4*)(HBb + o_ + 8 * c); nx[8 + c] = *(const u32x4*)(g_ + 8 * c); } } while (0)
    int r = row_lo + gw_;
    if (r < row_hi) C1_LOAD(r);
    for (; r < row_hi; r += F.NGW) {
        u32x4 cu[12];
#pragma unroll
        for (int i = 0; i < 12; ++i) cu[i] = nx[i];
        if (r + F.NGW < row_hi) C1_LOAD(r + F.NGW);
        float a[4][8]; float ss = 0.f;
#pragma unroll
        for (int c = 0; c < 4; ++c) { float y8[8]; unpack8(cu[c], a[c]); unpack8(cu[4 + c], y8);
#pragma unroll
            for (int e = 0; e < 8; ++e) { a[c][e] += y8[e]; ss += a[c][e] * a[c][e]; } }
        ss += __shfl_xor(ss, 1); ss += __shfl_xor(ss, 2); ss += __shfl_xor(ss, 4);
        const float rr = rsqrtf(ss * (1.0f / 256.0f) + EPS);
#pragma unroll
        for (int c = 0; c < 4; ++c) { float g8[8], o8[8]; unpack8(cu[8 + c], g8);
#pragma unroll
            for (int e = 0; e < 8; ++e) o8[e] = a[c][e] * rr * gn[2 * c + (e >> 2)][e & 3] * sigmoid_f(g8[e]);
            *(u32x4*)(U + (size_t)r * D + e0 + 8 * c) = pack8(o8); }
    }
#undef C1_LOAD
}

#define WG_BAR() do { asm volatile("s_waitcnt lgkmcnt(0)" ::: "memory"); __builtin_amdgcn_s_barrier(); asm volatile("" ::: "memory"); } while (0)
__device__ __forceinline__ int chunk_rlo(int b, int dir, int c) {
    return c < 4 ? b * CTXL + (dir ? (CTXL - 64 - 64 * c) : 64 * c) : MC + b * SEQ + (dir ? (SEQ - 64 - 64 * (c - 4)) : 64 * (c - 4));
}
__device__ __forceinline__ bf16x8 tr_frag(LAS unsigned char* tile, int pitch, int k0, int c0, int lane) {
    const int g = lane >> 4, q = (lane & 15) >> 2, p = lane & 3;
    LAS unsigned char* a0 = tile + (k0 + 8 * g + q) * pitch + (c0 + 4 * p) * 2;
    const bf16x4 lo = __builtin_amdgcn_ds_read_tr16_b64_v4i16((LAS bf16x4*)a0);
    const bf16x4 hi = __builtin_amdgcn_ds_read_tr16_b64_v4i16((LAS bf16x4*)(a0 + 4 * pitch));
    return __builtin_shufflevector(lo, hi, 0, 1, 2, 3, 4, 5, 6, 7);
}
__device__ __forceinline__ u32x4 scale8(const u32x4 v, float s) {
    u32x4 o; o.x = pk2(bflo(v.x) * s, bfhi(v.x) * s); o.y = pk2(bflo(v.y) * s, bfhi(v.y) * s); o.z = pk2(bflo(v.z) * s, bfhi(v.z) * s); o.w = pk2(bflo(v.w) * s, bfhi(v.w) * s); return o;
}
__device__ __forceinline__ u32x4 scale8v(const u32x4 v, const f32x4 s0, const f32x4 s1) {
    u32x4 o; o.x = pk2(bflo(v.x) * s0.x, bfhi(v.x) * s0.y); o.y = pk2(bflo(v.y) * s0.z, bfhi(v.y) * s0.w); o.z = pk2(bflo(v.z) * s1.x, bfhi(v.z) * s1.y); o.w = pk2(bflo(v.w) * s1.z, bfhi(v.w) * s1.w); return o;
}
template <int N> __device__ __forceinline__ float dpp_row_shr_ninf(float x) { return __int_as_float(__builtin_amdgcn_update_dpp((int)0xff800000u, __float_as_int(x), 0x110 + N, 0xF, 0xF, false)); }
__device__ __forceinline__ float wave_incl_sum(float x, int lane) {
    x += dpp_row_shr<1>(x); x += dpp_row_shr<2>(x); x += dpp_row_shr<4>(x); x += dpp_row_shr<8>(x);
    const int xi = __float_as_int(x);
    const float t0 = __int_as_float(__builtin_amdgcn_readlane(xi, 15)), t1 = __int_as_float(__builtin_amdgcn_readlane(xi, 31)), t2 = __int_as_float(__builtin_amdgcn_readlane(xi, 47));
    return x + (lane >= 16 ? t0 : 0.f) + (lane >= 32 ? t1 : 0.f) + (lane >= 48 ? t2 : 0.f);
}
__device__ __forceinline__ float wave_incl_max(float x, int lane) {
    x = fmaxf(x, dpp_row_shr_ninf<1>(x)); x = fmaxf(x, dpp_row_shr_ninf<2>(x)); x = fmaxf(x, dpp_row_shr_ninf<4>(x)); x = fmaxf(x, dpp_row_shr_ninf<8>(x));
    const int xi = __float_as_int(x);
    const float t0 = __int_as_float(__builtin_amdgcn_readlane(xi, 15)), t1 = __int_as_float(__builtin_amdgcn_readlane(xi, 31)), t2 = __int_as_float(__builtin_amdgcn_readlane(xi, 47));
    const float ninf = __int_as_float((int)0xff800000u);
    return fmaxf(fmaxf(x, lane >= 16 ? t0 : ninf), fmaxf(lane >= 32 ? t1 : ninf, lane >= 48 ? t2 : ninf));
}

constexpr size_t GLA_GK_OFF = (size_t)8 * NCH * 8192;
static_assert(NBG == 1 && 2 * GLA_GK_OFF * 2 <= U_G && (size_t)M * NP0 * 2 + (size_t)8 * NCH * 384 * 4 <= BIG_G, "GLA pre-pass buffers");
__device__ __forceinline__ float* gGE(const Frame& F) { return (float*)((unsigned char*)gBIG(F) + (size_t)M * NP0 * 2); }
__device__ __forceinline__ void gla_prep(Frame& F, const float* __restrict__ w2all, const float* __restrict__ baall) {
    LAS unsigned char* lds = F.lds;
    const int tid = fresh_tid(); const int lane = tid & 63, wave = __builtin_amdgcn_readfirstlane(tid >> 6);
    constexpr int PQ = 272; constexpr int O_QS = 0, O_KS = 17408, O_SM = 137472;
    LAS float* LR = (LAS float*)(lds + O_SM); LAS float* E1 = LR + 1024; LAS float* E2 = E1 + 128; LAS float* DEC = E2 + 128;
    const int fr = lane & 15, fq = lane >> 4;
    const int hd = F.wg & 7, dir = hd >> 2, h = hd & 3;
    const bf16* __restrict__ proj = gBIG(F); const float* __restrict__ gates = gGATES(F);
    bf16* GQ = gU(F) + (size_t)hd * NCH * 8192; bf16* GK = GQ + GLA_GK_OFF; float* GE = gGE(F) + (size_t)hd * NCH * 384;
    const float* w2 = w2all + (size_t)dir * 16 * 512 + h * 128; const float* ba = baall + dir * 512 + h * 128;
    const int qcol = h * 128, kcol = 512 + h * 128, gcol = dir * 16, NP = NP0;
    bf16x8 W2A = (bf16x8){0, 0, 0, 0, 0, 0, 0, 0};
    if (fq < 2) { float wv[8];
#pragma unroll
        for (int e = 0; e < 8; ++e) wv[e] = w2[(8 * fq + e) * 512 + 16 * wave + fr];
        const u32x4 pk = pack8(wv); W2A = __builtin_bit_cast(bf16x8, pk); }
    const f32x4 bias4 = *(const f32x4*)(ba + 16 * wave + 4 * fq);
    const int sj0 = tid >> 4, sj1 = (tid + 512) >> 4, sch = tid & 15;
    u32x4 pq[2], pk[2]; f32x4 plr = (f32x4){0.f, 0.f, 0.f, 0.f};
#define GP_PREFETCH(cc) do { const int rl_ = chunk_rlo(0, dir, (cc)); \
        { const int row_ = dir ? rl_ + 63 - sj0 : rl_ + sj0; const bf16* rp_ = proj + (size_t)row_ * NP + 8 * sch; pq[0] = *(const u32x4*)(rp_ + qcol); pk[0] = *(const u32x4*)(rp_ + kcol); } \
        { const int row_ = dir ? rl_ + 63 - sj1 : rl_ + sj1; const bf16* rp_ = proj + (size_t)row_ * NP + 8 * sch; pq[1] = *(const u32x4*)(rp_ + qcol); pk[1] = *(const u32x4*)(rp_ + kcol); } \
        if (tid < 256) { const int j_ = tid >> 2; const int row_ = dir ? rl_ + 63 - j_ : rl_ + j_; plr = *(const f32x4*)(gates + (size_t)row_ * 32 + gcol + 4 * (tid & 3)); } } while (0)
    const int cstep = F.G >> 3;
    int c = F.wg >> 3;
    __syncthreads();
    if (c < NCH) GP_PREFETCH(c);
    for (; c < NCH; c += cstep) {
        *(LAS u32x4*)(lds + O_QS + sj0 * PQ + 16 * sch) = pq[0]; *(LAS u32x4*)(lds + O_QS + sj1 * PQ + 16 * sch) = pq[1];
        *(LAS u32x4*)(lds + O_KS + sj0 * PQ + 16 * sch) = pk[0]; *(LAS u32x4*)(lds + O_KS + sj1 * PQ + 16 * sch) = pk[1];
        if (tid < 256) *(LAS f32x4*)(LR + (tid >> 2) * 16 + 4 * (tid & 3)) = plr;
        if (c + cstep < NCH) GP_PREFETCH(c + cstep);
        WG_BAR();
        {
            f32x4 zz[4];
#pragma unroll
            for (int tb = 0; tb < 4; ++tb) {
                bf16x8 Bf = (bf16x8){0, 0, 0, 0, 0, 0, 0, 0};
                if (fq < 2) { const f32x4 l0 = *(const LAS f32x4*)(LR + (16 * tb + fr) * 16 + 8 * fq), l1 = *(const LAS f32x4*)(LR + (16 * tb + fr) * 16 + 8 * fq + 4);
                    u32x4 pk; pk.x = pk2(l0.x, l0.y); pk.y = pk2(l0.z, l0.w); pk.z = pk2(l1.x, l1.y); pk.w = pk2(l1.z, l1.w); Bf = __builtin_bit_cast(bf16x8, pk); }
                zz[tb] = __builtin_amdgcn_mfma_f32_16x16x32_bf16(W2A, Bf, bias4, 0, 0, 0);
            }
            f32x4 bb[4]; f32x4 carry = (f32x4){0.f, 0.f, 0.f, 0.f};
#pragma unroll
            for (int tb = 0; tb < 4; ++tb) {
#pragma unroll
                for (int r = 0; r < 4; ++r) { float x = fmaxf(logsig_f(zz[tb][r]) * (1.0f / 16.0f), -1.0f);
                    x += dpp_row_shr<1>(x); x += dpp_row_shr<2>(x); x += dpp_row_shr<4>(x); x += dpp_row_shr<8>(x);
                    const float tot = __shfl(x, (lane & 48) | 15);
                    bb[tb][r] = x + carry[r]; carry[r] += tot; }
            }
            f32x4 bref, e1, e2;
#pragma unroll
            for (int r = 0; r < 4; ++r) { bref[r] = __shfl(bb[2][r], lane & 48); e1[r] = fexp(bref[r]); e2[r] = fexp(carry[r] - bref[r]); }
#pragma unroll
            for (int tb = 0; tb < 4; ++tb) {
                const int off = (16 * tb + fr) * PQ + (16 * wave + 4 * fq) * 2;
                const u32x2 qw = *(const LAS u32x2*)(lds + O_QS + off), kw = *(const LAS u32x2*)(lds + O_KS + off);
                const f32x4 qv = (f32x4){bflo(qw.x), bfhi(qw.x), bflo(qw.y), bfhi(qw.y)} * QSCALE, kv = (f32x4){bflo(kw.x), bfhi(kw.x), bflo(kw.y), bfhi(kw.y)};
                f32x4 ef, er;
#pragma unroll
                for (int r = 0; r < 4; ++r) { ef[r] = fexp(bb[tb][r] - bref[r]); er[r] = __builtin_amdgcn_rcpf(ef[r]); }
                const f32x4 qt = qv * ef, kt = kv * er;
                u32x2 w; w.x = pk2(qt[0], qt[1]); w.y = pk2(qt[2], qt[3]); *(LAS u32x2*)(lds + O_QS + off) = w;
                w.x = pk2(kt[0], kt[1]); w.y = pk2(kt[2], kt[3]); *(LAS u32x2*)(lds + O_KS + off) = w;
            }
            if (fr == 0) { f32x4 dv;
#pragma unroll
                for (int r = 0; r < 4; ++r) dv[r] = fexp(carry[r]);
                *(LAS f32x4*)(DEC + 16 * wave + 4 * fq) = dv; *(LAS f32x4*)(E1 + 16 * wave + 4 * fq) = e1; *(LAS f32x4*)(E2 + 16 * wave + 4 * fq) = e2; }
                }
        WG_BAR();
        {
            bf16* gq = GQ + (size_t)c * 8192; bf16* gk = GK + (size_t)c * 8192;
            *(u32x4*)(gq + sj0 * 128 + 8 * sch) = *(const LAS u32x4*)(lds + O_QS + sj0 * PQ + 16 * sch); *(u32x4*)(gq + sj1 * 128 + 8 * sch) = *(const LAS u32x4*)(lds + O_QS + sj1 * PQ + 16 * sch);
            *(u32x4*)(gk + sj0 * 128 + 8 * sch) = *(const LAS u32x4*)(lds + O_KS + sj0 * PQ + 16 * sch); *(u32x4*)(gk + sj1 * 128 + 8 * sch) = *(const LAS u32x4*)(lds + O_KS + sj1 * PQ + 16 * sch);
            if (tid < 96) *(f32x4*)(GE + (size_t)c * 384 + 4 * tid) = *(const LAS f32x4*)(E1 + 4 * tid);
        }
        WG_BAR();
    }
#undef GP_PREFETCH
    __syncthreads();
}

template <int MODE>
__device__ __forceinline__ void chain_scan(LAS unsigned char* lds,
        const bf16* __restrict__ proj, const int NP, const int qcol, const int kcol, const int vcol,
        const float* __restrict__ gates, const int gcol, const int b, const int dir,
        bf16* __restrict__ outb, const int out_ld, const int ocol, const bool ctx_out,
        const bf16* __restrict__ gq, const bf16* __restrict__ gk, const float* __restrict__ ge, const float bias_i, const float bias_f) {
    const int tid = fresh_tid(); const int lane = tid & 63, wave = __builtin_amdgcn_readfirstlane(tid >> 6);
    constexpr int NVB = MODE ? 9 : 8;
    constexpr int PQ = 272, PV = 304, PP = 144;
    constexpr int O_QS = 0, O_KS = 17408, O_QH = 34816, O_KH = 52224, O_VS = 69632, O_PS = 89088, O_SB = 98304, O_SM = 137472;
    LAS float* LR = (LAS float*)(lds + O_SM);
    LAS float* TOT = (LAS float*)(lds + O_SM + 4096);
    LAS float* FIRST = (LAS float*)(lds + O_SM + 8192);
    LAS float* DEC = (LAS float*)(lds + O_SM + 8704);
    LAS float* A_ = (LAS float*)(lds + O_SM);
    LAS float* MI = A_ + 64; LAS float* WI = A_ + 128; LAS float* WK = A_ + 192; LAS float* MR = A_ + 256; LAS float* DEN = A_ + 320; LAS float* DECS = A_ + 384;
    const int fr = lane & 15, fq = lane >> 4;

    __syncthreads();
    for (int i = tid; i < (9216 + 39168) / 16; i += 512) *(LAS u32x4*)(lds + O_PS + 16 * i) = (u32x4){0u, 0u, 0u, 0u};
    if (MODE) { if (tid < 64) { *(LAS u32x4*)(lds + O_VS + tid * PV + 256) = (u32x4){0x3F80u, 0u, 0u, 0u}; *(LAS u32x4*)(lds + O_VS + tid * PV + 272) = (u32x4){0u, 0u, 0u, 0u}; } }
    constexpr int NVW = MODE ? 5 : 4;
    const int dq = wave & 3, vh2 = wave >> 2;
    f32x4 S[2][NVW];
#pragma unroll
    for (int dl = 0; dl < 2; ++dl)
#pragma unroll
        for (int v = 0; v < NVW; ++v) S[dl][v] = (f32x4){0.f, 0.f, 0.f, 0.f};
    float mst = 0.f;
    const int sj0 = tid >> 4, sj1 = (tid + 512) >> 4, sch = tid & 15;
    u32x4 pq[2], pk[2], pv[2]; f32x4 pe1[2], pe2[2], pdec = (f32x4){0.f, 0.f, 0.f, 0.f}; float pgi = 0.f, pgf = 0.f;
#define CH_PREFETCH(cc) do { const int rl_ = chunk_rlo(b, dir, (cc)); \
        { const int row_ = dir ? rl_ + 63 - sj0 : rl_ + sj0; const bf16* rp_ = proj + (size_t)row_ * NP + 8 * sch; pv[0] = *(const u32x4*)(rp_ + vcol); if (MODE) { pq[0] = *(const u32x4*)(rp_ + qcol); pk[0] = *(const u32x4*)(rp_ + kcol); } } \
        { const int row_ = dir ? rl_ + 63 - sj1 : rl_ + sj1; const bf16* rp_ = proj + (size_t)row_ * NP + 8 * sch; pv[1] = *(const u32x4*)(rp_ + vcol); if (MODE) { pq[1] = *(const u32x4*)(rp_ + qcol); pk[1] = *(const u32x4*)(rp_ + kcol); } } \
        if (MODE == 0) { const bf16* q_ = gq + (size_t)(cc) * 8192 + 8 * sch; const bf16* k_ = gk + (size_t)(cc) * 8192 + 8 * sch; const float* e_ = ge + (size_t)(cc) * 384; \
            pq[0] = *(const u32x4*)(q_ + sj0 * 128); pq[1] = *(const u32x4*)(q_ + sj1 * 128); pk[0] = *(const u32x4*)(k_ + sj0 * 128); pk[1] = *(const u32x4*)(k_ + sj1 * 128); \
            pe1[0] = *(const f32x4*)(e_ + 8 * sch); pe1[1] = *(const f32x4*)(e_ + 8 * sch + 4); pe2[0] = *(const f32x4*)(e_ + 128 + 8 * sch); pe2[1] = *(const f32x4*)(e_ + 128 + 8 * sch + 4); \
            if (tid < 32) pdec = *(const f32x4*)(e_ + 256 + 4 * tid); } \
        else { const int row_ = dir ? rl_ + 63 - lane : rl_ + lane; pgi = gates[(size_t)row_ * 32 + gcol]; pgf = gates[(size_t)row_ * 32 + gcol + 8]; } } while (0)
#if defined(MK_CHAIN_PROBE)
    unsigned long long cp_acc = 0ull, cp_t = 0ull;
#define CP_MARK(seg) do { if (MODE == MK_CHAIN_PROBE_MODE) { const unsigned long long n_ = __builtin_amdgcn_s_memrealtime(); if ((seg) == MK_CHAIN_PROBE + 1 || (MK_CHAIN_PROBE == 9 && (seg) != 0)) cp_acc += n_ - cp_t; cp_t = n_; } } while (0)
#else
#define CP_MARK(seg) do {} while (0)
#endif
    CH_PREFETCH(0);
    for (int c = 0; c < NCH; ++c) {
        const int rl = chunk_rlo(b, dir, c);
        CP_MARK(0);
        *(LAS u32x4*)(lds + O_QS + sj0 * PQ + 16 * sch) = pq[0]; *(LAS u32x4*)(lds + O_QS + sj1 * PQ + 16 * sch) = pq[1];
        *(LAS u32x4*)(lds + O_KS + sj0 * PQ + 16 * sch) = pk[0]; *(LAS u32x4*)(lds + O_KS + sj1 * PQ + 16 * sch) = pk[1];
        *(LAS u32x4*)(lds + O_VS + sj0 * PV + 16 * sch) = pv[0]; *(LAS u32x4*)(lds + O_VS + sj1 * PV + 16 * sch) = pv[1];
        if (MODE == 0) {
            *(LAS u32x4*)(lds + O_QH + sj0 * PQ + 16 * sch) = scale8v(pq[0], pe1[0], pe1[1]); *(LAS u32x4*)(lds + O_QH + sj1 * PQ + 16 * sch) = scale8v(pq[1], pe1[0], pe1[1]);
            *(LAS u32x4*)(lds + O_KH + sj0 * PQ + 16 * sch) = scale8v(pk[0], pe2[0], pe2[1]); *(LAS u32x4*)(lds + O_KH + sj1 * PQ + 16 * sch) = scale8v(pk[1], pe2[0], pe2[1]);
            if (tid < 32) *(LAS f32x4*)(DEC + 4 * tid) = pdec; }
        if (MODE == 1) {
            const float ipre = pgi + bias_i, lf = logsig_f(pgf + bias_f);
            const float bsum = wave_incl_sum(lf, lane);
            const float a = ipre - bsum;
            const float cm = wave_incl_max(a, lane);
            const float Mi = fmaxf(mst, cm);
            const float blast = __int_as_float(__builtin_amdgcn_readlane(__float_as_int(bsum), 63)), M63 = __int_as_float(__builtin_amdgcn_readlane(__float_as_int(Mi), 63));
            const float wi = fexp(mst - Mi) * QSCALE, wk = fexp(a - M63);
            if (wave == 0) { A_[lane] = a; MI[lane] = Mi; ((c & 1) ? WI : MR)[lane] = fexp(-(bsum + Mi)); if (lane == 0) DECS[0] = fexp(mst - M63); }
            mst = blast + M63;
            const float wi0 = __shfl(wi, sj0), wi1 = __shfl(wi, sj1), wk0 = __shfl(wk, sj0), wk1 = __shfl(wk, sj1);
            *(LAS u32x4*)(lds + O_QH + sj0 * PQ + 16 * sch) = scale8(pq[0], wi0); *(LAS u32x4*)(lds + O_QH + sj1 * PQ + 16 * sch) = scale8(pq[1], wi1);
            *(LAS u32x4*)(lds + O_KH + sj0 * PQ + 16 * sch) = scale8(pk[0], wk0); *(LAS u32x4*)(lds + O_KH + sj1 * PQ + 16 * sch) = scale8(pk[1], wk1);
        }
        if (c + 1 < NCH) CH_PREFETCH(c + 1);
        WG_BAR();
        CP_MARK(1);
        for (int tix = wave; tix < 10; tix += 8) {
            const int ib = tix >= 6 ? 3 : (tix >= 3 ? 2 : (tix >= 1 ? 1 : 0)); const int jb = tix - ib * (ib + 1) / 2;
            f32x4 acc = (f32x4){0.f, 0.f, 0.f, 0.f};
            bf16x8 Ak[4], Bq[4];
#pragma unroll
            for (int ks = 0; ks < 4; ++ks) { Ak[ks] = *(const LAS bf16x8*)(lds + O_KS + (16 * jb + fr) * PQ + (32 * ks + 8 * fq) * 2); Bq[ks] = *(const LAS bf16x8*)(lds + O_QS + (16 * ib + fr) * PQ + (32 * ks + 8 * fq) * 2); }
#pragma unroll
            for (int ks = 0; ks < 4; ++ks) acc = __builtin_amdgcn_mfma_f32_16x16x32_bf16(Ak[ks], Bq[ks], acc, 0, 0, 0);
            const int i = 16 * ib + fr, j0 = 16 * jb + 4 * fq;
            float w[4];
            if (MODE) { const float Mi = MI[i];
#pragma unroll
                for (int r = 0; r < 4; ++r) w[r] = (j0 + r <= i) ? acc[r] * QSCALE * fexp(A_[j0 + r] - Mi) : 0.f;
            } else {
#pragma unroll
                for (int r = 0; r < 4; ++r) w[r] = (j0 + r <= i) ? acc[r] : 0.f;
            }
            u32x2 pw; pw.x = pk2(w[0], w[1]); pw.y = pk2(w[2], w[3]);
            *(LAS u32x2*)(lds + O_PS + i * PP + j0 * 2) = pw;
        }
        WG_BAR();
        CP_MARK(2);
        const int ibp = wave & 1, vq = wave >> 1;
        const bool has8 = MODE && vq == 0;
        f32x4 ao[2][3];
#pragma unroll
        for (int il = 0; il < 2; ++il)
#pragma unroll
            for (int vl = 0; vl < 3; ++vl) ao[il][vl] = (f32x4){0.f, 0.f, 0.f, 0.f};
#pragma unroll
        for (int ks = 0; ks < 2; ++ks) {
            bf16x8 Bp[2], Av[3];
#pragma unroll
            for (int il = 0; il < 2; ++il) Bp[il] = *(const LAS bf16x8*)(lds + O_PS + (16 * (2 * ibp + il) + fr) * PP + (32 * ks + 8 * fq) * 2);
#pragma unroll
            for (int vl = 0; vl < 2; ++vl) Av[vl] = tr_frag(lds + O_VS, PV, 32 * ks, 16 * (2 * vq + vl), lane);
            if (MODE) Av[2] = tr_frag(lds + O_VS, PV, 32 * ks, 128, lane);
#pragma unroll
            for (int il = 0; il < 2; ++il) {
#pragma unroll
                for (int vl = 0; vl < 2; ++vl) ao[il][vl] = __builtin_amdgcn_mfma_f32_16x16x32_bf16(Av[vl], Bp[il], ao[il][vl], 0, 0, 0);
                if (MODE) { if (has8) ao[il][2] = __builtin_amdgcn_mfma_f32_16x16x32_bf16(Av[2], Bp[il], ao[il][2], 0, 0, 0); } }
        }
#pragma unroll
        for (int ks = 0; ks < 4; ++ks) {
            bf16x8 Bq[2], As[3];
#pragma unroll
            for (int il = 0; il < 2; ++il) Bq[il] = *(const LAS bf16x8*)(lds + O_QH + (16 * (2 * ibp + il) + fr) * PQ + (32 * ks + 8 * fq) * 2);
#pragma unroll
            for (int vl = 0; vl < 2; ++vl) As[vl] = *(const LAS bf16x8*)(lds + O_SB + (16 * (2 * vq + vl) + fr) * PQ + (32 * ks + 8 * fq) * 2);
            if (MODE) As[2] = *(const LAS bf16x8*)(lds + O_SB + (128 + fr) * PQ + (32 * ks + 8 * fq) * 2);
#pragma unroll
            for (int il = 0; il < 2; ++il) {
#pragma unroll
                for (int vl = 0; vl < 2; ++vl) ao[il][vl] = __builtin_amdgcn_mfma_f32_16x16x32_bf16(As[vl], Bq[il], ao[il][vl], 0, 0, 0);
                if (MODE) { if (has8) ao[il][2] = __builtin_amdgcn_mfma_f32_16x16x32_bf16(As[2], Bq[il], ao[il][2], 0, 0, 0); } }
        }
        if (MODE == 0) {
#pragma unroll
            for (int dl = 0; dl < 2; ++dl) { const f32x4 dec = *(const LAS f32x4*)(DEC + 16 * (2 * dq + dl) + 4 * fq);
#pragma unroll
                for (int v = 0; v < NVW; ++v) S[dl][v] = S[dl][v] * dec; }
        } else { const float dsc = DECS[0];
#pragma unroll
            for (int dl = 0; dl < 2; ++dl)
#pragma unroll
                for (int v = 0; v < NVW; ++v) S[dl][v] = S[dl][v] * dsc;
        }
#pragma unroll
        for (int ks = 0; ks < 2; ++ks) {
            bf16x8 Ak[2], Bv[NVW];
#pragma unroll
            for (int dl = 0; dl < 2; ++dl) Ak[dl] = tr_frag(lds + O_KH, PQ, 32 * ks, 16 * (2 * dq + dl), lane);
#pragma unroll
            for (int v = 0; v < 4; ++v) Bv[v] = tr_frag(lds + O_VS, PV, 32 * ks, 16 * (4 * vh2 + v), lane);
            if (MODE) Bv[NVW - 1] = tr_frag(lds + O_VS, PV, 32 * ks, 128, lane);
#pragma unroll
            for (int dl = 0; dl < 2; ++dl) {
#pragma unroll
                for (int v = 0; v < 4; ++v) S[dl][v] = __builtin_amdgcn_mfma_f32_16x16x32_bf16(Ak[dl], Bv[v], S[dl][v], 0, 0, 0);
                if (MODE) { if (vh2 == 1) S[dl][NVW - 1] = __builtin_amdgcn_mfma_f32_16x16x32_bf16(Ak[dl], Bv[NVW - 1], S[dl][NVW - 1], 0, 0, 0); } }
        }
        if (MODE) { if (has8 && lane < 16) { DEN[16 * (2 * ibp) + lane] = ao[0][2][0]; DEN[16 * (2 * ibp + 1) + lane] = ao[1][2][0]; } }
        WG_BAR();
        CP_MARK(3);
        if (ctx_out || c >= 4) {
#pragma unroll
            for (int il = 0; il < 2; ++il) {
                const int irow = 16 * (2 * ibp + il) + fr; const int row = dir ? rl + 63 - irow : rl + irow;
                float sc = 1.0f;
                if (MODE) sc = 1.0f / fmaxf(fabsf(DEN[irow]), ((c & 1) ? WI : MR)[irow]);
                bf16* op = outb + (size_t)row * out_ld + ocol + 16 * (2 * vq) + 4 * fq;
#pragma unroll
                for (int vl = 0; vl < 2; ++vl) { u32x2 w; w.x = pk2(ao[il][vl][0] * sc, ao[il][vl][1] * sc); w.y = pk2(ao[il][vl][2] * sc, ao[il][vl][3] * sc); *(u32x2*)(op + 16 * vl) = w; }
            }
        }
#pragma unroll
        for (int dl = 0; dl < 2; ++dl) {
#pragma unroll
            for (int v = 0; v < 4; ++v) { u32x2 w; w.x = pk2(S[dl][v][0], S[dl][v][1]); w.y = pk2(S[dl][v][2], S[dl][v][3]); *(LAS u32x2*)(lds + O_SB + (16 * (4 * vh2 + v) + fr) * PQ + (16 * (2 * dq + dl) + 4 * fq) * 2) = w; }
            if (MODE) { if (vh2 == 1) { u32x2 w; w.x = pk2(S[dl][NVW - 1][0], S[dl][NVW - 1][1]); w.y = pk2(S[dl][NVW - 1][2], S[dl][NVW - 1][3]); *(LAS u32x2*)(lds + O_SB + (128 + fr) * PQ + (16 * (2 * dq + dl) + 4 * fq) * 2) = w; } }
        }
        CP_MARK(4);
    }
#undef CH_PREFETCH
#if defined(MK_CHAIN_PROBE)
    if (MODE == MK_CHAIN_PROBE_MODE && tid == 0) *(LAS unsigned long long*)(lds + LDSCTL_OFF + 128) += cp_acc;
#endif
#undef CP_MARK
    __syncthreads();
}

__device__ __forceinline__ void rg_chain(LAS unsigned char* lds,
        const bf16* __restrict__ proj, const int b, const int n, const int dir, const bf16* __restrict__ wrg,
        const float* __restrict__ lam, const float* __restrict__ b_a, const float* __restrict__ b_i, const float* __restrict__ conv_w, const float* __restrict__ conv_b,
        bf16* __restrict__ hout) {
    const int tid = fresh_tid(); const int lane = tid & 63, wave = __builtin_amdgcn_readfirstlane(tid >> 6);
    constexpr int O_XR = 0, O_XBF = 17408, O_XBH = 51200, O_AA = 68608, O_BX = 102400, O_CW = 136192;
    constexpr int PXF = 528, PXH = 272;
    const int fr = lane & 15, fq = lane >> 4;
    LAS float* CW = (LAS float*)(lds + O_CW);
    LAS float* SEG = (LAS float*)(lds + 139264);
    LAS float* HST = (LAS float*)(lds + 143360);
    __syncthreads();
    for (int i = tid; i < 5 * 128; i += 512) CW[i] = i < 512 ? conv_w[(i >> 7) * 1024 + 128 * n + (i & 127)] : conv_b[128 * n + (i - 512)];
    if (tid < 128) HST[tid] = 0.f;
    bf16x8 Afr[2][4];
#pragma unroll
    for (int mat = 0; mat < 2; ++mat)
#pragma unroll
        for (int ks = 0; ks < 4; ++ks) Afr[mat][ks] = *(const bf16x8*)(wrg + ((size_t)((dir * 2 + mat) * 8 + n) * 128 + 16 * wave + fr) * 128 + 32 * ks + 8 * fq);
    f32x4 c8, bav, biv;
#pragma unroll
    for (int r = 0; r < 4; ++r) { const int ch = 128 * n + 16 * wave + 4 * fq + r; const float l = lam[dir * 1024 + ch];
        c8[r] = -8.0f * (fmaxf(-l, 0.f) + log1pf(expf(-fabsf(l)))); bav[r] = b_a[dir * 1024 + ch]; biv[r] = b_i[dir * 1024 + ch]; }
    const int ch2 = tid & 63, tg = tid >> 6;
    u32x4 px[3];
#define RG_PREFETCH(cc) do { const int c_ = (cc); const int L_ = c_ < 4 ? CTXL : SEQ, cs_ = c_ < 4 ? c_ : c_ - 4, base_ = c_ < 4 ? b * CTXL : MC + b * SEQ; \
        const int t0_ = dir ? L_ - 64 * (cs_ + 1) : 64 * cs_; \
        _Pragma("unroll") for (int e_ = 0; e_ < 3; ++e_) { const int id_ = tid + 512 * e_, rr_ = id_ >> 4, tt_ = t0_ - 2 + rr_; \
            px[e_] = (rr_ < 67 && tt_ >= 0 && tt_ < L_) ? *(const u32x4*)(proj + (size_t)(base_ + tt_) * NP0 + 3072 + 128 * n + 8 * (id_ & 15)) : (u32x4){0u, 0u, 0u, 0u}; } } while (0)
#if defined(MK_CHAIN_PROBE)
    const unsigned long long rg_t0 = __builtin_amdgcn_s_memrealtime();
#endif
    RG_PREFETCH(0);
    for (int c = 0; c < NCH; ++c) {
        const int L = c < 4 ? CTXL : SEQ, cs = c < 4 ? c : c - 4, base = c < 4 ? b * CTXL : MC + b * SEQ;
        const int t0 = dir ? L - 64 * (cs + 1) : 64 * cs;
#pragma unroll
        for (int e = 0; e < 3; ++e) { const int id = tid + 512 * e, rr = id >> 4; if (rr < 68) *(LAS u32x4*)(lds + O_XR + rr * 256 + 16 * (id & 15)) = px[e]; }
        if (c + 1 < NCH) RG_PREFETCH(c + 1);
        WG_BAR();
        {
            const f32x2 w0 = *(const LAS f32x2*)(CW + 0 * 128 + 2 * ch2), w1 = *(const LAS f32x2*)(CW + 1 * 128 + 2 * ch2), w2_ = *(const LAS f32x2*)(CW + 2 * 128 + 2 * ch2), w3 = *(const LAS f32x2*)(CW + 3 * 128 + 2 * ch2), cb = *(const LAS f32x2*)(CW + 512 + 2 * ch2);
            f32x2 xw[11];
#pragma unroll
            for (int rr = 0; rr < 11; ++rr) { const unsigned u = *(const LAS unsigned*)(lds + O_XR + (8 * tg + rr) * 256 + 4 * ch2); xw[rr].x = bflo(u); xw[rr].y = bfhi(u); }
#pragma unroll
            for (int jj = 0; jj < 8; ++jj) {
                f32x2 y = cb; y += xw[jj] * w0; y += xw[jj + 1] * w1; y += xw[jj + 2] * w2_; y += xw[jj + 3] * w3;
                *(LAS f32x2*)(lds + O_XBF + (8 * tg + jj) * PXF + 8 * ch2) = y;
                *(LAS unsigned*)(lds + O_XBH + (8 * tg + jj) * PXH + 4 * ch2) = pk2(y.x, y.y);
            }
        }
        WG_BAR();
#pragma unroll
        for (int tb = 0; tb < 4; ++tb) {
            f32x4 ga = (f32x4){0.f, 0.f, 0.f, 0.f}, gi = (f32x4){0.f, 0.f, 0.f, 0.f};
            bf16x8 Bx[4];
#pragma unroll
            for (int ks = 0; ks < 4; ++ks) Bx[ks] = *(const LAS bf16x8*)(lds + O_XBH + (16 * tb + fr) * PXH + (32 * ks + 8 * fq) * 2);
#pragma unroll
            for (int ks = 0; ks < 4; ++ks) { ga = __builtin_amdgcn_mfma_f32_16x16x32_bf16(Afr[0][ks], Bx[ks], ga, 0, 0, 0); gi = __builtin_amdgcn_mfma_f32_16x16x32_bf16(Afr[1][ks], Bx[ks], gi, 0, 0, 0); }
            const int t = 16 * tb + fr;
            const f32x4 xb = *(const LAS f32x4*)(lds + O_XBF + t * PXF + (16 * wave + 4 * fq) * 4);
            f32x4 av, bx;
#pragma unroll
            for (int r = 0; r < 4; ++r) { const float rg = sigmoid_f(ga[r] + bav[r]), ig = sigmoid_f(gi[r] + biv[r]); const float la = c8[r] * rg;
                const float a_ = fexp(la); av[r] = a_; bx[r] = __builtin_amdgcn_sqrtf(fmaxf(1.0f - a_ * a_, 0.f)) * (ig * xb[r]); }
            *(LAS f32x4*)(lds + O_AA + t * PXF + (16 * wave + 4 * fq) * 4) = av;
            *(LAS f32x4*)(lds + O_BX + t * PXF + (16 * wave + 4 * fq) * 4) = bx;
        }
        WG_BAR();
        {
            const int ch = tid & 127, seg = tid >> 7;
            float av[16], bv[16];
#pragma unroll
            for (int e = 0; e < 16; ++e) { const int s_ = 16 * seg + e, jj = dir ? 63 - s_ : s_; av[e] = *(const LAS float*)(lds + O_AA + jj * PXF + 4 * ch); bv[e] = *(const LAS float*)(lds + O_BX + jj * PXF + 4 * ch); }
            float h = HST[ch];
            float A = 1.0f, B = 0.0f;
#pragma unroll
            for (int e = 0; e < 16; ++e) { B = av[e] * B + bv[e]; A *= av[e]; }
            *(LAS f32x2*)(SEG + (seg * 128 + ch) * 2) = (f32x2){A, B};
            WG_BAR();
            for (int s2 = 0; s2 < seg; ++s2) { const f32x2 ab = *(const LAS f32x2*)(SEG + (s2 * 128 + ch) * 2); h = ab.x * h + ab.y; }
            bf16* hp = hout + (size_t)(base + t0) * 1024 + 128 * n + ch;
#pragma unroll
            for (int e = 0; e < 16; ++e) { const int s_ = 16 * seg + e, jj = dir ? 63 - s_ : s_; h = av[e] * h + bv[e]; hp[(size_t)jj * 1024] = (bf16)f2bf(h); }
            if (seg == 3) HST[ch] = h;
        }
    }
#undef RG_PREFETCH
#if defined(MK_CHAIN_PROBE)
    if (MK_CHAIN_PROBE_MODE == 2 && tid == 0) *(LAS unsigned long long*)(lds + LDSCTL_OFF + 128) += __builtin_amdgcn_s_memrealtime() - rg_t0;
#endif
    __syncthreads();
}

#ifndef MK_LAST_PHASE
#define MK_LAST_PHASE 24
#endif
constexpr int NPH = 24;
__global__ void __launch_bounds__(NWAVES * 64, 2) mk_fwd(Args args) {
    extern __shared__ __attribute__((aligned(16))) unsigned char lds_raw[];
    const int GA = (int)gridDim.x, bx = (int)blockIdx.x;
    const int grp = (bx & 7) / XPG, gi = (bx >> 3) * XPG + (bx & 7) % XPG, GG = GA / NGRP;
    Frame FA{(LAS unsigned char*)lds_raw, GA, bx, GA * NWAVES, 0, args.out, args.ws, args};
    Frame F{(LAS unsigned char*)lds_raw, GG, gi, GG * NWAVES, grp, args.out, args.ws, args};
    volatile LAS unsigned* MISC = (volatile LAS unsigned*)(F.lds + LDSCTL_OFF);
    for (int u = threadIdx.x; u < (LDS_BYTES - LDSCTL_OFF) / 4; u += NWAVES * 64) ((LAS unsigned*)(F.lds + LDSCTL_OFF))[u] = 0u;
    __syncthreads();
    const int lo = args.ph_lo, hi = args.ph_hi;
    unsigned* ctl = (unsigned*)(F.ws + WS_CTL);
    XcdBarrier barA = xcd_barrier_post(ctl + CW_BAR, MISC + 8, (unsigned)GA);
    XcdBarrier barG = xcd_barrier_post(ctl + CW_BAR + (1 + grp) * XCD_BAR_WORDS, MISC + 12, (unsigned)GG);
#ifndef MK_REP_GEMM
#define MK_REP_GEMM 1
#endif
#ifndef MK_REP_SCAN
#define MK_REP_SCAN 1
#endif
#ifndef MK_REP_COMB
#define MK_REP_COMB 1
#endif
#ifndef MK_REP_CVT
#define MK_REP_CVT 1
#endif
#ifndef MK_G1_DELAY_US
#define MK_G1_DELAY_US 0
#endif
#ifndef MK_STAG_C
#define MK_STAG_C 30
#endif
#ifndef MK_OFFMASK
#define MK_OFFMASK 0x7FF
#endif
#ifndef MK_PREMASK
#define MK_PREMASK 3
#endif
#define IN(k) (lo <= (k) && (k) < hi)
#define INL(o) (((MK_OFFMASK >> (o)) & 1) && IN(pb + (o)))
#ifdef MK_PROBE_MASK
    unsigned long long prb_acc = 0ull, prb_t0 = 0ull;
#ifdef MK_PROBE_CYCLES
#define PRB_NOW() ((unsigned long long)clock64())
#else
#define PRB_NOW() ((unsigned long long)__builtin_amdgcn_s_memrealtime())
#endif
#define PRB_BEGIN(bit) do { if ((MK_PROBE_MASK >> (bit)) & 1) prb_t0 = PRB_NOW(); } while (0)
#define PRB_END(bit) do { if ((MK_PROBE_MASK >> (bit)) & 1) prb_acc += PRB_NOW() - prb_t0; } while (0)
#else
#define PRB_BEGIN(bit) do {} while (0)
#define PRB_END(bit) do {} while (0)
#endif
#if defined(MK_PROBE_MASK) && ((MK_PROBE_MASK >> 13) & 1)
#define SEAM(k) do { if (IN(k) && IN((k) + 1)) { const unsigned long long ts_ = PRB_NOW(); xcd_barrier(barG); prb_acc += PRB_NOW() - ts_; } } while (0)
#else
#define SEAM(k) do { if (IN(k) && IN((k) + 1)) xcd_barrier(barG); } while (0)
#endif
    float* MOD = (float*)(F.ws + WS_MOD); const float* CS = (const float*)(F.ws + WS_CS);
    bf16* U = gU(F); bf16* Yb = gY(F); bf16* BIG = gBIG(F); float* GATES = gGATES(F); float* YC = gYC(F);

    PRB_BEGIN(11);
    if ((MK_PREMASK & 1) && IN(0)) { pre_mod(FA); pre_pe(FA); for (int rep_ = 0; rep_ < MK_REP_CVT; ++rep_) cvt_layer<0>(FA); }
    if (IN(0) && IN(1)) xcd_barrier(barA);
    PRB_END(11); PRB_BEGIN(12);
    if ((MK_PREMASK & 2) && IN(1)) {
        {
            for (int rep_ = 0; rep_ < MK_REP_CVT; ++rep_) cvt_layer<1>(F, grp * 1024 / NGRP, (grp + 1) * 1024 / NGRP);
        }
#if MK_G1_DELAY_US > 0
        if (grp > 0) { const unsigned long long t0 = __builtin_amdgcn_s_memrealtime(); while (__builtin_amdgcn_s_memrealtime() - t0 < (unsigned long long)MK_G1_DELAY_US * grp * 100ull) __builtin_amdgcn_s_sleep(16); }
#endif
        nrm_rows<true, false, true, false, 1>(F, 0, M, 0.f, nullptr, nullptr, 0, F.A.in[I_NORMG], MOD, 0, 1);
    }
    SEAM(1);
    if (IN(1) && IN(2) && gi == 0 && threadIdx.x == 0) __hip_atomic_store(ctl + CW_W1READY + 64 * grp, 1u, __ATOMIC_RELAXED, __HIP_MEMORY_SCOPE_AGENT);
    PRB_END(12);
    for (int layer = 0; layer < 2; ++layer) {
        const int pb = 2 + 11 * layer; const bool last = layer == 1;
        const float* ng = F.A.in[I_NORMG] + (size_t)layer * 6 * D; const float* modl = MOD + (size_t)layer * 9 * 18432;
        const int NP = layer == 0 ? NP0 : NP1;
        const int rlo2 = last ? MC : 0;
        const unsigned char* W = F.ws + WS_W + (size_t)layer * W_LAYER;
        if (layer == 1 && IN(pb)) {
            if (threadIdx.x == 0) { unsigned sp = 0;
                for (int g = 0; g < NGRP; ++g) while (__hip_atomic_load(ctl + CW_W1READY + 64 * g, __ATOMIC_RELAXED, __HIP_MEMORY_SCOPE_AGENT) == 0u) { __builtin_amdgcn_s_sleep(4); if (++sp > (1u << 22)) { atomicAdd(ctl + CW_BAR + XB_TMO, 1u); break; } }
                __builtin_amdgcn_fence(__ATOMIC_ACQUIRE, "agent"); asm volatile("s_waitcnt vmcnt(0)" ::: "memory"); }
            __syncthreads();
        }
        PRB_BEGIN(0);
        if (INL(0)) {
            pg8::Gemm g{U, (const bf16*)(W + W_F1I), M, 2 * DFF, D / 2}; pg8::StaticOrder S; S.init(M, 2 * DFF, F.G, F.wg, D / 2, 0, XPG); pg8::EpiSwigluI8 E{BIG, DFF, gRS(F), CS + (size_t)layer * 2 * (2 * DFF)};
            for (int rep_ = 0; rep_ < MK_REP_GEMM; ++rep_) pg8::gemm_phase<pg8::EpiSwigluI8, pg8::StaticOrder, PG8_ALIGN_SWI, PG8_SP2, true>(F.lds, g, S, E); }
        SEAM(pb + 0); PRB_END(0);
        PRB_BEGIN(1);
        if (INL(1)) {
            requant_rows(F, 0, M); xcd_barrier(barG);
            pg8::Gemm g{BIG, (const bf16*)(W + W_F1O), M, D, DFF}; pg8::MixedOrder S; S.init(MLAT, D, F.G, F.wg, DFF / 2, MC / 256, MC, 2, XPG);
            pg8::EpiYI8 E{Yb, D, YC, (size_t)MC * D, DFF / 2 / 64, gRS(F), (const float*)(F.ws + WS_CS3) + (layer * 2 + 0) * 2048};
            for (int rep_ = 0; rep_ < MK_REP_GEMM; ++rep_) pg8::gemm_phase<pg8::EpiYI8, pg8::MixedOrder, PG8_ALIGN, PG8_SP2, true>(F.lds, g, S, E);
        }
        SEAM(pb + 1); PRB_END(1);
        PRB_BEGIN(2);
        if (INL(2)) nrm_rows<false, true, true, false, 2>(F, 0, M, 0.5f, ng + 1 * D, modl, 2, ng + 2 * D, modl, 3, 4, 2);
        SEAM(pb + 2); PRB_END(2);
        PRB_BEGIN(3);
        if (INL(3)) {
            const int r0 = layer == 0 ? 1024 : 2048;
            { pg8::Gemm g{(const bf16*)gU8B(F), (const bf16*)(W + W_MI8), M, 4096, D / 2}; pg8::StaticOrder S; S.init(M, 4096, F.G, F.wg, D / 2, 0, XPG);
              pg8::EpiProjI8 E{BIG + r0, NP, gRS(F), (const float*)(F.ws + WS_CS2) + layer * 4096};
              for (int rep_ = 0; rep_ < MK_REP_GEMM; ++rep_) pg8::gemm_phase<pg8::EpiProjI8, pg8::StaticOrder, PG8_ALIGN, PG8_SP2, true>(F.lds, g, S, E); }
            { const int nl = layer == 0 ? 5 : 9;
              pg8::Gemm g{U, (const bf16*)(W + W_MI), M, nl * 256, D}; pg8::MixedOrder S;
              S.init(MLAT, nl * 256, F.G, F.wg, D, MC / 256, MC, 1, XPG, 5, 4, last ? 4 : 0, NP / 256 - 1); S.cmA = nl - 1; S.cmB = NP / 256 - 1;
              pg8::EpiProj E{BIG, NP, GATES, NP / 256 - 1};
              for (int rep_ = 0; rep_ < MK_REP_GEMM; ++rep_) pg8::gemm_phase<pg8::EpiProj, pg8::MixedOrder, PG8_ALIGN, PG8_SP2>(F.lds, g, S, E); }
        }
        SEAM(pb + 3); PRB_END(3);
        PRB_BEGIN(4);
        if (INL(4)) {
            if (layer == 0) {
                bf16* OFb = Yb; bf16* OBb = OFb + (size_t)M * 1024; bf16* HFb = OBb + (size_t)M * 1024; bf16* HBb = HFb + (size_t)M * 1024;
                gla_prep(F, F.A.in[I_WALPHA2], F.A.in[I_BALPHA]); xcd_barrier(barG);
                for (int item = F.wg; item < 32 * NBG * MK_REP_SCAN; item += F.G) { const int it = item % (32 * NBG);
                    if (it < 16 * NBG) { const int ci = it >> 1, vh = it & 1, b = ci >> 3, h = (ci >> 1) & 3, dir = ci & 1;
                        chain_scan<0>(F.lds, BIG, NP0, h * 128, 512 + h * 128, 1024 + h * 256 + vh * 128, GATES, dir * 16, b, dir,
                                      dir ? OBb : OFb, 1024, h * 256 + vh * 128, true, gU(F) + (size_t)(dir * 4 + h) * NCH * 8192, gU(F) + GLA_GK_OFF + (size_t)(dir * 4 + h) * NCH * 8192, gGE(F) + (size_t)(dir * 4 + h) * NCH * 384, 0.f, 0.f);
                    } else { const int ri = it - 16 * NBG, b = ri >> 4, n = (ri >> 1) & 7, dir = ri & 1;
                        rg_chain(F.lds, BIG, b, n, dir, (const bf16*)(F.ws + WS_WRG), F.A.in[I_LAM], F.A.in[I_RGBA], F.A.in[I_RGBI], F.A.in[I_CONVW], F.A.in[I_CONVB], dir ? HBb : HFb);
                    }
                }
            } else {
                bf16* HFb = Yb; bf16* HBb = HFb + (size_t)M * D;
                for (int item = F.wg; item < 32 * NBG * MK_REP_SCAN; item += F.G) { const int it = item % (32 * NBG); const int ci = it >> 1, vh = it & 1, b = ci >> 4, h = (ci >> 1) & 7, dir = ci & 1;
                    chain_scan<1>(F.lds, BIG, NP1, h * 128, 1024 + h * 128, 2048 + h * 256 + vh * 128, GATES, dir * 16 + h, b, dir,
                                  dir ? HBb : HFb, D, h * 256 + vh * 128, false, nullptr, nullptr, nullptr, F.A.in[I_MLBG][dir * 16 + h], F.A.in[I_MLBG][dir * 16 + 8 + h]);
                }
            }
        }
        SEAM(pb + 4); PRB_END(4);
        PRB_BEGIN(5);
        if (INL(5)) { for (int rep_ = 0; rep_ < MK_REP_COMB; ++rep_) { if (layer == 0) comb0_rows(F, 0, M); else comb1_rows(F, MC, M); } }
        SEAM(pb + 5); PRB_END(5);
        PRB_BEGIN(6);
        if (INL(6)) {
            pg8::Gemm g{U, (const bf16*)(W + W_MO), M, D, D}; pg8::MixedOrder S; S.init(MLAT, D, F.G, F.wg, D, MC / 256, last ? 0 : MC, KSPLIT, XPG);
            pg8::EpiY E{Yb, D, YC, (size_t)MC * D, D / 64};
            for (int rep_ = 0; rep_ < MK_REP_GEMM; ++rep_) pg8::gemm_phase<pg8::EpiY, pg8::MixedOrder, PG8_ALIGN, PG8_SP2>(F.lds, g, S, E);
        }
        SEAM(pb + 6); PRB_END(6);
        PRB_BEGIN(7);
        if (INL(7)) nrm_rows<false, true, true, false, 1>(F, rlo2, M, 1.0f, ng + 3 * D, modl, 5, ng + 4 * D, modl, 6, 7);
        SEAM(pb + 7); PRB_END(7);
        PRB_BEGIN(8);
        if (INL(8)) { pg8::Gemm g{U + (size_t)rlo2 * (D / 2), (const bf16*)(W + W_F2I), M - rlo2, 2 * DFF, D / 2}; pg8::StaticOrder S; S.init(M - rlo2, 2 * DFF, F.G, F.wg, D / 2, 0, XPG);
            pg8::EpiSwigluI8 E{BIG + (size_t)rlo2 * DFF, DFF, gRS(F) + rlo2, CS + (size_t)(layer * 2 + 1) * (2 * DFF)};
            for (int rep_ = 0; rep_ < MK_REP_GEMM; ++rep_) pg8::gemm_phase<pg8::EpiSwigluI8, pg8::StaticOrder, PG8_ALIGN_SWI, PG8_SP2, true>(F.lds, g, S, E); }
        SEAM(pb + 8); PRB_END(8);
        PRB_BEGIN(9);
        if (INL(9)) {
            requant_rows(F, rlo2, M); xcd_barrier(barG);
            pg8::Gemm g{BIG, (const bf16*)(W + W_F2O), M, D, DFF}; pg8::MixedOrder S; S.init(MLAT, D, F.G, F.wg, DFF / 2, MC / 256, last ? 0 : MC, 2, XPG);
            pg8::EpiYI8 E{Yb, D, YC, (size_t)MC * D, DFF / 2 / 64, gRS(F), (const float*)(F.ws + WS_CS3) + (layer * 2 + 1) * 2048};
            for (int rep_ = 0; rep_ < MK_REP_GEMM; ++rep_) pg8::gemm_phase<pg8::EpiYI8, pg8::MixedOrder, PG8_ALIGN, PG8_SP2, true>(F.lds, g, S, E);
        }
        SEAM(pb + 9); PRB_END(9);
        PRB_BEGIN(10);
        if (INL(10)) {
            if (!last) nrm_rows<false, true, true, false, 1>(F, 0, M, 0.5f, ng + 5 * D, modl, 8, F.A.in[I_NORMG] + 6 * D, MOD + (size_t)9 * 18432, 0, 1, 2);
            else nrm_rows<false, true, false, true>(F, MC, M, 0.5f, ng + 5 * D, modl, 8, nullptr, nullptr, 0, 0, 2);
        }
        SEAM(pb + 10); PRB_END(10);
    }
#ifdef MK_PROBE_MASK
#ifndef MK_PROBE_BX
#define MK_PROBE_BX 0
#endif
    if (bx == MK_PROBE_BX) {
#if defined(MK_CHAIN_PROBE)
        const unsigned long long want = *(LAS unsigned long long*)(F.lds + LDSCTL_OFF + 128) * MK_PROBE_K;
#elif defined(MK_PROBE_CYCLES)
        const unsigned long long want = prb_acc >> 6;
#else
        const unsigned long long want = prb_acc * MK_PROBE_K;
#endif
        const unsigned long long t0 = __builtin_amdgcn_s_memrealtime(); while (__builtin_amdgcn_s_memrealtime() - t0 < want) __builtin_amdgcn_s_sleep(8); }
#endif
#undef IN
#undef SEAM
}

extern "C" void kernel_launch(void* const* d_in, const int* in_sizes, int n_in, void* d_out, int out_size, void* d_ws, size_t ws_size, hipStream_t stream) {
    static int grid = 0;
    if (grid == 0) {
        if (n_in != 27 || out_size != NB * SEQ * D || ws_size < WS_END) { fprintf(stderr, "kernel_launch: unexpected problem (n_in %d, out %d, ws %zu; need ws >= %zu); nothing launched\n", n_in, out_size, ws_size, (size_t)WS_END); grid = -1; return; }
        int dev = 0, cus = 0, per_cu = 0;
        if (hipGetDevice(&dev) != hipSuccess || hipDeviceGetAttribute(&cus, hipDeviceAttributeMultiprocessorCount, dev) != hipSuccess) { fprintf(stderr, "kernel_launch: device query failed\n"); grid = -1; return; }
        if (hipFuncSetAttribute((const void*)mk_fwd, hipFuncAttributeMaxDynamicSharedMemorySize, LDS_BYTES) != hipSuccess) { fprintf(stderr, "kernel_launch: hipFuncSetAttribute failed\n"); grid = -1; return; }
        if (hipOccupancyMaxActiveBlocksPerMultiprocessor(&per_cu, (const void*)mk_fwd, NWAVES * 64, LDS_BYTES) != hipSuccess || per_cu < 1)
            fprintf(stderr, "kernel_launch: note: occupancy query reports %d workgroups per CU\n", per_cu);
        (void)hipGetLastError();
        grid = cus;
        if (grid % 8 != 0) { fprintf(stderr, "kernel_launch: %d CUs; this kernel splits the grid into two groups of whole XCD octets and needs a multiple of 16; nothing launched\n", cus); grid = -1; return; }
    }
    if (grid < 0) return;
    if (hipMemsetAsync((char*)d_ws + WS_CTL, 0, CTL_ZERO_BYTES, stream) != hipSuccess) { fprintf(stderr, "kernel_launch: memset failed\n"); return; }
    Args a{};
    for (int i = 0; i < 27; ++i) a.in[i] = (const float*)d_in[i];
    a.out = (float*)d_out; a.ws = (unsigned char*)d_ws;
    a.ph_lo = 0; a.ph_hi = MK_LAST_PHASE;
    hipLaunchKernelGGL(mk_fwd, dim3(grid), dim3(NWAVES * 64), LDS_BYTES, stream, a);
    const hipError_t le = hipPeekAtLastError();
    if (le != hipSuccess) fprintf(stderr, "kernel_launch: launch failed: %s\n", hipGetErrorName(le));
}
```
